# Optimizing an MI355X kernel written in HIP

```python
import math
import jax, jax.numpy as jnp
from jax import lax
import numpy as np

D_MODEL = 2048
BATCH = 2
SEQ = 16384
DEPTH = 2
DEC_BATCH = 2
DEC_SEQ = 8192
PAST_LEN = 128

GRID_W = 64
HEAD_DIM = 64
Q_BLOCK = 128
EPS = 1e-6
NEG_INF = -1e30
SCALE = HEAD_DIM ** -0.5
GROUP_WIDTH = D_MODEL // 4
MIX_WIDTH = 4 * GROUP_WIDTH
A_HEADS = GROUP_WIDTH // HEAD_DIM
A_KV_HEADS = A_HEADS // 4
ROPE_THETA = 10000.0
B_QK_DIM = HEAD_DIM
B_V_DIM = 2 * B_QK_DIM
B_HEADS = GROUP_WIDTH // B_V_DIM
C_HEADS = GROUP_WIDTH // HEAD_DIM
C_WIN_ROWS = 8
C_WIN_COLS = 16
D_HEADS = GROUP_WIDTH // HEAD_DIM
D_BRANCHES = ((128, 1), (512, 4), (2048, 16))
T5_BUCKETS = 32
T5_MAX_DIST = 1024
T5_HEADS = B_HEADS + D_HEADS
D_FF = 5632

IN_SPLITS = (A_HEADS * HEAD_DIM, A_KV_HEADS * HEAD_DIM, A_KV_HEADS * HEAD_DIM,
             B_HEADS * 2 * B_QK_DIM, B_HEADS * 2 * B_QK_DIM, B_HEADS * B_V_DIM,
             C_HEADS * HEAD_DIM, C_HEADS * HEAD_DIM, C_HEADS * HEAD_DIM,
             D_HEADS * HEAD_DIM, D_HEADS * HEAD_DIM, D_HEADS * HEAD_DIM)
IN_WIDTH = sum(IN_SPLITS)
IN_SPLIT_POINTS = tuple(int(v) for v in np.cumsum(IN_SPLITS)[:-1])

kernel_name = 'hymba_style_hybrid_bidirectional_encoder'


def rms_norm(x, g):
    xf = x.astype(jnp.float32)
    y = xf * lax.rsqrt(jnp.mean(xf * xf, axis=-1, keepdims=True) + EPS)
    return (y * g.astype(jnp.float32)).astype(x.dtype)


def swiglu(h, w_gate, w_up, w_down):
    return (jax.nn.silu(h @ w_gate) * (h @ w_up)) @ w_down


def to_blocks(x):
    b, t = x.shape[:2]
    return jnp.swapaxes(x.reshape((b, t // Q_BLOCK, Q_BLOCK) + x.shape[2:]), 0, 1)


def from_blocks(y):
    nb, b, qb = y.shape[:3]
    return jnp.swapaxes(y, 0, 1).reshape((b, nb * qb) + y.shape[3:])


def t5_bucket(rel):
    nb = T5_BUCKETS // 2
    max_exact = nb // 2
    side = (rel > 0).astype(jnp.int32) * nb
    n = jnp.abs(rel)
    large = max_exact + (jnp.log(jnp.maximum(n, 1).astype(jnp.float32) / max_exact)
                         / math.log(T5_MAX_DIST / max_exact) * (nb - max_exact)).astype(jnp.int32)
    large = jnp.minimum(large, nb - 1)
    return side + jnp.where(n < max_exact, n, large)


def axial_rope(x):
    t_len = x.shape[1]
    t = jnp.arange(t_len, dtype=jnp.int32)
    n_freq = HEAD_DIM // 4
    inv_freq = ROPE_THETA ** (-jnp.arange(n_freq, dtype=jnp.float32) / n_freq)
    ang = jnp.concatenate([(t // GRID_W).astype(jnp.float32)[:, None] * inv_freq[None, :],
                           (t % GRID_W).astype(jnp.float32)[:, None] * inv_freq[None, :]], axis=-1)
    cos = jnp.cos(ang)[None, :, None, :]
    sin = jnp.sin(ang)[None, :, None, :]
    xf = x.astype(jnp.float32).reshape(x.shape[:-1] + (HEAD_DIM // 2, 2))
    x1, x2 = xf[..., 0], xf[..., 1]
    out = jnp.stack([x1 * cos - x2 * sin, x1 * sin + x2 * cos], axis=-1).reshape(x.shape)
    return out.astype(x.dtype)


def gqa_axial_attention(q, k, v, g_q, g_k):
    b, t_len = q.shape[:2]
    q = axial_rope(rms_norm(q, g_q))
    k = axial_rope(rms_norm(k, g_k))
    qg = q.reshape(b, t_len, A_KV_HEADS, A_HEADS // A_KV_HEADS, HEAD_DIM)

    def block(qi):
        s = jnp.einsum('bqkgd,bskd->bkgqs', qi, k, preferred_element_type=jnp.float32) * SCALE
        p = jax.nn.softmax(s, axis=-1).astype(v.dtype)
        return jnp.einsum('bkgqs,bskd->bqkgd', p, v)

    o = from_blocks(lax.map(block, to_blocks(qg)))
    return o.reshape(b, t_len, A_HEADS * HEAD_DIM)


def differential_attention(q, k, v, lam_params, subln_g, lam_init, t5_b):
    b, t_len = q.shape[:2]
    lp = lam_params.astype(jnp.float32)
    lam = jnp.exp(jnp.sum(lp[0] * lp[1])) - jnp.exp(jnp.sum(lp[2] * lp[3])) + lam_init
    key_pos = jnp.arange(t_len, dtype=jnp.int32)
    starts = jnp.arange(t_len // Q_BLOCK, dtype=jnp.int32) * Q_BLOCK

    def block(args):
        qi, q0 = args
        rel = key_pos[None, :] - (q0 + jnp.arange(Q_BLOCK, dtype=jnp.int32))[:, None]
        bias = jnp.moveaxis(t5_b[t5_bucket(rel)].astype(jnp.float32), -1, 0)
        s = jnp.einsum('bqhmd,bshmd->bhmqs', qi, k, preferred_element_type=jnp.float32) * SCALE
        p = jax.nn.softmax(s + bias[None, :, None], axis=-1)
        a = (p[:, :, 0] - lam * p[:, :, 1]).astype(v.dtype)
        return jnp.einsum('bhqs,bshe->bqhe', a, v)

    o = from_blocks(lax.map(block, (to_blocks(q), starts)))
    o = rms_norm(o, subln_g) * (1.0 - lam_init)
    return o.reshape(b, t_len, B_HEADS * B_V_DIM)


def neighbourhood_attention(q, k, v, rpb):
    b, t_len = q.shape[:2]
    rows = t_len // GRID_W
    kr = min(C_WIN_ROWS, rows)
    n_keys = kr * C_WIN_COLS
    nb = t_len // Q_BLOCK
    t = jnp.arange(t_len, dtype=jnp.int32)
    r, c = t // GRID_W, t % GRID_W
    rs = jnp.clip(r - kr // 2, 0, rows - kr)
    cs = jnp.clip(c - C_WIN_COLS // 2, 0, GRID_W - C_WIN_COLS)
    key_r = jnp.broadcast_to(rs[:, None, None] + jnp.arange(kr, dtype=jnp.int32)[None, :, None], (t_len, kr, C_WIN_COLS))
    key_c = jnp.broadcast_to(cs[:, None, None] + jnp.arange(C_WIN_COLS, dtype=jnp.int32)[None, None, :], (t_len, kr, C_WIN_COLS))
    idx = (key_r * GRID_W + key_c).reshape(nb, Q_BLOCK, n_keys)
    rel_r = (key_r - r[:, None, None] + (C_WIN_ROWS - 1)).reshape(nb, Q_BLOCK, n_keys)
    rel_c = (key_c - c[:, None, None] + (C_WIN_COLS - 1)).reshape(nb, Q_BLOCK, n_keys)

    def block(args):
        qi, idx_b, rr, cc = args
        kg = jnp.take(k, idx_b, axis=1)
        vg = jnp.take(v, idx_b, axis=1)
        s = jnp.einsum('bqhd,bqkhd->bhqk', qi, kg, preferred_element_type=jnp.float32) * SCALE
        s = s + rpb[:, rr, cc].astype(jnp.float32)[None]
        p = jax.nn.softmax(s, axis=-1).astype(v.dtype)
        return jnp.einsum('bhqk,bqkhd->bqhd', p, vg)

    o = from_blocks(lax.map(block, (to_blocks(q), idx, rel_r, rel_c)))
    return o.reshape(b, t_len, C_HEADS * HEAD_DIM)


def dilated_mixture_attention(q, k, v, t5_d):
    b, t_len = q.shape[:2]
    starts = jnp.arange(t_len // Q_BLOCK, dtype=jnp.int32) * Q_BLOCK
    branch_offs = [jnp.arange(-(w // (2 * d)), w // (2 * d) + 1, dtype=jnp.int32) * d for w, d in D_BRANCHES]
    branch_bias = [jnp.transpose(t5_d[t5_bucket(o)]).astype(jnp.float32) for o in branch_offs]

    def block(args):
        qi, q0 = args
        tq = q0 + jnp.arange(Q_BLOCK, dtype=jnp.int32)
        outs, lses = [], []
        for offs, bias in zip(branch_offs, branch_bias):
            pos = tq[:, None] + offs[None, :]
            valid = (pos >= 0) & (pos < t_len)
            pos = jnp.clip(pos, 0, t_len - 1)
            kg = jnp.take(k, pos, axis=1)
            vg = jnp.take(v, pos, axis=1)
            s = jnp.einsum('bqhd,bqkhd->bhqk', qi, kg, preferred_element_type=jnp.float32) * SCALE
            s = jnp.where(valid[None, None], s + bias[None, :, None, :], NEG_INF)
            lse = jax.nn.logsumexp(s, axis=-1)
            p = jnp.exp(s - lse[..., None]).astype(v.dtype)
            outs.append(jnp.einsum('bhqk,bqkhd->bqhd', p, vg))
            lses.append(lse)
        wts = jax.nn.softmax(jnp.stack(lses, axis=0), axis=0).astype(v.dtype)
        return jnp.einsum('gbhq,gbqhd->bqhd', wts, jnp.stack(outs, axis=0))

    o = from_blocks(lax.map(block, (to_blocks(q), starts)))
    return o.reshape(b, t_len, D_HEADS * HEAD_DIM)


def mixing_sublayer(h, layer, w_in, a_q_norm, a_k_norm, b_lambda, b_subln, c_rpb, w_out, t5_table):
    b, t_len, _ = h.shape
    qa, ka, va, qb, kb, vb, qc, kc, vc, qd, kd, vd = jnp.split(h @ w_in, IN_SPLIT_POINTS, axis=-1)
    hd4 = lambda z, nh: z.reshape(b, t_len, nh, HEAD_DIM)
    out_a = gqa_axial_attention(hd4(qa, A_HEADS), hd4(ka, A_KV_HEADS), hd4(va, A_KV_HEADS), a_q_norm, a_k_norm)
    lam_init = 0.8 - 0.6 * math.exp(-0.3 * layer)
    out_b = differential_attention(qb.reshape(b, t_len, B_HEADS, 2, B_QK_DIM),
                                   kb.reshape(b, t_len, B_HEADS, 2, B_QK_DIM),
                                   vb.reshape(b, t_len, B_HEADS, B_V_DIM),
                                   b_lambda, b_subln, lam_init, t5_table[:, :B_HEADS])
    out_c = neighbourhood_attention(hd4(qc, C_HEADS), hd4(kc, C_HEADS), hd4(vc, C_HEADS), c_rpb)
    out_d = dilated_mixture_attention(hd4(qd, D_HEADS), hd4(kd, D_HEADS), hd4(vd, D_HEADS), t5_table[:, B_HEADS:])
    return jnp.concatenate([out_a, out_b, out_c, out_d], axis=-1) @ w_out


def encoder_trunk(x, ffn1_norm, ffn1_w_gate, ffn1_w_up, ffn1_w_down, mix_norm, w_in, a_q_norm, a_k_norm,
                  b_lambda, b_subln, c_rpb, w_out, ffn2_norm, ffn2_w_gate, ffn2_w_up, ffn2_w_down,
                  t5_table, final_norm):
    for l in range(DEPTH):
        x = x + 0.5 * swiglu(rms_norm(x, ffn1_norm[l]), ffn1_w_gate[l], ffn1_w_up[l], ffn1_w_down[l])
        x = x + mixing_sublayer(rms_norm(x, mix_norm[l]), l, w_in[l], a_q_norm[l], a_k_norm[l],
                                b_lambda[l], b_subln[l], c_rpb[l], w_out[l], t5_table)
        x = x + 0.5 * swiglu(rms_norm(x, ffn2_norm[l]), ffn2_w_gate[l], ffn2_w_up[l], ffn2_w_down[l])
    return rms_norm(x, final_norm)


def setup_inputs(seed: int = 0) -> dict:
    key = jax.random.key(seed)
    ks = jax.random.split(key, 24)
    f32 = jnp.float32

    def nrm(k, shape, scale):
        return scale * jax.random.normal(k, shape, dtype=f32)

    def gain(k, shape):
        return 1.0 + 0.02 * jax.random.normal(k, shape, dtype=f32)

    return {
        'x_prompt': nrm(ks[0], (BATCH, SEQ, D_MODEL), 1.0),
        'x_sample': nrm(ks[1], (DEC_BATCH, DEC_SEQ, D_MODEL), 1.0),
        'ffn1_norm': gain(ks[2], (DEPTH, D_MODEL)),
        'ffn1_w_gate': nrm(ks[3], (DEPTH, D_MODEL, D_FF), D_MODEL ** -0.5),
        'ffn1_w_up': nrm(ks[4], (DEPTH, D_MODEL, D_FF), D_MODEL ** -0.5),
        'ffn1_w_down': nrm(ks[5], (DEPTH, D_FF, D_MODEL), D_FF ** -0.5),
        'mix_norm': gain(ks[6], (DEPTH, D_MODEL)),
        'w_in': nrm(ks[7], (DEPTH, D_MODEL, IN_WIDTH), D_MODEL ** -0.5),
        'a_q_norm': gain(ks[8], (DEPTH, HEAD_DIM)),
        'a_k_norm': gain(ks[9], (DEPTH, HEAD_DIM)),
        'b_lambda': nrm(ks[10], (DEPTH, 4, B_QK_DIM), 0.1),
        'b_subln': gain(ks[11], (DEPTH, B_V_DIM)),
        'c_rpb': nrm(ks[12], (DEPTH, C_HEADS, 2 * C_WIN_ROWS - 1, 2 * C_WIN_COLS - 1), 0.02),
        'w_out': nrm(ks[13], (DEPTH, MIX_WIDTH, D_MODEL), MIX_WIDTH ** -0.5),
        'ffn2_norm': gain(ks[14], (DEPTH, D_MODEL)),
        'ffn2_w_gate': nrm(ks[15], (DEPTH, D_MODEL, D_FF), D_MODEL ** -0.5),
        'ffn2_w_up': nrm(ks[16], (DEPTH, D_MODEL, D_FF), D_MODEL ** -0.5),
        'ffn2_w_down': nrm(ks[17], (DEPTH, D_FF, D_MODEL), D_FF ** -0.5),
        't5_table': nrm(ks[18], (T5_BUCKETS, T5_HEADS), 0.1),
        'final_norm': gain(ks[19], (D_MODEL,)),
    }


def reference(x_prompt, x_sample, ffn1_norm, ffn1_w_gate, ffn1_w_up, ffn1_w_down, mix_norm, w_in,
              a_q_norm, a_k_norm, b_lambda, b_subln, c_rpb, w_out, ffn2_norm, ffn2_w_gate, ffn2_w_up,
              ffn2_w_down, t5_table, final_norm):
    y_prompt = encoder_trunk(x_prompt, ffn1_norm, ffn1_w_gate, ffn1_w_up, ffn1_w_down, mix_norm, w_in,
                             a_q_norm, a_k_norm, b_lambda, b_subln, c_rpb, w_out, ffn2_norm, ffn2_w_gate,
                             ffn2_w_up, ffn2_w_down, t5_table, final_norm)
    y_sample = encoder_trunk(x_sample, ffn1_norm, ffn1_w_gate, ffn1_w_up, ffn1_w_down, mix_norm, w_in,
                             a_q_norm, a_k_norm, b_lambda, b_subln, c_rpb, w_out, ffn2_norm, ffn2_w_gate,
                             ffn2_w_up, ffn2_w_down, t5_table, final_norm)
    return (y_prompt, y_sample)
```

```cpp
#include <hip/hip_runtime.h>
#include <cstdio>
#include <cstdint>

#ifndef MK_PER_PHASE
#define MK_PER_PHASE 0
#endif

namespace cfg {
constexpr int DM = 2048, DFF = 5632, NIN = 5376, NGU = 2 * DFF;
constexpr int TP = 16384, TS = 8192, MP = 2 * TP, MS = 2 * TS, M = MP + MS;
constexpr float EPS = 1e-6f;
constexpr float LOG2E = 1.4426950408889634f;
constexpr float C2 = 0.125f * LOG2E;
}
namespace pg8 {
#define PG8_LAS __attribute__((address_space(3)))
typedef unsigned short bf16_t;
typedef short bf16x8 __attribute__((ext_vector_type(8)));
typedef float f32x4 __attribute__((ext_vector_type(4)));
typedef unsigned u32x4 __attribute__((ext_vector_type(4)));
constexpr int BM = 256, BK = 64, HALF = 128, HTB = HALF * BK * 2  , STAGE_BYTES = 8 * HTB, NXCD = 8, WGM = 8;

__host__ __device__ __forceinline__ int lds_byte(int r, int c) { const int st = (r >> 4) * 2 + (c >> 5), rr = r & 15, cc = c & 31, ob = rr * 64 + cc * 2; return st * 1024 + (ob ^ (((ob >> 9) & 1) << 5)); }
__host__ __device__ __forceinline__ void stage_rc(int b, int& R, int& C) { const int st = b / 1024, sb = b % 1024, swz = sb ^ (((sb >> 9) & 1) << 5); R = (st >> 1) * 16 + swz / 64; C = (st & 1) * 32 + (swz % 64) / 2; }
__host__ __device__ __forceinline__ int perm32(int rho) { const int n = rho >> 4, i = rho & 15; return 8 * (i >> 2) + 4 * n + (i & 3); }

struct Unit { int pm, pn; };
struct Gemm { const bf16_t* A; const bf16_t* Bt; int M, N, K; };

struct StaticOrder {
    int nM, nN, nwg, G, c;
    __host__ __device__ void init(int M, int N, int G_, int c_) { nM = M / BM; nN = N / BM; nwg = nM * nN; G = G_; c = c_; }
    __host__ __device__ bool next(int i, Unit& u) const {
        const long L = (long)i * G + c; if (L >= nwg) return false;
        int wgid = (int)L; { const int q = nwg / NXCD, r = nwg % NXCD, xcd = wgid % NXCD, off = wgid / NXCD; wgid = (xcd < r ? xcd * (q + 1) : r * (q + 1) + (xcd - r) * q) + off; }
        const int nig = WGM * nN, gid = wgid / nig, fm = gid * WGM, gsz = (nM - fm) < WGM ? (nM - fm) : WGM;
        u.pm = fm + ((wgid % nig) % gsz); u.pn = (wgid % nig) / gsz; return true;
    }
    __device__ __forceinline__ void a_ready(const Unit&) const {}
    __device__ __forceinline__ void done(const Unit&) const {}
};

__device__ __forceinline__ unsigned cvt_pk_bf16(float lo, float hi) { unsigned r; asm volatile("v_cvt_pk_bf16_f32 %0, %1, %2" : "=v"(r) : "v"(lo), "v"(hi)); return r; }
typedef float f32x2 __attribute__((ext_vector_type(2)));

struct EpiSwiglu {
    static constexpr bool PERM = true, AFTER_DRAIN = false;
    bf16_t* H;
    __device__ __forceinline__ void operator()(const f32x4 (&acc)[2][2][4][2], const Unit& u, int wr, int wc, int fr, int fq) const {
        const int row0 = u.pm * BM + wr * 64 + fr, col0 = u.pn * 128 + wc * 32 + 8 * fq;
#pragma unroll
        for (int ai = 0; ai < 2; ++ai)
#pragma unroll
            for (int m = 0; m < 4; ++m) {
                bf16_t* rowp = H + (unsigned)((row0 + ai * HALF + m * 16) * cfg::DFF + col0);
                float hv[8];
#pragma unroll
                for (int n = 0; n < 2; ++n)
#pragma unroll
                    for (int j = 0; j < 4; ++j) {
                        const float g = acc[ai][0][m][n][j], up = acc[ai][1][m][n][j];
                        const float e = __builtin_amdgcn_exp2f(-g * cfg::LOG2E);
                        hv[n * 4 + j] = (g * up) * __builtin_amdgcn_rcpf(1.0f + e);
                    }
                u32x4 w; w.x = cvt_pk_bf16(hv[0], hv[1]); w.y = cvt_pk_bf16(hv[2], hv[3]); w.z = cvt_pk_bf16(hv[4], hv[5]); w.w = cvt_pk_bf16(hv[6], hv[7]);
                *(u32x4*)rowp = w;
                asm volatile("" ::: "memory");
            }
    }
};
struct EpiResid {
    static constexpr bool PERM = false, AFTER_DRAIN = false;
    const float* xp; const float* xs; float* out; int first; float alpha;
    __device__ __forceinline__ void operator()(const f32x4 (&acc)[2][2][4][2], const Unit& u, int wr, int wc, int fr, int fq) const {
        const float* bb = first ? (u.pm < cfg::MP / BM ? xp + (size_t)u.pm * BM * cfg::DM : xs + (size_t)(u.pm - cfg::MP / BM) * BM * cfg::DM) : out + (size_t)u.pm * BM * cfg::DM;
        float* ob = out + (size_t)u.pm * BM * cfg::DM;
        const unsigned off0 = (unsigned)(wr * 64 + fr) * cfg::DM + (unsigned)(u.pn * BM + wc * 32 + 4 * fq);
#pragma unroll
        for (int ai = 0; ai < 2; ++ai)
#pragma unroll
            for (int m = 0; m < 4; ++m) {
                const unsigned off = off0 + (unsigned)(ai * HALF + m * 16) * cfg::DM;
                f32x4 v[2][2];
#pragma unroll
                for (int bj = 0; bj < 2; ++bj)
#pragma unroll
                    for (int n = 0; n < 2; ++n) v[bj][n] = *(const f32x4*)(bb + off + bj * HALF + n * 16);
#pragma unroll
                for (int bj = 0; bj < 2; ++bj)
#pragma unroll
                    for (int n = 0; n < 2; ++n) *(f32x4*)(ob + off + bj * HALF + n * 16) = v[bj][n] + acc[ai][bj][m][n] * alpha;
                asm volatile("" ::: "memory");
            }
    }
};
struct EpiWin {
    static constexpr bool PERM = true, AFTER_DRAIN = false;
    bf16_t* QKV; const float* gq; const float* gk;
    __device__ __forceinline__ void operator()(const f32x4 (&acc)[2][2][4][2], const Unit& u, int wr, int wc, int fr, int fq) const {
        const int pn = u.pn;
        int kind = 0; float sc = 1.f;
        if (pn < 2) { kind = 1; sc = cfg::C2; }
        else if (pn == 2) { kind = (wc < 2) ? 2 : 0; }
        else if (pn == 3 || pn == 4 || pn == 9 || pn == 10 || pn == 15 || pn == 16) sc = cfg::C2;
        const int row0 = u.pm * BM + wr * 64 + fr;
        const int colb = pn * 256 + wc * 64 + 8 * fq;
        if (kind == 0) {
#pragma unroll
            for (int ai = 0; ai < 2; ++ai)
#pragma unroll
                for (int m = 0; m < 4; ++m) {
                    bf16_t* rowp = QKV + (unsigned)((row0 + ai * HALF + m * 16) * cfg::NIN + colb);
#pragma unroll
                    for (int bj = 0; bj < 2; ++bj) { const f32x4 v0 = acc[ai][bj][m][0] * sc, v1 = acc[ai][bj][m][1] * sc;
                        u32x4 w; w.x = cvt_pk_bf16(v0[0], v0[1]); w.y = cvt_pk_bf16(v0[2], v0[3]); w.z = cvt_pk_bf16(v1[0], v1[1]); w.w = cvt_pk_bf16(v1[2], v1[3]);
                        *(u32x4*)(rowp + 32 * bj) = w; }
                    asm volatile("" ::: "memory");
                }
        } else {
            const float* g = (kind == 1) ? gq : gk;
            float invrev[2][2];
#pragma unroll
            for (int n = 0; n < 2; ++n)
#pragma unroll
                for (int jj = 0; jj < 2; ++jj) invrev[n][jj] = __builtin_amdgcn_exp2f(-(float)(4 * fq + 2 * n + jj) * (13.287712379549449f / 16.0f)) * 0.15915494309189535f;
#pragma unroll
            for (int ai = 0; ai < 2; ++ai)
#pragma unroll
                for (int m = 0; m < 4; ++m) {
                    const int row = row0 + ai * HALF + m * 16;
                    const int t = (row < cfg::MP) ? (row & (cfg::TP - 1)) : (row & (cfg::TS - 1));
                    float prow = (float)(t >> 6), pcol = (float)(row & 63);
                    asm volatile("" : "+v"(prow), "+v"(pcol) :: "memory");
                    float ss = 0.f;
#pragma unroll
                    for (int bj = 0; bj < 2; ++bj)
#pragma unroll
                        for (int n = 0; n < 2; ++n) { const f32x4 v = acc[ai][bj][m][n]; ss += (v[0] * v[0] + v[1] * v[1]) + (v[2] * v[2] + v[3] * v[3]); }
                    ss += __shfl_xor(ss, 16); ss += __shfl_xor(ss, 32);
                    const float rinv = __builtin_amdgcn_rsqf(ss * (1.0f / 64.0f) + cfg::EPS);
                    bf16_t* rowp = QKV + (unsigned)(row * cfg::NIN + colb);
#pragma unroll
                    for (int bj = 0; bj < 2; ++bj) {
                        const float pos = bj ? pcol : prow;
                        float o[8];
#pragma unroll
                        for (int n = 0; n < 2; ++n) {
                            const f32x4 y = acc[ai][bj][m][n] * rinv * *(const f32x4*)(g + 32 * bj + 8 * fq + 4 * n);
#pragma unroll
                            for (int jj = 0; jj < 2; ++jj) {
                                const float rev = __builtin_amdgcn_fractf(pos * invrev[n][jj]);
                                const float sn = __builtin_amdgcn_sinf(rev), cs = __builtin_amdgcn_cosf(rev);
                                const float x1 = y[2 * jj], x2 = y[2 * jj + 1];
                                o[4 * n + 2 * jj] = (x1 * cs - x2 * sn) * sc; o[4 * n + 2 * jj + 1] = (x1 * sn + x2 * cs) * sc;
                            }
                        }
                        u32x4 w; w.x = cvt_pk_bf16(o[0], o[1]); w.y = cvt_pk_bf16(o[2], o[3]); w.z = cvt_pk_bf16(o[4], o[5]); w.w = cvt_pk_bf16(o[6], o[7]);
                        *(u32x4*)(rowp + 32 * bj) = w;
                        asm volatile("" ::: "memory");
                    }
                }
        }
    }
};

template <class Epi, class Sched, bool ALIGN_EPI = false, bool SP2 = false>
__device__ __forceinline__ void gemm_phase(PG8_LAS unsigned char* lds, const Gemm g, const Sched& S, const Epi& E) {
    int tid_ = threadIdx.x; asm volatile("" : "+v"(tid_));
    const int tid = tid_, wid = __builtin_amdgcn_readfirstlane(tid >> 6), lane = tid & 63, wr = wid >> 2, wc = wid & 3, fr = lane & 15, fq = lane >> 4;
    const int K = g.K, nt = K / BK;
    unsigned voffA[2], voffB[2];
#pragma unroll
    for (int i = 0; i < 2; ++i) { int R, C; stage_rc(tid * 16 + i * 8192, R, C); const int Rb = Epi::PERM ? ((R & ~31) + perm32(R & 31)) : R;
        voffA[i] = (unsigned)(R * K + C) * 2u; voffB[i] = (unsigned)(Rb * K + C) * 2u; }
    const size_t kstep = (size_t)(BK * 2);
    const size_t hstep = (size_t)HALF * K * 2;
    const size_t tstep = 2 * hstep;
    const unsigned ldsw = (unsigned)wid * 1024u;
    const int aoff = lds_byte(wr * 64 + fr, fq * 8), boff = lds_byte(wc * 32 + fr, fq * 8);
#define PG8_SA(b, h) (((b) * 2 + (h)) * HTB)
#define PG8_SB(b, h) ((4 + (b) * 2 + (h)) * HTB)
#define PG8_STAGE(bufoff, gbase, voff) do { _Pragma("unroll") for (int _i = 0; _i < 2; ++_i) \
        __builtin_amdgcn_global_load_lds((const unsigned*)((const char*)(gbase) + (voff)[_i]), (PG8_LAS unsigned*)(lds + (bufoff) + ldsw + _i * 8192), 16, 0, 0); } while (0)
#define PG8_LDA(dst, b, h) do { _Pragma("unroll") for (int m = 0; m < 4; ++m) _Pragma("unroll") for (int k = 0; k < 2; ++k) dst[m][k] = *(const PG8_LAS bf16x8*)(lds + PG8_SA(b, h) + aoff + m * 2048 + k * 1024); } while (0)
#define PG8_LDB(dst, b, h) do { _Pragma("unroll") for (int n = 0; n < 2; ++n) _Pragma("unroll") for (int k = 0; k < 2; ++k) dst[n][k] = *(const PG8_LAS bf16x8*)(lds + PG8_SB(b, h) + boff + n * 2048 + k * 1024); } while (0)
#define PG8_MMA(ai, bj, At, Bt) do { __builtin_amdgcn_s_setprio(1); _Pragma("unroll") for (int m = 0; m < 4; ++m) _Pragma("unroll") for (int n = 0; n < 2; ++n) _Pragma("unroll") for (int k = 0; k < 2; ++k) \
        acc[ai][bj][m][n] = __builtin_amdgcn_mfma_f32_16x16x32_bf16(Bt[n][k], At[m][k], acc[ai][bj][m][n], 0, 0, 0); __builtin_amdgcn_s_setprio(0); } while (0)
#define PG8_WAIT_V(n) asm volatile("s_waitcnt vmcnt(" #n ")" ::: "memory")
#define PG8_WAIT_L(n) asm volatile("s_waitcnt lgkmcnt(" #n ")" ::: "memory")
#define PG8_BAR __builtin_amdgcn_s_barrier()
#define PG8_SCHED __builtin_amdgcn_sched_barrier(0)
    Unit cur, nxt; int ui = 0;
    if (!S.next(0, cur)) return;
    f32x4 acc[2][2][4][2];
#pragma unroll
    for (int a = 0; a < 2; ++a)
#pragma unroll
        for (int b = 0; b < 2; ++b)
#pragma unroll
            for (int m = 0; m < 4; ++m)
#pragma unroll
                for (int n = 0; n < 2; ++n) acc[a][b][m][n] = (f32x4){0.f, 0.f, 0.f, 0.f};
    bf16x8 At[4][2], B0[2][2], B1[2][2];
    const char* cA = (const char*)g.A + (size_t)cur.pm * tstep; const char* cB = (const char*)g.Bt + (size_t)cur.pn * tstep;
    S.a_ready(cur);
    if constexpr (SP2) {
        PG8_STAGE(PG8_SB(0, 0), cB, voffB); PG8_STAGE(PG8_SB(0, 1), cB + hstep, voffB); PG8_STAGE(PG8_SA(0, 0), cA, voffA); PG8_STAGE(PG8_SA(0, 1), cA + hstep, voffA);
        if (wr == 1) PG8_BAR;
        PG8_WAIT_V(2); PG8_BAR;
        PG8_STAGE(PG8_SB(1, 0), cB + kstep, voffB); PG8_STAGE(PG8_SA(1, 0), cA + kstep, voffA); PG8_STAGE(PG8_SB(1, 1), cB + hstep + kstep, voffB);
        PG8_WAIT_V(6); PG8_BAR;
    } else {
        PG8_STAGE(PG8_SB(0, 0), cB, voffB); PG8_STAGE(PG8_SA(0, 0), cA, voffA); PG8_STAGE(PG8_SB(0, 1), cB + hstep, voffB); PG8_STAGE(PG8_SA(0, 1), cA + hstep, voffA);
        if (wr == 1) PG8_BAR;
        PG8_WAIT_V(4); PG8_BAR;
        PG8_STAGE(PG8_SB(1, 0), cB + kstep, voffB); PG8_STAGE(PG8_SA(1, 0), cA + kstep, voffA); PG8_STAGE(PG8_SB(1, 1), cB + hstep + kstep, voffB);
        PG8_WAIT_V(6); PG8_BAR;
    }
    for (;;) {
        const bool has_next = S.next(ui + 1, nxt);
        const char* nA = has_next ? (const char*)g.A + (size_t)nxt.pm * tstep : cA; const char* nB = has_next ? (const char*)g.Bt + (size_t)nxt.pn * tstep : cB;
        for (int t = 0; t < nt; t += 2) {
            const bool last = (t == nt - 2);
            const char* a1 = cA + (size_t)(t + 1) * kstep;
            const char* a2 = last ? nA : cA + (size_t)(t + 2) * kstep; const char* b2 = last ? nB : cB + (size_t)(t + 2) * kstep;
            const char* a3 = a2 + kstep; const char* b3 = b2 + kstep;
            if (last && has_next) S.a_ready(nxt);
            if constexpr (SP2) {
            PG8_LDB(B0, 0, 0); PG8_LDB(B1, 0, 1); PG8_SCHED; PG8_LDA(At, 0, 0); PG8_STAGE(PG8_SA(1, 1), a1 + hstep, voffA);
            PG8_WAIT_V(8); PG8_WAIT_L(0); PG8_BAR; PG8_MMA(0, 0, At, B0); PG8_MMA(0, 1, At, B1); PG8_BAR; PG8_SCHED;
            PG8_LDA(At, 0, 1); PG8_STAGE(PG8_SB(0, 0), b2, voffB); PG8_STAGE(PG8_SB(0, 1), b2 + hstep, voffB); PG8_STAGE(PG8_SA(0, 0), a2, voffA);
            PG8_WAIT_V(8); PG8_WAIT_L(0); PG8_BAR; PG8_MMA(1, 0, At, B0); PG8_MMA(1, 1, At, B1); PG8_BAR; PG8_SCHED;
            PG8_LDB(B0, 1, 0); PG8_LDB(B1, 1, 1); PG8_SCHED; PG8_LDA(At, 1, 0); PG8_STAGE(PG8_SA(0, 1), a2 + hstep, voffA);
            PG8_WAIT_V(8); PG8_WAIT_L(0); PG8_BAR; PG8_MMA(0, 0, At, B0); PG8_MMA(0, 1, At, B1); PG8_BAR; PG8_SCHED;
            PG8_LDA(At, 1, 1); PG8_STAGE(PG8_SB(1, 0), b3, voffB); PG8_STAGE(PG8_SB(1, 1), b3 + hstep, voffB); PG8_STAGE(PG8_SA(1, 0), a3, voffA);
            PG8_WAIT_V(8); PG8_WAIT_L(0); PG8_BAR; PG8_MMA(1, 0, At, B0); PG8_MMA(1, 1, At, B1); PG8_BAR; PG8_SCHED;
            } else {
            PG8_LDB(B0, 0, 0); PG8_SCHED; PG8_LDA(At, 0, 0); PG8_STAGE(PG8_SA(1, 1), a1 + hstep, voffA);
            PG8_WAIT_L(8); PG8_BAR; PG8_WAIT_L(0); PG8_MMA(0, 0, At, B0); PG8_BAR; PG8_SCHED;
            PG8_LDB(B1, 0, 1); PG8_STAGE(PG8_SB(0, 0), b2, voffB);
            PG8_BAR; PG8_WAIT_L(0); PG8_MMA(0, 1, At, B1); PG8_BAR;
            PG8_LDA(At, 0, 1); PG8_STAGE(PG8_SA(0, 0), a2, voffA);
            PG8_BAR; PG8_WAIT_L(0); PG8_MMA(1, 0, At, B0); PG8_BAR; PG8_SCHED;
            PG8_STAGE(PG8_SB(0, 1), b2 + hstep, voffB);
            PG8_WAIT_V(6); PG8_BAR; PG8_MMA(1, 1, At, B1); PG8_BAR;
            PG8_LDB(B0, 1, 0); PG8_SCHED; PG8_LDA(At, 1, 0); PG8_STAGE(PG8_SA(0, 1), a2 + hstep, voffA);
            PG8_WAIT_L(8); PG8_BAR; PG8_WAIT_L(0); PG8_MMA(0, 0, At, B0); PG8_BAR; PG8_SCHED;
            PG8_LDB(B1, 1, 1); PG8_STAGE(PG8_SB(1, 0), b3, voffB);
            PG8_BAR; PG8_WAIT_L(0); PG8_MMA(0, 1, At, B1); PG8_BAR;
            PG8_LDA(At, 1, 1); PG8_STAGE(PG8_SA(1, 0), a3, voffA);
            PG8_BAR; PG8_WAIT_L(0); PG8_MMA(1, 0, At, B0); PG8_BAR; PG8_SCHED;
            PG8_STAGE(PG8_SB(1, 1), b3 + hstep, voffB);
            PG8_WAIT_V(6); PG8_BAR; PG8_MMA(1, 1, At, B1); PG8_BAR;
            }
        }
        if constexpr (ALIGN_EPI) { if (wr == 0) PG8_BAR; }
        if constexpr (!Epi::AFTER_DRAIN) { E(acc, cur, wr, wc, fr, fq); S.done(cur); }
        if (!has_next) break;
#pragma unroll
        for (int a = 0; a < 2; ++a)
#pragma unroll
            for (int b = 0; b < 2; ++b)
#pragma unroll
                for (int m = 0; m < 4; ++m)
#pragma unroll
                    for (int n = 0; n < 2; ++n) acc[a][b][m][n] = (f32x4){0.f, 0.f, 0.f, 0.f};
        cur = nxt; cA = nA; cB = nB; ++ui;
        if constexpr (ALIGN_EPI) { if (wr == 1) PG8_BAR; }
    }
    PG8_WAIT_V(0);
    if constexpr (!ALIGN_EPI) { if (wr == 0) PG8_BAR; }
    PG8_BAR;
    if constexpr (Epi::AFTER_DRAIN) { E.fused(acc, cur, wr, wc, fr, fq, lds, wid, lane); S.done(cur); }
#undef PG8_SA
#undef PG8_SB
#undef PG8_STAGE
#undef PG8_LDA
#undef PG8_LDB
#undef PG8_MMA
#undef PG8_WAIT_V
#undef PG8_WAIT_L
#undef PG8_BAR
#undef PG8_SCHED
}
}
namespace att {
#define ATT_LAS __attribute__((address_space(3)))
using bf16x8 = __attribute__((ext_vector_type(8))) short;
using s16x4  = __attribute__((ext_vector_type(4))) short;
using f32x16 = __attribute__((ext_vector_type(16))) float;
using u32x4  = __attribute__((ext_vector_type(4))) unsigned;
typedef unsigned short bf16_t;
typedef ATT_LAS char* lptr;
constexpr int PITCH = cfg::NIN, OPITCH = cfg::DM;
constexpr float LOG2E = cfg::LOG2E, NEG = -1e30f, THR = 8.f;
constexpr int L_K = 0, L_V = 32768, L_WS = 65536, L_LUT = 67584, L_OST = 81920, L_END = 114688;
constexpr int LUTB_R = 704, LUTD_R = 1344;
#define ATT_SBAR() __builtin_amdgcn_sched_barrier(0)
__device__ __forceinline__ int crow(int r, int hi) { return (r & 3) + 8 * (r >> 2) + 4 * hi; }
__device__ __forceinline__ unsigned cvtpk(float lo, float hi) { unsigned r; asm volatile("v_cvt_pk_bf16_f32 %0, %1, %2" : "=v"(r) : "v"(lo), "v"(hi)); return r; }
__device__ __forceinline__ float wave_sum(float v) {
#pragma unroll
    for (int o = 1; o < 64; o <<= 1) v += __shfl_xor(v, o);
    return v;
}
__device__ __forceinline__ int t5_bucket(int rel) {
    const int n = rel < 0 ? -rel : rel;
    int b = n;
    if (n >= 8) b = 8 + (n >= 15) + (n >= 27) + (n >= 50) + (n >= 91) + (n >= 166) + (n >= 305) + (n >= 559);
    return b + (rel > 0 ? 16 : 0);
}
template <int KC> __device__ __forceinline__ int kswz(int row, int colB) { return KC == 128 ? row * 256 + (colB ^ ((row & 7) << 4)) : row * 128 + (colB ^ (((row >> 1) & 7) << 4)); }
template <int NCB> __device__ __forceinline__ int v_st(int k, int c) { const int kk = (k & ~0xC) | ((k & 4) << 1) | ((k & 8) >> 1); return ((kk >> 3) * NCB + (c >> 5)) * 512 + ((kk & 7) * 32 + (c & 31)) * 2; }
__device__ __forceinline__ int v_rd_base(int lane) { return ((lane & 3) << 3) | (((lane >> 2) & 3) << 6) | (((lane >> 4) & 1) << 5) | (((lane >> 5) & 1) << 8); }
template <int OFF> __device__ __forceinline__ s16x4 tr_read(int vb) { s16x4 r; asm volatile("ds_read_b64_tr_b16 %0, %1 offset:%2" : "=&v"(r) : "v"(vb), "i"(OFF) : "memory"); return r; }
template <int NCB, int D0> __device__ __forceinline__ void pv_one(f32x16& od, int vb, bf16x8 pa0, bf16x8 pa1, bf16x8 pa2, bf16x8 pa3) {
#define ATT_VOFF(ks, half) (D0 * 512 + (ks) * (NCB * 1024) + (half) * (NCB * 512))
    const s16x4 l0 = tr_read<ATT_VOFF(0, 0)>(vb), h0 = tr_read<ATT_VOFF(0, 1)>(vb), l1 = tr_read<ATT_VOFF(1, 0)>(vb), h1 = tr_read<ATT_VOFF(1, 1)>(vb);
    const s16x4 l2 = tr_read<ATT_VOFF(2, 0)>(vb), h2 = tr_read<ATT_VOFF(2, 1)>(vb), l3 = tr_read<ATT_VOFF(3, 0)>(vb), h3 = tr_read<ATT_VOFF(3, 1)>(vb);
#undef ATT_VOFF
    asm volatile("s_waitcnt lgkmcnt(0)" ::: "memory"); ATT_SBAR();
#define ATT_PK(L, H) (bf16x8){L[0], L[1], L[2], L[3], H[0], H[1], H[2], H[3]}
    od = __builtin_amdgcn_mfma_f32_32x32x16_bf16(pa0, ATT_PK(l0, h0), od, 0, 0, 0);
    od = __builtin_amdgcn_mfma_f32_32x32x16_bf16(pa1, ATT_PK(l1, h1), od, 0, 0, 0);
    od = __builtin_amdgcn_mfma_f32_32x32x16_bf16(pa2, ATT_PK(l2, h2), od, 0, 0, 0);
    od = __builtin_amdgcn_mfma_f32_32x32x16_bf16(pa3, ATT_PK(l3, h3), od, 0, 0, 0);
#undef ATT_PK
}
template <int NCB> __device__ __forceinline__ void pv_all(f32x16* o, int vb, bf16x8 pa0, bf16x8 pa1, bf16x8 pa2, bf16x8 pa3) {
    pv_one<NCB, 0>(o[0], vb, pa0, pa1, pa2, pa3); pv_one<NCB, 1>(o[1], vb, pa0, pa1, pa2, pa3);
    if constexpr (NCB == 4) { pv_one<NCB, 2>(o[2], vb, pa0, pa1, pa2, pa3); pv_one<NCB, 3>(o[3], vb, pa0, pa1, pa2, pa3); }
}
__device__ __forceinline__ void partialSM(f32x16& p0, f32x16& p1, float cb, float& m_reg, float& alpha) {
    float pmax = p0[0];
#pragma unroll
    for (int r = 1; r < 16; ++r) pmax = fmaxf(pmax, p0[r]);
#pragma unroll
    for (int r = 0; r < 16; ++r) pmax = fmaxf(pmax, p1[r]);
    { auto rr = __builtin_amdgcn_permlane32_swap(__float_as_uint(pmax), __float_as_uint(pmax), false, false); pmax = fmaxf(__uint_as_float(rr[0]), __uint_as_float(rr[1])); }
    pmax += cb;
    float mn;
    if (__builtin_expect(__all(pmax - m_reg <= THR), 1)) { mn = m_reg; alpha = 1.f; }
    else { mn = fmaxf(m_reg, pmax); alpha = __builtin_amdgcn_exp2f(m_reg - mn); m_reg = mn; }
    const float sub = cb - mn;
#pragma unroll
    for (int r = 0; r < 16; ++r) p0[r] += sub;
#pragma unroll
    for (int r = 0; r < 16; ++r) p1[r] += sub;
#pragma unroll
    for (int r = 0; r < 16; ++r) p0[r] = __builtin_amdgcn_exp2f(p0[r]);
}
__device__ __forceinline__ void finishSM(f32x16& p0, f32x16& p1, float alpha, float& l_reg, bf16x8& pa0, bf16x8& pa1, bf16x8& pa2, bf16x8& pa3) {
#pragma unroll
    for (int r = 0; r < 16; ++r) p1[r] = __builtin_amdgcn_exp2f(p1[r]);
    float ps = 0.f;
#pragma unroll
    for (int r = 0; r < 16; ++r) ps += p0[r];
#pragma unroll
    for (int r = 0; r < 16; ++r) ps += p1[r];
    { auto rr = __builtin_amdgcn_permlane32_swap(__float_as_uint(ps), __float_as_uint(ps), false, false); ps = __uint_as_float(rr[0]) + __uint_as_float(rr[1]); }
    l_reg = l_reg * alpha + ps;
#define ATT_PK4(P, BASE, OUT) do { unsigned a0 = cvtpk(P[BASE + 0], P[BASE + 1]), a1 = cvtpk(P[BASE + 2], P[BASE + 3]);   \
    unsigned b0 = cvtpk(P[BASE + 4], P[BASE + 5]), b1 = cvtpk(P[BASE + 6], P[BASE + 7]);                              \
    auto r0 = __builtin_amdgcn_permlane32_swap(a0, b0, false, false); auto r1 = __builtin_amdgcn_permlane32_swap(a1, b1, false, false); \
    u32x4 w = {r0[0], r1[0], r0[1], r1[1]}; OUT = __builtin_bit_cast(bf16x8, w); } while (0)
    ATT_PK4(p0, 0, pa0); ATT_PK4(p0, 8, pa1); ATT_PK4(p1, 0, pa2); ATT_PK4(p1, 8, pa3);
#undef ATT_PK4
}
template <int KC> __device__ __forceinline__ void qkt(f32x16& p0, f32x16& p1, lptr Ks, int cb0, const bf16x8* qr, int r32, int hi) {
    p0 = f32x16{}; p1 = f32x16{};
#pragma unroll
    for (int d0 = 0; d0 < 4; ++d0) { const int cb = cb0 + d0 * 32 + hi * 16;
        const bf16x8 b0 = *(const ATT_LAS bf16x8*)(Ks + kswz<KC>(r32, cb));
        const bf16x8 b1 = *(const ATT_LAS bf16x8*)(Ks + kswz<KC>(32 + r32, cb));
        p0 = __builtin_amdgcn_mfma_f32_32x32x16_bf16(b0, qr[d0], p0, 0, 0, 0);
        p1 = __builtin_amdgcn_mfma_f32_32x32x16_bf16(b1, qr[d0], p1, 0, 0, 0); }
}
struct Aux { const float* t5; const float* rpb; const float* lam_p; const float* subln; float lam_init; };

template <int MODE>
__device__ __forceinline__ void attn_unit(const bf16_t* __restrict__ QKV, bf16_t* __restrict__ ATT, lptr lds, int row0, int T, int h, int qb, const Aux& ax) {
    constexpr int KC = (MODE == 1) ? 128 : 64, DV = (MODE == 1) ? 128 : 64, NCB = DV / 32, NR = KC / 64;
    constexpr int KBYTES = 64 * KC * 2, VBYTES = 64 * DV * 2, QROWS = (MODE == 1) ? 128 : 256;
    int tid_ = threadIdx.x; asm volatile("" : "+v"(tid_));
    const int tid = tid_, lane = tid & 63, r32 = lane & 31, hi = lane >> 5;
    const int wid = __builtin_amdgcn_readfirstlane(tid >> 6);
    const int map = (MODE == 1) ? (wid >> 2) : 0, wq = (MODE == 1) ? (wid & 3) : wid;
    const int q0 = qb * QROWS, qw = q0 + wq * 32, qpos = qw + r32;
    int qcol, kcol, vcol, ocol;
    if (MODE == 0)      { qcol = 64 * h;          kcol = 512 + 64 * (h >> 2); vcol = 640 + 64 * (h >> 2); ocol = 64 * h; }
    else if (MODE == 1) { qcol = 768 + 128 * h + 64 * map; kcol = 1280 + 128 * h; vcol = 1792 + 128 * h; ocol = 512 + 128 * h; }
    else if (MODE == 2) { qcol = 2304 + 64 * h;   kcol = 2816 + 64 * h;       vcol = 3328 + 64 * h;       ocol = 1024 + 64 * h; }
    else                { qcol = 3840 + 64 * h;   kcol = 4352 + 64 * h;       vcol = 4864 + 64 * h;       ocol = 1536 + 64 * h; }
    int tlo = 0, NT = T >> 6;
    if (MODE == 3) { int lo = q0 - 1024; lo = lo < 0 ? 0 : lo; int hi_k = q0 + 255 + 1024; hi_k = hi_k > T - 1 ? T - 1 : hi_k; int a = lo >> 6, b = hi_k >> 6;
        if (((b - a + 1) & 1) != 0) { if (a > 0) --a; else ++b; } tlo = a; NT = b - a + 1; }
    if (MODE == 2) { const int rows = T >> 6, R0 = 4 * qb; int a = R0 - 4; a = a < 0 ? 0 : (a > rows - 8 ? rows - 8 : a); int b = R0 - 1; b = b < 0 ? 0 : (b > rows - 8 ? rows - 8 : b); b += 7;
        if (((b - a + 1) & 1) != 0) { if (a > 0) --a; else ++b; } tlo = a; NT = b - a + 1; }
    ATT_LAS float* lut = (ATT_LAS float*)(lds + L_LUT);
    if (MODE == 1) { for (int i = tid; i < 2 * LUTB_R + 1; i += 512) lut[i] = ax.t5[t5_bucket(i - LUTB_R) * 12 + h] * LOG2E; }
    if (MODE == 3) { for (int i = tid; i < 2 * LUTD_R + 1; i += 512) { const int rel = i - LUTD_R, n = rel < 0 ? -rel : rel;
            const int mult = (n <= 64 ? 1 : 0) + (((n & 3) == 0 && n <= 256) ? 1 : 0) + (((n & 15) == 0 && n <= 1024) ? 1 : 0);
            lut[i] = mult == 0 ? NEG : ax.t5[t5_bucket(rel) * 12 + 4 + h] * LOG2E + (mult == 1 ? 0.f : (mult == 2 ? 1.f : 1.5849625007211562f)); } }
    if (MODE == 2) { for (int i = tid; i < 15 * 128; i += 512) { const int dr = i >> 7, dc = (i & 127) - 48; lut[i] = (dc >= 0 && dc <= 30) ? ax.rpb[(h * 15 + dr) * 31 + dc] * LOG2E : NEG; } }
    bf16x8 qr[4];
    { const bf16_t* Qw = QKV + (size_t)(row0 + qpos) * PITCH + qcol + hi * 8;
#pragma unroll
      for (int d0 = 0; d0 < 4; ++d0) qr[d0] = *(const bf16x8*)(Qw + d0 * 16); }
    const int sr = (KC == 128) ? (tid >> 4) : (tid >> 3), sc = (KC == 128) ? (tid & 15) * 8 : (tid & 7) * 8;
    const bf16_t* Kg = QKV + (size_t)(row0 + sr) * PITCH + kcol + sc;
    const bf16_t* Vg = QKV + (size_t)(row0 + sr) * PITCH + vcol + sc;
    const int kst0 = kswz<KC>(sr, sc * 2), kst1 = kswz<KC>(32 + sr, sc * 2), vst0 = v_st<NCB>(sr, sc), vst1 = v_st<NCB>(32 + sr, sc);
    const lptr K_lds = lds + L_K, V_lds = lds + L_V;
    const int vb0 = (int)(uintptr_t)V_lds + v_rd_base(lane);
    ATT_LAS float* wsf = (ATT_LAS float*)(lds + L_WS) + wid * 64; ATT_LAS float* li_l = wsf; ATT_LAS float* al_l = wsf + 32;
    struct { bf16x8 k[NR], v[NR]; } st_[2];
#define SLOAD(i, tt) do { const size_t ro_ = (size_t)((tlo + (tt)) * 64) * PITCH; st_[i].k[0] = *(const bf16x8*)(Kg + ro_); st_[i].v[0] = *(const bf16x8*)(Vg + ro_); \
        if constexpr (NR == 2) { st_[i].k[1] = *(const bf16x8*)(Kg + ro_ + (size_t)32 * PITCH); st_[i].v[1] = *(const bf16x8*)(Vg + ro_ + (size_t)32 * PITCH); } } while (0)
#define SWRITE(b, i) do { *(ATT_LAS bf16x8*)(K_lds + (b) * KBYTES + kst0) = st_[i].k[0]; *(ATT_LAS bf16x8*)(V_lds + (b) * VBYTES + vst0) = st_[i].v[0]; \
        if constexpr (NR == 2) { *(ATT_LAS bf16x8*)(K_lds + (b) * KBYTES + kst1) = st_[i].k[1]; *(ATT_LAS bf16x8*)(V_lds + (b) * VBYTES + vst1) = st_[i].v[1]; } } while (0)
#define SWAIT() do { if constexpr (NR == 2) asm volatile("s_waitcnt vmcnt(4)" ::: "memory"); else asm volatile("s_waitcnt vmcnt(2)" ::: "memory"); } while (0)
#define RESC(a) do { if (__any((a) < 1.f)) { if (hi == 0) al_l[r32] = (a); asm volatile("s_waitcnt lgkmcnt(0)" ::: "memory"); \
        _Pragma("unroll") for (int d = 0; d < NCB; ++d) _Pragma("unroll") for (int r = 0; r < 16; ++r) o[d][r] *= al_l[crow(r, hi)]; } } while (0)
    float cL = 0.f, cR = 0.f; int c_cs = 0, c_rs = 0, c_R = 0, c_c = 0;
    if (MODE == 2) { const int rows = T >> 6; c_R = 4 * qb + (wid >> 1); c_c = 32 * (wid & 1) + r32; c_cs = c_c - 8; c_cs = c_cs < 0 ? 0 : (c_cs > 48 ? 48 : c_cs); c_rs = c_R - 4; c_rs = c_rs < 0 ? 0 : (c_rs > rows - 8 ? rows - 8 : c_rs); }
#define MODIFY(P0, P1, tt, CB) do { CB = 0.f; const int k0_ = (tlo + (tt)) * 64; \
        if constexpr (MODE == 1) { if (k0_ + 63 - qw <= -559) CB = cL; else if (k0_ - qw - 31 >= 559) CB = cR; else { const ATT_LAS float* lp_ = lut + (k0_ - qpos + LUTB_R + 4 * hi); \
            _Pragma("unroll") for (int r = 0; r < 16; ++r) { P0[r] += lp_[(r & 3) + 8 * (r >> 2)]; P1[r] += lp_[32 + (r & 3) + 8 * (r >> 2)]; } } } \
        if constexpr (MODE == 3) { const ATT_LAS float* lp_ = lut + (k0_ - qpos + LUTD_R + 4 * hi); \
            _Pragma("unroll") for (int r = 0; r < 16; ++r) { P0[r] += lp_[(r & 3) + 8 * (r >> 2)]; P1[r] += lp_[32 + (r & 3) + 8 * (r >> 2)]; } } \
        if constexpr (MODE == 2) { const int kr_ = tlo + (tt); if (kr_ < c_rs || kr_ > c_rs + 7) { _Pragma("unroll") for (int r = 0; r < 16; ++r) { P0[r] = NEG; P1[r] = NEG; } } \
            else { const ATT_LAS float* lp_ = lut + ((kr_ - c_R + 7) * 128 + 48 + 15 - c_c + 4 * hi); const int kb_ = 4 * hi - c_cs; \
              _Pragma("unroll") for (int r = 0; r < 16; ++r) { const int ko_ = (r & 3) + 8 * (r >> 2); const float a_ = lp_[ko_], b_ = lp_[32 + ko_]; \
                P0[r] = ((unsigned)(kb_ + ko_) <= 15u) ? P0[r] + a_ : NEG; P1[r] = ((unsigned)(kb_ + 32 + ko_) <= 15u) ? P1[r] + b_ : NEG; } } } \
    } while (0)
    __syncthreads();
    if (MODE == 1) { cL = lut[0]; cR = lut[2 * LUTB_R]; }
    float m_reg = NEG, l_reg = 0.f; f32x16 o[NCB];
#pragma unroll
    for (int d = 0; d < NCB; ++d) o[d] = f32x16{};
    f32x16 pA0, pA1, pB0, pB1; float alA, alB, cbA, cbB; bf16x8 pa0, pa1, pa2, pa3;
    const int cb0 = map * 128;
    SLOAD(0, 0); asm volatile("s_waitcnt vmcnt(0)" ::: "memory"); SWRITE(0, 0); __syncthreads();
    qkt<KC>(pA0, pA1, K_lds, cb0, qr, r32, hi); MODIFY(pA0, pA1, 0, cbA); partialSM(pA0, pA1, cbA, m_reg, alA);
    SLOAD(1, 1); if (2 < NT) SLOAD(0, 2);
    SWAIT(); SWRITE(1, 1); __syncthreads();
    for (int j = 1; j + 1 < NT; j += 2) {
        ATT_SBAR(); qkt<KC>(pB0, pB1, K_lds + KBYTES, cb0, qr, r32, hi);
        finishSM(pA0, pA1, alA, l_reg, pa0, pa1, pa2, pa3); ATT_SBAR();
        SLOAD(1, j + 2); ATT_SBAR();
        pv_all<NCB>(o, vb0, pa0, pa1, pa2, pa3); MODIFY(pB0, pB1, j, cbB); partialSM(pB0, pB1, cbB, m_reg, alB);
        __syncthreads(); SWAIT(); SWRITE(0, 0);
        RESC(alB); __syncthreads();
        ATT_SBAR(); qkt<KC>(pA0, pA1, K_lds, cb0, qr, r32, hi);
        finishSM(pB0, pB1, alB, l_reg, pa0, pa1, pa2, pa3); ATT_SBAR();
        if (j + 3 < NT) SLOAD(0, j + 3); ATT_SBAR();
        pv_all<NCB>(o, vb0 + VBYTES, pa0, pa1, pa2, pa3); MODIFY(pA0, pA1, j + 1, cbA); partialSM(pA0, pA1, cbA, m_reg, alA);
        __syncthreads(); SWAIT(); SWRITE(1, 1);
        RESC(alA); __syncthreads();
    }
    ATT_SBAR(); qkt<KC>(pB0, pB1, K_lds + KBYTES, cb0, qr, r32, hi);
    finishSM(pA0, pA1, alA, l_reg, pa0, pa1, pa2, pa3); ATT_SBAR();
    pv_all<NCB>(o, vb0, pa0, pa1, pa2, pa3); MODIFY(pB0, pB1, NT - 1, cbB); partialSM(pB0, pB1, cbB, m_reg, alB);
    __syncthreads(); RESC(alB);
    finishSM(pB0, pB1, alB, l_reg, pa0, pa1, pa2, pa3); ATT_SBAR();
    pv_all<NCB>(o, vb0 + VBYTES, pa0, pa1, pa2, pa3);
    if (hi == 0) li_l[r32] = l_reg; asm volatile("s_waitcnt lgkmcnt(0)" ::: "memory");
    float rli[16];
#pragma unroll
    for (int r = 0; r < 16; ++r) rli[r] = __builtin_amdgcn_rcpf(li_l[crow(r, hi)]);
    if constexpr (MODE != 1) {
        ATT_LAS bf16_t* stg = (ATT_LAS bf16_t*)(lds + L_OST) + wid * 2048;
#pragma unroll
        for (int r = 0; r < 16; ++r) { const int orow = crow(r, hi);
#pragma unroll
            for (int d0 = 0; d0 < 2; ++d0) stg[orow * 64 + d0 * 32 + r32] = (bf16_t)(cvtpk(o[d0][r] * rli[r], 0.f) & 0xffffu); }
        asm volatile("s_waitcnt lgkmcnt(0)" ::: "memory");
        bf16_t* Ow = ATT + (size_t)(row0 + q0 + wid * 32) * OPITCH + ocol;
#pragma unroll
        for (int i = 0; i < 4; ++i) { const int row = i * 8 + (lane >> 3), ch = lane & 7; const u32x4 v = *(const ATT_LAS u32x4*)(stg + row * 64 + ch * 8); *(u32x4*)(Ow + (size_t)row * OPITCH + ch * 8) = v; }
    } else {
        __syncthreads();
        ATT_LAS float* ex = (ATT_LAS float*)(lds + L_K) + (wid & 3) * 4096;
        if (map == 1) {
#pragma unroll
            for (int d0 = 0; d0 < 4; ++d0)
#pragma unroll
                for (int r = 0; r < 16; ++r) ex[(d0 * 16 + r) * 64 + lane] = o[d0][r] * rli[r];
        }
        __syncthreads();
        if (map == 0) {
            const float sa = wave_sum(ax.lam_p[lane] * ax.lam_p[64 + lane]), sb = wave_sum(ax.lam_p[128 + lane] * ax.lam_p[192 + lane]);
            const float lam = __builtin_amdgcn_exp2f(sa * LOG2E) - __builtin_amdgcn_exp2f(sb * LOG2E) + ax.lam_init;
            float ssq[16];
#pragma unroll
            for (int r = 0; r < 16; ++r) ssq[r] = 0.f;
#pragma unroll
            for (int d0 = 0; d0 < 4; ++d0)
#pragma unroll
                for (int r = 0; r < 16; ++r) { const float d = o[d0][r] * rli[r] - lam * ex[(d0 * 16 + r) * 64 + lane]; o[d0][r] = d; ssq[r] += d * d; }
#pragma unroll
            for (int r = 0; r < 16; ++r) { float s = ssq[r]; s += __shfl_xor(s, 1); s += __shfl_xor(s, 2); s += __shfl_xor(s, 4); s += __shfl_xor(s, 8); s += __shfl_xor(s, 16);
                ssq[r] = __builtin_amdgcn_rsqf(s * (1.0f / 128.0f) + cfg::EPS) * (1.0f - ax.lam_init); }
            float gsub[4];
#pragma unroll
            for (int d0 = 0; d0 < 4; ++d0) gsub[d0] = ax.subln[d0 * 32 + r32];
            ATT_LAS bf16_t* stg = (ATT_LAS bf16_t*)(lds + L_OST) + wid * 4096;
#pragma unroll
            for (int r = 0; r < 16; ++r) { const int orow = crow(r, hi);
#pragma unroll
                for (int d0 = 0; d0 < 4; ++d0) stg[orow * 128 + d0 * 32 + r32] = (bf16_t)(cvtpk(o[d0][r] * ssq[r] * gsub[d0], 0.f) & 0xffffu); }
            asm volatile("s_waitcnt lgkmcnt(0)" ::: "memory");
            bf16_t* Ow = ATT + (size_t)(row0 + q0 + wid * 32) * OPITCH + ocol;
#pragma unroll
            for (int i = 0; i < 8; ++i) { const int row = i * 4 + (lane >> 4), ch = lane & 15; const u32x4 v = *(const ATT_LAS u32x4*)(stg + row * 128 + ch * 8); *(u32x4*)(Ow + (size_t)row * OPITCH + ch * 8) = v; }
        }
    }
    __syncthreads();
#undef SLOAD
#undef SWRITE
#undef SWAIT
#undef RESC
#undef MODIFY
}
#undef ATT_SBAR
}
#define GAS __attribute__((address_space(1)))
#define LAS __attribute__((address_space(3)))
typedef unsigned short bf16;
typedef unsigned v4u __attribute__((ext_vector_type(4)));
typedef float f32x4 __attribute__((ext_vector_type(4)));
typedef short bf16x8 __attribute__((ext_vector_type(8)));
typedef GAS unsigned gu32;
typedef GAS unsigned long long gu64;
#define RLX_AGENT __ATOMIC_RELAXED, __HIP_MEMORY_SCOPE_AGENT
#define LDS_WAIT() asm volatile("s_waitcnt lgkmcnt(0)" ::: "memory")
#define VM_WAIT() asm volatile("s_waitcnt vmcnt(0)" ::: "memory")
__device__ __forceinline__ unsigned long long rt() { return __builtin_amdgcn_s_memrealtime(); }
__device__ __forceinline__ unsigned f2bf(float f) { unsigned u = __builtin_bit_cast(unsigned, f); return (u + 0x7fffu + ((u >> 16) & 1u)) >> 16; }
__device__ __forceinline__ unsigned pk2(float lo, float hi) { return f2bf(lo) | (f2bf(hi) << 16); }

#define XB_TMO      128
#define XB_XCNT(j)  (256  + 64 * (j))
#define XB_XSUB(j)  (1280 + 64 * (j))
#define XB_XGEN(j)  (2304 + 64 * (j))
#define XB_TOP      3328
#define XB_TOPGEN   3392
#define XCD_BAR_WORDS 3456
#define XB_SPIN_CAP (1u << 18)

__device__ __forceinline__ unsigned xb_ld(unsigned* p)              { return __hip_atomic_load(p, __ATOMIC_RELAXED, __HIP_MEMORY_SCOPE_AGENT); }
__device__ __forceinline__ unsigned xb_add(unsigned* p, unsigned v) { return __hip_atomic_fetch_add(p, v, __ATOMIC_RELAXED, __HIP_MEMORY_SCOPE_AGENT); }
__device__ __forceinline__ unsigned xb_xcc_id() { return (unsigned)__builtin_amdgcn_s_getreg((3 << 11) | 20) & 0xFu; }
#define XB_SPIN(cond, bar) do { unsigned _sp = 0; while (cond) { __builtin_amdgcn_s_sleep(1); \
    if ((++_sp & 255u) == 0u) { if (xb_ld(&(bar)[XB_TMO])) break; if (_sp > XB_SPIN_CAP) { atomicAdd(&(bar)[XB_TMO], 1u); break; } } } } while (0)

struct XcdBarrier {
    unsigned* bar; unsigned x;
    volatile LAS unsigned* st;
};

__device__ __forceinline__ XcdBarrier xcd_barrier_post(unsigned* bar, volatile LAS unsigned* st) {
    XcdBarrier b; b.bar = bar; b.x = xb_xcc_id(); b.st = st;
    if (threadIdx.x == 0) (void)xb_add(&bar[XB_XCNT(b.x)], 1u);
    return b;
}
__device__ __forceinline__ void xcd_barrier_complete(unsigned* bar, unsigned x, unsigned& nloc, unsigned& nx) {
    const unsigned G = gridDim.x * gridDim.y * gridDim.z;
    unsigned sum, cnt, mine, sp = 0u;
    for (;;) {
        sum = 0u; cnt = 0u; mine = 0u;
#pragma unroll
        for (unsigned j = 0; j < 16; ++j) { const unsigned c = xb_ld(&bar[XB_XCNT(j)]); sum += c; cnt += (c > 0u) ? 1u : 0u; mine = (j == x) ? c : mine; }
        if (sum == G) break;
        __builtin_amdgcn_s_sleep(1);
        if ((++sp & 255u) == 0u) { if (xb_ld(&bar[XB_TMO])) break; if (sp > XB_SPIN_CAP) { atomicAdd(&bar[XB_TMO], 1u); break; } }
    }
    nloc = mine > 0u ? mine : 1u; nx = cnt > 0u ? cnt : 1u;
}

__device__ __forceinline__ void xcd_barrier(const XcdBarrier& b) {
    asm volatile("s_waitcnt vmcnt(0)" ::: "memory");
    __syncthreads();
    if (threadIdx.x == 0) {
        unsigned* bar = b.bar;
        __builtin_amdgcn_s_waitcnt(0);
        unsigned nloc = b.st[0], nx = b.st[1];
        if (nloc == 0u) { xcd_barrier_complete(bar, b.x, nloc, nx); b.st[0] = nloc; b.st[1] = nx; }
        const unsigned old = xb_add(&bar[XB_XSUB(b.x)], 1u);
        const unsigned gen = old / nloc;
        if (old + 1u == (gen + 1u) * nloc) {
            __builtin_amdgcn_fence(__ATOMIC_RELEASE, "agent");
            asm volatile("s_waitcnt vmcnt(0)" ::: "memory");
            const unsigned og = xb_add(&bar[XB_TOP], 1u);
            const unsigned tg = og / nx;
            if (og + 1u == (tg + 1u) * nx) xb_add(&bar[XB_TOPGEN], 1u);
            else XB_SPIN(xb_ld(&bar[XB_TOPGEN]) == tg, bar);
            __builtin_amdgcn_fence(__ATOMIC_ACQUIRE, "agent");
            xb_add(&bar[XB_XGEN(b.x)], 1u);
            asm volatile("s_waitcnt vmcnt(0)" ::: "memory");
        } else {
            XB_SPIN(xb_ld(&bar[XB_XGEN(b.x)]) == gen, bar);
            __builtin_amdgcn_fence(__ATOMIC_ACQUIRE, "agent");
            asm volatile("s_waitcnt vmcnt(0)" ::: "memory");
        }
    }
    __syncthreads();
}

constexpr int NWAVES = 8;
constexpr size_t MiB = 1u << 20;
constexpr size_t WS_CTL = 0, CTL_ZERO_BYTES = 1 * MiB;
constexpr size_t WS_WGU1 = 2 * MiB, WS_WD1 = 46 * MiB, WS_WIN = 68 * MiB, WS_WOUT = 89 * MiB, WS_WGU2 = 97 * MiB, WS_WD2 = 141 * MiB;
constexpr size_t WS_XN = 164 * MiB;
constexpr size_t WS_H = 356 * MiB;
constexpr size_t WS_END = 884 * MiB;
static_assert(WS_WGU1 + (size_t)cfg::NGU * cfg::DM * 2 <= WS_WD1 && WS_WD1 + (size_t)cfg::DM * cfg::DFF * 2 <= WS_WIN && WS_WIN + (size_t)cfg::NIN * cfg::DM * 2 <= WS_WOUT &&
              WS_WOUT + (size_t)cfg::DM * cfg::DM * 2 <= WS_WGU2 && WS_WGU2 + (size_t)cfg::NGU * cfg::DM * 2 <= WS_WD2 && WS_WD2 + (size_t)cfg::DM * cfg::DFF * 2 <= WS_XN &&
              WS_XN + (size_t)cfg::M * cfg::DM * 2 <= WS_H && WS_H + (size_t)cfg::M * cfg::DFF * 2 <= WS_END, "d_ws map");
constexpr int CW_BAR = 4096;
constexpr int RING_OFF = 0, RING_BYTES = 131072, LDSCTL_OFF = RING_BYTES, MISC_OFF = LDSCTL_OFF + 320, LDS_BYTES = 147456;
static_assert(att::L_END <= RING_BYTES && MISC_OFF + 128 <= LDS_BYTES, "LDS map");

struct Frame {
    LAS unsigned char* lds; volatile LAS unsigned* MISC; int tid, lane, wave, vcu, G;
};
__device__ __forceinline__ float wave_sum_f(float v) {
#pragma unroll
    for (int o = 1; o < 64; o <<= 1) v += __shfl_xor(v, o);
    return v;
}
__device__ __forceinline__ void transpose_item(const float* W, int K, int N, bf16* WT, int k0, int n0, int rowbase, LAS float* scr, int lane) {
#pragma unroll 8
    for (int i = 0; i < 32; ++i) { const int kk = 2 * i + (lane >> 5); scr[kk * 33 + (lane & 31)] = W[(size_t)(k0 + kk) * N + n0 + (lane & 31)]; }
    LDS_WAIT(); asm volatile("" ::: "memory");
    const int c = lane & 7;
#pragma unroll
    for (int j = 0; j < 4; ++j) { const int n = (lane >> 3) + 8 * j; const LAS float* s = scr + (8 * c) * 33 + n;
        v4u o; o.x = pk2(s[0 * 33], s[1 * 33]); o.y = pk2(s[2 * 33], s[3 * 33]); o.z = pk2(s[4 * 33], s[5 * 33]); o.w = pk2(s[6 * 33], s[7 * 33]);
        *(GAS v4u*)(WT + (size_t)(rowbase + n) * K + k0 + 8 * c) = o; }
    LDS_WAIT(); asm volatile("" ::: "memory");
}
__device__ __forceinline__ void conv_phase(const Frame& F, const float* f1g, const float* f1u, const float* f1d, const float* f2g, const float* f2u, const float* f2d, const float* win, const float* wout, unsigned char* ws, int L) {
    using namespace cfg;
    { const GAS float *a = (const GAS float*)f1g, *b = (const GAS float*)f1u, *c = (const GAS float*)f1d, *d = (const GAS float*)f2g, *e = (const GAS float*)f2u, *g = (const GAS float*)f2d, *h = (const GAS float*)win, *k = (const GAS float*)wout;
      asm volatile("" : "+s"(a), "+s"(b), "+s"(c), "+s"(d), "+s"(e), "+s"(g), "+s"(h), "+s"(k));
      f1g = (const float*)a; f1u = (const float*)b; f1d = (const float*)c; f2g = (const float*)d; f2u = (const float*)e; f2d = (const float*)g; win = (const float*)h; wout = (const float*)k; }
    int lane = F.lane; asm volatile("" : "+v"(lane));
    LAS float* scr = (LAS float*)(F.lds + RING_OFF + F.wave * 16384);
    const int gw = F.vcu * NWAVES + F.wave, NGW = F.G * NWAVES;
    constexpr int I_G = (DM / 64) * (DFF / 32), I_D = (DFF / 64) * (DM / 32), I_IN = (DM / 64) * (NIN / 32), I_O = (DM / 64) * (DM / 32);
    constexpr int NITEMS = 6 * I_G + I_IN + I_O;
    static_assert(I_G == I_D, "");
    const size_t oG = (size_t)L * DM * DFF, oIN = (size_t)L * DM * NIN, oO = (size_t)L * DM * DM;
    for (int it = gw; it < NITEMS; it += NGW) {
        int r = it;
        if (r < 3 * I_G || r >= 3 * I_G + I_IN + I_O) {
            int ffn = 0; if (r >= 3 * I_G) { r -= 3 * I_G + I_IN + I_O; ffn = 1; }
            const int which = r / I_G; r -= which * I_G;
            bf16* gu = (bf16*)(ws + (ffn ? WS_WGU2 : WS_WGU1)); bf16* dn = (bf16*)(ws + (ffn ? WS_WD2 : WS_WD1));
            if (which < 2) { const float* W = (which == 0 ? (ffn ? f2g : f1g) : (ffn ? f2u : f1u)) + oG;
                const int nblk = DFF / 32, kb = r / nblk, nb = r % nblk, n0 = 32 * nb;
                transpose_item(W, DM, DFF, gu, 64 * kb, n0, 256 * (n0 >> 7) + 128 * which + (n0 & 127), scr, lane); }
            else { const float* W = (ffn ? f2d : f1d) + oG;
                const int nblk = DM / 32, kb = r / nblk, nb = r % nblk, n0 = 32 * nb;
                transpose_item(W, DFF, DM, dn, 64 * kb, n0, n0, scr, lane); }
        } else { r -= 3 * I_G;
            if (r < I_IN) { const int nblk = NIN / 32, kb = r / nblk, nb = r % nblk, n0 = 32 * nb;
                transpose_item(win + oIN, DM, NIN, (bf16*)(ws + WS_WIN), 64 * kb, n0, 256 * (n0 >> 8) + 128 * ((n0 & 63) >> 5) + 32 * ((n0 & 255) >> 6), scr, lane); }
            else { r -= I_IN; const int nblk = DM / 32, kb = r / nblk, nb = r % nblk, n0 = 32 * nb;
                transpose_item(wout + oO, DM, DM, (bf16*)(ws + WS_WOUT), 64 * kb, n0, n0, scr, lane); }
        }
    }
}
template <bool FINAL>
__device__ __forceinline__ void norm_phase(const Frame& F, const float* xp, const float* xs, float* out, int first, const float* gain, bf16* XN) {
    using namespace cfg;
    { const GAS float* a = (const GAS float*)gain; asm volatile("" : "+s"(a)); gain = (const float*)a; }
    int lane = F.lane; asm volatile("" : "+v"(lane));
    const int gw = F.vcu * NWAVES + F.wave, NGW = F.G * NWAVES;
    f32x4 g[8];
#pragma unroll
    for (int j = 0; j < 8; ++j) g[j] = ((const f32x4*)gain)[lane + 64 * j];
    for (int m = gw; m < M; m += NGW) {
        const float* xrow = first ? (m < MP ? xp + (size_t)m * DM : xs + (size_t)(m - MP) * DM) : out + (size_t)m * DM;
        const GAS f32x4* xr = (const GAS f32x4*)xrow + lane;
        f32x4 v[8]; float s = 0.f;
#pragma unroll
        for (int j = 0; j < 8; ++j) { v[j] = xr[64 * j]; s += (v[j].x * v[j].x + v[j].y * v[j].y) + (v[j].z * v[j].z + v[j].w * v[j].w); }
        const float rinv = 1.0f / sqrtf(wave_sum_f(s) * (1.0f / DM) + EPS);
        if constexpr (FINAL) { GAS f32x4* o = (GAS f32x4*)(out + (size_t)m * DM) + lane;
#pragma unroll
            for (int j = 0; j < 8; ++j) o[64 * j] = v[j] * rinv * g[j];
        } else { GAS unsigned long long* o8 = (GAS unsigned long long*)(XN + (size_t)m * DM) + lane;
#pragma unroll
            for (int j = 0; j < 8; ++j) { const f32x4 y = v[j] * rinv * g[j]; o8[64 * j] = (unsigned long long)pk2(y.x, y.y) | ((unsigned long long)pk2(y.z, y.w) << 32); }
        }
    }
}

struct Args { const float* in[20]; float* out; unsigned char* ws; int ph_lo, ph_hi, pad0, pad1; };
__global__ void __launch_bounds__(NWAVES * 64, 2) mk_fwd(Args args) {
    using namespace cfg;
    extern __shared__ __attribute__((aligned(16))) unsigned char lds[];
    Frame F;
    F.lds = (LAS unsigned char*)lds; F.MISC = (volatile LAS unsigned*)(F.lds + MISC_OFF);
    F.tid = threadIdx.x; F.lane = F.tid & 63; F.wave = __builtin_amdgcn_readfirstlane(F.tid >> 6);
    F.G = gridDim.x; { const int bx = blockIdx.x; F.vcu = (F.G % 8 == 0) ? (bx % 8) * (F.G / 8) + bx / 8 : bx; }
    unsigned char* ws = args.ws; gu32* ctl = (gu32*)(ws + WS_CTL);
    const float* const p_xp = args.in[0]; const float* const p_xs = args.in[1]; const float* const p_f1n = args.in[2]; const float* const p_f1g = args.in[3]; const float* const p_f1u = args.in[4];
    const float* const p_f1d = args.in[5]; const float* const p_mixn = args.in[6]; const float* const p_win = args.in[7]; const float* const p_aqn = args.in[8]; const float* const p_akn = args.in[9];
    const float* const p_blam = args.in[10]; const float* const p_bsub = args.in[11]; const float* const p_crpb = args.in[12]; const float* const p_wout = args.in[13]; const float* const p_f2n = args.in[14];
    const float* const p_f2g = args.in[15]; const float* const p_f2u = args.in[16]; const float* const p_f2d = args.in[17]; const float* const p_t5 = args.in[18]; const float* const p_fin = args.in[19];
    float* out = args.out;
    bf16* XN = (bf16*)(ws + WS_XN); bf16* HB = (bf16*)(ws + WS_H);
    for (int u = F.tid; u < (LDS_BYTES - LDSCTL_OFF) / 4; u += NWAVES * 64) ((LAS unsigned*)(F.lds + LDSCTL_OFF))[u] = 0u;
    __syncthreads();
    XcdBarrier bar; bar.bar = (unsigned*)(ctl + CW_BAR); bar.x = 0; bar.st = nullptr;
    if (!MK_PER_PHASE) bar = xcd_barrier_post((unsigned*)(ctl + CW_BAR), F.MISC + 8);
    const int lo = args.ph_lo, hi = args.ph_hi;
    int ph = 0;
#define IN(k) (lo <= (k) && (k) < hi)
#define FRESH() GAS float* out_g = (GAS float*)out; GAS unsigned char* ws_g = (GAS unsigned char*)ws; GAS bf16* XN_g = (GAS bf16*)XN; GAS bf16* HB_g = (GAS bf16*)HB; const GAS float* xp_g = (const GAS float*)p_xp; const GAS float* xs_g = (const GAS float*)p_xs; \
    asm volatile("" : "+s"(out_g), "+s"(ws_g), "+s"(XN_g), "+s"(HB_g), "+s"(xp_g), "+s"(xs_g)); \
    float* out_ = (float*)out_g; unsigned char* ws_ = (unsigned char*)ws_g; bf16* XN_ = (bf16*)XN_g; bf16* HB_ = (bf16*)HB_g; const float* xp_ = (const float*)xp_g; const float* xs_ = (const float*)xs_g
#define SEAM() do { if (IN(ph) && IN(ph + 1)) { if (MK_PER_PHASE) { if (F.tid == 0) __hip_atomic_store(ctl, 0xBADBA0u, RLX_AGENT); } else xcd_barrier(bar); } ++ph; } while (0)

    for (int i = 0; i < 4; ++i) {
        const int L = i >> 1, f = i & 1;
        if (IN(ph)) { FRESH();
            if (f == 0) conv_phase(F, p_f1g, p_f1u, p_f1d, p_f2g, p_f2u, p_f2d, p_win, p_wout, ws_, L);
            norm_phase<false>(F, xp_, xs_, out_, i == 0, (f ? p_f2n : p_f1n) + L * DM, XN_);
        }
        SEAM();
        if (IN(ph)) { FRESH();
            pg8::Gemm g{XN_, (const bf16*)(ws_ + (f ? WS_WGU2 : WS_WGU1)), M, NGU, DM}; pg8::StaticOrder S; S.init(M, NGU, F.G, (int)blockIdx.x);
            pg8::EpiSwiglu E{HB_};
#ifndef NO_GU
            pg8::gemm_phase<pg8::EpiSwiglu, pg8::StaticOrder, true, true>(F.lds + RING_OFF, g, S, E);
#endif
        }
        SEAM();
        if (IN(ph)) { FRESH();
            pg8::Gemm g{HB_, (const bf16*)(ws_ + (f ? WS_WD2 : WS_WD1)), M, DM, DFF}; pg8::StaticOrder S; S.init(M, DM, F.G, (int)blockIdx.x);
            pg8::EpiResid E{xp_, xs_, out_, i == 0, 0.5f};
#ifndef NO_RES
            pg8::gemm_phase<pg8::EpiResid, pg8::StaticOrder, true, true>(F.lds + RING_OFF, g, S, E);
#endif
        }
        SEAM();
        if (f == 0) {
            if (IN(ph)) { FRESH(); norm_phase<false>(F, xp_, xs_, out_, 0, p_mixn + L * DM, XN_); }
            SEAM();
            if (IN(ph)) { FRESH();
                pg8::Gemm g{XN_, (const bf16*)(ws_ + WS_WIN), M, NIN, DM}; pg8::StaticOrder S; S.init(M, NIN, F.G, (int)blockIdx.x);
                pg8::EpiWin E{HB_, p_aqn + L * 64, p_akn + L * 64};
#ifndef NO_WIN
                pg8::gemm_phase<pg8::EpiWin, pg8::StaticOrder, true, true>(F.lds + RING_OFF, g, S, E);
#endif
            }
            SEAM();
            if (IN(ph)) { FRESH();
                att::Aux ax{p_t5, p_crpb + (size_t)L * 8 * 15 * 31, p_blam + L * 256, p_bsub + L * 128, (L == 0 ? 0.2f : 0.35550906759f)};
                const att::lptr al = (att::lptr)(F.lds + RING_OFF);
                for (int u = F.vcu; u < 1536; u += F.G) {
#ifndef NO_ATT1
                    if (u < 1024) att::attn_unit<1>(HB_, XN_, al, (u >> 9) * TP, TP, (u >> 7) & 3, u & 127, ax);
                    else { const int v = u - 1024; att::attn_unit<1>(HB_, XN_, al, MP + (v >> 8) * TS, TS, (v >> 6) & 3, v & 63, ax); }
#endif
                }
                for (int u = F.vcu; u < 1536; u += F.G) {
#ifndef NO_ATT0
                    if (u < 1024) att::attn_unit<0>(HB_, XN_, al, (u >> 9) * TP, TP, (u >> 6) & 7, u & 63, ax);
                    else { const int v = u - 1024; att::attn_unit<0>(HB_, XN_, al, MP + (v >> 8) * TS, TS, (v >> 5) & 7, v & 31, ax); }
#endif
                }
                for (int u = F.vcu; u < 1536; u += F.G) {
                    const int h = u / 192, qg = u % 192; int r0, T, qb;
                    if (qg < 128) { r0 = (qg >> 6) * TP; T = TP; qb = qg & 63; } else { r0 = MP + ((qg - 128) >> 5) * TS; T = TS; qb = (qg - 128) & 31; }
#ifndef NO_ATT3
                    att::attn_unit<3>(HB_, XN_, al, r0, T, h, qb, ax);
#endif
                }
                for (int u = F.vcu; u < 1536; u += F.G) {
                    const int h = u / 192, qg = u % 192; int r0, T, qb;
                    if (qg < 128) { r0 = (qg >> 6) * TP; T = TP; qb = qg & 63; } else { r0 = MP + ((qg - 128) >> 5) * TS; T = TS; qb = (qg - 128) & 31; }
#ifndef NO_ATT2
                    att::attn_unit<2>(HB_, XN_, al, r0, T, h, qb, ax);
#endif
                }
            }
            SEAM();
            if (IN(ph)) { FRESH();
                pg8::Gemm g{XN_, (const bf16*)(ws_ + WS_WOUT), M, DM, DM}; pg8::StaticOrder S; S.init(M, DM, F.G, (int)blockIdx.x);
                pg8::EpiResid E{xp_, xs_, out_, 0, 1.0f};
    #ifndef NO_RES
            pg8::gemm_phase<pg8::EpiResid, pg8::StaticOrder, true, true>(F.lds + RING_OFF, g, S, E);
#endif
            }
            SEAM();
        }
    }
    if (IN(ph)) { FRESH(); norm_phase<true>(F, xp_, xs_, out_, 0, p_fin, XN_); }
#undef IN
#undef SEAM
}
constexpr int N_PHASES = 21;

extern "C" void kernel_launch(void* const* d_in, const int* in_sizes, int n_in, void* d_out, int out_size, void* d_ws, size_t ws_size, hipStream_t stream) {
    static int grid = 0;
    if (grid == 0) {
        if (n_in != 20 || in_sizes[0] != cfg::MP * cfg::DM || in_sizes[1] != cfg::MS * cfg::DM || out_size != cfg::M * cfg::DM || ws_size < WS_END) {
            fprintf(stderr, "kernel_launch: shape mismatch (n_in %d, in0 %d, in1 %d, out %d, ws %zu need %zu); nothing launched\n", n_in, n_in > 0 ? in_sizes[0] : -1, n_in > 1 ? in_sizes[1] : -1, out_size, ws_size, (size_t)WS_END); grid = -1; return; }
        int dev = 0, cus = 0, per_cu = 0;
        if (hipGetDevice(&dev) != hipSuccess || hipDeviceGetAttribute(&cus, hipDeviceAttributeMultiprocessorCount, dev) != hipSuccess) { fprintf(stderr, "kernel_launch: device query failed\n"); grid = -1; return; }
        if (hipFuncSetAttribute((const void*)mk_fwd, hipFuncAttributeMaxDynamicSharedMemorySize, LDS_BYTES) != hipSuccess) { fprintf(stderr, "kernel_launch: hipFuncSetAttribute failed\n"); grid = -1; return; }
        if (hipOccupancyMaxActiveBlocksPerMultiprocessor(&per_cu, (const void*)mk_fwd, NWAVES * 64, LDS_BYTES) != hipSuccess || per_cu < 1) {
            fprintf(stderr, "kernel_launch: occupancy query reports %d workgroups per CU; nothing launched\n", per_cu); (void)hipGetLastError(); grid = -1; return; }
        (void)hipGetLastError();
        grid = cus;
    }
    if (grid < 0) return;
    if (hipMemsetAsync((char*)d_ws + WS_CTL, 0, CTL_ZERO_BYTES, stream) != hipSuccess) { fprintf(stderr, "kernel_launch: memset failed\n"); return; }
    Args a{};
    for (int i = 0; i < 20; ++i) a.in[i] = (const float*)d_in[i];
    a.out = (float*)d_out; a.ws = (unsigned char*)d_ws;
#if MK_PER_PHASE
    for (int p = 0; p < N_PHASES; ++p) { a.ph_lo = p; a.ph_hi = p + 1; hipLaunchKernelGGL(mk_fwd, dim3(grid), dim3(NWAVES * 64), LDS_BYTES, stream, a); }
#else
    a.ph_lo = 0; a.ph_hi = N_PHASES;
    hipLaunchKernelGGL(mk_fwd, dim3(grid), dim3(NWAVES * 64), LDS_BYTES, stream, a);
#endif
    const hipError_t le = hipPeekAtLastError();
    if (le != hipSuccess) fprintf(stderr, "kernel_launch: launch failed: %s\n", hipGetErrorName(le));
}
```

```cpp
#include <hip/hip_runtime.h>
#include <cstdio>
#include <cstdint>

#ifndef MK_PER_PHASE
#define MK_PER_PHASE 0
#endif

namespace cfg {
constexpr int DM = 2048, DFF = 5632, NIN = 5376, NGU = 2 * DFF;
constexpr int TP = 16384, TS = 8192, MP = 2 * TP, MS = 2 * TS, M = MP + MS;
constexpr float EPS = 1e-6f;
constexpr float LOG2E = 1.4426950408889634f;
constexpr float C2 = 0.125f * LOG2E;
}
namespace pg8 {
#define PG8_LAS __attribute__((address_space(3)))
typedef unsigned short bf16_t;
typedef short bf16x8 __attribute__((ext_vector_type(8)));
typedef float f32x4 __attribute__((ext_vector_type(4)));
typedef unsigned u32x4 __attribute__((ext_vector_type(4)));
constexpr int BM = 256, BK = 64, HALF = 128, HTB = HALF * BK * 2  , STAGE_BYTES = 8 * HTB, NXCD = 8, WGM = 8;

__host__ __device__ __forceinline__ int lds_byte(int r, int c) { const int st = (r >> 4) * 2 + (c >> 5), rr = r & 15, cc = c & 31, ob = rr * 64 + cc * 2; return st * 1024 + (ob ^ (((ob >> 9) & 1) << 5)); }
__host__ __device__ __forceinline__ void stage_rc(int b, int& R, int& C) { const int st = b / 1024, sb = b % 1024, swz = sb ^ (((sb >> 9) & 1) << 5); R = (st >> 1) * 16 + swz / 64; C = (st & 1) * 32 + (swz % 64) / 2; }
__host__ __device__ __forceinline__ int perm32(int rho) { const int n = rho >> 4, i = rho & 15; return 8 * (i >> 2) + 4 * n + (i & 3); }

struct Unit { int pm, pn; };
struct Gemm { const bf16_t* A; const bf16_t* Bt; int M, N, K; };

struct StaticOrder {
    int nM, nN, nwg, G, c, wgm;
    __host__ __device__ void init(int M, int N, int G_, int c_, int wgm_ = WGM) { nM = M / BM; nN = N / BM; nwg = nM * nN; G = G_; c = c_; wgm = wgm_; }
    __host__ __device__ bool next(int i, Unit& u) const {
        const long L = (long)i * G + c; if (L >= nwg) return false;
        int wgid = (int)L; { const int q = nwg / NXCD, r = nwg % NXCD, xcd = wgid % NXCD, off = wgid / NXCD; wgid = (xcd < r ? xcd * (q + 1) : r * (q + 1) + (xcd - r) * q) + off; }
        const int nig = wgm * nN, gid = wgid / nig, fm = gid * wgm, gsz = (nM - fm) < wgm ? (nM - fm) : wgm;
        u.pm = fm + ((wgid % nig) % gsz); u.pn = (wgid % nig) / gsz; return true;
    }
    __device__ __forceinline__ void a_ready(const Unit&) const {}
    __device__ __forceinline__ void done(const Unit&) const {}
};

__device__ __forceinline__ unsigned cvt_pk_bf16(float lo, float hi) { unsigned r; asm volatile("v_cvt_pk_bf16_f32 %0, %1, %2" : "=v"(r) : "v"(lo), "v"(hi)); return r; }
typedef float f32x2 __attribute__((ext_vector_type(2)));

struct EpiSwiglu {
    static constexpr bool PERM = true, AFTER_DRAIN = false, PROBE_TWICE = true;
    bf16_t* H; const float* rss;
    __device__ __forceinline__ void operator()(const f32x4 (&acc)[2][2][4][2], const Unit& u, int wr, int wc, int fr, int fq) const {
        const int row0 = u.pm * BM + wr * 64 + fr, col0 = u.pn * 128 + wc * 32 + 8 * fq;
        float rv[2][4];
#pragma unroll
        for (int ai = 0; ai < 2; ++ai)
#pragma unroll
            for (int m = 0; m < 4; ++m) rv[ai][m] = rss[row0 + ai * HALF + m * 16];
#pragma unroll
        for (int ai = 0; ai < 2; ++ai)
#pragma unroll
            for (int m = 0; m < 4; ++m) {
                bf16_t* rowp = H + (unsigned)((row0 + ai * HALF + m * 16) * cfg::DFF + col0);
                const float rinv = __builtin_amdgcn_rsqf(rv[ai][m] * (1.0f / cfg::DM) + cfg::EPS);
                float hv[8];
#pragma unroll
                for (int n = 0; n < 2; ++n)
#pragma unroll
                    for (int j = 0; j < 4; ++j) {
                        const float g = acc[ai][0][m][n][j] * rinv, up = acc[ai][1][m][n][j] * rinv;
                        const float e = __builtin_amdgcn_exp2f(-g * cfg::LOG2E);
                        hv[n * 4 + j] = (g * up) * __builtin_amdgcn_rcpf(1.0f + e);
                    }
                u32x4 w; w.x = cvt_pk_bf16(hv[0], hv[1]); w.y = cvt_pk_bf16(hv[2], hv[3]); w.z = cvt_pk_bf16(hv[4], hv[5]); w.w = cvt_pk_bf16(hv[6], hv[7]);
                *(u32x4*)rowp = w;
                asm volatile("" ::: "memory");
            }
    }
};
struct EpiResid {
    static constexpr bool PERM = true, AFTER_DRAIN = false, PROBE_TWICE = false;
    const float* xp; const float* xs; float* out; int first; float alpha; bf16_t* XB; float* rssw;
    __device__ __forceinline__ void operator()(const f32x4 (&acc)[2][2][4][2], const Unit& u, int wr, int wc, int fr, int fq) const {
        const float* bb = first ? (u.pm < cfg::MP / BM ? xp + (size_t)u.pm * BM * cfg::DM : xs + (size_t)(u.pm - cfg::MP / BM) * BM * cfg::DM) : out + (size_t)u.pm * BM * cfg::DM;
        float* ob = out + (size_t)u.pm * BM * cfg::DM;
        const unsigned off0 = (unsigned)(wr * 64 + fr) * cfg::DM + (unsigned)(u.pn * BM + wc * 32 + 8 * fq);
        float sel[2] = {0.f, 0.f};
        f32x4 va[2][2], vb[2][2];
#define RES_LOAD(V, it_) do { const unsigned o_ = off0 + (unsigned)(((it_) >> 2) * HALF + ((it_) & 3) * 16) * cfg::DM; \
        _Pragma("unroll") for (int bj = 0; bj < 2; ++bj) _Pragma("unroll") for (int n = 0; n < 2; ++n) V[bj][n] = *(const f32x4*)(bb + o_ + bj * HALF + n * 4); } while (0)
#define RES_DO(V, it_) do { const int ai = (it_) >> 2, m = (it_) & 3; const unsigned off = off0 + (unsigned)(ai * HALF + m * 16) * cfg::DM; float ss = 0.f; \
        _Pragma("unroll") for (int bj = 0; bj < 2; ++bj) { const f32x4 o0 = V[bj][0] + acc[ai][bj][m][0] * alpha, o1 = V[bj][1] + acc[ai][bj][m][1] * alpha; \
            *(f32x4*)(ob + off + bj * HALF) = o0; *(f32x4*)(ob + off + bj * HALF + 4) = o1; \
            if (XB) { ss += (o0[0] * o0[0] + o0[1] * o0[1]) + (o0[2] * o0[2] + o0[3] * o0[3]) + (o1[0] * o1[0] + o1[1] * o1[1]) + (o1[2] * o1[2] + o1[3] * o1[3]); \
                u32x4 w; w.x = cvt_pk_bf16(o0[0], o0[1]); w.y = cvt_pk_bf16(o0[2], o0[3]); w.z = cvt_pk_bf16(o1[0], o1[1]); w.w = cvt_pk_bf16(o1[2], o1[3]); \
                *(u32x4*)(XB + (size_t)u.pm * BM * cfg::DM + off + bj * HALF) = w; } } \
        if (XB) { ss += __shfl_xor(ss, 16); ss += __shfl_xor(ss, 32); if (fq == m) sel[ai] = ss; } } while (0)
        RES_LOAD(va, 0);
#pragma unroll
        for (int it = 0; it < 8; it += 2) {
            RES_LOAD(vb, it + 1); RES_DO(va, it); asm volatile("" ::: "memory");
            if (it + 2 < 8) RES_LOAD(va, it + 2);
            RES_DO(vb, it + 1); asm volatile("" ::: "memory");
        }
#undef RES_LOAD
#undef RES_DO
        if (XB) {
#pragma unroll
            for (int ai = 0; ai < 2; ++ai) atomicAdd(rssw + u.pm * BM + wr * 64 + ai * HALF + fq * 16 + fr, sel[ai]);
        }
    }
};
struct EpiWin {
    static constexpr bool PERM = true, AFTER_DRAIN = false, PROBE_TWICE = false;
    bf16_t* QKV; const float* gq; const float* gk; const float* rss; unsigned* nrm2;
    __device__ __forceinline__ void operator()(const f32x4 (&acc)[2][2][4][2], const Unit& u, int wr, int wc, int fr, int fq) const {
        const int pn = u.pn;
        int kind = 0; float sc = 1.f;
        if (pn < 2) { kind = 1; sc = cfg::C2; }
        else if (pn == 2) { kind = (wc < 2) ? 2 : 0; }
        else if (pn == 3 || pn == 4 || pn == 9 || pn == 10 || pn == 15 || pn == 16) sc = cfg::C2;
        const int row0 = u.pm * BM + wr * 64 + fr;
        const int colb = pn * 256 + wc * 64 + 8 * fq;
        float rv[2][4];
#pragma unroll
        for (int ai = 0; ai < 2; ++ai)
#pragma unroll
            for (int m = 0; m < 4; ++m) rv[ai][m] = rss[row0 + ai * HALF + m * 16];
        if (kind == 0) {
            const bool want = (pn >= 3 && pn <= 6) || (pn >= 9 && pn <= 12) || (pn >= 15 && pn <= 18);
            float nmax = 0.f;
#pragma unroll
            for (int ai = 0; ai < 2; ++ai)
#pragma unroll
                for (int m = 0; m < 4; ++m) {
                    bf16_t* rowp = QKV + (unsigned)((row0 + ai * HALF + m * 16) * cfg::NIN + colb);
                    const float rs_ = __builtin_amdgcn_rsqf(rv[ai][m] * (1.0f / cfg::DM) + cfg::EPS) * sc;
                    float ss = 0.f;
#pragma unroll
                    for (int bj = 0; bj < 2; ++bj) { const f32x4 v0 = acc[ai][bj][m][0] * rs_, v1 = acc[ai][bj][m][1] * rs_;
                        ss += (v0[0] * v0[0] + v0[1] * v0[1]) + (v0[2] * v0[2] + v0[3] * v0[3]) + (v1[0] * v1[0] + v1[1] * v1[1]) + (v1[2] * v1[2] + v1[3] * v1[3]);
                        u32x4 w; w.x = cvt_pk_bf16(v0[0], v0[1]); w.y = cvt_pk_bf16(v0[2], v0[3]); w.z = cvt_pk_bf16(v1[0], v1[1]); w.w = cvt_pk_bf16(v1[2], v1[3]);
                        *(u32x4*)(rowp + 32 * bj) = w; }
                    if (want) { ss += __shfl_xor(ss, 16); ss += __shfl_xor(ss, 32); nmax = fmaxf(nmax, ss); }
                    asm volatile("" ::: "memory");
                }
            if (want) {
                float t = nmax;
                t = fmaxf(t, __shfl_xor(t, 1)); t = fmaxf(t, __shfl_xor(t, 2)); t = fmaxf(t, __shfl_xor(t, 4)); t = fmaxf(t, __shfl_xor(t, 8));
                const int rowt = u.pm * BM; const int seq = rowt < cfg::MP ? (rowt >> 14) : 2 + ((rowt - cfg::MP) >> 13);
                if ((fr | fq) == 0) atomicMax(nrm2 + (4 * pn + wc) * 4 + seq, __float_as_uint(t));
            }
        } else {
            const float* g = (kind == 1) ? gq : gk;
            float invrev[2][2];
#pragma unroll
            for (int n = 0; n < 2; ++n)
#pragma unroll
                for (int jj = 0; jj < 2; ++jj) invrev[n][jj] = __builtin_amdgcn_exp2f(-(float)(4 * fq + 2 * n + jj) * (13.287712379549449f / 16.0f)) * 0.15915494309189535f;
#pragma unroll
            for (int ai = 0; ai < 2; ++ai)
#pragma unroll
                for (int m = 0; m < 4; ++m) {
                    const int row = row0 + ai * HALF + m * 16;
                    const int t = (row < cfg::MP) ? (row & (cfg::TP - 1)) : (row & (cfg::TS - 1));
                    float prow = (float)(t >> 6), pcol = (float)(row & 63);
                    asm volatile("" : "+v"(prow), "+v"(pcol) :: "memory");
                    float ss = 0.f;
#pragma unroll
                    for (int bj = 0; bj < 2; ++bj)
#pragma unroll
                        for (int n = 0; n < 2; ++n) { const f32x4 v = acc[ai][bj][m][n]; ss += (v[0] * v[0] + v[1] * v[1]) + (v[2] * v[2] + v[3] * v[3]); }
                    ss += __shfl_xor(ss, 16); ss += __shfl_xor(ss, 32);
                    const float rw = __builtin_amdgcn_rsqf(rv[ai][m] * (1.0f / cfg::DM) + cfg::EPS);
                    const float rinv = rw * __builtin_amdgcn_rsqf(ss * rw * rw * (1.0f / 64.0f) + cfg::EPS);
                    bf16_t* rowp = QKV + (unsigned)(row * cfg::NIN + colb);
#pragma unroll
                    for (int bj = 0; bj < 2; ++bj) {
                        const float pos = bj ? pcol : prow;
                        float o[8];
#pragma unroll
                        for (int n = 0; n < 2; ++n) {
                            const f32x4 y = acc[ai][bj][m][n] * rinv * *(const f32x4*)(g + 32 * bj + 8 * fq + 4 * n);
#pragma unroll
                            for (int jj = 0; jj < 2; ++jj) {
                                const float rev = __builtin_amdgcn_fractf(pos * invrev[n][jj]);
                                const float sn = __builtin_amdgcn_sinf(rev), cs = __builtin_amdgcn_cosf(rev);
                                const float x1 = y[2 * jj], x2 = y[2 * jj + 1];
                                o[4 * n + 2 * jj] = (x1 * cs - x2 * sn) * sc; o[4 * n + 2 * jj + 1] = (x1 * sn + x2 * cs) * sc;
                            }
                        }
                        u32x4 w; w.x = cvt_pk_bf16(o[0], o[1]); w.y = cvt_pk_bf16(o[2], o[3]); w.z = cvt_pk_bf16(o[4], o[5]); w.w = cvt_pk_bf16(o[6], o[7]);
                        *(u32x4*)(rowp + 32 * bj) = w;
                        asm volatile("" ::: "memory");
                    }
                }
        }
    }
};

template <class Epi, class Sched, bool ALIGN_EPI = false, bool SP2 = false>
__device__ __forceinline__ void gemm_phase(PG8_LAS unsigned char* lds, const Gemm g, const Sched& S, const Epi& E) {
    int tid_ = threadIdx.x; asm volatile("" : "+v"(tid_));
    const int tid = tid_, wid = __builtin_amdgcn_readfirstlane(tid >> 6), lane = tid & 63, wr = wid >> 2, wc = wid & 3, fr = lane & 15, fq = lane >> 4;
    const int K = g.K, nt = K / BK;
    unsigned voffA[2], voffB[2];
#pragma unroll
    for (int i = 0; i < 2; ++i) { int R, C; stage_rc(tid * 16 + i * 8192, R, C); const int Rb = Epi::PERM ? ((R & ~31) + perm32(R & 31)) : R;
        voffA[i] = (unsigned)(R * K + C) * 2u; voffB[i] = (unsigned)(Rb * K + C) * 2u; }
    const size_t kstep = (size_t)(BK * 2);
    const size_t hstep = (size_t)HALF * K * 2;
    const size_t tstep = 2 * hstep;
    const unsigned ldsw = (unsigned)wid * 1024u;
    const int aoff = lds_byte(wr * 64 + fr, fq * 8), boff = lds_byte(wc * 32 + fr, fq * 8);
#define PG8_SA(b, h) (((b) * 2 + (h)) * HTB)
#define PG8_SB(b, h) ((4 + (b) * 2 + (h)) * HTB)
#define PG8_STAGE(bufoff, gbase, voff) do { _Pragma("unroll") for (int _i = 0; _i < 2; ++_i) \
        __builtin_amdgcn_global_load_lds((const unsigned*)((const char*)(gbase) + (voff)[_i]), (PG8_LAS unsigned*)(lds + (bufoff) + ldsw + _i * 8192), 16, 0, 0); } while (0)
#define PG8_LDA(dst, b, h) do { _Pragma("unroll") for (int m = 0; m < 4; ++m) _Pragma("unroll") for (int k = 0; k < 2; ++k) dst[m][k] = *(const PG8_LAS bf16x8*)(lds + PG8_SA(b, h) + aoff + m * 2048 + k * 1024); } while (0)
#define PG8_LDB(dst, b, h) do { _Pragma("unroll") for (int n = 0; n < 2; ++n) _Pragma("unroll") for (int k = 0; k < 2; ++k) dst[n][k] = *(const PG8_LAS bf16x8*)(lds + PG8_SB(b, h) + boff + n * 2048 + k * 1024); } while (0)
#define PG8_MMA(ai, bj, At, Bt) do { __builtin_amdgcn_s_setprio(1); _Pragma("unroll") for (int m = 0; m < 4; ++m) _Pragma("unroll") for (int n = 0; n < 2; ++n) _Pragma("unroll") for (int k = 0; k < 2; ++k) \
        acc[ai][bj][m][n] = __builtin_amdgcn_mfma_f32_16x16x32_bf16(Bt[n][k], At[m][k], acc[ai][bj][m][n], 0, 0, 0); __builtin_amdgcn_s_setprio(0); } while (0)
#define PG8_WAIT_V(n) asm volatile("s_waitcnt vmcnt(" #n ")" ::: "memory")
#define PG8_WAIT_L(n) asm volatile("s_waitcnt lgkmcnt(" #n ")" ::: "memory")
#define PG8_BAR __builtin_amdgcn_s_barrier()
#define PG8_SCHED __builtin_amdgcn_sched_barrier(0)
    Unit cur, nxt; int ui = 0;
    if (!S.next(0, cur)) return;
    f32x4 acc[2][2][4][2];
#pragma unroll
    for (int a = 0; a < 2; ++a)
#pragma unroll
        for (int b = 0; b < 2; ++b)
#pragma unroll
            for (int m = 0; m < 4; ++m)
#pragma unroll
                for (int n = 0; n < 2; ++n) acc[a][b][m][n] = (f32x4){0.f, 0.f, 0.f, 0.f};
    bf16x8 At[4][2], B0[2][2], B1[2][2];
    const char* cA = (const char*)g.A + (size_t)cur.pm * tstep; const char* cB = (const char*)g.Bt + (size_t)cur.pn * tstep;
    S.a_ready(cur);
    if constexpr (SP2) {
        PG8_STAGE(PG8_SB(0, 0), cB, voffB); PG8_STAGE(PG8_SB(0, 1), cB + hstep, voffB); PG8_STAGE(PG8_SA(0, 0), cA, voffA); PG8_STAGE(PG8_SA(0, 1), cA + hstep, voffA);
        if (wr == 1) PG8_BAR;
        PG8_WAIT_V(2); PG8_BAR;
        PG8_STAGE(PG8_SB(1, 0), cB + kstep, voffB); PG8_STAGE(PG8_SA(1, 0), cA + kstep, voffA); PG8_STAGE(PG8_SB(1, 1), cB + hstep + kstep, voffB);
        PG8_WAIT_V(6); PG8_BAR;
    } else {
        PG8_STAGE(PG8_SB(0, 0), cB, voffB); PG8_STAGE(PG8_SA(0, 0), cA, voffA); PG8_STAGE(PG8_SB(0, 1), cB + hstep, voffB); PG8_STAGE(PG8_SA(0, 1), cA + hstep, voffA);
        if (wr == 1) PG8_BAR;
        PG8_WAIT_V(4); PG8_BAR;
        PG8_STAGE(PG8_SB(1, 0), cB + kstep, voffB); PG8_STAGE(PG8_SA(1, 0), cA + kstep, voffA); PG8_STAGE(PG8_SB(1, 1), cB + hstep + kstep, voffB);
        PG8_WAIT_V(6); PG8_BAR;
    }
    for (;;) {
        const bool has_next = S.next(ui + 1, nxt);
        const char* nA = has_next ? (const char*)g.A + (size_t)nxt.pm * tstep : cA; const char* nB = has_next ? (const char*)g.Bt + (size_t)nxt.pn * tstep : cB;
        for (int t = 0; t < nt; t += 2) {
            const bool last = (t == nt - 2);
            const char* a1 = cA + (size_t)(t + 1) * kstep;
            const char* a2 = last ? nA : cA + (size_t)(t + 2) * kstep; const char* b2 = last ? nB : cB + (size_t)(t + 2) * kstep;
            const char* a3 = a2 + kstep; const char* b3 = b2 + kstep;
            if (last && has_next) S.a_ready(nxt);
            if constexpr (SP2) {
            PG8_LDB(B0, 0, 0); PG8_LDB(B1, 0, 1); PG8_SCHED; PG8_LDA(At, 0, 0); PG8_STAGE(PG8_SA(1, 1), a1 + hstep, voffA);
            PG8_WAIT_V(8); PG8_WAIT_L(0); PG8_BAR; PG8_MMA(0, 0, At, B0); PG8_MMA(0, 1, At, B1); PG8_BAR; PG8_SCHED;
            PG8_LDA(At, 0, 1); PG8_STAGE(PG8_SB(0, 0), b2, voffB); PG8_STAGE(PG8_SB(0, 1), b2 + hstep, voffB); PG8_STAGE(PG8_SA(0, 0), a2, voffA);
            PG8_WAIT_V(8); PG8_WAIT_L(0); PG8_BAR; PG8_MMA(1, 0, At, B0); PG8_MMA(1, 1, At, B1); PG8_BAR; PG8_SCHED;
            PG8_LDB(B0, 1, 0); PG8_LDB(B1, 1, 1); PG8_SCHED; PG8_LDA(At, 1, 0); PG8_STAGE(PG8_SA(0, 1), a2 + hstep, voffA);
            PG8_WAIT_V(8); PG8_WAIT_L(0); PG8_BAR; PG8_MMA(0, 0, At, B0); PG8_MMA(0, 1, At, B1); PG8_BAR; PG8_SCHED;
            PG8_LDA(At, 1, 1); PG8_STAGE(PG8_SB(1, 0), b3, voffB); PG8_STAGE(PG8_SB(1, 1), b3 + hstep, voffB); PG8_STAGE(PG8_SA(1, 0), a3, voffA);
            PG8_WAIT_V(8); PG8_WAIT_L(0); PG8_BAR; PG8_MMA(1, 0, At, B0); PG8_MMA(1, 1, At, B1); PG8_BAR; PG8_SCHED;
            } else {
            PG8_LDB(B0, 0, 0); PG8_SCHED; PG8_LDA(At, 0, 0); PG8_STAGE(PG8_SA(1, 1), a1 + hstep, voffA);
            PG8_WAIT_L(8); PG8_BAR; PG8_WAIT_L(0); PG8_MMA(0, 0, At, B0); PG8_BAR; PG8_SCHED;
            PG8_LDB(B1, 0, 1); PG8_STAGE(PG8_SB(0, 0), b2, voffB);
            PG8_BAR; PG8_WAIT_L(0); PG8_MMA(0, 1, At, B1); PG8_BAR;
            PG8_LDA(At, 0, 1); PG8_STAGE(PG8_SA(0, 0), a2, voffA);
            PG8_BAR; PG8_WAIT_L(0); PG8_MMA(1, 0, At, B0); PG8_BAR; PG8_SCHED;
            PG8_STAGE(PG8_SB(0, 1), b2 + hstep, voffB);
            PG8_WAIT_V(6); PG8_BAR; PG8_MMA(1, 1, At, B1); PG8_BAR;
            PG8_LDB(B0, 1, 0); PG8_SCHED; PG8_LDA(At, 1, 0); PG8_STAGE(PG8_SA(0, 1), a2 + hstep, voffA);
            PG8_WAIT_L(8); PG8_BAR; PG8_WAIT_L(0); PG8_MMA(0, 0, At, B0); PG8_BAR; PG8_SCHED;
            PG8_LDB(B1, 1, 1); PG8_STAGE(PG8_SB(1, 0), b3, voffB);
            PG8_BAR; PG8_WAIT_L(0); PG8_MMA(0, 1, At, B1); PG8_BAR;
            PG8_LDA(At, 1, 1); PG8_STAGE(PG8_SA(1, 0), a3, voffA);
            PG8_BAR; PG8_WAIT_L(0); PG8_MMA(1, 0, At, B0); PG8_BAR; PG8_SCHED;
            PG8_STAGE(PG8_SB(1, 1), b3 + hstep, voffB);
            PG8_WAIT_V(6); PG8_BAR; PG8_MMA(1, 1, At, B1); PG8_BAR;
            }
        }
        if constexpr (ALIGN_EPI) { if (wr == 0) PG8_BAR; }
        if constexpr (!Epi::AFTER_DRAIN) { E(acc, cur, wr, wc, fr, fq);
#if defined(PROBE_EPI2)
            if constexpr (Epi::PROBE_TWICE) { asm volatile("" ::: "memory"); E(acc, cur, wr, wc, fr, fq); }
#endif
            S.done(cur); }
        if (!has_next) break;
#pragma unroll
        for (int a = 0; a < 2; ++a)
#pragma unroll
            for (int b = 0; b < 2; ++b)
#pragma unroll
                for (int m = 0; m < 4; ++m)
#pragma unroll
                    for (int n = 0; n < 2; ++n) acc[a][b][m][n] = (f32x4){0.f, 0.f, 0.f, 0.f};
        cur = nxt; cA = nA; cB = nB; ++ui;
        if constexpr (ALIGN_EPI) { if (wr == 1) PG8_BAR; }
    }
    PG8_WAIT_V(0);
    if constexpr (!ALIGN_EPI) { if (wr == 0) PG8_BAR; }
    PG8_BAR;
    if constexpr (Epi::AFTER_DRAIN) { E.fused(acc, cur, wr, wc, fr, fq, lds, wid, lane); S.done(cur); }
#undef PG8_SA
#undef PG8_SB
#undef PG8_STAGE
#undef PG8_LDA
#undef PG8_LDB
#undef PG8_MMA
#undef PG8_WAIT_V
#undef PG8_WAIT_L
#undef PG8_BAR
#undef PG8_SCHED
}
}
namespace att {
#define ATT_LAS __attribute__((address_space(3)))
using bf16x8 = __attribute__((ext_vector_type(8))) short;
using s16x4  = __attribute__((ext_vector_type(4))) short;
using f32x16 = __attribute__((ext_vector_type(16))) float;
using u32x4  = __attribute__((ext_vector_type(4))) unsigned;
typedef unsigned short bf16_t;
typedef ATT_LAS char* lptr;
constexpr int PITCH = cfg::NIN, OPITCH = cfg::DM;
constexpr float LOG2E = cfg::LOG2E, NEG = -1e30f, THR = 8.f;
constexpr int L_K = 0, L_V = 32768, L_WS = 65536, L_LUT = 67584, L_OST = 81920, L_END = 114688;
constexpr int LUTB_R = 704, LUTD_R = 1344;
#define ATT_SBAR() __builtin_amdgcn_sched_barrier(0)
__device__ __forceinline__ int crow(int r, int hi) { return (r & 3) + 8 * (r >> 2) + 4 * hi; }
__device__ __forceinline__ unsigned cvtpk(float lo, float hi) { unsigned r; asm volatile("v_cvt_pk_bf16_f32 %0, %1, %2" : "=v"(r) : "v"(lo), "v"(hi)); return r; }
__device__ __forceinline__ float wave_sum(float v) {
#pragma unroll
    for (int o = 1; o < 64; o <<= 1) v += __shfl_xor(v, o);
    return v;
}
__device__ __forceinline__ int t5_bucket(int rel) {
    const int n = rel < 0 ? -rel : rel;
    int b = n;
    if (n >= 8) b = 8 + (n >= 15) + (n >= 27) + (n >= 50) + (n >= 91) + (n >= 166) + (n >= 305) + (n >= 559);
    return b + (rel > 0 ? 16 : 0);
}
template <int KC> __device__ __forceinline__ int kswz(int row, int colB) { return KC == 128 ? row * 256 + (colB ^ ((row & 7) << 4)) : row * 128 + (colB ^ (((row >> 1) & 7) << 4)); }
template <int NCB> __device__ __forceinline__ int v_st(int k, int c) { const int kk = (k & ~0xC) | ((k & 4) << 1) | ((k & 8) >> 1); return ((kk >> 3) * NCB + (c >> 5)) * 512 + ((kk & 7) * 32 + (c & 31)) * 2; }
__device__ __forceinline__ int v_rd_base(int lane) { return ((lane & 3) << 3) | (((lane >> 2) & 3) << 6) | (((lane >> 4) & 1) << 5) | (((lane >> 5) & 1) << 8); }
template <int OFF> __device__ __forceinline__ s16x4 tr_read(int vb) { s16x4 r; asm volatile("ds_read_b64_tr_b16 %0, %1 offset:%2" : "=&v"(r) : "v"(vb), "i"(OFF) : "memory"); return r; }
template <int NCB, int D0> __device__ __forceinline__ void pv_one(f32x16& od, int vb, bf16x8 pa0, bf16x8 pa1, bf16x8 pa2, bf16x8 pa3) {
#define ATT_VOFF(ks, half) (D0 * 512 + (ks) * (NCB * 1024) + (half) * (NCB * 512))
    const s16x4 l0 = tr_read<ATT_VOFF(0, 0)>(vb), h0 = tr_read<ATT_VOFF(0, 1)>(vb), l1 = tr_read<ATT_VOFF(1, 0)>(vb), h1 = tr_read<ATT_VOFF(1, 1)>(vb);
    const s16x4 l2 = tr_read<ATT_VOFF(2, 0)>(vb), h2 = tr_read<ATT_VOFF(2, 1)>(vb), l3 = tr_read<ATT_VOFF(3, 0)>(vb), h3 = tr_read<ATT_VOFF(3, 1)>(vb);
#undef ATT_VOFF
    asm volatile("s_waitcnt lgkmcnt(0)" ::: "memory"); ATT_SBAR();
#define ATT_PK(L, H) (bf16x8){L[0], L[1], L[2], L[3], H[0], H[1], H[2], H[3]}
    od = __builtin_amdgcn_mfma_f32_32x32x16_bf16(pa0, ATT_PK(l0, h0), od, 0, 0, 0);
    od = __builtin_amdgcn_mfma_f32_32x32x16_bf16(pa1, ATT_PK(l1, h1), od, 0, 0, 0);
    od = __builtin_amdgcn_mfma_f32_32x32x16_bf16(pa2, ATT_PK(l2, h2), od, 0, 0, 0);
    od = __builtin_amdgcn_mfma_f32_32x32x16_bf16(pa3, ATT_PK(l3, h3), od, 0, 0, 0);
#undef ATT_PK
}
template <int NCB, bool ONES> __device__ __forceinline__ void pv_all(f32x16* o, f32x16& lacc, int vb, bf16x8 pa0, bf16x8 pa1, bf16x8 pa2, bf16x8 pa3) {
    if constexpr (ONES) { const bf16x8 ones = {0x3F80, 0x3F80, 0x3F80, 0x3F80, 0x3F80, 0x3F80, 0x3F80, 0x3F80};
        lacc = __builtin_amdgcn_mfma_f32_32x32x16_bf16(pa0, ones, lacc, 0, 0, 0); lacc = __builtin_amdgcn_mfma_f32_32x32x16_bf16(pa1, ones, lacc, 0, 0, 0);
        lacc = __builtin_amdgcn_mfma_f32_32x32x16_bf16(pa2, ones, lacc, 0, 0, 0); lacc = __builtin_amdgcn_mfma_f32_32x32x16_bf16(pa3, ones, lacc, 0, 0, 0); }
    pv_one<NCB, 0>(o[0], vb, pa0, pa1, pa2, pa3); pv_one<NCB, 1>(o[1], vb, pa0, pa1, pa2, pa3);
    if constexpr (NCB == 4) { pv_one<NCB, 2>(o[2], vb, pa0, pa1, pa2, pa3); pv_one<NCB, 3>(o[3], vb, pa0, pa1, pa2, pa3); }
}
template <bool NOMAX> __device__ __forceinline__ void partialSM(f32x16& p0, f32x16& p1, float cb, float& m_reg, float& alpha) {
    if constexpr (NOMAX) { alpha = 1.f;
        (void)cb;
#pragma unroll
        for (int r = 0; r < 16; ++r) p0[r] = __builtin_amdgcn_exp2f(p0[r]);
        return; }
    float ma = fmaxf(p0[0], p0[1]), mb = fmaxf(p0[2], p0[3]), mc = fmaxf(p1[0], p1[1]), md = fmaxf(p1[2], p1[3]);
#pragma unroll
    for (int r = 4; r < 16; r += 4) { ma = fmaxf(fmaxf(ma, p0[r]), p0[r + 1]); mb = fmaxf(fmaxf(mb, p0[r + 2]), p0[r + 3]); mc = fmaxf(fmaxf(mc, p1[r]), p1[r + 1]); md = fmaxf(fmaxf(md, p1[r + 2]), p1[r + 3]); }
    float pmax = fmaxf(fmaxf(ma, mb), fmaxf(mc, md));
    { auto rr = __builtin_amdgcn_permlane32_swap(__float_as_uint(pmax), __float_as_uint(pmax), false, false); pmax = fmaxf(__uint_as_float(rr[0]), __uint_as_float(rr[1])); }
    pmax += cb;
    float mn;
    if (__builtin_expect(__all(pmax - m_reg <= THR), 1)) { mn = m_reg; alpha = 1.f; }
    else { mn = fmaxf(m_reg, pmax); alpha = __builtin_amdgcn_exp2f(m_reg - mn); m_reg = mn; }
    const float sub = cb - mn;
#pragma unroll
    for (int r = 0; r < 16; ++r) p0[r] += sub;
#pragma unroll
    for (int r = 0; r < 16; ++r) p1[r] += sub;
#pragma unroll
    for (int r = 0; r < 16; ++r) p0[r] = __builtin_amdgcn_exp2f(p0[r]);
}
template <bool ONES> __device__ __forceinline__ void finishSM(f32x16& p0, f32x16& p1, float alpha, float& l_reg, bf16x8& pa0, bf16x8& pa1, bf16x8& pa2, bf16x8& pa3) {
#pragma unroll
    for (int r = 0; r < 16; ++r) p1[r] = __builtin_amdgcn_exp2f(p1[r]);
    if constexpr (!ONES) {
    float sa = p0[0] + p0[1], sb = p0[2] + p0[3], sc_ = p1[0] + p1[1], sd = p1[2] + p1[3];
#pragma unroll
    for (int r = 4; r < 16; r += 4) { sa += p0[r]; sa += p0[r + 1]; sb += p0[r + 2]; sb += p0[r + 3]; sc_ += p1[r]; sc_ += p1[r + 1]; sd += p1[r + 2]; sd += p1[r + 3]; }
    float ps = (sa + sb) + (sc_ + sd);
    { auto rr = __builtin_amdgcn_permlane32_swap(__float_as_uint(ps), __float_as_uint(ps), false, false); ps = __uint_as_float(rr[0]) + __uint_as_float(rr[1]); }
    l_reg = l_reg * alpha + ps;
    }
#define ATT_PK4(P, BASE, OUT) do { unsigned a0 = cvtpk(P[BASE + 0], P[BASE + 1]), a1 = cvtpk(P[BASE + 2], P[BASE + 3]);   \
    unsigned b0 = cvtpk(P[BASE + 4], P[BASE + 5]), b1 = cvtpk(P[BASE + 6], P[BASE + 7]);                              \
    auto r0 = __builtin_amdgcn_permlane32_swap(a0, b0, false, false); auto r1 = __builtin_amdgcn_permlane32_swap(a1, b1, false, false); \
    u32x4 w = {r0[0], r1[0], r0[1], r1[1]}; OUT = __builtin_bit_cast(bf16x8, w); } while (0)
    ATT_PK4(p0, 0, pa0); ATT_PK4(p0, 8, pa1); ATT_PK4(p1, 0, pa2); ATT_PK4(p1, 8, pa3);
#undef ATT_PK4
}
template <int KC, bool USEC> __device__ __forceinline__ void qkt(f32x16& p0, f32x16& p1, lptr Ks, int cb0, const bf16x8* qr, const f32x16& c0, int r32, int hi) {
    if constexpr (!USEC) { p0 = f32x16{}; p1 = f32x16{}; }
#pragma unroll
    for (int d0 = 0; d0 < 4; ++d0) { const int cb = cb0 + d0 * 32 + hi * 16;
        const bf16x8 b0 = *(const ATT_LAS bf16x8*)(Ks + kswz<KC>(r32, cb));
        const bf16x8 b1 = *(const ATT_LAS bf16x8*)(Ks + kswz<KC>(32 + r32, cb));
        if (USEC && d0 == 0) { p0 = __builtin_amdgcn_mfma_f32_32x32x16_bf16(b0, qr[0], c0, 0, 0, 0); p1 = __builtin_amdgcn_mfma_f32_32x32x16_bf16(b1, qr[0], c0, 0, 0, 0); }
        else { p0 = __builtin_amdgcn_mfma_f32_32x32x16_bf16(b0, qr[d0], p0, 0, 0, 0); p1 = __builtin_amdgcn_mfma_f32_32x32x16_bf16(b1, qr[d0], p1, 0, 0, 0); } }
}
struct Aux { const float* t5; const float* rpb; const float* lam_p; const float* subln; float lam_init; };

template <int MODE, bool NOMAX = false>
__device__ __forceinline__ void attn_unit(const bf16_t* __restrict__ QKV, bf16_t* __restrict__ ATT, lptr lds, int row0, int T, int h, int qb, const Aux& ax) {
#ifndef ATT_ONES
#define ATT_ONES 1
#endif
    constexpr bool ONES = (ATT_ONES != 0) && (MODE != 1);
    constexpr int KC = (MODE == 1) ? 128 : 64, DV = (MODE == 1) ? 128 : 64, NCB = DV / 32, NR = KC / 64;
    constexpr int KBYTES = 64 * KC * 2, VBYTES = 64 * DV * 2, QROWS = (MODE == 1) ? 128 : 256;
    int tid_ = threadIdx.x; asm volatile("" : "+v"(tid_));
    const int tid = tid_, lane = tid & 63, r32 = lane & 31, hi = lane >> 5;
    const int wid = __builtin_amdgcn_readfirstlane(tid >> 6);
    const int map = (MODE == 1) ? (wid >> 2) : 0, wq = (MODE == 1) ? (wid & 3) : wid;
    const int q0 = qb * QROWS, qw = q0 + wq * 32, qpos = qw + r32;
    int qcol, kcol, vcol, ocol;
    if (MODE == 0)      { qcol = 64 * h;          kcol = 512 + 64 * (h >> 2); vcol = 640 + 64 * (h >> 2); ocol = 64 * h; }
    else if (MODE == 1) { qcol = 768 + 128 * h + 64 * map; kcol = 1280 + 128 * h; vcol = 1792 + 128 * h; ocol = 512 + 128 * h; }
    else if (MODE == 2) { qcol = 2304 + 64 * h;   kcol = 2816 + 64 * h;       vcol = 3328 + 64 * h;       ocol = 1024 + 64 * h; }
    else                { qcol = 3840 + 64 * h;   kcol = 4352 + 64 * h;       vcol = 4864 + 64 * h;       ocol = 1536 + 64 * h; }
    int tlo = 0, NT = T >> 6;
    if (MODE == 3) { int lo = q0 - 1024; lo = lo < 0 ? 0 : lo; int hi_k = q0 + 255 + 1024; hi_k = hi_k > T - 1 ? T - 1 : hi_k; int a = lo >> 6, b = hi_k >> 6;
        if (((b - a + 1) & 1) != 0) { if (a > 0) --a; else ++b; } tlo = a; NT = b - a + 1; }
    if (MODE == 2) { const int rows = T >> 6, R0 = 4 * qb; int a = R0 - 4; a = a < 0 ? 0 : (a > rows - 8 ? rows - 8 : a); int b = R0 - 1; b = b < 0 ? 0 : (b > rows - 8 ? rows - 8 : b); b += 7;
        if (((b - a + 1) & 1) != 0) { if (a > 0) --a; else ++b; } tlo = a; NT = b - a + 1; }
    ATT_LAS float* lut = (ATT_LAS float*)(lds + L_LUT);
    if (MODE == 1) { for (int i = tid; i < 2 * LUTB_R + 1; i += 512) lut[i] = ax.t5[t5_bucket(i - LUTB_R) * 12 + h] * LOG2E; }
    if (MODE == 3) { for (int i = tid; i < 2 * LUTD_R + 1; i += 512) { const int rel = i - LUTD_R, n = rel < 0 ? -rel : rel;
            const int mult = (n <= 64 ? 1 : 0) + (((n & 3) == 0 && n <= 256) ? 1 : 0) + (((n & 15) == 0 && n <= 1024) ? 1 : 0);
            lut[i] = mult == 0 ? NEG : ax.t5[t5_bucket(rel) * 12 + 4 + h] * LOG2E + (mult == 1 ? 0.f : (mult == 2 ? 1.f : 1.5849625007211562f)); } }
    if (MODE == 2) { for (int i = tid; i < 15 * 128; i += 512) { const int dr = i >> 7, dc = (i & 127) - 48; lut[i] = (dc >= 0 && dc <= 30) ? ax.rpb[(h * 15 + dr) * 31 + dc] * LOG2E : NEG; } }
    bf16x8 qr[4];
    { const bf16_t* Qw = QKV + (size_t)(row0 + qpos) * PITCH + qcol + hi * 8;
#pragma unroll
      for (int d0 = 0; d0 < 4; ++d0) qr[d0] = *(const bf16x8*)(Qw + d0 * 16); }
    const int sr = (KC == 128) ? (tid >> 4) : (tid >> 3), sc = (KC == 128) ? (tid & 15) * 8 : (tid & 7) * 8;
    const bf16_t* Kg = QKV + (size_t)(row0 + sr) * PITCH + kcol + sc;
    const bf16_t* Vg = QKV + (size_t)(row0 + sr) * PITCH + vcol + sc;
    const int kst0 = kswz<KC>(sr, sc * 2), kst1 = kswz<KC>(32 + sr, sc * 2), vst0 = v_st<NCB>(sr, sc), vst1 = v_st<NCB>(32 + sr, sc);
    const lptr K_lds = lds + L_K, V_lds = lds + L_V;
    const int vb0 = (int)(uintptr_t)V_lds + v_rd_base(lane);
    ATT_LAS float* wsf = (ATT_LAS float*)(lds + L_WS) + wid * 64; ATT_LAS float* li_l = wsf; ATT_LAS float* al_l = wsf + 32;
    struct { bf16x8 k[NR], v[NR]; } st_[2];
#define SLOAD(i, tt) do { const size_t ro_ = (size_t)((tlo + (tt)) * 64) * PITCH; st_[i].k[0] = *(const bf16x8*)(Kg + ro_); st_[i].v[0] = *(const bf16x8*)(Vg + ro_); \
        if constexpr (NR == 2) { st_[i].k[1] = *(const bf16x8*)(Kg + ro_ + (size_t)32 * PITCH); st_[i].v[1] = *(const bf16x8*)(Vg + ro_ + (size_t)32 * PITCH); } } while (0)
#define SWRITE(b, i) do { *(ATT_LAS bf16x8*)(K_lds + (b) * KBYTES + kst0) = st_[i].k[0]; *(ATT_LAS bf16x8*)(V_lds + (b) * VBYTES + vst0) = st_[i].v[0]; \
        if constexpr (NR == 2) { *(ATT_LAS bf16x8*)(K_lds + (b) * KBYTES + kst1) = st_[i].k[1]; *(ATT_LAS bf16x8*)(V_lds + (b) * VBYTES + vst1) = st_[i].v[1]; } } while (0)
#define SWAIT() do { if constexpr (NR == 2) asm volatile("s_waitcnt vmcnt(4)" ::: "memory"); else asm volatile("s_waitcnt vmcnt(2)" ::: "memory"); } while (0)
#define RESC(a) do { if (!NOMAX && __any((a) < 1.f)) { if (hi == 0) al_l[r32] = (a); asm volatile("s_waitcnt lgkmcnt(0)" ::: "memory"); \
        _Pragma("unroll") for (int r = 0; r < 16; ++r) { const float f_ = al_l[crow(r, hi)]; if (ONES) lacc[r] *= f_; _Pragma("unroll") for (int d = 0; d < NCB; ++d) o[d][r] *= f_; } } } while (0)
    float cL = 0.f, cR = 0.f; int c_cs = 0, c_rs = 0, c_R = 0, c_c = 0;
    if (MODE == 2) { const int rows = T >> 6; c_R = 4 * qb + (wid >> 1); c_c = 32 * (wid & 1) + r32; c_cs = c_c - 8; c_cs = c_cs < 0 ? 0 : (c_cs > 48 ? 48 : c_cs); c_rs = c_R - 4; c_rs = c_rs < 0 ? 0 : (c_rs > rows - 8 ? rows - 8 : c_rs); }
#define MODIFY(P0, P1, tt, CB) do { CB = 0.f; const int k0_ = (tlo + (tt)) * 64; \
        if constexpr (MODE == 1) { if (k0_ + 63 - qw <= -559) CB = cL; else if (k0_ - qw - 31 >= 559) CB = cR; else { const ATT_LAS float* lp_ = lut + (k0_ - qpos + LUTB_R + 4 * hi); \
            _Pragma("unroll") for (int r = 0; r < 16; ++r) { P0[r] += lp_[(r & 3) + 8 * (r >> 2)]; P1[r] += lp_[32 + (r & 3) + 8 * (r >> 2)]; } } } \
        if constexpr (MODE == 3) { const ATT_LAS float* lp_ = lut + (k0_ - qpos + LUTD_R + 4 * hi); \
            _Pragma("unroll") for (int r = 0; r < 16; ++r) { P0[r] += lp_[(r & 3) + 8 * (r >> 2)]; P1[r] += lp_[32 + (r & 3) + 8 * (r >> 2)]; } } \
        if constexpr (MODE == 2) { const int kr_ = tlo + (tt); if (kr_ < c_rs || kr_ > c_rs + 7) { _Pragma("unroll") for (int r = 0; r < 16; ++r) { P0[r] = NEG; P1[r] = NEG; } } \
            else { const ATT_LAS float* lp_ = lut + ((kr_ - c_R + 7) * 128 + 48 + 15 - c_c + 4 * hi); const int kb_ = 4 * hi - c_cs; \
              _Pragma("unroll") for (int r = 0; r < 16; ++r) { const int ko_ = (r & 3) + 8 * (r >> 2); const float a_ = lp_[ko_], b_ = lp_[32 + ko_]; \
                P0[r] = ((unsigned)(kb_ + ko_) <= 15u) ? P0[r] + a_ : NEG; P1[r] = ((unsigned)(kb_ + 32 + ko_) <= 15u) ? P1[r] + b_ : NEG; } } } \
    } while (0)
    __syncthreads();
    if (MODE == 1) { cL = lut[0]; cR = lut[2 * LUTB_R]; }
    constexpr bool USEC = false;
    float m_reg = NEG, l_reg = 0.f, cbcur = 0.f, cbacc = 0.f; f32x16 o[NCB], lacc = f32x16{}, cbt = f32x16{};
#define REGSC(CB) do { if constexpr (MODE == 1 && NOMAX) { if ((CB) != cbacc) { const float f_ = __builtin_amdgcn_exp2f(cbacc - (CB)); cbacc = (CB); l_reg *= f_; \
        _Pragma("unroll") for (int r = 0; r < 16; ++r) { if (ONES) lacc[r] *= f_; _Pragma("unroll") for (int d = 0; d < NCB; ++d) o[d][r] *= f_; } } } } while (0)
#define REGIONC(tt) do { if constexpr (USEC) { const int k0_ = (tlo + (tt)) * 64; const float cb_ = (k0_ + 63 - qw <= -559) ? cL : ((k0_ - qw - 31 >= 559) ? cR : 0.f); \
        if (cb_ != cbcur) { cbcur = cb_; _Pragma("unroll") for (int r = 0; r < 16; ++r) cbt[r] = cb_; } } } while (0)
#pragma unroll
    for (int d = 0; d < NCB; ++d) o[d] = f32x16{};
    f32x16 pA0, pA1, pB0, pB1; float alA, alB, cbA, cbB; bf16x8 pa0, pa1, pa2, pa3;
    const int cb0 = map * 128;
    SLOAD(0, 0); asm volatile("s_waitcnt vmcnt(0)" ::: "memory"); SWRITE(0, 0); __syncthreads();
    REGIONC(0); qkt<KC, USEC>(pA0, pA1, K_lds, cb0, qr, cbt, r32, hi); MODIFY(pA0, pA1, 0, cbA); partialSM<NOMAX>(pA0, pA1, cbA, m_reg, alA);
    SLOAD(1, 1); if (2 < NT) SLOAD(0, 2);
    SWAIT(); SWRITE(1, 1); __syncthreads();
    for (int j = 1; j + 1 < NT; j += 2) {
        REGIONC(j); ATT_SBAR(); qkt<KC, USEC>(pB0, pB1, K_lds + KBYTES, cb0, qr, cbt, r32, hi);
        REGSC(cbA); finishSM<ONES>(pA0, pA1, alA, l_reg, pa0, pa1, pa2, pa3); ATT_SBAR();
        SLOAD(1, j + 2); ATT_SBAR();
        pv_all<NCB, ONES>(o, lacc, vb0, pa0, pa1, pa2, pa3); MODIFY(pB0, pB1, j, cbB); partialSM<NOMAX>(pB0, pB1, cbB, m_reg, alB);
        __syncthreads(); SWAIT(); SWRITE(0, 0);
        RESC(alB); __syncthreads();
        REGIONC(j + 1); ATT_SBAR(); qkt<KC, USEC>(pA0, pA1, K_lds, cb0, qr, cbt, r32, hi);
        REGSC(cbB); finishSM<ONES>(pB0, pB1, alB, l_reg, pa0, pa1, pa2, pa3); ATT_SBAR();
        if (j + 3 < NT) SLOAD(0, j + 3); ATT_SBAR();
        pv_all<NCB, ONES>(o, lacc, vb0 + VBYTES, pa0, pa1, pa2, pa3); MODIFY(pA0, pA1, j + 1, cbA); partialSM<NOMAX>(pA0, pA1, cbA, m_reg, alA);
        __syncthreads(); SWAIT(); SWRITE(1, 1);
        RESC(alA); __syncthreads();
    }
    REGIONC(NT - 1); ATT_SBAR(); qkt<KC, USEC>(pB0, pB1, K_lds + KBYTES, cb0, qr, cbt, r32, hi);
    REGSC(cbA); finishSM<ONES>(pA0, pA1, alA, l_reg, pa0, pa1, pa2, pa3); ATT_SBAR();
    pv_all<NCB, ONES>(o, lacc, vb0, pa0, pa1, pa2, pa3); MODIFY(pB0, pB1, NT - 1, cbB); partialSM<NOMAX>(pB0, pB1, cbB, m_reg, alB);
    __syncthreads(); RESC(alB);
    REGSC(cbB); finishSM<ONES>(pB0, pB1, alB, l_reg, pa0, pa1, pa2, pa3); ATT_SBAR();
    pv_all<NCB, ONES>(o, lacc, vb0 + VBYTES, pa0, pa1, pa2, pa3);
    float rli[16];
    if constexpr (ONES) {
#pragma unroll
        for (int r = 0; r < 16; ++r) rli[r] = __builtin_amdgcn_rcpf(lacc[r]);
    } else {
        if (hi == 0) li_l[r32] = l_reg; asm volatile("s_waitcnt lgkmcnt(0)" ::: "memory");
#pragma unroll
        for (int r = 0; r < 16; ++r) rli[r] = __builtin_amdgcn_rcpf(li_l[crow(r, hi)]);
    }
    if constexpr (MODE != 1) {
        ATT_LAS bf16_t* stg = (ATT_LAS bf16_t*)(lds + L_OST) + wid * 2048;
#pragma unroll
        for (int r = 0; r < 16; ++r) { const int orow = crow(r, hi);
#pragma unroll
            for (int d0 = 0; d0 < 2; ++d0) stg[orow * 64 + d0 * 32 + r32] = (bf16_t)(cvtpk(o[d0][r] * rli[r], 0.f) & 0xffffu); }
        asm volatile("s_waitcnt lgkmcnt(0)" ::: "memory");
        bf16_t* Ow = ATT + (size_t)(row0 + q0 + wid * 32) * OPITCH + ocol;
#pragma unroll
        for (int i = 0; i < 4; ++i) { const int row = i * 8 + (lane >> 3), ch = lane & 7; const u32x4 v = *(const ATT_LAS u32x4*)(stg + row * 64 + ch * 8); *(u32x4*)(Ow + (size_t)row * OPITCH + ch * 8) = v; }
    } else {
        __syncthreads();
        ATT_LAS float* ex = (ATT_LAS float*)(lds + L_K) + (wid & 3) * 4096;
        if (map == 1) {
#pragma unroll
            for (int d0 = 0; d0 < 4; ++d0)
#pragma unroll
                for (int r = 0; r < 16; ++r) ex[(d0 * 16 + r) * 64 + lane] = o[d0][r] * rli[r];
        }
        __syncthreads();
        if (map == 0) {
            const float sa = wave_sum(ax.lam_p[lane] * ax.lam_p[64 + lane]), sb = wave_sum(ax.lam_p[128 + lane] * ax.lam_p[192 + lane]);
            const float lam = __builtin_amdgcn_exp2f(sa * LOG2E) - __builtin_amdgcn_exp2f(sb * LOG2E) + ax.lam_init;
            float ssq[16];
#pragma unroll
            for (int r = 0; r < 16; ++r) ssq[r] = 0.f;
#pragma unroll
            for (int d0 = 0; d0 < 4; ++d0)
#pragma unroll
                for (int r = 0; r < 16; ++r) { const float d = o[d0][r] * rli[r] - lam * ex[(d0 * 16 + r) * 64 + lane]; o[d0][r] = d; ssq[r] += d * d; }
#pragma unroll
            for (int r = 0; r < 16; ++r) { float s = ssq[r]; s += __shfl_xor(s, 1); s += __shfl_xor(s, 2); s += __shfl_xor(s, 4); s += __shfl_xor(s, 8); s += __shfl_xor(s, 16);
                ssq[r] = __builtin_amdgcn_rsqf(s * (1.0f / 128.0f) + cfg::EPS) * (1.0f - ax.lam_init); }
            float gsub[4];
#pragma unroll
            for (int d0 = 0; d0 < 4; ++d0) gsub[d0] = ax.subln[d0 * 32 + r32];
            ATT_LAS bf16_t* stg = (ATT_LAS bf16_t*)(lds + L_OST) + wid * 4096;
#pragma unroll
            for (int r = 0; r < 16; ++r) { const int orow = crow(r, hi);
#pragma unroll
                for (int d0 = 0; d0 < 4; ++d0) stg[orow * 128 + d0 * 32 + r32] = (bf16_t)(cvtpk(o[d0][r] * ssq[r] * gsub[d0], 0.f) & 0xffffu); }
            asm volatile("s_waitcnt lgkmcnt(0)" ::: "memory");
            bf16_t* Ow = ATT + (size_t)(row0 + q0 + wid * 32) * OPITCH + ocol;
#pragma unroll
            for (int i = 0; i < 8; ++i) { const int row = i * 4 + (lane >> 4), ch = lane & 15; const u32x4 v = *(const ATT_LAS u32x4*)(stg + row * 128 + ch * 8); *(u32x4*)(Ow + (size_t)row * OPITCH + ch * 8) = v; }
        }
    }
    __syncthreads();
#undef SLOAD
#undef SWRITE
#undef SWAIT
#undef RESC
#undef MODIFY
#undef REGIONC
#undef REGSC
}
#undef ATT_SBAR
}
#define GAS __attribute__((address_space(1)))
#define LAS __attribute__((address_space(3)))
typedef unsigned short bf16;
typedef unsigned v4u __attribute__((ext_vector_type(4)));
typedef float f32x4 __attribute__((ext_vector_type(4)));
typedef short bf16x8 __attribute__((ext_vector_type(8)));
typedef GAS unsigned gu32;
typedef GAS unsigned long long gu64;
#define RLX_AGENT __ATOMIC_RELAXED, __HIP_MEMORY_SCOPE_AGENT
#define LDS_WAIT() asm volatile("s_waitcnt lgkmcnt(0)" ::: "memory")
#define VM_WAIT() asm volatile("s_waitcnt vmcnt(0)" ::: "memory")
__device__ __forceinline__ unsigned long long rt() { return __builtin_amdgcn_s_memrealtime(); }
__device__ __forceinline__ unsigned f2bf(float f) { unsigned u = __builtin_bit_cast(unsigned, f); return (u + 0x7fffu + ((u >> 16) & 1u)) >> 16; }
__device__ __forceinline__ unsigned pk2(float lo, float hi) { return f2bf(lo) | (f2bf(hi) << 16); }

#define XB_TMO      128
#define XB_XCNT(j)  (256  + 64 * (j))
#define XB_XSUB(j)  (1280 + 64 * (j))
#define XB_XGEN(j)  (2304 + 64 * (j))
#define XB_TOP      3328
#define XB_TOPGEN   3392
#define XCD_BAR_WORDS 3456
#define XB_SPIN_CAP (1u << 18)

__device__ __forceinline__ unsigned xb_ld(unsigned* p)              { return __hip_atomic_load(p, __ATOMIC_RELAXED, __HIP_MEMORY_SCOPE_AGENT); }
__device__ __forceinline__ unsigned xb_add(unsigned* p, unsigned v) { return __hip_atomic_fetch_add(p, v, __ATOMIC_RELAXED, __HIP_MEMORY_SCOPE_AGENT); }
__device__ __forceinline__ unsigned xb_xcc_id() { return (unsigned)__builtin_amdgcn_s_getreg((3 << 11) | 20) & 0xFu; }
#define XB_SPIN(cond, bar) do { unsigned _sp = 0; while (cond) { __builtin_amdgcn_s_sleep(1); \
    if ((++_sp & 255u) == 0u) { if (xb_ld(&(bar)[XB_TMO])) break; if (_sp > XB_SPIN_CAP) { atomicAdd(&(bar)[XB_TMO], 1u); break; } } } } while (0)

struct XcdBarrier {
    unsigned* bar; unsigned x;
    volatile LAS unsigned* st;
};

__device__ __forceinline__ XcdBarrier xcd_barrier_post(unsigned* bar, volatile LAS unsigned* st) {
    XcdBarrier b; b.bar = bar; b.x = xb_xcc_id(); b.st = st;
    if (threadIdx.x == 0) (void)xb_add(&bar[XB_XCNT(b.x)], 1u);
    return b;
}
__device__ __forceinline__ void xcd_barrier_complete(unsigned* bar, unsigned x, unsigned& nloc, unsigned& nx) {
    const unsigned G = gridDim.x * gridDim.y * gridDim.z;
    unsigned sum, cnt, mine, sp = 0u;
    for (;;) {
        sum = 0u; cnt = 0u; mine = 0u;
#pragma unroll
        for (unsigned j = 0; j < 16; ++j) { const unsigned c = xb_ld(&bar[XB_XCNT(j)]); sum += c; cnt += (c > 0u) ? 1u : 0u; mine = (j == x) ? c : mine; }
        if (sum == G) break;
        __builtin_amdgcn_s_sleep(1);
        if ((++sp & 255u) == 0u) { if (xb_ld(&bar[XB_TMO])) break; if (sp > XB_SPIN_CAP) { atomicAdd(&bar[XB_TMO], 1u); break; } }
    }
    nloc = mine > 0u ? mine : 1u; nx = cnt > 0u ? cnt : 1u;
}

__device__ __forceinline__ void xcd_barrier(const XcdBarrier& b) {
    asm volatile("s_waitcnt vmcnt(0)" ::: "memory");
    __syncthreads();
    if (threadIdx.x == 0) {
        unsigned* bar = b.bar;
        __builtin_amdgcn_s_waitcnt(0);
        unsigned nloc = b.st[0], nx = b.st[1];
        if (nloc == 0u) { xcd_barrier_complete(bar, b.x, nloc, nx); b.st[0] = nloc; b.st[1] = nx; }
        const unsigned old = xb_add(&bar[XB_XSUB(b.x)], 1u);
        const unsigned gen = old / nloc;
        if (old + 1u == (gen + 1u) * nloc) {
            __builtin_amdgcn_fence(__ATOMIC_RELEASE, "agent");
            asm volatile("s_waitcnt vmcnt(0)" ::: "memory");
            const unsigned og = xb_add(&bar[XB_TOP], 1u);
            const unsigned tg = og / nx;
            if (og + 1u == (tg + 1u) * nx) xb_add(&bar[XB_TOPGEN], 1u);
            else XB_SPIN(xb_ld(&bar[XB_TOPGEN]) == tg, bar);
            __builtin_amdgcn_fence(__ATOMIC_ACQUIRE, "agent");
            xb_add(&bar[XB_XGEN(b.x)], 1u);
            asm volatile("s_waitcnt vmcnt(0)" ::: "memory");
        } else {
            XB_SPIN(xb_ld(&bar[XB_XGEN(b.x)]) == gen, bar);
            __builtin_amdgcn_fence(__ATOMIC_ACQUIRE, "agent");
            asm volatile("s_waitcnt vmcnt(0)" ::: "memory");
        }
    }
    __syncthreads();
}

constexpr int NWAVES = 8;
constexpr size_t MiB = 1u << 20;
constexpr size_t WS_CTL = 0, CTL_ZERO_BYTES = 2 * MiB;
constexpr size_t WS_WGU = 2 * MiB, WS_WD = 46 * MiB, WS_WIN = 68 * MiB, WS_WOUT = 89 * MiB;
constexpr size_t WS_XA = 98 * MiB;
constexpr size_t WS_BIG = 290 * MiB;
constexpr size_t WS_H2 = 482 * MiB;
constexpr size_t WS_END = 1010 * MiB;
static_assert(WS_WGU + (size_t)cfg::NGU * cfg::DM * 2 <= WS_WD && WS_WD + (size_t)cfg::DM * cfg::DFF * 2 <= WS_WIN && WS_WIN + (size_t)cfg::NIN * cfg::DM * 2 <= WS_WOUT &&
              WS_WOUT + (size_t)cfg::DM * cfg::DM * 2 <= WS_XA && WS_XA + (size_t)cfg::M * cfg::DM * 2 <= WS_BIG && WS_BIG + (size_t)cfg::M * cfg::DFF * 2 <= WS_END &&
              WS_BIG + (size_t)cfg::M * cfg::DM * 2 <= WS_H2 && WS_H2 + (size_t)cfg::M * cfg::DFF * 2 <= WS_END, "d_ws map");
#ifndef WGM_DN
#define WGM_DN 4
#endif
#ifndef WGM_GU
#define WGM_GU 8
#endif
constexpr int CW_BAR = 4096;
constexpr int CW_RSS = 131072;
constexpr int CW_NRM = 8192;
constexpr int RING_OFF = 0, RING_BYTES = 131072, LDSCTL_OFF = RING_BYTES, MISC_OFF = LDSCTL_OFF + 320, LDS_BYTES = 147456;
static_assert(att::L_END <= RING_BYTES && MISC_OFF + 128 <= LDS_BYTES, "LDS map");

struct Frame {
    LAS unsigned char* lds; volatile LAS unsigned* MISC; int wave, vcu, G;
};
__device__ __forceinline__ float wave_sum_f(float v) {
#pragma unroll
    for (int o = 1; o < 64; o <<= 1) v += __shfl_xor(v, o);
    return v;
}
__device__ __forceinline__ void transpose_item(const float* W, int K, int N, bf16* WT, int k0, int n0, int rowbase, const float* gain, LAS float* scr, int lane) {
#pragma unroll 8
    for (int i = 0; i < 32; ++i) { const int kk = 2 * i + (lane >> 5); scr[kk * 33 + (lane & 31)] = W[(size_t)(k0 + kk) * N + n0 + (lane & 31)]; }
    LDS_WAIT(); asm volatile("" ::: "memory");
    const int c = lane & 7;
    f32x4 g0 = {1.f, 1.f, 1.f, 1.f}, g1 = g0;
    if (gain) { g0 = *(const f32x4*)(gain + k0 + 8 * c); g1 = *(const f32x4*)(gain + k0 + 8 * c + 4); }
#pragma unroll
    for (int j = 0; j < 4; ++j) { const int n = (lane >> 3) + 8 * j; const LAS float* s = scr + (8 * c) * 33 + n;
        v4u o; o.x = pk2(s[0 * 33] * g0[0], s[1 * 33] * g0[1]); o.y = pk2(s[2 * 33] * g0[2], s[3 * 33] * g0[3]); o.z = pk2(s[4 * 33] * g1[0], s[5 * 33] * g1[1]); o.w = pk2(s[6 * 33] * g1[2], s[7 * 33] * g1[3]);
        *(GAS v4u*)(WT + (size_t)(rowbase + n) * K + k0 + 8 * c) = o; }
    LDS_WAIT(); asm volatile("" ::: "memory");
}
__device__ __forceinline__ void conv_ffn(const Frame& F, const float* wg, const float* wu, const float* wd, const float* gain, unsigned char* ws) {
    using namespace cfg;
    { const GAS float *a = (const GAS float*)wg, *b = (const GAS float*)wu, *c = (const GAS float*)wd, *d = (const GAS float*)gain; asm volatile("" : "+s"(a), "+s"(b), "+s"(c), "+s"(d));
      wg = (const float*)a; wu = (const float*)b; wd = (const float*)c; gain = (const float*)d; }
    int lane = threadIdx.x; asm volatile("" : "+v"(lane)); lane &= 63;
    LAS float* scr = (LAS float*)(F.lds + RING_OFF + F.wave * 16384);
    const int gw = F.vcu * NWAVES + F.wave, NGW = F.G * NWAVES;
    constexpr int I_G = (DM / 64) * (DFF / 32), I_D = (DFF / 64) * (DM / 32);
    static_assert(I_G == I_D, "");
    for (int it = gw; it < 3 * I_G; it += NGW) {
        const int which = it / I_G, r = it - which * I_G;
        if (which < 2) { const int nblk = DFF / 32, kb = r / nblk, nb = r % nblk, n0 = 32 * nb;
            transpose_item(which ? wu : wg, DM, DFF, (bf16*)(ws + WS_WGU), 64 * kb, n0, 256 * (n0 >> 7) + 128 * which + (n0 & 127), gain, scr, lane); }
        else { const int nblk = DM / 32, kb = r / nblk, nb = r % nblk, n0 = 32 * nb;
            transpose_item(wd, DFF, DM, (bf16*)(ws + WS_WD), 64 * kb, n0, n0, nullptr, scr, lane); }
    }
}
__device__ __forceinline__ void conv_mix(const Frame& F, const float* win, const float* wout, const float* gain, unsigned char* ws) {
    using namespace cfg;
    { const GAS float *a = (const GAS float*)win, *b = (const GAS float*)wout, *d = (const GAS float*)gain; asm volatile("" : "+s"(a), "+s"(b), "+s"(d)); win = (const float*)a; wout = (const float*)b; gain = (const float*)d; }
    int lane = threadIdx.x; asm volatile("" : "+v"(lane)); lane &= 63;
    LAS float* scr = (LAS float*)(F.lds + RING_OFF + F.wave * 16384);
    const int gw = F.vcu * NWAVES + F.wave, NGW = F.G * NWAVES;
    constexpr int I_IN = (DM / 64) * (NIN / 32), I_O = (DM / 64) * (DM / 32);
    for (int it = gw; it < I_IN + I_O; it += NGW) {
        if (it < I_IN) { const int nblk = NIN / 32, kb = it / nblk, nb = it % nblk, n0 = 32 * nb;
            transpose_item(win, DM, NIN, (bf16*)(ws + WS_WIN), 64 * kb, n0, 256 * (n0 >> 8) + 128 * ((n0 & 63) >> 5) + 32 * ((n0 & 255) >> 6), gain, scr, lane); }
        else { const int r = it - I_IN, nblk = DM / 32, kb = r / nblk, nb = r % nblk, n0 = 32 * nb;
            transpose_item(wout, DM, DM, (bf16*)(ws + WS_WOUT), 64 * kb, n0, n0, nullptr, scr, lane); }
    }
}
template <bool FINAL>
__device__ __forceinline__ void row_phase(const Frame& F, const float* xp, const float* xs, float* out, const float* gain, bf16* XB, float* rss) {
    using namespace cfg;
    int lane = threadIdx.x; asm volatile("" : "+v"(lane)); lane &= 63;
    const int gw = F.vcu * NWAVES + F.wave, NGW = F.G * NWAVES;
    f32x4 g[8];
    if constexpr (FINAL) { { const GAS float* a = (const GAS float*)gain; asm volatile("" : "+s"(a)); gain = (const float*)a; }
#pragma unroll
        for (int j = 0; j < 8; ++j) g[j] = ((const f32x4*)gain)[lane + 64 * j]; }
    for (int m = gw; m < M; m += NGW) {
        const float* xrow = FINAL ? out + (size_t)m * DM : (m < MP ? xp + (size_t)m * DM : xs + (size_t)(m - MP) * DM);
        const GAS f32x4* xr = (const GAS f32x4*)xrow + lane;
        f32x4 v[8]; float s = 0.f;
#pragma unroll
        for (int j = 0; j < 8; ++j) { v[j] = xr[64 * j]; s += (v[j].x * v[j].x + v[j].y * v[j].y) + (v[j].z * v[j].z + v[j].w * v[j].w); }
        const float ssum = wave_sum_f(s);
        if constexpr (FINAL) { const float rinv = 1.0f / sqrtf(ssum * (1.0f / DM) + EPS); GAS f32x4* o = (GAS f32x4*)(out + (size_t)m * DM) + lane;
#pragma unroll
            for (int j = 0; j < 8; ++j) o[64 * j] = v[j] * rinv * g[j];
        } else { GAS unsigned long long* o8 = (GAS unsigned long long*)(XB + (size_t)m * DM) + lane;
#pragma unroll
            for (int j = 0; j < 8; ++j) o8[64 * j] = (unsigned long long)pk2(v[j].x, v[j].y) | ((unsigned long long)pk2(v[j].z, v[j].w) << 32);
            if (lane == 0) ((GAS float*)rss)[m] = ssum; }
    }
}

struct Args { const float* in[20]; float* out; unsigned char* ws; int ph_lo, ph_hi, pad0, pad1; };
__global__ void __launch_bounds__(NWAVES * 64, 2) mk_fwd(Args args) {
    using namespace cfg;
    extern __shared__ __attribute__((aligned(16))) unsigned char lds[];
    Frame F;
    F.lds = (LAS unsigned char*)lds; F.MISC = (volatile LAS unsigned*)(F.lds + MISC_OFF);
    F.wave = __builtin_amdgcn_readfirstlane((int)threadIdx.x >> 6);
    F.G = gridDim.x; { const int bx = blockIdx.x; F.vcu = (F.G % 8 == 0) ? (bx % 8) * (F.G / 8) + bx / 8 : bx; }
    unsigned char* ws = args.ws; gu32* ctl = (gu32*)(ws + WS_CTL);
    const float* const p_xp = args.in[0]; const float* const p_xs = args.in[1]; const float* const p_f1n = args.in[2]; const float* const p_f1g = args.in[3]; const float* const p_f1u = args.in[4];
    const float* const p_f1d = args.in[5]; const float* const p_mixn = args.in[6]; const float* const p_win = args.in[7]; const float* const p_aqn = args.in[8]; const float* const p_akn = args.in[9];
    const float* const p_blam = args.in[10]; const float* const p_bsub = args.in[11]; const float* const p_crpb = args.in[12]; const float* const p_wout = args.in[13]; const float* const p_f2n = args.in[14];
    const float* const p_f2g = args.in[15]; const float* const p_f2u = args.in[16]; const float* const p_f2d = args.in[17]; const float* const p_t5 = args.in[18]; const float* const p_fin = args.in[19];
    float* out = args.out;
    bf16* XA = (bf16*)(ws + WS_XA); bf16* BIG = (bf16*)(ws + WS_BIG); bf16* H2 = (bf16*)(ws + WS_H2);
    for (int u = threadIdx.x; u < (LDS_BYTES - LDSCTL_OFF) / 4; u += NWAVES * 64) ((LAS unsigned*)(F.lds + LDSCTL_OFF))[u] = 0u;
    __syncthreads();
    XcdBarrier bar; bar.bar = (unsigned*)(ctl + CW_BAR); bar.x = 0; bar.st = nullptr;
    if (!MK_PER_PHASE) bar = xcd_barrier_post((unsigned*)(ctl + CW_BAR), F.MISC + 8);
    const int lo = args.ph_lo, hi = args.ph_hi;
    int ph = 0;
#define IN(k) (lo <= (k) && (k) < hi)
#define FRESH() GAS float* out_g = (GAS float*)out; GAS unsigned char* ws_g = (GAS unsigned char*)ws; GAS bf16* XA_g = (GAS bf16*)XA; GAS bf16* BIG_g = (GAS bf16*)BIG; GAS bf16* H2_g = (GAS bf16*)H2; const GAS float* xp_g = (const GAS float*)p_xp; const GAS float* xs_g = (const GAS float*)p_xs; \
    asm volatile("" : "+s"(out_g), "+s"(ws_g), "+s"(XA_g), "+s"(BIG_g), "+s"(H2_g), "+s"(xp_g), "+s"(xs_g)); \
    float* out_ = (float*)out_g; unsigned char* ws_ = (unsigned char*)ws_g; bf16* XA_ = (bf16*)XA_g; bf16* BIG_ = (bf16*)BIG_g; bf16* H2_ = (bf16*)H2_g; const float* xp_ = (const float*)xp_g; const float* xs_ = (const float*)xs_g; (void)H2_; (void)BIG_; (void)XA_; (void)xp_; (void)xs_
#define SEAM() do { if (IN(ph) && IN(ph + 1)) { if (MK_PER_PHASE) { if (threadIdx.x == 0) __hip_atomic_store(ctl, 0xBADBA0u, RLX_AGENT); } else xcd_barrier(bar); } ++ph; } while (0)

    for (int L = 0; L < 2; ++L) {
        float* const rssA = (float*)(ctl + CW_RSS) + (size_t)(L == 0 ? 0 : 3) * M;
        float* const rssB = (float*)(ctl + CW_RSS) + (size_t)(L == 0 ? 1 : 4) * M;
        float* const rssC = (float*)(ctl + CW_RSS) + (size_t)(L == 0 ? 2 : 5) * M;
        if (IN(ph)) { FRESH();
            conv_ffn(F, p_f1g + (size_t)L * DM * DFF, p_f1u + (size_t)L * DM * DFF, p_f1d + (size_t)L * DM * DFF, p_f1n + L * DM, ws_);
            conv_mix(F, p_win + (size_t)L * DM * NIN, p_wout + (size_t)L * DM * DM, p_mixn + L * DM, ws_);
            if (L == 0) row_phase<false>(F, xp_, xs_, out_, nullptr, XA_, rssA);
        }
        SEAM();
        if (IN(ph)) { FRESH();
            pg8::Gemm g{XA_, (const bf16*)(ws_ + WS_WGU), M, NGU, DM}; pg8::StaticOrder S; S.init(M, NGU, F.G, (int)blockIdx.x, WGM_GU);
            pg8::EpiSwiglu E{BIG_, rssA};
#ifndef NO_GU
            pg8::gemm_phase<pg8::EpiSwiglu, pg8::StaticOrder, true, true>(F.lds + RING_OFF, g, S, E);
#endif
        }
        SEAM();
        if (IN(ph)) { FRESH();
            pg8::Gemm g{BIG_, (const bf16*)(ws_ + WS_WD), M, DM, DFF}; pg8::StaticOrder S; S.init(M, DM, F.G, (int)blockIdx.x, WGM_DN);
            pg8::EpiResid E{xp_, xs_, out_, L == 0, 0.5f, XA_, rssB};
#ifndef NO_RES
            pg8::gemm_phase<pg8::EpiResid, pg8::StaticOrder, true, true>(F.lds + RING_OFF, g, S, E);
#endif
        }
        SEAM();
        if (IN(ph)) { FRESH();
            conv_ffn(F, p_f2g + (size_t)L * DM * DFF, p_f2u + (size_t)L * DM * DFF, p_f2d + (size_t)L * DM * DFF, p_f2n + L * DM, ws_);
            __syncthreads();
            pg8::Gemm g{XA_, (const bf16*)(ws_ + WS_WIN), M, NIN, DM}; pg8::StaticOrder S; S.init(M, NIN, F.G, (int)blockIdx.x, WGM_GU);
            pg8::EpiWin E{BIG_, p_aqn + L * 64, p_akn + L * 64, rssB, (unsigned*)(ctl + CW_NRM + L * 336)};
#ifndef NO_WIN
            pg8::gemm_phase<pg8::EpiWin, pg8::StaticOrder, true, true>(F.lds + RING_OFF, g, S, E);
#endif
        }
        SEAM();
        if (IN(ph)) { FRESH(); bf16* const QKV_ = BIG_; bf16* const ATT_ = XA_;
                att::Aux ax{p_t5, p_crpb + (size_t)L * 8 * 15 * 31, p_blam + L * 256, p_bsub + L * 128, (L == 0 ? 0.2f : 0.35550906759f)};
                const att::lptr al = (att::lptr)(F.lds + RING_OFF);
#ifdef ATT_PRIO
                if (F.wave >= 4) __builtin_amdgcn_s_setprio(1);
#endif
#ifndef PROBE_ATT_REP
#define PROBE_ATT_REP 1
#endif
                for (int rep_ = 0; rep_ < PROBE_ATT_REP; ++rep_) {
#ifndef REP_B
#define REP_B 1
#endif
#ifndef REP_A
#define REP_A 1
#endif
#ifndef REP_D
#define REP_D 1
#endif
#ifndef REP_C
#define REP_C 1
#endif
                float t5max = 0.f, rpbmax = 0.f;
                { int ln = threadIdx.x; asm volatile("" : "+v"(ln)); ln &= 63;
#pragma unroll
                  for (int k_ = 0; k_ < 6; ++k_) t5max = fmaxf(t5max, fabsf(p_t5[ln + 64 * k_]));
                  for (int k_ = 0; k_ < 59; ++k_) { const int ix = ln + 64 * k_; if (ix < 8 * 15 * 31) rpbmax = fmaxf(rpbmax, fabsf(ax.rpb[ix])); }
#pragma unroll
                  for (int o_ = 1; o_ < 64; o_ <<= 1) { t5max = fmaxf(t5max, __shfl_xor(t5max, o_)); rpbmax = fmaxf(rpbmax, __shfl_xor(rpbmax, o_)); } }
                t5max = __uint_as_float(__builtin_amdgcn_readfirstlane(__float_as_uint(t5max))); rpbmax = __uint_as_float(__builtin_amdgcn_readfirstlane(__float_as_uint(rpbmax)));
                const GAS unsigned* nrm2 = (const GAS unsigned*)(ctl + CW_NRM + L * 336);
#define SEQ_OF(r0_) ((r0_) < MP ? ((r0_) >> 14) : 2 + (((r0_) - MP) >> 13))
#define NRM(blk_, sq_) __uint_as_float(nrm2[(blk_) * 4 + (sq_)])
                for (int rb_ = 0; rb_ < REP_B; ++rb_)
                for (int u = F.vcu; u < 1536; u += F.G) {
#ifndef NO_ATT1
                    int r0, T, h, qb;
                    if (u < 1024) { r0 = (u >> 9) * TP; T = TP; h = (u >> 7) & 3; qb = u & 127; } else { const int v = u - 1024; r0 = MP + (v >> 8) * TS; T = TS; h = (v >> 6) & 3; qb = v & 63; }
                    const int sq = SEQ_OF(r0);
                    const float bnd = sqrtf(fmaxf(NRM(12 + 2 * h, sq), NRM(13 + 2 * h, sq)) * fmaxf(NRM(20 + 2 * h, sq), NRM(21 + 2 * h, sq))) * 1.01f + t5max * LOG2E;
                    if (__builtin_amdgcn_readfirstlane((int)(bnd <= 80.0f))) att::attn_unit<1, true>(QKV_, ATT_, al, r0, T, h, qb, ax); else att::attn_unit<1, false>(QKV_, ATT_, al, r0, T, h, qb, ax);
#endif
                }
                bool a_nomax;
                { int ln_ = threadIdx.x; asm volatile("" : "+v"(ln_)); ln_ &= 63; float gq = fabsf(p_aqn[L * 64 + ln_]), gk = fabsf(p_akn[L * 64 + ln_]);
#pragma unroll
                  for (int o_ = 1; o_ < 64; o_ <<= 1) { gq = fmaxf(gq, __shfl_xor(gq, o_)); gk = fmaxf(gk, __shfl_xor(gk, o_)); }
                  const float bound = 8.0f * LOG2E * gq * gk * 1.01f; a_nomax = __builtin_amdgcn_readfirstlane((int)(bound <= 80.0f)) != 0; }
                for (int ra_ = 0; ra_ < REP_A; ++ra_)
                for (int u = F.vcu; u < 1536; u += F.G) {
#ifndef NO_ATT0
                    int r0, T, h, qb;
                    if (u < 1024) { r0 = (u >> 9) * TP; T = TP; h = (u >> 6) & 7; qb = u & 63; } else { const int v = u - 1024; r0 = MP + (v >> 8) * TS; T = TS; h = (v >> 5) & 7; qb = v & 31; }
                    if (a_nomax) att::attn_unit<0, true>(QKV_, ATT_, al, r0, T, h, qb, ax); else att::attn_unit<0, false>(QKV_, ATT_, al, r0, T, h, qb, ax);
#endif
                }
                for (int rd_ = 0; rd_ < REP_D; ++rd_)
                for (int u = F.vcu; u < 1536; u += F.G) {
                    const int h = u / 192, qg = u % 192; int r0, T, qb;
                    if (qg < 128) { r0 = (qg >> 6) * TP; T = TP; qb = qg & 63; } else { r0 = MP + ((qg - 128) >> 5) * TS; T = TS; qb = (qg - 128) & 31; }
#ifndef NO_ATT3
                    { const int sq = SEQ_OF(r0); const float bnd = sqrtf(NRM(60 + h, sq) * NRM(68 + h, sq)) * 1.01f + t5max * LOG2E + 1.6f;
                      if (__builtin_amdgcn_readfirstlane((int)(bnd <= 80.0f))) att::attn_unit<3, true>(QKV_, ATT_, al, r0, T, h, qb, ax); else att::attn_unit<3, false>(QKV_, ATT_, al, r0, T, h, qb, ax); }
#endif
                }
                for (int rc_ = 0; rc_ < REP_C; ++rc_)
                for (int u = F.vcu; u < 1536; u += F.G) {
                    const int h = u / 192, qg = u % 192; int r0, T, qb;
                    if (qg < 128) { r0 = (qg >> 6) * TP; T = TP; qb = qg & 63; } else { r0 = MP + ((qg - 128) >> 5) * TS; T = TS; qb = (qg - 128) & 31; }
#ifndef NO_ATT2
                    { const int sq = SEQ_OF(r0); const float bnd = sqrtf(NRM(36 + h, sq) * NRM(44 + h, sq)) * 1.01f + rpbmax * LOG2E;
                      if (__builtin_amdgcn_readfirstlane((int)(bnd <= 80.0f))) att::attn_unit<2, true>(QKV_, ATT_, al, r0, T, h, qb, ax); else att::attn_unit<2, false>(QKV_, ATT_, al, r0, T, h, qb, ax); }
#endif
                }
                }
                    }
        SEAM();
        if (IN(ph)) { FRESH();
            pg8::Gemm g{XA_, (const bf16*)(ws_ + WS_WOUT), M, DM, DM}; pg8::StaticOrder S; S.init(M, DM, F.G, (int)blockIdx.x, WGM_DN);
            pg8::EpiResid E{xp_, xs_, out_, 0, 1.0f, BIG_, rssC};
#ifndef NO_RES
            pg8::gemm_phase<pg8::EpiResid, pg8::StaticOrder, true, true>(F.lds + RING_OFF, g, S, E);
#endif
        }
        SEAM();
        if (IN(ph)) { FRESH();
            pg8::Gemm g{BIG_, (const bf16*)(ws_ + WS_WGU), M, NGU, DM}; pg8::StaticOrder S; S.init(M, NGU, F.G, (int)blockIdx.x, WGM_GU);
            pg8::EpiSwiglu E{H2_, rssC};
#ifndef NO_GU
            pg8::gemm_phase<pg8::EpiSwiglu, pg8::StaticOrder, true, true>(F.lds + RING_OFF, g, S, E);
#endif
        }
        SEAM();
        if (IN(ph)) { FRESH();
            pg8::Gemm g{H2_, (const bf16*)(ws_ + WS_WD), M, DM, DFF}; pg8::StaticOrder S; S.init(M, DM, F.G, (int)blockIdx.x, WGM_DN);
            pg8::EpiResid E{xp_, xs_, out_, 0, 0.5f, L == 0 ? XA_ : (bf16*)nullptr, L == 0 ? (float*)(ctl + CW_RSS) + (size_t)3 * M : (float*)nullptr};
#ifndef NO_RES
            pg8::gemm_phase<pg8::EpiResid, pg8::StaticOrder, true, true>(F.lds + RING_OFF, g, S, E);
#endif
        }
        SEAM();
    }
    if (IN(ph)) { FRESH(); row_phase<true>(F, xp_, xs_, out_, p_fin, XA_, nullptr); }
#undef IN
#undef SEAM
}
constexpr int N_PHASES = 17;

extern "C" void kernel_launch(void* const* d_in, const int* in_sizes, int n_in, void* d_out, int out_size, void* d_ws, size_t ws_size, hipStream_t stream) {
    static int grid = 0;
    if (grid == 0) {
        if (n_in != 20 || in_sizes[0] != cfg::MP * cfg::DM || in_sizes[1] != cfg::MS * cfg::DM || out_size != cfg::M * cfg::DM || ws_size < WS_END) {
            fprintf(stderr, "kernel_launch: shape mismatch (n_in %d, in0 %d, in1 %d, out %d, ws %zu need %zu); nothing launched\n", n_in, n_in > 0 ? in_sizes[0] : -1, n_in > 1 ? in_sizes[1] : -1, out_size, ws_size, (size_t)WS_END); grid = -1; return; }
        int dev = 0, cus = 0, per_cu = 0;
        if (hipGetDevice(&dev) != hipSuccess || hipDeviceGetAttribute(&cus, hipDeviceAttributeMultiprocessorCount, dev) != hipSuccess) { fprintf(stderr, "kernel_launch: device query failed\n"); grid = -1; return; }
        if (hipFuncSetAttribute((const void*)mk_fwd, hipFuncAttributeMaxDynamicSharedMemorySize, LDS_BYTES) != hipSuccess) { fprintf(stderr, "kernel_launch: hipFuncSetAttribute failed\n"); grid = -1; return; }
        if (hipOccupancyMaxActiveBlocksPerMultiprocessor(&per_cu, (const void*)mk_fwd, NWAVES * 64, LDS_BYTES) != hipSuccess || per_cu < 1) {
            fprintf(stderr, "kernel_launch: occupancy query reports %d workgroups per CU; nothing launched\n", per_cu); (void)hipGetLastError(); grid = -1; return; }
        (void)hipGetLastError();
        grid = cus;
    }
    if (grid < 0) return;
    if (hipMemsetAsync((char*)d_ws + WS_CTL, 0, CTL_ZERO_BYTES, stream) != hipSuccess) { fprintf(stderr, "kernel_launch: memset failed\n"); return; }
    Args a{};
    for (int i = 0; i < 20; ++i) a.in[i] = (const float*)d_in[i];
    a.out = (float*)d_out; a.ws = (unsigned char*)d_ws;
#if MK_PER_PHASE
    for (int p = 0; p < N_PHASES; ++p) { a.ph_lo = p; a.ph_hi = p + 1; hipLaunchKernelGGL(mk_fwd, dim3(grid), dim3(NWAVES * 64), LDS_BYTES, stream, a); }
#else
    a.ph_lo = 0; a.ph_hi = N_PHASES;
    hipLaunchKernelGGL(mk_fwd, dim3(grid), dim3(NWAVES * 64), LDS_BYTES, stream, a);
#endif
    const hipError_t le = hipPeekAtLastError();
    if (le != hipSuccess) fprintf(stderr, "kernel_launch: launch failed: %s\n", hipGetErrorName(le));
}
```

```cpp
#include <hip/hip_runtime.h>
#include <cstdio>
#include <cstdint>

#ifndef MK_PER_PHASE
#define MK_PER_PHASE 0
#endif

namespace cfg {
constexpr int DM = 2048, DFF = 5632, NIN = 5376, NGU = 2 * DFF;
constexpr int TP = 16384, TS = 8192, MP = 2 * TP, MS = 2 * TS, M = MP + MS;
constexpr float EPS = 1e-6f;
constexpr float LOG2E = 1.4426950408889634f;
constexpr float C2 = 0.125f * LOG2E;
}
namespace pg8 {
#define PG8_LAS __attribute__((address_space(3)))
typedef unsigned short bf16_t;
typedef short bf16x8 __attribute__((ext_vector_type(8)));
typedef float f32x4 __attribute__((ext_vector_type(4)));
typedef unsigned u32x4 __attribute__((ext_vector_type(4)));
constexpr int BM = 256, BK = 64, HALF = 128, HTB = HALF * BK * 2  , STAGE_BYTES = 8 * HTB, NXCD = 8, WGM = 8;

__host__ __device__ __forceinline__ int lds_byte(int r, int c) { const int st = (r >> 4) * 2 + (c >> 5), rr = r & 15, cc = c & 31, ob = rr * 64 + cc * 2; return st * 1024 + (ob ^ (((ob >> 9) & 1) << 5)); }
__host__ __device__ __forceinline__ void stage_rc(int b, int& R, int& C) { const int st = b / 1024, sb = b % 1024, swz = sb ^ (((sb >> 9) & 1) << 5); R = (st >> 1) * 16 + swz / 64; C = (st & 1) * 32 + (swz % 64) / 2; }
__host__ __device__ __forceinline__ int perm32(int rho) { const int n = rho >> 4, i = rho & 15; return 8 * (i >> 2) + 4 * n + (i & 3); }

struct Unit { int pm, pn; };
struct Gemm { const bf16_t* A; const bf16_t* Bt; int M, N, K; };

struct StaticOrder {
    int nM, nN, nwg, G, c, wgm;
    __host__ __device__ void init(int M, int N, int G_, int c_, int wgm_ = WGM) { nM = M / BM; nN = N / BM; nwg = nM * nN; G = G_; c = c_; wgm = wgm_; }
    __host__ __device__ bool next(int i, Unit& u) const {
        const long L = (long)i * G + c; if (L >= nwg) return false;
        int wgid = (int)L; { const int q = nwg / NXCD, r = nwg % NXCD, xcd = wgid % NXCD, off = wgid / NXCD; wgid = (xcd < r ? xcd * (q + 1) : r * (q + 1) + (xcd - r) * q) + off; }
        const int nig = wgm * nN, gid = wgid / nig, fm = gid * wgm, gsz = (nM - fm) < wgm ? (nM - fm) : wgm;
        u.pm = fm + ((wgid % nig) % gsz); u.pn = (wgid % nig) / gsz; return true;
    }
    __device__ __forceinline__ void a_ready(const Unit&) const {}
    __device__ __forceinline__ void done(const Unit&) const {}
};

__device__ __forceinline__ unsigned cvt_pk_bf16(float lo, float hi) { unsigned r; asm volatile("v_cvt_pk_bf16_f32 %0, %1, %2" : "=v"(r) : "v"(lo), "v"(hi)); return r; }
typedef float f32x2 __attribute__((ext_vector_type(2)));

struct EpiSwiglu {
    static constexpr bool PERM = true, AFTER_DRAIN = false, PROBE_TWICE = true;
    bf16_t* H; const unsigned long long* rss;
    __device__ __forceinline__ void operator()(const f32x4 (&acc)[2][2][4][2], const Unit& u, int wr, int wc, int fr, int fq) const {
        const int row0 = u.pm * BM + wr * 64 + fr, col0 = u.pn * 128 + wc * 32 + 8 * fq;
        float rv[2][4];
#pragma unroll
        for (int ai = 0; ai < 2; ++ai)
#pragma unroll
            for (int m = 0; m < 4; ++m) rv[ai][m] = (float)rss[row0 + ai * HALF + m * 16] * 2.3283064365386963e-10f;
#pragma unroll
        for (int ai = 0; ai < 2; ++ai)
#pragma unroll
            for (int m = 0; m < 4; ++m) {
                bf16_t* rowp = H + (unsigned)((row0 + ai * HALF + m * 16) * cfg::DFF + col0);
                const float rinv = __builtin_amdgcn_rsqf(rv[ai][m] * (1.0f / cfg::DM) + cfg::EPS);
                float hv[8];
#pragma unroll
                for (int n = 0; n < 2; ++n)
#pragma unroll
                    for (int j = 0; j < 4; ++j) {
                        const float g = acc[ai][0][m][n][j] * rinv, up = acc[ai][1][m][n][j] * rinv;
                        const float e = __builtin_amdgcn_exp2f(-g * cfg::LOG2E);
                        hv[n * 4 + j] = (g * up) * __builtin_amdgcn_rcpf(1.0f + e);
                    }
                u32x4 w; w.x = cvt_pk_bf16(hv[0], hv[1]); w.y = cvt_pk_bf16(hv[2], hv[3]); w.z = cvt_pk_bf16(hv[4], hv[5]); w.w = cvt_pk_bf16(hv[6], hv[7]);
                *(u32x4*)rowp = w;
                asm volatile("" ::: "memory");
            }
    }
};
__device__ __forceinline__ f32x4 bf16x4_lo(u32x4 w, int h) { f32x4 r; const unsigned a = h ? w.z : w.x, b = h ? w.w : w.y;
    r[0] = __uint_as_float(a << 16); r[1] = __uint_as_float(a & 0xffff0000u); r[2] = __uint_as_float(b << 16); r[3] = __uint_as_float(b & 0xffff0000u); return r; }
struct EpiResid {
    static constexpr bool PERM = true, AFTER_DRAIN = false, PROBE_TWICE = false;
    bf16_t* R; float alpha; unsigned long long* rssw;
    __device__ __forceinline__ void operator()(const f32x4 (&acc)[2][2][4][2], const Unit& u, int wr, int wc, int fr, int fq) const {
        bf16_t* rb = R + (size_t)u.pm * BM * cfg::DM;
        const unsigned off0 = (unsigned)(wr * 64 + fr) * cfg::DM + (unsigned)(u.pn * BM + wc * 32 + 8 * fq);
        float sel[2] = {0.f, 0.f};
        u32x4 vq[4][2];
#define RES_LOAD(S, it_) do { const unsigned o_ = off0 + (unsigned)(((it_) >> 2) * HALF + ((it_) & 3) * 16) * cfg::DM; \
        vq[S][0] = *(const u32x4*)(rb + o_); vq[S][1] = *(const u32x4*)(rb + o_ + HALF); } while (0)
#define RES_DO(S, it_) do { const int ai = (it_) >> 2, m = (it_) & 3; const unsigned off = off0 + (unsigned)(ai * HALF + m * 16) * cfg::DM; float ss = 0.f; \
        _Pragma("unroll") for (int bj = 0; bj < 2; ++bj) { const f32x4 o0 = bf16x4_lo(vq[S][bj], 0) + acc[ai][bj][m][0] * alpha, o1 = bf16x4_lo(vq[S][bj], 1) + acc[ai][bj][m][1] * alpha; \
            ss += (o0[0] * o0[0] + o0[1] * o0[1]) + (o0[2] * o0[2] + o0[3] * o0[3]) + (o1[0] * o1[0] + o1[1] * o1[1]) + (o1[2] * o1[2] + o1[3] * o1[3]); \
            u32x4 w; w.x = cvt_pk_bf16(o0[0], o0[1]); w.y = cvt_pk_bf16(o0[2], o0[3]); w.z = cvt_pk_bf16(o1[0], o1[1]); w.w = cvt_pk_bf16(o1[2], o1[3]); \
            *(u32x4*)(rb + off + bj * HALF) = w; } \
        if (rssw) { ss += __shfl_xor(ss, 16); ss += __shfl_xor(ss, 32); if (fq == m) sel[ai] = ss; } } while (0)
        RES_LOAD(0, 0); RES_LOAD(1, 1); RES_LOAD(2, 2);
        RES_LOAD(3, 3); RES_DO(0, 0); asm volatile("" ::: "memory");
        RES_LOAD(0, 4); RES_DO(1, 1); asm volatile("" ::: "memory");
        RES_LOAD(1, 5); RES_DO(2, 2); asm volatile("" ::: "memory");
        RES_LOAD(2, 6); RES_DO(3, 3); asm volatile("" ::: "memory");
        RES_LOAD(3, 7); RES_DO(0, 4); asm volatile("" ::: "memory");
        RES_DO(1, 5); asm volatile("" ::: "memory");
        RES_DO(2, 6); asm volatile("" ::: "memory");
        RES_DO(3, 7); asm volatile("" ::: "memory");
#undef RES_LOAD
#undef RES_DO
        if (rssw) {
#pragma unroll
            for (int ai = 0; ai < 2; ++ai) atomicAdd(rssw + u.pm * BM + wr * 64 + ai * HALF + fq * 16 + fr, (unsigned long long)(sel[ai] * 4294967296.0f));
        }
    }
};
struct EpiWin {
    static constexpr bool PERM = true, AFTER_DRAIN = false, PROBE_TWICE = false;
    bf16_t* QKV; const float* gq; const float* gk; const unsigned long long* rss; unsigned* nrm2;
    __device__ __forceinline__ void operator()(const f32x4 (&acc)[2][2][4][2], const Unit& u, int wr, int wc, int fr, int fq) const {
        const int pn = u.pn;
        int kind = 0; float sc = 1.f;
        if (pn < 2) { kind = 1; sc = cfg::C2; }
        else if (pn == 2) { kind = (wc < 2) ? 2 : 0; }
        else if (pn == 3 || pn == 4 || pn == 9 || pn == 10 || pn == 15 || pn == 16) sc = cfg::C2;
        const int row0 = u.pm * BM + wr * 64 + fr;
        const int colb = pn * 256 + wc * 64 + 8 * fq;
        float rv[2][4];
#pragma unroll
        for (int ai = 0; ai < 2; ++ai)
#pragma unroll
            for (int m = 0; m < 4; ++m) rv[ai][m] = (float)rss[row0 + ai * HALF + m * 16] * 2.3283064365386963e-10f;
        if (kind == 0) {
            const bool want = (pn >= 3 && pn <= 6) || (pn >= 9 && pn <= 12) || (pn >= 15 && pn <= 18);
            float nmax = 0.f;
#pragma unroll
            for (int ai = 0; ai < 2; ++ai)
#pragma unroll
                for (int m = 0; m < 4; ++m) {
                    bf16_t* rowp = QKV + (unsigned)((row0 + ai * HALF + m * 16) * cfg::NIN + colb);
                    const float rs_ = __builtin_amdgcn_rsqf(rv[ai][m] * (1.0f / cfg::DM) + cfg::EPS) * sc;
                    float ss = 0.f;
#pragma unroll
                    for (int bj = 0; bj < 2; ++bj) { const f32x4 v0 = acc[ai][bj][m][0] * rs_, v1 = acc[ai][bj][m][1] * rs_;
                        ss += (v0[0] * v0[0] + v0[1] * v0[1]) + (v0[2] * v0[2] + v0[3] * v0[3]) + (v1[0] * v1[0] + v1[1] * v1[1]) + (v1[2] * v1[2] + v1[3] * v1[3]);
                        u32x4 w; w.x = cvt_pk_bf16(v0[0], v0[1]); w.y = cvt_pk_bf16(v0[2], v0[3]); w.z = cvt_pk_bf16(v1[0], v1[1]); w.w = cvt_pk_bf16(v1[2], v1[3]);
                        *(u32x4*)(rowp + 32 * bj) = w; }
                    if (want) { ss += __shfl_xor(ss, 16); ss += __shfl_xor(ss, 32); nmax = fmaxf(nmax, ss); }
                    asm volatile("" ::: "memory");
                }
            if (want) {
                float t = nmax;
                t = fmaxf(t, __shfl_xor(t, 1)); t = fmaxf(t, __shfl_xor(t, 2)); t = fmaxf(t, __shfl_xor(t, 4)); t = fmaxf(t, __shfl_xor(t, 8));
                const int rowt = u.pm * BM; const int seq = rowt < cfg::MP ? (rowt >> 14) : 2 + ((rowt - cfg::MP) >> 13);
                if ((fr | fq) == 0) atomicMax(nrm2 + (4 * pn + wc) * 4 + seq, __float_as_uint(t));
            }
        } else {
            const float* g = (kind == 1) ? gq : gk;
            float invrev[2][2];
#pragma unroll
            for (int n = 0; n < 2; ++n)
#pragma unroll
                for (int jj = 0; jj < 2; ++jj) invrev[n][jj] = __builtin_amdgcn_exp2f(-(float)(4 * fq + 2 * n + jj) * (13.287712379549449f / 16.0f)) * 0.15915494309189535f;
#pragma unroll
            for (int ai = 0; ai < 2; ++ai)
#pragma unroll
                for (int m = 0; m < 4; ++m) {
                    const int row = row0 + ai * HALF + m * 16;
                    const int t = (row < cfg::MP) ? (row & (cfg::TP - 1)) : (row & (cfg::TS - 1));
                    float prow = (float)(t >> 6), pcol = (float)(row & 63);
                    asm volatile("" : "+v"(prow), "+v"(pcol) :: "memory");
                    float ss = 0.f;
#pragma unroll
                    for (int bj = 0; bj < 2; ++bj)
#pragma unroll
                        for (int n = 0; n < 2; ++n) { const f32x4 v = acc[ai][bj][m][n]; ss += (v[0] * v[0] + v[1] * v[1]) + (v[2] * v[2] + v[3] * v[3]); }
                    ss += __shfl_xor(ss, 16); ss += __shfl_xor(ss, 32);
                    const float rw = __builtin_amdgcn_rsqf(rv[ai][m] * (1.0f / cfg::DM) + cfg::EPS);
                    const float rinv = rw * __builtin_amdgcn_rsqf(ss * rw * rw * (1.0f / 64.0f) + cfg::EPS);
                    bf16_t* rowp = QKV + (unsigned)(row * cfg::NIN + colb);
#pragma unroll
                    for (int bj = 0; bj < 2; ++bj) {
                        const float pos = bj ? pcol : prow;
                        float o[8];
#pragma unroll
                        for (int n = 0; n < 2; ++n) {
                            const f32x4 y = acc[ai][bj][m][n] * rinv * *(const f32x4*)(g + 32 * bj + 8 * fq + 4 * n);
#pragma unroll
                            for (int jj = 0; jj < 2; ++jj) {
                                const float rev = __builtin_amdgcn_fractf(pos * invrev[n][jj]);
                                const float sn = __builtin_amdgcn_sinf(rev), cs = __builtin_amdgcn_cosf(rev);
                                const float x1 = y[2 * jj], x2 = y[2 * jj + 1];
                                o[4 * n + 2 * jj] = (x1 * cs - x2 * sn) * sc; o[4 * n + 2 * jj + 1] = (x1 * sn + x2 * cs) * sc;
                            }
                        }
                        u32x4 w; w.x = cvt_pk_bf16(o[0], o[1]); w.y = cvt_pk_bf16(o[2], o[3]); w.z = cvt_pk_bf16(o[4], o[5]); w.w = cvt_pk_bf16(o[6], o[7]);
                        *(u32x4*)(rowp + 32 * bj) = w;
                        asm volatile("" ::: "memory");
                    }
                }
        }
    }
};

template <class Epi, class Sched, bool ALIGN_EPI = false, bool SP2 = false>
__device__ __forceinline__ void gemm_phase(PG8_LAS unsigned char* lds, const Gemm g, const Sched& S, const Epi& E) {
    int tid_ = threadIdx.x; asm volatile("" : "+v"(tid_));
    const int tid = tid_, wid = __builtin_amdgcn_readfirstlane(tid >> 6), lane = tid & 63, wr = wid >> 2, wc = wid & 3, fr = lane & 15, fq = lane >> 4;
    const int K = g.K, nt = K / BK;
    unsigned voffA[2], voffB[2];
#pragma unroll
    for (int i = 0; i < 2; ++i) { int R, C; stage_rc(tid * 16 + i * 8192, R, C); const int Rb = Epi::PERM ? ((R & ~31) + perm32(R & 31)) : R;
        voffA[i] = (unsigned)(R * K + C) * 2u; voffB[i] = (unsigned)(Rb * K + C) * 2u; }
    const size_t kstep = (size_t)(BK * 2);
    const size_t hstep = (size_t)HALF * K * 2;
    const size_t tstep = 2 * hstep;
    const unsigned ldsw = (unsigned)wid * 1024u;
    const int aoff = lds_byte(wr * 64 + fr, fq * 8), boff = lds_byte(wc * 32 + fr, fq * 8);
#define PG8_SA(b, h) (((b) * 2 + (h)) * HTB)
#define PG8_SB(b, h) ((4 + (b) * 2 + (h)) * HTB)
#define PG8_STAGE(bufoff, gbase, voff) do { _Pragma("unroll") for (int _i = 0; _i < 2; ++_i) \
        __builtin_amdgcn_global_load_lds((const unsigned*)((const char*)(gbase) + (voff)[_i]), (PG8_LAS unsigned*)(lds + (bufoff) + ldsw + _i * 8192), 16, 0, 0); } while (0)
#define PG8_LDA(dst, b, h) do { _Pragma("unroll") for (int m = 0; m < 4; ++m) _Pragma("unroll") for (int k = 0; k < 2; ++k) dst[m][k] = *(const PG8_LAS bf16x8*)(lds + PG8_SA(b, h) + aoff + m * 2048 + k * 1024); } while (0)
#define PG8_LDB(dst, b, h) do { _Pragma("unroll") for (int n = 0; n < 2; ++n) _Pragma("unroll") for (int k = 0; k < 2; ++k) dst[n][k] = *(const PG8_LAS bf16x8*)(lds + PG8_SB(b, h) + boff + n * 2048 + k * 1024); } while (0)
#define PG8_MMA(ai, bj, At, Bt) do { __builtin_amdgcn_s_setprio(1); _Pragma("unroll") for (int m = 0; m < 4; ++m) _Pragma("unroll") for (int n = 0; n < 2; ++n) _Pragma("unroll") for (int k = 0; k < 2; ++k) \
        acc[ai][bj][m][n] = __builtin_amdgcn_mfma_f32_16x16x32_bf16(Bt[n][k], At[m][k], acc[ai][bj][m][n], 0, 0, 0); __builtin_amdgcn_s_setprio(0); } while (0)
#define PG8_WAIT_V(n) asm volatile("s_waitcnt vmcnt(" #n ")" ::: "memory")
#define PG8_WAIT_L(n) asm volatile("s_waitcnt lgkmcnt(" #n ")" ::: "memory")
#define PG8_BAR __builtin_amdgcn_s_barrier()
#define PG8_SCHED __builtin_amdgcn_sched_barrier(0)
    Unit cur, nxt; int ui = 0;
    if (!S.next(0, cur)) return;
    f32x4 acc[2][2][4][2];
#pragma unroll
    for (int a = 0; a < 2; ++a)
#pragma unroll
        for (int b = 0; b < 2; ++b)
#pragma unroll
            for (int m = 0; m < 4; ++m)
#pragma unroll
                for (int n = 0; n < 2; ++n) acc[a][b][m][n] = (f32x4){0.f, 0.f, 0.f, 0.f};
    bf16x8 At[4][2], B0[2][2], B1[2][2];
    const char* cA = (const char*)g.A + (size_t)cur.pm * tstep; const char* cB = (const char*)g.Bt + (size_t)cur.pn * tstep;
    S.a_ready(cur);
    if constexpr (SP2) {
        PG8_STAGE(PG8_SB(0, 0), cB, voffB); PG8_STAGE(PG8_SB(0, 1), cB + hstep, voffB); PG8_STAGE(PG8_SA(0, 0), cA, voffA); PG8_STAGE(PG8_SA(0, 1), cA + hstep, voffA);
        if (wr == 1) PG8_BAR;
        PG8_WAIT_V(2); PG8_BAR;
        PG8_STAGE(PG8_SB(1, 0), cB + kstep, voffB); PG8_STAGE(PG8_SA(1, 0), cA + kstep, voffA); PG8_STAGE(PG8_SB(1, 1), cB + hstep + kstep, voffB);
        PG8_WAIT_V(6); PG8_BAR;
    } else {
        PG8_STAGE(PG8_SB(0, 0), cB, voffB); PG8_STAGE(PG8_SA(0, 0), cA, voffA); PG8_STAGE(PG8_SB(0, 1), cB + hstep, voffB); PG8_STAGE(PG8_SA(0, 1), cA + hstep, voffA);
        if (wr == 1) PG8_BAR;
        PG8_WAIT_V(4); PG8_BAR;
        PG8_STAGE(PG8_SB(1, 0), cB + kstep, voffB); PG8_STAGE(PG8_SA(1, 0), cA + kstep, voffA); PG8_STAGE(PG8_SB(1, 1), cB + hstep + kstep, voffB);
        PG8_WAIT_V(6); PG8_BAR;
    }
    for (;;) {
        const bool has_next = S.next(ui + 1, nxt);
        const char* nA = has_next ? (const char*)g.A + (size_t)nxt.pm * tstep : cA; const char* nB = has_next ? (const char*)g.Bt + (size_t)nxt.pn * tstep : cB;
        for (int t = 0; t < nt; t += 2) {
            const bool last = (t == nt - 2);
            const char* a1 = cA + (size_t)(t + 1) * kstep;
            const char* a2 = last ? nA : cA + (size_t)(t + 2) * kstep; const char* b2 = last ? nB : cB + (size_t)(t + 2) * kstep;
            const char* a3 = a2 + kstep; const char* b3 = b2 + kstep;
            if (last && has_next) S.a_ready(nxt);
            if constexpr (SP2) {
            PG8_LDB(B0, 0, 0); PG8_LDB(B1, 0, 1); PG8_SCHED; PG8_LDA(At, 0, 0); PG8_STAGE(PG8_SA(1, 1), a1 + hstep, voffA);
            PG8_WAIT_V(8); PG8_WAIT_L(0); PG8_BAR; PG8_MMA(0, 0, At, B0); PG8_MMA(0, 1, At, B1); PG8_BAR; PG8_SCHED;
            PG8_LDA(At, 0, 1); PG8_STAGE(PG8_SB(0, 0), b2, voffB); PG8_STAGE(PG8_SB(0, 1), b2 + hstep, voffB); PG8_STAGE(PG8_SA(0, 0), a2, voffA);
            PG8_WAIT_V(8); PG8_WAIT_L(0); PG8_BAR; PG8_MMA(1, 0, At, B0); PG8_MMA(1, 1, At, B1); PG8_BAR; PG8_SCHED;
            PG8_LDB(B0, 1, 0); PG8_LDB(B1, 1, 1); PG8_SCHED; PG8_LDA(At, 1, 0); PG8_STAGE(PG8_SA(0, 1), a2 + hstep, voffA);
            PG8_WAIT_V(8); PG8_WAIT_L(0); PG8_BAR; PG8_MMA(0, 0, At, B0); PG8_MMA(0, 1, At, B1); PG8_BAR; PG8_SCHED;
            PG8_LDA(At, 1, 1); PG8_STAGE(PG8_SB(1, 0), b3, voffB); PG8_STAGE(PG8_SB(1, 1), b3 + hstep, voffB); PG8_STAGE(PG8_SA(1, 0), a3, voffA);
            PG8_WAIT_V(8); PG8_WAIT_L(0); PG8_BAR; PG8_MMA(1, 0, At, B0); PG8_MMA(1, 1, At, B1); PG8_BAR; PG8_SCHED;
            } else {
            PG8_LDB(B0, 0, 0); PG8_SCHED; PG8_LDA(At, 0, 0); PG8_STAGE(PG8_SA(1, 1), a1 + hstep, voffA);
            PG8_WAIT_L(8); PG8_BAR; PG8_WAIT_L(0); PG8_MMA(0, 0, At, B0); PG8_BAR; PG8_SCHED;
            PG8_LDB(B1, 0, 1); PG8_STAGE(PG8_SB(0, 0), b2, voffB);
            PG8_BAR; PG8_WAIT_L(0); PG8_MMA(0, 1, At, B1); PG8_BAR;
            PG8_LDA(At, 0, 1); PG8_STAGE(PG8_SA(0, 0), a2, voffA);
            PG8_BAR; PG8_WAIT_L(0); PG8_MMA(1, 0, At, B0); PG8_BAR; PG8_SCHED;
            PG8_STAGE(PG8_SB(0, 1), b2 + hstep, voffB);
            PG8_WAIT_V(6); PG8_BAR; PG8_MMA(1, 1, At, B1); PG8_BAR;
            PG8_LDB(B0, 1, 0); PG8_SCHED; PG8_LDA(At, 1, 0); PG8_STAGE(PG8_SA(0, 1), a2 + hstep, voffA);
            PG8_WAIT_L(8); PG8_BAR; PG8_WAIT_L(0); PG8_MMA(0, 0, At, B0); PG8_BAR; PG8_SCHED;
            PG8_LDB(B1, 1, 1); PG8_STAGE(PG8_SB(1, 0), b3, voffB);
            PG8_BAR; PG8_WAIT_L(0); PG8_MMA(0, 1, At, B1); PG8_BAR;
            PG8_LDA(At, 1, 1); PG8_STAGE(PG8_SA(1, 0), a3, voffA);
            PG8_BAR; PG8_WAIT_L(0); PG8_MMA(1, 0, At, B0); PG8_BAR; PG8_SCHED;
            PG8_STAGE(PG8_SB(1, 1), b3 + hstep, voffB);
            PG8_WAIT_V(6); PG8_BAR; PG8_MMA(1, 1, At, B1); PG8_BAR;
            }
        }
        if constexpr (ALIGN_EPI) { if (wr == 0) PG8_BAR; }
        if constexpr (!Epi::AFTER_DRAIN) { E(acc, cur, wr, wc, fr, fq);
#if defined(PROBE_EPI2)
            if constexpr (Epi::PROBE_TWICE) { asm volatile("" ::: "memory"); E(acc, cur, wr, wc, fr, fq); }
#endif
            S.done(cur); }
        if (!has_next) break;
#pragma unroll
        for (int a = 0; a < 2; ++a)
#pragma unroll
            for (int b = 0; b < 2; ++b)
#pragma unroll
                for (int m = 0; m < 4; ++m)
#pragma unroll
                    for (int n = 0; n < 2; ++n) acc[a][b][m][n] = (f32x4){0.f, 0.f, 0.f, 0.f};
        cur = nxt; cA = nA; cB = nB; ++ui;
        if constexpr (ALIGN_EPI) { if (wr == 1) PG8_BAR; }
    }
    PG8_WAIT_V(0);
    if constexpr (!ALIGN_EPI) { if (wr == 0) PG8_BAR; }
    PG8_BAR;
    if constexpr (Epi::AFTER_DRAIN) { E.fused(acc, cur, wr, wc, fr, fq, lds, wid, lane); S.done(cur); }
#undef PG8_SA
#undef PG8_SB
#undef PG8_STAGE
#undef PG8_LDA
#undef PG8_LDB
#undef PG8_MMA
#undef PG8_WAIT_V
#undef PG8_WAIT_L
#undef PG8_BAR
#undef PG8_SCHED
}
}
namespace att {
#define ATT_LAS __attribute__((address_space(3)))
using bf16x8 = __attribute__((ext_vector_type(8))) short;
using s16x4  = __attribute__((ext_vector_type(4))) short;
using f32x16 = __attribute__((ext_vector_type(16))) float;
using u32x4  = __attribute__((ext_vector_type(4))) unsigned;
typedef unsigned short bf16_t;
typedef ATT_LAS char* lptr;
constexpr int PITCH = cfg::NIN, OPITCH = cfg::DM;
constexpr float LOG2E = cfg::LOG2E, NEG = -1e30f, THR = 8.f;
#ifndef ATT_RING
#define ATT_RING 0
#endif
#if ATT_RING
constexpr int L_K = 0, L_V = 49152, L_WS = 98304, L_LUT = 100352, L_OST = 65536, L_END = 112640;
#else
constexpr int L_K = 0, L_V = 32768, L_WS = 65536, L_LUT = 67584, L_OST = 81920, L_END = 114688;
#endif
constexpr int LUTB_R = 704, LUTD_R = 1344;
#define ATT_SBAR() __builtin_amdgcn_sched_barrier(0)
__device__ __forceinline__ int crow(int r, int hi) { return (r & 3) + 8 * (r >> 2) + 4 * hi; }
__device__ __forceinline__ unsigned cvtpk(float lo, float hi) { unsigned r; asm volatile("v_cvt_pk_bf16_f32 %0, %1, %2" : "=v"(r) : "v"(lo), "v"(hi)); return r; }
__device__ __forceinline__ float wave_sum(float v) {
#pragma unroll
    for (int o = 1; o < 64; o <<= 1) v += __shfl_xor(v, o);
    return v;
}
__device__ __forceinline__ int t5_bucket(int rel) {
    const int n = rel < 0 ? -rel : rel;
    int b = n;
    if (n >= 8) b = 8 + (n >= 15) + (n >= 27) + (n >= 50) + (n >= 91) + (n >= 166) + (n >= 305) + (n >= 559);
    return b + (rel > 0 ? 16 : 0);
}
template <int KC> __device__ __forceinline__ int kswz(int row, int colB) { return KC == 128 ? row * 256 + (colB ^ ((row & 7) << 4)) : row * 128 + (colB ^ (((row >> 1) & 7) << 4)); }
template <int NCB> __device__ __forceinline__ int v_st(int k, int c) { const int kk = (k & ~0xC) | ((k & 4) << 1) | ((k & 8) >> 1); return ((kk >> 3) * NCB + (c >> 5)) * 512 + ((kk & 7) * 32 + (c & 31)) * 2; }
__device__ __forceinline__ int v_rd_base(int lane) { return ((lane & 3) << 3) | (((lane >> 2) & 3) << 6) | (((lane >> 4) & 1) << 5) | (((lane >> 5) & 1) << 8); }
template <int OFF> __device__ __forceinline__ s16x4 tr_read(int vb) { s16x4 r; asm volatile("ds_read_b64_tr_b16 %0, %1 offset:%2" : "=&v"(r) : "v"(vb), "i"(OFF) : "memory"); return r; }
template <int NCB, int D0> __device__ __forceinline__ void pv_one(f32x16& od, int vb, bf16x8 pa0, bf16x8 pa1, bf16x8 pa2, bf16x8 pa3) {
#define ATT_VOFF(ks, half) (D0 * 512 + (ks) * (NCB * 1024) + (half) * (NCB * 512))
    const s16x4 l0 = tr_read<ATT_VOFF(0, 0)>(vb), h0 = tr_read<ATT_VOFF(0, 1)>(vb), l1 = tr_read<ATT_VOFF(1, 0)>(vb), h1 = tr_read<ATT_VOFF(1, 1)>(vb);
    const s16x4 l2 = tr_read<ATT_VOFF(2, 0)>(vb), h2 = tr_read<ATT_VOFF(2, 1)>(vb), l3 = tr_read<ATT_VOFF(3, 0)>(vb), h3 = tr_read<ATT_VOFF(3, 1)>(vb);
#undef ATT_VOFF
    asm volatile("s_waitcnt lgkmcnt(0)" ::: "memory"); ATT_SBAR();
#define ATT_PK(L, H) (bf16x8){L[0], L[1], L[2], L[3], H[0], H[1], H[2], H[3]}
    od = __builtin_amdgcn_mfma_f32_32x32x16_bf16(pa0, ATT_PK(l0, h0), od, 0, 0, 0);
    od = __builtin_amdgcn_mfma_f32_32x32x16_bf16(pa1, ATT_PK(l1, h1), od, 0, 0, 0);
    od = __builtin_amdgcn_mfma_f32_32x32x16_bf16(pa2, ATT_PK(l2, h2), od, 0, 0, 0);
    od = __builtin_amdgcn_mfma_f32_32x32x16_bf16(pa3, ATT_PK(l3, h3), od, 0, 0, 0);
#undef ATT_PK
}
template <int NCB, bool ONES> __device__ __forceinline__ void pv_all(f32x16* o, f32x16& lacc, int vb, bf16x8 pa0, bf16x8 pa1, bf16x8 pa2, bf16x8 pa3) {
    if constexpr (ONES) { const bf16x8 ones = {0x3F80, 0x3F80, 0x3F80, 0x3F80, 0x3F80, 0x3F80, 0x3F80, 0x3F80};
        lacc = __builtin_amdgcn_mfma_f32_32x32x16_bf16(pa0, ones, lacc, 0, 0, 0); lacc = __builtin_amdgcn_mfma_f32_32x32x16_bf16(pa1, ones, lacc, 0, 0, 0);
        lacc = __builtin_amdgcn_mfma_f32_32x32x16_bf16(pa2, ones, lacc, 0, 0, 0); lacc = __builtin_amdgcn_mfma_f32_32x32x16_bf16(pa3, ones, lacc, 0, 0, 0); }
    pv_one<NCB, 0>(o[0], vb, pa0, pa1, pa2, pa3); pv_one<NCB, 1>(o[1], vb, pa0, pa1, pa2, pa3);
    if constexpr (NCB == 4) { pv_one<NCB, 2>(o[2], vb, pa0, pa1, pa2, pa3); pv_one<NCB, 3>(o[3], vb, pa0, pa1, pa2, pa3); }
}
template <bool NOMAX> __device__ __forceinline__ void partialSM(f32x16& p0, f32x16& p1, float cb, float& m_reg, float& alpha) {
    if constexpr (NOMAX) { alpha = 1.f;
        (void)cb;
#pragma unroll
        for (int r = 0; r < 16; ++r) p0[r] = __builtin_amdgcn_exp2f(p0[r]);
        return; }
    float ma = fmaxf(p0[0], p0[1]), mb = fmaxf(p0[2], p0[3]), mc = fmaxf(p1[0], p1[1]), md = fmaxf(p1[2], p1[3]);
#pragma unroll
    for (int r = 4; r < 16; r += 4) { ma = fmaxf(fmaxf(ma, p0[r]), p0[r + 1]); mb = fmaxf(fmaxf(mb, p0[r + 2]), p0[r + 3]); mc = fmaxf(fmaxf(mc, p1[r]), p1[r + 1]); md = fmaxf(fmaxf(md, p1[r + 2]), p1[r + 3]); }
    float pmax = fmaxf(fmaxf(ma, mb), fmaxf(mc, md));
    { auto rr = __builtin_amdgcn_permlane32_swap(__float_as_uint(pmax), __float_as_uint(pmax), false, false); pmax = fmaxf(__uint_as_float(rr[0]), __uint_as_float(rr[1])); }
    pmax += cb;
    float mn;
    if (__builtin_expect(__all(pmax - m_reg <= THR), 1)) { mn = m_reg; alpha = 1.f; }
    else { mn = fmaxf(m_reg, pmax); alpha = __builtin_amdgcn_exp2f(m_reg - mn); m_reg = mn; }
    const float sub = cb - mn;
#pragma unroll
    for (int r = 0; r < 16; ++r) p0[r] += sub;
#pragma unroll
    for (int r = 0; r < 16; ++r) p1[r] += sub;
#pragma unroll
    for (int r = 0; r < 16; ++r) p0[r] = __builtin_amdgcn_exp2f(p0[r]);
}
template <bool ONES> __device__ __forceinline__ void finishSM(f32x16& p0, f32x16& p1, float alpha, float& l_reg, bf16x8& pa0, bf16x8& pa1, bf16x8& pa2, bf16x8& pa3) {
#pragma unroll
    for (int r = 0; r < 16; ++r) p1[r] = __builtin_amdgcn_exp2f(p1[r]);
    if constexpr (!ONES) {
    float sa = p0[0] + p0[1], sb = p0[2] + p0[3], sc_ = p1[0] + p1[1], sd = p1[2] + p1[3];
#pragma unroll
    for (int r = 4; r < 16; r += 4) { sa += p0[r]; sa += p0[r + 1]; sb += p0[r + 2]; sb += p0[r + 3]; sc_ += p1[r]; sc_ += p1[r + 1]; sd += p1[r + 2]; sd += p1[r + 3]; }
    float ps = (sa + sb) + (sc_ + sd);
    { auto rr = __builtin_amdgcn_permlane32_swap(__float_as_uint(ps), __float_as_uint(ps), false, false); ps = __uint_as_float(rr[0]) + __uint_as_float(rr[1]); }
    l_reg = l_reg * alpha + ps;
    }
#define ATT_PK4(P, BASE, OUT) do { unsigned a0 = cvtpk(P[BASE + 0], P[BASE + 1]), a1 = cvtpk(P[BASE + 2], P[BASE + 3]);   \
    unsigned b0 = cvtpk(P[BASE + 4], P[BASE + 5]), b1 = cvtpk(P[BASE + 6], P[BASE + 7]);                              \
    auto r0 = __builtin_amdgcn_permlane32_swap(a0, b0, false, false); auto r1 = __builtin_amdgcn_permlane32_swap(a1, b1, false, false); \
    u32x4 w = {r0[0], r1[0], r0[1], r1[1]}; OUT = __builtin_bit_cast(bf16x8, w); } while (0)
    ATT_PK4(p0, 0, pa0); ATT_PK4(p0, 8, pa1); ATT_PK4(p1, 0, pa2); ATT_PK4(p1, 8, pa3);
#undef ATT_PK4
}
template <int KC, bool USEC> __device__ __forceinline__ void qkt(f32x16& p0, f32x16& p1, lptr Ks, int cb0, const bf16x8* qr, const f32x16& c0, int r32, int hi) {
    if constexpr (!USEC) { p0 = f32x16{}; p1 = f32x16{}; }
#pragma unroll
    for (int d0 = 0; d0 < 4; ++d0) { const int cb = cb0 + d0 * 32 + hi * 16;
        const bf16x8 b0 = *(const ATT_LAS bf16x8*)(Ks + kswz<KC>(r32, cb));
        const bf16x8 b1 = *(const ATT_LAS bf16x8*)(Ks + kswz<KC>(32 + r32, cb));
        if (USEC && d0 == 0) { p0 = __builtin_amdgcn_mfma_f32_32x32x16_bf16(b0, qr[0], c0, 0, 0, 0); p1 = __builtin_amdgcn_mfma_f32_32x32x16_bf16(b1, qr[0], c0, 0, 0, 0); }
        else { p0 = __builtin_amdgcn_mfma_f32_32x32x16_bf16(b0, qr[d0], p0, 0, 0, 0); p1 = __builtin_amdgcn_mfma_f32_32x32x16_bf16(b1, qr[d0], p1, 0, 0, 0); } }
}
struct Aux { const float* t5; const float* rpb; const float* lam_p; const float* subln; float lam_init; };

template <int MODE, bool NOMAX = false>
__device__ __forceinline__ void attn_unit(const bf16_t* __restrict__ QKV, bf16_t* __restrict__ ATT, lptr lds, int row0, int T, int h, int qb, const Aux& ax) {
#ifndef ATT_ONES
#define ATT_ONES 1
#endif
    constexpr bool ONES = (ATT_ONES != 0) && (MODE != 1);
    constexpr int KC = (MODE == 1) ? 128 : 64, DV = (MODE == 1) ? 128 : 64, NCB = DV / 32, NR = KC / 64;
    constexpr int KBYTES = 64 * KC * 2, VBYTES = 64 * DV * 2, QROWS = (MODE == 1) ? 128 : 256;
    int tid_ = threadIdx.x; asm volatile("" : "+v"(tid_));
    const int tid = tid_, lane = tid & 63, r32 = lane & 31, hi = lane >> 5;
    const int wid = __builtin_amdgcn_readfirstlane(tid >> 6);
    const int map = (MODE == 1) ? (wid >> 2) : 0, wq = (MODE == 1) ? (wid & 3) : wid;
    const int q0 = qb * QROWS, qw = q0 + wq * 32, qpos = qw + r32;
    int qcol, kcol, vcol, ocol;
    if (MODE == 0)      { qcol = 64 * h;          kcol = 512 + 64 * (h >> 2); vcol = 640 + 64 * (h >> 2); ocol = 64 * h; }
    else if (MODE == 1) { qcol = 768 + 128 * h + 64 * map; kcol = 1280 + 128 * h; vcol = 1792 + 128 * h; ocol = 512 + 128 * h; }
    else if (MODE == 2) { qcol = 2304 + 64 * h;   kcol = 2816 + 64 * h;       vcol = 3328 + 64 * h;       ocol = 1024 + 64 * h; }
    else                { qcol = 3840 + 64 * h;   kcol = 4352 + 64 * h;       vcol = 4864 + 64 * h;       ocol = 1536 + 64 * h; }
    int tlo = 0, NT = T >> 6;
    if (MODE == 3) { int lo = q0 - 1024; lo = lo < 0 ? 0 : lo; int hi_k = q0 + 255 + 1024; hi_k = hi_k > T - 1 ? T - 1 : hi_k; int a = lo >> 6, b = hi_k >> 6;
        if (((b - a + 1) & 1) != 0) { if (a > 0) --a; else ++b; } tlo = a; NT = b - a + 1; }
    if (MODE == 2) { const int rows = T >> 6, R0 = 4 * qb; int a = R0 - 4; a = a < 0 ? 0 : (a > rows - 8 ? rows - 8 : a); int b = R0 - 1; b = b < 0 ? 0 : (b > rows - 8 ? rows - 8 : b); b += 7;
        if (((b - a + 1) & 1) != 0) { if (a > 0) --a; else ++b; } tlo = a; NT = b - a + 1; }
    const int sr = (KC == 128) ? (tid >> 4) : (tid >> 3), sc = (KC == 128) ? (tid & 15) * 8 : (tid & 7) * 8;
    const bf16_t* Kg = QKV + (size_t)(row0 + sr) * PITCH + kcol + sc;
    const bf16_t* Vg = QKV + (size_t)(row0 + sr) * PITCH + vcol + sc;
    const int kst0 = kswz<KC>(sr, sc * 2), kst1 = kswz<KC>(32 + sr, sc * 2), vst0 = v_st<NCB>(sr, sc), vst1 = v_st<NCB>(32 + sr, sc);
    const lptr K_lds = lds + L_K, V_lds = lds + L_V;
    const int vb0 = (int)(uintptr_t)V_lds + v_rd_base(lane);
    ATT_LAS float* wsf = (ATT_LAS float*)(lds + L_WS) + wid * 64; ATT_LAS float* li_l = wsf; ATT_LAS float* al_l = wsf + 32;
    struct { bf16x8 k[NR], v[NR]; } st_[2];
#define SLOAD(i, tt) do { const size_t ro_ = (size_t)((tlo + (tt)) * 64) * PITCH; st_[i].k[0] = *(const bf16x8*)(Kg + ro_); st_[i].v[0] = *(const bf16x8*)(Vg + ro_); \
        if constexpr (NR == 2) { st_[i].k[1] = *(const bf16x8*)(Kg + ro_ + (size_t)32 * PITCH); st_[i].v[1] = *(const bf16x8*)(Vg + ro_ + (size_t)32 * PITCH); } } while (0)
#define SWRITE(b, i) do { *(ATT_LAS bf16x8*)(K_lds + (b) * KBYTES + kst0) = st_[i].k[0]; *(ATT_LAS bf16x8*)(V_lds + (b) * VBYTES + vst0) = st_[i].v[0]; \
        if constexpr (NR == 2) { *(ATT_LAS bf16x8*)(K_lds + (b) * KBYTES + kst1) = st_[i].k[1]; *(ATT_LAS bf16x8*)(V_lds + (b) * VBYTES + vst1) = st_[i].v[1]; } } while (0)
#define SWAIT() do { if constexpr (NR == 2) asm volatile("s_waitcnt vmcnt(4)" ::: "memory"); else asm volatile("s_waitcnt vmcnt(2)" ::: "memory"); } while (0)
#define RESC(a) do { if (!NOMAX && __any((a) < 1.f)) { if (hi == 0) al_l[r32] = (a); asm volatile("s_waitcnt lgkmcnt(0)" ::: "memory"); \
        _Pragma("unroll") for (int r = 0; r < 16; ++r) { const float f_ = al_l[crow(r, hi)]; if (ONES) lacc[r] *= f_; _Pragma("unroll") for (int d = 0; d < NCB; ++d) o[d][r] *= f_; } } } while (0)
    SLOAD(0, 0); SLOAD(1, 1);
    bf16x8 qr[4];
    { const bf16_t* Qw = QKV + (size_t)(row0 + qpos) * PITCH + qcol + hi * 8;
#pragma unroll
      for (int d0 = 0; d0 < 4; ++d0) qr[d0] = *(const bf16x8*)(Qw + d0 * 16); }
    ATT_LAS float* lut = (ATT_LAS float*)(lds + L_LUT);
    if (MODE == 1) { for (int i = tid; i < 2 * LUTB_R + 1; i += 512) lut[i] = ax.t5[t5_bucket(i - LUTB_R) * 12 + h] * LOG2E; }
    if (MODE == 3) { for (int i = tid; i < 2 * LUTD_R + 1; i += 512) { const int rel = i - LUTD_R, n = rel < 0 ? -rel : rel;
            const int mult = (n <= 64 ? 1 : 0) + (((n & 3) == 0 && n <= 256) ? 1 : 0) + (((n & 15) == 0 && n <= 1024) ? 1 : 0);
            lut[i] = mult == 0 ? NEG : ax.t5[t5_bucket(rel) * 12 + 4 + h] * LOG2E + (mult == 1 ? 0.f : (mult == 2 ? 1.f : 1.5849625007211562f)); } }
    if (MODE == 2) { for (int i = tid; i < 15 * 128; i += 512) { const int dr = i >> 7, dc = (i & 127) - 48; lut[i] = (dc >= 0 && dc <= 30) ? ax.rpb[(h * 15 + dr) * 31 + dc] * LOG2E : NEG; } }
    float cL = 0.f, cR = 0.f; int c_cs = 0, c_rs = 0, c_R = 0, c_c = 0;
    if (MODE == 2) { const int rows = T >> 6; c_R = 4 * qb + (wid >> 1); c_c = 32 * (wid & 1) + r32; c_cs = c_c - 8; c_cs = c_cs < 0 ? 0 : (c_cs > 48 ? 48 : c_cs); c_rs = c_R - 4; c_rs = c_rs < 0 ? 0 : (c_rs > rows - 8 ? rows - 8 : c_rs); }
#define MODIFY(P0, P1, tt, CB) do { CB = 0.f; const int k0_ = (tlo + (tt)) * 64; \
        if constexpr (MODE == 1) { if (k0_ + 63 - qw <= -559) CB = cL; else if (k0_ - qw - 31 >= 559) CB = cR; else { const ATT_LAS float* lp_ = lut + (k0_ - qpos + LUTB_R + 4 * hi); \
            _Pragma("unroll") for (int r = 0; r < 16; ++r) { P0[r] += lp_[(r & 3) + 8 * (r >> 2)]; P1[r] += lp_[32 + (r & 3) + 8 * (r >> 2)]; } } } \
        if constexpr (MODE == 3) { const ATT_LAS float* lp_ = lut + (k0_ - qpos + LUTD_R + 4 * hi); \
            _Pragma("unroll") for (int r = 0; r < 16; ++r) { P0[r] += lp_[(r & 3) + 8 * (r >> 2)]; P1[r] += lp_[32 + (r & 3) + 8 * (r >> 2)]; } } \
        if constexpr (MODE == 2) { const int kr_ = tlo + (tt); if (kr_ < c_rs || kr_ > c_rs + 7) { _Pragma("unroll") for (int r = 0; r < 16; ++r) { P0[r] = NEG; P1[r] = NEG; } } \
            else { const ATT_LAS float* lp_ = lut + ((kr_ - c_R + 7) * 128 + 48 + 15 - c_c + 4 * hi); const int kb_ = 4 * hi - c_cs; \
              _Pragma("unroll") for (int r = 0; r < 16; ++r) { const int ko_ = (r & 3) + 8 * (r >> 2); const float a_ = lp_[ko_], b_ = lp_[32 + ko_]; \
                P0[r] = ((unsigned)(kb_ + ko_) <= 15u) ? P0[r] + a_ : NEG; P1[r] = ((unsigned)(kb_ + 32 + ko_) <= 15u) ? P1[r] + b_ : NEG; } } } \
    } while (0)
    __syncthreads();
    if (MODE == 1) { cL = lut[0]; cR = lut[2 * LUTB_R]; }
    constexpr bool USEC = false;
    float m_reg = NEG, l_reg = 0.f, cbcur = 0.f, cbacc = 0.f; f32x16 o[NCB], lacc = f32x16{}, cbt = f32x16{};
#define REGSC(CB) do { if constexpr (MODE == 1 && NOMAX) { if ((CB) != cbacc) { const float f_ = __builtin_amdgcn_exp2f(cbacc - (CB)); cbacc = (CB); l_reg *= f_; \
        _Pragma("unroll") for (int r = 0; r < 16; ++r) { if (ONES) lacc[r] *= f_; _Pragma("unroll") for (int d = 0; d < NCB; ++d) o[d][r] *= f_; } } } } while (0)
#define REGIONC(tt) do { if constexpr (USEC) { const int k0_ = (tlo + (tt)) * 64; const float cb_ = (k0_ + 63 - qw <= -559) ? cL : ((k0_ - qw - 31 >= 559) ? cR : 0.f); \
        if (cb_ != cbcur) { cbcur = cb_; _Pragma("unroll") for (int r = 0; r < 16; ++r) cbt[r] = cb_; } } } while (0)
#pragma unroll
    for (int d = 0; d < NCB; ++d) o[d] = f32x16{};
    f32x16 pA0, pA1, pB0, pB1; float alA, alB, cbA, cbB; bf16x8 pa0, pa1, pa2, pa3;
    const int cb0 = map * 128;
#if ATT_RING
    int s_prev = 2, s_cur = 0, s_next = 1;
#define ROT() do { const int t_ = s_prev; s_prev = s_cur; s_cur = s_next; s_next = t_; } while (0)
    asm volatile("s_waitcnt vmcnt(0)" ::: "memory"); SWRITE(0, 0); if (2 < NT) SLOAD(0, 2); __syncthreads();
    SWAIT(); SWRITE(1, 1); if (3 < NT) SLOAD(1, 3);
    REGIONC(0); qkt<KC, USEC>(pA0, pA1, K_lds, cb0, qr, cbt, r32, hi); MODIFY(pA0, pA1, 0, cbA); partialSM<NOMAX>(pA0, pA1, cbA, m_reg, alA);
    __syncthreads(); ROT();
    for (int j = 1; j + 1 < NT; j += 2) {
        SWAIT(); SWRITE(s_next, 0); if (j + 3 < NT) SLOAD(0, j + 3);
        REGIONC(j); ATT_SBAR(); qkt<KC, USEC>(pB0, pB1, K_lds + s_cur * KBYTES, cb0, qr, cbt, r32, hi);
        REGSC(cbA); finishSM<ONES>(pA0, pA1, alA, l_reg, pa0, pa1, pa2, pa3); ATT_SBAR();
        pv_all<NCB, ONES>(o, lacc, vb0 + s_prev * (int)VBYTES, pa0, pa1, pa2, pa3); MODIFY(pB0, pB1, j, cbB); partialSM<NOMAX>(pB0, pB1, cbB, m_reg, alB);
        RESC(alB); __syncthreads(); ROT();
        SWAIT(); SWRITE(s_next, 1); if (j + 4 < NT) SLOAD(1, j + 4);
        REGIONC(j + 1); ATT_SBAR(); qkt<KC, USEC>(pA0, pA1, K_lds + s_cur * KBYTES, cb0, qr, cbt, r32, hi);
        REGSC(cbB); finishSM<ONES>(pB0, pB1, alB, l_reg, pa0, pa1, pa2, pa3); ATT_SBAR();
        pv_all<NCB, ONES>(o, lacc, vb0 + s_prev * (int)VBYTES, pa0, pa1, pa2, pa3); MODIFY(pA0, pA1, j + 1, cbA); partialSM<NOMAX>(pA0, pA1, cbA, m_reg, alA);
        RESC(alA); __syncthreads(); ROT();
    }
    REGIONC(NT - 1); ATT_SBAR(); qkt<KC, USEC>(pB0, pB1, K_lds + s_cur * KBYTES, cb0, qr, cbt, r32, hi);
    REGSC(cbA); finishSM<ONES>(pA0, pA1, alA, l_reg, pa0, pa1, pa2, pa3); ATT_SBAR();
    pv_all<NCB, ONES>(o, lacc, vb0 + s_prev * (int)VBYTES, pa0, pa1, pa2, pa3); MODIFY(pB0, pB1, NT - 1, cbB); partialSM<NOMAX>(pB0, pB1, cbB, m_reg, alB);
    RESC(alB);
    REGSC(cbB); finishSM<ONES>(pB0, pB1, alB, l_reg, pa0, pa1, pa2, pa3); ATT_SBAR();
    pv_all<NCB, ONES>(o, lacc, vb0 + s_cur * (int)VBYTES, pa0, pa1, pa2, pa3);
    __syncthreads();
#undef ROT
#else
    asm volatile("s_waitcnt vmcnt(0)" ::: "memory"); SWRITE(0, 0); __syncthreads();
    REGIONC(0); qkt<KC, USEC>(pA0, pA1, K_lds, cb0, qr, cbt, r32, hi); MODIFY(pA0, pA1, 0, cbA); partialSM<NOMAX>(pA0, pA1, cbA, m_reg, alA);
    if (2 < NT) SLOAD(0, 2);
    SWAIT(); SWRITE(1, 1); __syncthreads();
    for (int j = 1; j + 1 < NT; j += 2) {
        REGIONC(j); ATT_SBAR(); qkt<KC, USEC>(pB0, pB1, K_lds + KBYTES, cb0, qr, cbt, r32, hi);
        REGSC(cbA); finishSM<ONES>(pA0, pA1, alA, l_reg, pa0, pa1, pa2, pa3); ATT_SBAR();
        SLOAD(1, j + 2); ATT_SBAR();
        pv_all<NCB, ONES>(o, lacc, vb0, pa0, pa1, pa2, pa3); MODIFY(pB0, pB1, j, cbB); partialSM<NOMAX>(pB0, pB1, cbB, m_reg, alB);
        __syncthreads(); SWAIT(); SWRITE(0, 0);
        RESC(alB); __syncthreads();
        REGIONC(j + 1); ATT_SBAR(); qkt<KC, USEC>(pA0, pA1, K_lds, cb0, qr, cbt, r32, hi);
        REGSC(cbB); finishSM<ONES>(pB0, pB1, alB, l_reg, pa0, pa1, pa2, pa3); ATT_SBAR();
        if (j + 3 < NT) SLOAD(0, j + 3); ATT_SBAR();
        pv_all<NCB, ONES>(o, lacc, vb0 + VBYTES, pa0, pa1, pa2, pa3); MODIFY(pA0, pA1, j + 1, cbA); partialSM<NOMAX>(pA0, pA1, cbA, m_reg, alA);
        __syncthreads(); SWAIT(); SWRITE(1, 1);
        RESC(alA); __syncthreads();
    }
    REGIONC(NT - 1); ATT_SBAR(); qkt<KC, USEC>(pB0, pB1, K_lds + KBYTES, cb0, qr, cbt, r32, hi);
    REGSC(cbA); finishSM<ONES>(pA0, pA1, alA, l_reg, pa0, pa1, pa2, pa3); ATT_SBAR();
    pv_all<NCB, ONES>(o, lacc, vb0, pa0, pa1, pa2, pa3); MODIFY(pB0, pB1, NT - 1, cbB); partialSM<NOMAX>(pB0, pB1, cbB, m_reg, alB);
    __syncthreads(); RESC(alB);
    REGSC(cbB); finishSM<ONES>(pB0, pB1, alB, l_reg, pa0, pa1, pa2, pa3); ATT_SBAR();
    pv_all<NCB, ONES>(o, lacc, vb0 + VBYTES, pa0, pa1, pa2, pa3);
#endif
    float rli[16];
    if constexpr (ONES) {
#pragma unroll
        for (int r = 0; r < 16; ++r) rli[r] = __builtin_amdgcn_rcpf(lacc[r]);
    } else {
        if (hi == 0) li_l[r32] = l_reg; asm volatile("s_waitcnt lgkmcnt(0)" ::: "memory");
#pragma unroll
        for (int r = 0; r < 16; ++r) rli[r] = __builtin_amdgcn_rcpf(li_l[crow(r, hi)]);
    }
    if constexpr (MODE != 1) {
        ATT_LAS bf16_t* stg = (ATT_LAS bf16_t*)(lds + L_OST) + wid * 2048;
#pragma unroll
        for (int r = 0; r < 16; ++r) { const int orow = crow(r, hi);
#pragma unroll
            for (int d0 = 0; d0 < 2; ++d0) stg[orow * 64 + d0 * 32 + r32] = (bf16_t)(cvtpk(o[d0][r] * rli[r], 0.f) & 0xffffu); }
        asm volatile("s_waitcnt lgkmcnt(0)" ::: "memory");
        bf16_t* Ow = ATT + (size_t)(row0 + q0 + wid * 32) * OPITCH + ocol;
#pragma unroll
        for (int i = 0; i < 4; ++i) { const int row = i * 8 + (lane >> 3), ch = lane & 7; const u32x4 v = *(const ATT_LAS u32x4*)(stg + row * 64 + ch * 8); *(u32x4*)(Ow + (size_t)row * OPITCH + ch * 8) = v; }
    } else {
        __syncthreads();
        ATT_LAS float* ex = (ATT_LAS float*)(lds + L_K) + (wid & 3) * 4096;
        if (map == 1) {
#pragma unroll
            for (int d0 = 0; d0 < 4; ++d0)
#pragma unroll
                for (int r = 0; r < 16; ++r) ex[(d0 * 16 + r) * 64 + lane] = o[d0][r] * rli[r];
        }
        __syncthreads();
        if (map == 0) {
            const float sa = wave_sum(ax.lam_p[lane] * ax.lam_p[64 + lane]), sb = wave_sum(ax.lam_p[128 + lane] * ax.lam_p[192 + lane]);
            const float lam = __builtin_amdgcn_exp2f(sa * LOG2E) - __builtin_amdgcn_exp2f(sb * LOG2E) + ax.lam_init;
            float ssq[16];
#pragma unroll
            for (int r = 0; r < 16; ++r) ssq[r] = 0.f;
#pragma unroll
            for (int d0 = 0; d0 < 4; ++d0)
#pragma unroll
                for (int r = 0; r < 16; ++r) { const float d = o[d0][r] * rli[r] - lam * ex[(d0 * 16 + r) * 64 + lane]; o[d0][r] = d; ssq[r] += d * d; }
#pragma unroll
            for (int r = 0; r < 16; ++r) { float s = ssq[r]; s += __shfl_xor(s, 1); s += __shfl_xor(s, 2); s += __shfl_xor(s, 4); s += __shfl_xor(s, 8); s += __shfl_xor(s, 16);
                ssq[r] = __builtin_amdgcn_rsqf(s * (1.0f / 128.0f) + cfg::EPS) * (1.0f - ax.lam_init); }
            float gsub[4];
#pragma unroll
            for (int d0 = 0; d0 < 4; ++d0) gsub[d0] = ax.subln[d0 * 32 + r32];
            ATT_LAS bf16_t* stg = (ATT_LAS bf16_t*)(lds + L_OST) + wid * 4096;
#pragma unroll
            for (int r = 0; r < 16; ++r) { const int orow = crow(r, hi);
#pragma unroll
                for (int d0 = 0; d0 < 4; ++d0) stg[orow * 128 + d0 * 32 + r32] = (bf16_t)(cvtpk(o[d0][r] * ssq[r] * gsub[d0], 0.f) & 0xffffu); }
            asm volatile("s_waitcnt lgkmcnt(0)" ::: "memory");
            bf16_t* Ow = ATT + (size_t)(row0 + q0 + wid * 32) * OPITCH + ocol;
#pragma unroll
            for (int i = 0; i < 8; ++i) { const int row = i * 4 + (lane >> 4), ch = lane & 15; const u32x4 v = *(const ATT_LAS u32x4*)(stg + row * 128 + ch * 8); *(u32x4*)(Ow + (size_t)row * OPITCH + ch * 8) = v; }
        }
    }
    __syncthreads();
#undef SLOAD
#undef SWRITE
#undef SWAIT
#undef RESC
#undef MODIFY
#undef REGIONC
#undef REGSC
}
#undef ATT_SBAR
}
#define GAS __attribute__((address_space(1)))
#define LAS __attribute__((address_space(3)))
typedef unsigned short bf16;
typedef unsigned v4u __attribute__((ext_vector_type(4)));
typedef float f32x4 __attribute__((ext_vector_type(4)));
typedef short bf16x8 __attribute__((ext_vector_type(8)));
typedef GAS unsigned gu32;
typedef GAS unsigned long long gu64;
#define RLX_AGENT __ATOMIC_RELAXED, __HIP_MEMORY_SCOPE_AGENT
#define LDS_WAIT() asm volatile("s_waitcnt lgkmcnt(0)" ::: "memory")
#define VM_WAIT() asm volatile("s_waitcnt vmcnt(0)" ::: "memory")
__device__ __forceinline__ unsigned long long rt() { return __builtin_amdgcn_s_memrealtime(); }
__device__ __forceinline__ unsigned f2bf(float f) { unsigned u = __builtin_bit_cast(unsigned, f); return (u + 0x7fffu + ((u >> 16) & 1u)) >> 16; }
__device__ __forceinline__ unsigned pk2(float lo, float hi) { return f2bf(lo) | (f2bf(hi) << 16); }

#define XB_TMO      128
#define XB_XCNT(j)  (256  + 64 * (j))
#define XB_XSUB(j)  (1280 + 64 * (j))
#define XB_XGEN(j)  (2304 + 64 * (j))
#define XB_TOP      3328
#define XB_TOPGEN   3392
#define XCD_BAR_WORDS 3456
#define XB_SPIN_CAP (1u << 18)

__device__ __forceinline__ unsigned xb_ld(unsigned* p)              { return __hip_atomic_load(p, __ATOMIC_RELAXED, __HIP_MEMORY_SCOPE_AGENT); }
__device__ __forceinline__ unsigned xb_add(unsigned* p, unsigned v) { return __hip_atomic_fetch_add(p, v, __ATOMIC_RELAXED, __HIP_MEMORY_SCOPE_AGENT); }
__device__ __forceinline__ unsigned xb_xcc_id() { return (unsigned)__builtin_amdgcn_s_getreg((3 << 11) | 20) & 0xFu; }
#define XB_SPIN(cond, bar) do { unsigned _sp = 0; while (cond) { __builtin_amdgcn_s_sleep(1); \
    if ((++_sp & 255u) == 0u) { if (xb_ld(&(bar)[XB_TMO])) break; if (_sp > XB_SPIN_CAP) { atomicAdd(&(bar)[XB_TMO], 1u); break; } } } } while (0)

struct XcdBarrier {
    unsigned* bar; unsigned x;
    volatile LAS unsigned* st;
};

__device__ __forceinline__ XcdBarrier xcd_barrier_post(unsigned* bar, volatile LAS unsigned* st) {
    XcdBarrier b; b.bar = bar; b.x = xb_xcc_id(); b.st = st;
    if (threadIdx.x == 0) (void)xb_add(&bar[XB_XCNT(b.x)], 1u);
    return b;
}
__device__ __forceinline__ void xcd_barrier_complete(unsigned* bar, unsigned x, unsigned& nloc, unsigned& nx) {
    const unsigned G = gridDim.x * gridDim.y * gridDim.z;
    unsigned sum, cnt, mine, sp = 0u;
    for (;;) {
        sum = 0u; cnt = 0u; mine = 0u;
#pragma unroll
        for (unsigned j = 0; j < 16; ++j) { const unsigned c = xb_ld(&bar[XB_XCNT(j)]); sum += c; cnt += (c > 0u) ? 1u : 0u; mine = (j == x) ? c : mine; }
        if (sum == G) break;
        __builtin_amdgcn_s_sleep(1);
        if ((++sp & 255u) == 0u) { if (xb_ld(&bar[XB_TMO])) break; if (sp > XB_SPIN_CAP) { atomicAdd(&bar[XB_TMO], 1u); break; } }
    }
    nloc = mine > 0u ? mine : 1u; nx = cnt > 0u ? cnt : 1u;
}

__device__ __forceinline__ void xcd_barrier(const XcdBarrier& b) {
    asm volatile("s_waitcnt vmcnt(0)" ::: "memory");
    __syncthreads();
    if (threadIdx.x == 0) {
        unsigned* bar = b.bar;
        __builtin_amdgcn_s_waitcnt(0);
        unsigned nloc = b.st[0], nx = b.st[1];
        if (nloc == 0u) { xcd_barrier_complete(bar, b.x, nloc, nx); b.st[0] = nloc; b.st[1] = nx; }
        const unsigned old = xb_add(&bar[XB_XSUB(b.x)], 1u);
        const unsigned gen = old / nloc;
        if (old + 1u == (gen + 1u) * nloc) {
            __builtin_amdgcn_fence(__ATOMIC_RELEASE, "agent");
            asm volatile("s_waitcnt vmcnt(0)" ::: "memory");
            const unsigned og = xb_add(&bar[XB_TOP], 1u);
            const unsigned tg = og / nx;
            if (og + 1u == (tg + 1u) * nx) xb_add(&bar[XB_TOPGEN], 1u);
            else XB_SPIN(xb_ld(&bar[XB_TOPGEN]) == tg, bar);
            __builtin_amdgcn_fence(__ATOMIC_ACQUIRE, "agent");
            xb_add(&bar[XB_XGEN(b.x)], 1u);
            asm volatile("s_waitcnt vmcnt(0)" ::: "memory");
        } else {
            XB_SPIN(xb_ld(&bar[XB_XGEN(b.x)]) == gen, bar);
            __builtin_amdgcn_fence(__ATOMIC_ACQUIRE, "agent");
            asm volatile("s_waitcnt vmcnt(0)" ::: "memory");
        }
    }
    __syncthreads();
}

__device__ __forceinline__ void xcd_local_barrier(const XcdBarrier& b) {
    asm volatile("s_waitcnt vmcnt(0)" ::: "memory");
    __syncthreads();
    if (threadIdx.x == 0) {
        unsigned* bar = b.bar;
        __builtin_amdgcn_s_waitcnt(0);
        unsigned nloc = b.st[0]; nloc = nloc ? nloc : 1u;
        const unsigned old = xb_add(&bar[XB_XSUB(b.x)], 1u);
        const unsigned gen = old / nloc;
        if (old + 1u == (gen + 1u) * nloc) xb_add(&bar[XB_XGEN(b.x)], 1u);
        else XB_SPIN(xb_ld(&bar[XB_XGEN(b.x)]) == gen, bar);
        __builtin_amdgcn_fence(__ATOMIC_ACQUIRE, "agent");
        asm volatile("s_waitcnt vmcnt(0)" ::: "memory");
    }
    __syncthreads();
}

constexpr int NWAVES = 8;
constexpr size_t MiB = 1u << 20;
constexpr size_t WS_CTL = 0, CTL_ZERO_BYTES = 1 * MiB;
constexpr size_t WS_WGU = 2 * MiB, WS_WD = 46 * MiB, WS_WIN = 68 * MiB, WS_WOUT = 89 * MiB;
constexpr size_t WS_R = 98 * MiB;
constexpr size_t WS_ATT = 290 * MiB;
constexpr size_t WS_BIG = 482 * MiB;
constexpr size_t WS_RSS = 1010 * MiB, RSS_BYTES = 3 * MiB;
constexpr size_t WS_END = 1013 * MiB;
static_assert(WS_WGU + (size_t)cfg::NGU * cfg::DM * 2 <= WS_WD && WS_WD + (size_t)cfg::DM * cfg::DFF * 2 <= WS_WIN && WS_WIN + (size_t)cfg::NIN * cfg::DM * 2 <= WS_WOUT &&
              WS_WOUT + (size_t)cfg::DM * cfg::DM * 2 <= WS_R && WS_R + (size_t)cfg::M * cfg::DM * 2 <= WS_ATT && WS_ATT + (size_t)cfg::M * cfg::DM * 2 <= WS_BIG && WS_BIG + (size_t)cfg::M * cfg::DFF * 2 <= WS_END, "d_ws map");
#ifndef WGM_DN
#define WGM_DN 4
#endif
#ifndef GEMM_SP2
#define GEMM_SP2 true
#endif
#ifndef GEMM_ALIGN
#define GEMM_ALIGN true
#endif
#ifndef WGM_GU
#define WGM_GU 8
#endif
constexpr int CW_BAR = 4096;
constexpr int CW_NRM = 8192;
constexpr int RING_OFF = 0, RING_BYTES = 131072, LDSCTL_OFF = RING_BYTES, MISC_OFF = LDSCTL_OFF + 320, LDS_BYTES = 147456;
static_assert(att::L_END <= RING_BYTES && MISC_OFF + 128 <= LDS_BYTES, "LDS map");

struct Frame {
    LAS unsigned char* lds; volatile LAS unsigned* MISC; int wave, vcu, G;
};
__device__ __forceinline__ float wave_sum_f(float v) {
#pragma unroll
    for (int o = 1; o < 64; o <<= 1) v += __shfl_xor(v, o);
    return v;
}
__device__ __forceinline__ void transpose_item(const float* W, int K, int N, bf16* WT, int k0, int n0, int rowbase, const float* gain, LAS float* scr, int lane) {
#pragma unroll 8
    for (int i = 0; i < 32; ++i) { const int kk = 2 * i + (lane >> 5); scr[kk * 33 + (lane & 31)] = W[(size_t)(k0 + kk) * N + n0 + (lane & 31)]; }
    LDS_WAIT(); asm volatile("" ::: "memory");
    const int c = lane & 7;
    f32x4 g0 = {1.f, 1.f, 1.f, 1.f}, g1 = g0;
    if (gain) { g0 = *(const f32x4*)(gain + k0 + 8 * c); g1 = *(const f32x4*)(gain + k0 + 8 * c + 4); }
#pragma unroll
    for (int j = 0; j < 4; ++j) { const int n = (lane >> 3) + 8 * j; const LAS float* s = scr + (8 * c) * 33 + n;
        v4u o; o.x = pk2(s[0 * 33] * g0[0], s[1 * 33] * g0[1]); o.y = pk2(s[2 * 33] * g0[2], s[3 * 33] * g0[3]); o.z = pk2(s[4 * 33] * g1[0], s[5 * 33] * g1[1]); o.w = pk2(s[6 * 33] * g1[2], s[7 * 33] * g1[3]);
        *(GAS v4u*)(WT + (size_t)(rowbase + n) * K + k0 + 8 * c) = o; }
    LDS_WAIT(); asm volatile("" ::: "memory");
}
__device__ __forceinline__ void conv_ffn(const Frame& F, const float* wg, const float* wu, const float* wd, const float* gain, unsigned char* ws) {
    using namespace cfg;
    { const GAS float *a = (const GAS float*)wg, *b = (const GAS float*)wu, *c = (const GAS float*)wd, *d = (const GAS float*)gain; asm volatile("" : "+s"(a), "+s"(b), "+s"(c), "+s"(d));
      wg = (const float*)a; wu = (const float*)b; wd = (const float*)c; gain = (const float*)d; }
    int lane = threadIdx.x; asm volatile("" : "+v"(lane)); lane &= 63;
    LAS float* scr = (LAS float*)(F.lds + RING_OFF + F.wave * 16384);
    const int gw = F.vcu * NWAVES + F.wave, NGW = F.G * NWAVES;
    constexpr int I_G = (DM / 64) * (DFF / 32), I_D = (DFF / 64) * (DM / 32);
    static_assert(I_G == I_D, "");
    for (int it = gw; it < 3 * I_G; it += NGW) {
        const int which = it / I_G, r = it - which * I_G;
        if (which < 2) { const int nblk = DFF / 32, kb = r / nblk, nb = r % nblk, n0 = 32 * nb;
            transpose_item(which ? wu : wg, DM, DFF, (bf16*)(ws + WS_WGU), 64 * kb, n0, 256 * (n0 >> 7) + 128 * which + (n0 & 127), gain, scr, lane); }
        else { const int nblk = DM / 32, kb = r / nblk, nb = r % nblk, n0 = 32 * nb;
            transpose_item(wd, DFF, DM, (bf16*)(ws + WS_WD), 64 * kb, n0, n0, nullptr, scr, lane); }
    }
}
__device__ __forceinline__ void conv_mix(const Frame& F, const float* win, const float* wout, const float* gain, unsigned char* ws) {
    using namespace cfg;
    { const GAS float *a = (const GAS float*)win, *b = (const GAS float*)wout, *d = (const GAS float*)gain; asm volatile("" : "+s"(a), "+s"(b), "+s"(d)); win = (const float*)a; wout = (const float*)b; gain = (const float*)d; }
    int lane = threadIdx.x; asm volatile("" : "+v"(lane)); lane &= 63;
    LAS float* scr = (LAS float*)(F.lds + RING_OFF + F.wave * 16384);
    const int gw = F.vcu * NWAVES + F.wave, NGW = F.G * NWAVES;
    constexpr int I_IN = (DM / 64) * (NIN / 32), I_O = (DM / 64) * (DM / 32);
    for (int it = gw; it < I_IN + I_O; it += NGW) {
        if (it < I_IN) { const int nblk = NIN / 32, kb = it / nblk, nb = it % nblk, n0 = 32 * nb;
            transpose_item(win, DM, NIN, (bf16*)(ws + WS_WIN), 64 * kb, n0, 256 * (n0 >> 8) + 128 * ((n0 & 63) >> 5) + 32 * ((n0 & 255) >> 6), gain, scr, lane); }
        else { const int r = it - I_IN, nblk = DM / 32, kb = r / nblk, nb = r % nblk, n0 = 32 * nb;
            transpose_item(wout, DM, DM, (bf16*)(ws + WS_WOUT), 64 * kb, n0, n0, nullptr, scr, lane); }
    }
}
template <bool FINAL>
__device__ __forceinline__ void row_phase(const Frame& F, const float* xp, const float* xs, float* out, const float* gain, bf16* R, unsigned long long* rss) {
    using namespace cfg;
    int lane = threadIdx.x; asm volatile("" : "+v"(lane)); lane &= 63;
    const int gw = F.vcu * NWAVES + F.wave, NGW = F.G * NWAVES;
    if constexpr (FINAL) {
        { const GAS float* a = (const GAS float*)gain; asm volatile("" : "+s"(a)); gain = (const float*)a; }
        f32x4 g[4][2];
#pragma unroll
        for (int k = 0; k < 4; ++k) { g[k][0] = ((const f32x4*)gain)[2 * (lane + 64 * k)]; g[k][1] = ((const f32x4*)gain)[2 * (lane + 64 * k) + 1]; }
        for (int m = gw; m < M; m += NGW) {
            const GAS v4u* xr = (const GAS v4u*)(R + (size_t)m * DM) + lane;
            v4u w[4]; f32x4 v[4][2]; float s = 0.f;
#pragma unroll
            for (int k = 0; k < 4; ++k) w[k] = xr[64 * k];
#pragma unroll
            for (int k = 0; k < 4; ++k) { v[k][0] = (f32x4){__uint_as_float(w[k].x << 16), __uint_as_float(w[k].x & 0xffff0000u), __uint_as_float(w[k].y << 16), __uint_as_float(w[k].y & 0xffff0000u)};
                v[k][1] = (f32x4){__uint_as_float(w[k].z << 16), __uint_as_float(w[k].z & 0xffff0000u), __uint_as_float(w[k].w << 16), __uint_as_float(w[k].w & 0xffff0000u)};
#pragma unroll
                for (int e = 0; e < 2; ++e) s += (v[k][e].x * v[k][e].x + v[k][e].y * v[k][e].y) + (v[k][e].z * v[k][e].z + v[k][e].w * v[k][e].w); }
            const float rinv = 1.0f / sqrtf(wave_sum_f(s) * (1.0f / DM) + EPS);
            GAS f32x4* o = (GAS f32x4*)(out + (size_t)m * DM);
#pragma unroll
            for (int k = 0; k < 4; ++k) { o[2 * (lane + 64 * k)] = v[k][0] * rinv * g[k][0]; o[2 * (lane + 64 * k) + 1] = v[k][1] * rinv * g[k][1]; }
        }
    } else {
        for (int m = gw; m < M; m += NGW) {
            const float* xrow = m < MP ? xp + (size_t)m * DM : xs + (size_t)(m - MP) * DM;
            const GAS f32x4* xr = (const GAS f32x4*)xrow + lane;
            f32x4 v[8]; float s = 0.f;
#pragma unroll
            for (int j = 0; j < 8; ++j) { v[j] = xr[64 * j]; s += (v[j].x * v[j].x + v[j].y * v[j].y) + (v[j].z * v[j].z + v[j].w * v[j].w); }
            const float ssum = wave_sum_f(s);
            GAS unsigned long long* o8 = (GAS unsigned long long*)(R + (size_t)m * DM) + lane;
#pragma unroll
            for (int j = 0; j < 8; ++j) o8[64 * j] = (unsigned long long)pk2(v[j].x, v[j].y) | ((unsigned long long)pk2(v[j].z, v[j].w) << 32);
            if (lane == 0) ((GAS unsigned long long*)rss)[m] = (unsigned long long)(ssum * 4294967296.0f);
        }
    }
}

struct Args { const float* in[20]; float* out; unsigned char* ws; int ph_lo, ph_hi, pad0, pad1; };
__global__ void __launch_bounds__(NWAVES * 64, 2) mk_fwd(Args args) {
    using namespace cfg;
    extern __shared__ __attribute__((aligned(16))) unsigned char lds[];
    Frame F;
    F.lds = (LAS unsigned char*)lds; F.MISC = (volatile LAS unsigned*)(F.lds + MISC_OFF);
    F.wave = __builtin_amdgcn_readfirstlane((int)threadIdx.x >> 6);
    F.G = gridDim.x; { const int bx = blockIdx.x; F.vcu = (F.G % 8 == 0) ? (bx % 8) * (F.G / 8) + bx / 8 : bx; }
    unsigned char* ws = args.ws; gu32* ctl = (gu32*)(ws + WS_CTL);
    const float* const p_xp = args.in[0]; const float* const p_xs = args.in[1]; const float* const p_f1n = args.in[2]; const float* const p_f1g = args.in[3]; const float* const p_f1u = args.in[4];
    const float* const p_f1d = args.in[5]; const float* const p_mixn = args.in[6]; const float* const p_win = args.in[7]; const float* const p_aqn = args.in[8]; const float* const p_akn = args.in[9];
    const float* const p_blam = args.in[10]; const float* const p_bsub = args.in[11]; const float* const p_crpb = args.in[12]; const float* const p_wout = args.in[13]; const float* const p_f2n = args.in[14];
    const float* const p_f2g = args.in[15]; const float* const p_f2u = args.in[16]; const float* const p_f2d = args.in[17]; const float* const p_t5 = args.in[18]; const float* const p_fin = args.in[19];
    float* out = args.out;
    bf16* RS = (bf16*)(ws + WS_R); bf16* ATB = (bf16*)(ws + WS_ATT); bf16* BIG = (bf16*)(ws + WS_BIG);
    for (int u = threadIdx.x; u < (LDS_BYTES - LDSCTL_OFF) / 4; u += NWAVES * 64) ((LAS unsigned*)(F.lds + LDSCTL_OFF))[u] = 0u;
    __syncthreads();
    XcdBarrier bar; bar.bar = (unsigned*)(ctl + CW_BAR); bar.x = 0; bar.st = nullptr;
    if (!MK_PER_PHASE) bar = xcd_barrier_post((unsigned*)(ctl + CW_BAR), F.MISC + 8);
    const int lo = args.ph_lo, hi = args.ph_hi;
    int ph = 0;
#define IN(k) (lo <= (k) && (k) < hi)
#define FRESH() GAS float* out_g = (GAS float*)out; GAS unsigned char* ws_g = (GAS unsigned char*)ws; GAS bf16* R_g = (GAS bf16*)RS; GAS bf16* BIG_g = (GAS bf16*)BIG; GAS bf16* AT_g = (GAS bf16*)ATB; const GAS float* xp_g = (const GAS float*)p_xp; const GAS float* xs_g = (const GAS float*)p_xs; \
    asm volatile("" : "+s"(out_g), "+s"(ws_g), "+s"(R_g), "+s"(BIG_g), "+s"(AT_g), "+s"(xp_g), "+s"(xs_g)); \
    float* out_ = (float*)out_g; unsigned char* ws_ = (unsigned char*)ws_g; bf16* R_ = (bf16*)R_g; bf16* BIG_ = (bf16*)BIG_g; bf16* ATB_ = (bf16*)AT_g; const float* xp_ = (const float*)xp_g; const float* xs_ = (const float*)xs_g; (void)ATB_; (void)BIG_; (void)R_; (void)xp_; (void)xs_; (void)out_
#define SEAM() do { if (IN(ph) && IN(ph + 1)) { if (MK_PER_PHASE) { if (threadIdx.x == 0) __hip_atomic_store(ctl, 0xBADBA0u, RLX_AGENT); } else xcd_barrier(bar); } ++ph; } while (0)

    for (int L = 0; L < 2; ++L) {
        unsigned long long* const rssA = (unsigned long long*)(ws + WS_RSS) + (size_t)(L == 0 ? 0 : 3) * M;
        unsigned long long* const rssB = (unsigned long long*)(ws + WS_RSS) + (size_t)(L == 0 ? 1 : 4) * M;
        unsigned long long* const rssC = (unsigned long long*)(ws + WS_RSS) + (size_t)(L == 0 ? 2 : 5) * M;
        if (IN(ph)) { FRESH();
            conv_ffn(F, p_f1g + (size_t)L * DM * DFF, p_f1u + (size_t)L * DM * DFF, p_f1d + (size_t)L * DM * DFF, p_f1n + L * DM, ws_);
            conv_mix(F, p_win + (size_t)L * DM * NIN, p_wout + (size_t)L * DM * DM, p_mixn + L * DM, ws_);
            if (L == 0) row_phase<false>(F, xp_, xs_, out_, nullptr, R_, rssA);
        }
        SEAM();
        if (IN(ph)) { FRESH();
            pg8::Gemm g{R_, (const bf16*)(ws_ + WS_WGU), M, NGU, DM}; pg8::StaticOrder S; S.init(M, NGU, F.G, (int)blockIdx.x, WGM_GU);
            pg8::EpiSwiglu E{BIG_, rssA};
#ifndef NO_GU
            pg8::gemm_phase<pg8::EpiSwiglu, pg8::StaticOrder, GEMM_ALIGN, GEMM_SP2>(F.lds + RING_OFF, g, S, E);
#endif
        }
        SEAM();
        if (IN(ph)) { FRESH();
            pg8::Gemm g{BIG_, (const bf16*)(ws_ + WS_WD), M, DM, DFF}; pg8::StaticOrder S; S.init(M, DM, F.G, (int)blockIdx.x, WGM_DN);
            pg8::EpiResid E{R_, 0.5f, rssB};
#ifndef NO_RES
            pg8::gemm_phase<pg8::EpiResid, pg8::StaticOrder, GEMM_ALIGN, GEMM_SP2>(F.lds + RING_OFF, g, S, E);
#endif
        }
        SEAM();
        if (IN(ph)) { FRESH();
            conv_ffn(F, p_f2g + (size_t)L * DM * DFF, p_f2u + (size_t)L * DM * DFF, p_f2d + (size_t)L * DM * DFF, p_f2n + L * DM, ws_);
            __syncthreads();
            pg8::Gemm g{R_, (const bf16*)(ws_ + WS_WIN), M, NIN, DM}; pg8::StaticOrder S; S.init(M, NIN, F.G, (int)blockIdx.x, WGM_GU);
            pg8::EpiWin E{BIG_, p_aqn + L * 64, p_akn + L * 64, rssB, (unsigned*)(ctl + CW_NRM + L * 336)};
#ifndef NO_WIN
            pg8::gemm_phase<pg8::EpiWin, pg8::StaticOrder, GEMM_ALIGN, GEMM_SP2>(F.lds + RING_OFF, g, S, E);
#endif
        }
        SEAM();
        if (IN(ph)) { FRESH(); bf16* const QKV_ = BIG_; bf16* const ATT_ = ATB_;
                att::Aux ax{p_t5, p_crpb + (size_t)L * 8 * 15 * 31, p_blam + L * 256, p_bsub + L * 128, (L == 0 ? 0.2f : 0.35550906759f)};
                const att::lptr al = (att::lptr)(F.lds + RING_OFF);
#ifdef ATT_PRIO
                if (F.wave >= 4) __builtin_amdgcn_s_setprio(1);
#endif
#ifndef PROBE_ATT_REP
#define PROBE_ATT_REP 1
#endif
                for (int rep_ = 0; rep_ < PROBE_ATT_REP; ++rep_) {
#ifndef REP_B
#define REP_B 1
#endif
#ifndef REP_A
#define REP_A 1
#endif
#ifndef REP_D
#define REP_D 1
#endif
#ifndef REP_C
#define REP_C 1
#endif
                float t5max = 0.f, rpbmax = 0.f;
                { int ln = threadIdx.x; asm volatile("" : "+v"(ln)); ln &= 63;
#pragma unroll
                  for (int k_ = 0; k_ < 6; ++k_) t5max = fmaxf(t5max, fabsf(p_t5[ln + 64 * k_]));
                  for (int k_ = 0; k_ < 59; ++k_) { const int ix = ln + 64 * k_; if (ix < 8 * 15 * 31) rpbmax = fmaxf(rpbmax, fabsf(ax.rpb[ix])); }
#pragma unroll
                  for (int o_ = 1; o_ < 64; o_ <<= 1) { t5max = fmaxf(t5max, __shfl_xor(t5max, o_)); rpbmax = fmaxf(rpbmax, __shfl_xor(rpbmax, o_)); } }
                t5max = __uint_as_float(__builtin_amdgcn_readfirstlane(__float_as_uint(t5max))); rpbmax = __uint_as_float(__builtin_amdgcn_readfirstlane(__float_as_uint(rpbmax)));
                const GAS unsigned* nrm2 = (const GAS unsigned*)(ctl + CW_NRM + L * 336);
#define SEQ_OF(r0_) ((r0_) < MP ? ((r0_) >> 14) : 2 + (((r0_) - MP) >> 13))
#define NRM(blk_, sq_) __uint_as_float(nrm2[(blk_) * 4 + (sq_)])
                for (int rb_ = 0; rb_ < REP_B; ++rb_)
                for (int u = F.vcu; u < 1536; u += F.G) {
#ifndef NO_ATT1
                    int r0, T, h, qb;
                    if (u < 1024) { r0 = (u >> 9) * TP; T = TP; h = (u >> 7) & 3; qb = u & 127; } else { const int v = u - 1024; r0 = MP + (v >> 8) * TS; T = TS; h = (v >> 6) & 3; qb = v & 63; }
                    const int sq = SEQ_OF(r0);
                    const float bnd = sqrtf(fmaxf(NRM(12 + 2 * h, sq), NRM(13 + 2 * h, sq)) * fmaxf(NRM(20 + 2 * h, sq), NRM(21 + 2 * h, sq))) * 1.01f + t5max * LOG2E;
                    if (__builtin_amdgcn_readfirstlane((int)(bnd <= 80.0f))) att::attn_unit<1, true>(QKV_, ATT_, al, r0, T, h, qb, ax); else att::attn_unit<1, false>(QKV_, ATT_, al, r0, T, h, qb, ax);
#endif
                }
                bool a_nomax;
                { int ln_ = threadIdx.x; asm volatile("" : "+v"(ln_)); ln_ &= 63; float gq = fabsf(p_aqn[L * 64 + ln_]), gk = fabsf(p_akn[L * 64 + ln_]);
#pragma unroll
                  for (int o_ = 1; o_ < 64; o_ <<= 1) { gq = fmaxf(gq, __shfl_xor(gq, o_)); gk = fmaxf(gk, __shfl_xor(gk, o_)); }
                  const float bound = 8.0f * LOG2E * gq * gk * 1.01f; a_nomax = __builtin_amdgcn_readfirstlane((int)(bound <= 80.0f)) != 0; }
                for (int ra_ = 0; ra_ < REP_A; ++ra_)
                for (int u = F.vcu; u < 1536; u += F.G) {
#ifndef NO_ATT0
                    int r0, T, h, qb;
                    if (u < 1024) { r0 = (u >> 9) * TP; T = TP; h = (u >> 6) & 7; qb = u & 63; } else { const int v = u - 1024; r0 = MP + (v >> 8) * TS; T = TS; h = (v >> 5) & 7; qb = v & 31; }
                    if (a_nomax) att::attn_unit<0, true>(QKV_, ATT_, al, r0, T, h, qb, ax); else att::attn_unit<0, false>(QKV_, ATT_, al, r0, T, h, qb, ax);
#endif
                }
                for (int rd_ = 0; rd_ < REP_D; ++rd_)
                for (int u = F.vcu; u < 1536; u += F.G) {
                    const int h = u / 192, qg = u % 192; int r0, T, qb;
                    if (qg < 128) { r0 = (qg >> 6) * TP; T = TP; qb = qg & 63; } else { r0 = MP + ((qg - 128) >> 5) * TS; T = TS; qb = (qg - 128) & 31; }
#ifndef NO_ATT3
                    { const int sq = SEQ_OF(r0); const float bnd = sqrtf(NRM(60 + h, sq) * NRM(68 + h, sq)) * 1.01f + t5max * LOG2E + 1.6f;
                      if (__builtin_amdgcn_readfirstlane((int)(bnd <= 80.0f))) att::attn_unit<3, true>(QKV_, ATT_, al, r0, T, h, qb, ax); else att::attn_unit<3, false>(QKV_, ATT_, al, r0, T, h, qb, ax); }
#endif
                }
                for (int rc_ = 0; rc_ < REP_C; ++rc_)
                for (int u = F.vcu; u < 1536; u += F.G) {
                    const int h = u / 192, qg = u % 192; int r0, T, qb;
                    if (qg < 128) { r0 = (qg >> 6) * TP; T = TP; qb = qg & 63; } else { r0 = MP + ((qg - 128) >> 5) * TS; T = TS; qb = (qg - 128) & 31; }
#ifndef NO_ATT2
                    { const int sq = SEQ_OF(r0); const float bnd = sqrtf(NRM(36 + h, sq) * NRM(44 + h, sq)) * 1.01f + rpbmax * LOG2E;
                      if (__builtin_amdgcn_readfirstlane((int)(bnd <= 80.0f))) att::attn_unit<2, true>(QKV_, ATT_, al, r0, T, h, qb, ax); else att::attn_unit<2, false>(QKV_, ATT_, al, r0, T, h, qb, ax); }
#endif
                }
                }
                    }
        SEAM();
        if (IN(ph)) { FRESH();
            pg8::Gemm g{ATB_, (const bf16*)(ws_ + WS_WOUT), M, DM, DM}; pg8::StaticOrder S; S.init(M, DM, F.G, (int)blockIdx.x, WGM_DN);
            pg8::EpiResid E{R_, 1.0f, rssC};
#ifndef NO_RES
            pg8::gemm_phase<pg8::EpiResid, pg8::StaticOrder, GEMM_ALIGN, GEMM_SP2>(F.lds + RING_OFF, g, S, E);
#endif
        }
        SEAM();
        if (IN(ph)) { FRESH();
            pg8::Gemm g{R_, (const bf16*)(ws_ + WS_WGU), M, NGU, DM}; pg8::StaticOrder S; S.init(M, NGU, F.G, (int)blockIdx.x, WGM_GU);
            pg8::EpiSwiglu E{BIG_, rssC};
#ifndef NO_GU
            pg8::gemm_phase<pg8::EpiSwiglu, pg8::StaticOrder, GEMM_ALIGN, GEMM_SP2>(F.lds + RING_OFF, g, S, E);
#endif
        }
        SEAM();
        if (IN(ph)) { FRESH();
            pg8::Gemm g{BIG_, (const bf16*)(ws_ + WS_WD), M, DM, DFF}; pg8::StaticOrder S; S.init(M, DM, F.G, (int)blockIdx.x, WGM_DN);
            pg8::EpiResid E{R_, 0.5f, L == 0 ? (unsigned long long*)(ws + WS_RSS) + (size_t)3 * M : (unsigned long long*)nullptr};
#ifndef NO_RES
            pg8::gemm_phase<pg8::EpiResid, pg8::StaticOrder, GEMM_ALIGN, GEMM_SP2>(F.lds + RING_OFF, g, S, E);
#endif
        }
        SEAM();
    }
    if (IN(ph)) { FRESH(); row_phase<true>(F, xp_, xs_, out_, p_fin, R_, nullptr); }
#undef IN
#undef SEAM
}
constexpr int N_PHASES = 17;

extern "C" void kernel_launch(void* const* d_in, const int* in_sizes, int n_in, void* d_out, int out_size, void* d_ws, size_t ws_size, hipStream_t stream) {
    static int grid = 0;
    if (grid == 0) {
        if (n_in != 20 || in_sizes[0] != cfg::MP * cfg::DM || in_sizes[1] != cfg::MS * cfg::DM || out_size != cfg::M * cfg::DM || ws_size < WS_END) {
            fprintf(stderr, "kernel_launch: shape mismatch (n_in %d, in0 %d, in1 %d, out %d, ws %zu need %zu); nothing launched\n", n_in, n_in > 0 ? in_sizes[0] : -1, n_in > 1 ? in_sizes[1] : -1, out_size, ws_size, (size_t)WS_END); grid = -1; return; }
        int dev = 0, cus = 0, per_cu = 0;
        if (hipGetDevice(&dev) != hipSuccess || hipDeviceGetAttribute(&cus, hipDeviceAttributeMultiprocessorCount, dev) != hipSuccess) { fprintf(stderr, "kernel_launch: device query failed\n"); grid = -1; return; }
        if (hipFuncSetAttribute((const void*)mk_fwd, hipFuncAttributeMaxDynamicSharedMemorySize, LDS_BYTES) != hipSuccess) { fprintf(stderr, "kernel_launch: hipFuncSetAttribute failed\n"); grid = -1; return; }
        if (hipOccupancyMaxActiveBlocksPerMultiprocessor(&per_cu, (const void*)mk_fwd, NWAVES * 64, LDS_BYTES) != hipSuccess || per_cu < 1) {
            fprintf(stderr, "kernel_launch: occupancy query reports %d workgroups per CU; nothing launched\n", per_cu); (void)hipGetLastError(); grid = -1; return; }
        (void)hipGetLastError();
        grid = cus;
    }
    if (grid < 0) return;
    if (hipMemsetAsync((char*)d_ws + WS_CTL, 0, CTL_ZERO_BYTES, stream) != hipSuccess || hipMemsetAsync((char*)d_ws + WS_RSS, 0, RSS_BYTES, stream) != hipSuccess) { fprintf(stderr, "kernel_launch: memset failed\n"); return; }
    Args a{};
    for (int i = 0; i < 20; ++i) a.in[i] = (const float*)d_in[i];
    a.out = (float*)d_out; a.ws = (unsigned char*)d_ws;
#if MK_PER_PHASE
    for (int p = 0; p < N_PHASES; ++p) { a.ph_lo = p; a.ph_hi = p + 1; hipLaunchKernelGGL(mk_fwd, dim3(grid), dim3(NWAVES * 64), LDS_BYTES, stream, a); }
#else
    a.ph_lo = 0; a.ph_hi = N_PHASES;
    hipLaunchKernelGGL(mk_fwd, dim3(grid), dim3(NWAVES * 64), LDS_BYTES, stream, a);
#endif
    const hipError_t le = hipPeekAtLastError();
    if (le != hipSuccess) fprintf(stderr, "kernel_launch: launch failed: %s\n", hipGetErrorName(le));
}
```

```cpp
#include <hip/hip_runtime.h>
#include <cstdio>
#include <cstdint>

#ifndef MK_PER_PHASE
#define MK_PER_PHASE 0
#endif

namespace cfg {
constexpr int DM = 2048, DFF = 5632, NIN = 5376, NGU = 2 * DFF;
constexpr int TP = 16384, TS = 8192, MP = 2 * TP, MS = 2 * TS, M = MP + MS;
constexpr float EPS = 1e-6f;
constexpr float LOG2E = 1.4426950408889634f;
constexpr float C2 = 0.125f * LOG2E;
}
namespace pg8 {
#define PG8_LAS __attribute__((address_space(3)))
typedef unsigned short bf16_t;
typedef short bf16x8 __attribute__((ext_vector_type(8)));
typedef float f32x4 __attribute__((ext_vector_type(4)));
typedef unsigned u32x4 __attribute__((ext_vector_type(4)));
constexpr int BM = 256, BK = 64, HALF = 128, HTB = HALF * BK * 2  , STAGE_BYTES = 8 * HTB, NXCD = 8, WGM = 8;

__host__ __device__ __forceinline__ int lds_byte(int r, int c) { const int st = (r >> 4) * 2 + (c >> 5), rr = r & 15, cc = c & 31, ob = rr * 64 + cc * 2; return st * 1024 + (ob ^ (((ob >> 9) & 1) << 5)); }
__host__ __device__ __forceinline__ void stage_rc(int b, int& R, int& C) { const int st = b / 1024, sb = b % 1024, swz = sb ^ (((sb >> 9) & 1) << 5); R = (st >> 1) * 16 + swz / 64; C = (st & 1) * 32 + (swz % 64) / 2; }
__host__ __device__ __forceinline__ int perm32(int rho) { const int n = rho >> 4, i = rho & 15; return 8 * (i >> 2) + 4 * n + (i & 3); }

struct Unit { int pm, pn; };
struct Gemm { const bf16_t* A; const bf16_t* Bt; int M, N, K; };

struct StaticOrder {
    int nM, nN, nwg, G, c, wgm;
    __host__ __device__ void init(int M, int N, int G_, int c_, int wgm_ = WGM) { nM = M / BM; nN = N / BM; nwg = nM * nN; G = G_; c = c_; wgm = wgm_; }
    __host__ __device__ bool next(int i, Unit& u) const {
        const long L = (long)i * G + c; if (L >= nwg) return false;
        int wgid = (int)L; { const int q = nwg / NXCD, r = nwg % NXCD, xcd = wgid % NXCD, off = wgid / NXCD; wgid = (xcd < r ? xcd * (q + 1) : r * (q + 1) + (xcd - r) * q) + off; }
        const int nig = wgm * nN, gid = wgid / nig, fm = gid * wgm, gsz = (nM - fm) < wgm ? (nM - fm) : wgm;
        u.pm = fm + ((wgid % nig) % gsz); u.pn = (wgid % nig) / gsz; return true;
    }
    __device__ __forceinline__ void a_ready(const Unit&) const {}
    __device__ __forceinline__ void done(const Unit&) const {}
};

__device__ __forceinline__ unsigned cvt_pk_bf16(float lo, float hi) { unsigned r; asm volatile("v_cvt_pk_bf16_f32 %0, %1, %2" : "=v"(r) : "v"(lo), "v"(hi)); return r; }
typedef float f32x2 __attribute__((ext_vector_type(2)));

struct EpiSwiglu {
    static constexpr bool PERM = true, AFTER_DRAIN = false, PROBE_TWICE = true;
    bf16_t* H; const unsigned long long* rss;
    __device__ __forceinline__ void operator()(const f32x4 (&acc)[2][2][4][2], const Unit& u, int wr, int wc, int fr, int fq) const {
        const int row0 = u.pm * BM + wr * 64 + fr, col0 = u.pn * 128 + wc * 32 + 8 * fq;
        float rv[2][4];
#pragma unroll
        for (int ai = 0; ai < 2; ++ai)
#pragma unroll
            for (int m = 0; m < 4; ++m) rv[ai][m] = (float)rss[row0 + ai * HALF + m * 16] * 2.3283064365386963e-10f;
#pragma unroll
        for (int ai = 0; ai < 2; ++ai)
#pragma unroll
            for (int m = 0; m < 4; ++m) {
                bf16_t* rowp = H + (unsigned)((row0 + ai * HALF + m * 16) * cfg::DFF + col0);
                const float rinv = __builtin_amdgcn_rsqf(rv[ai][m] * (1.0f / cfg::DM) + cfg::EPS);
                float hv[8];
#pragma unroll
                for (int n = 0; n < 2; ++n)
#pragma unroll
                    for (int j = 0; j < 4; ++j) {
                        const float g = acc[ai][0][m][n][j] * rinv, up = acc[ai][1][m][n][j] * rinv;
                        const float e = __builtin_amdgcn_exp2f(-g * cfg::LOG2E);
                        hv[n * 4 + j] = (g * up) * __builtin_amdgcn_rcpf(1.0f + e);
                    }
                u32x4 w; w.x = cvt_pk_bf16(hv[0], hv[1]); w.y = cvt_pk_bf16(hv[2], hv[3]); w.z = cvt_pk_bf16(hv[4], hv[5]); w.w = cvt_pk_bf16(hv[6], hv[7]);
                *(u32x4*)rowp = w;
                asm volatile("" ::: "memory");
            }
    }
};
__device__ __forceinline__ f32x4 bf16x4_lo(u32x4 w, int h) { f32x4 r; const unsigned a = h ? w.z : w.x, b = h ? w.w : w.y;
    r[0] = __uint_as_float(a << 16); r[1] = __uint_as_float(a & 0xffff0000u); r[2] = __uint_as_float(b << 16); r[3] = __uint_as_float(b & 0xffff0000u); return r; }
struct EpiResid {
    static constexpr bool PERM = true, AFTER_DRAIN = false, PROBE_TWICE = false;
    bf16_t* R; float alpha; unsigned long long* rssw;
    __device__ __forceinline__ void operator()(const f32x4 (&acc)[2][2][4][2], const Unit& u, int wr, int wc, int fr, int fq) const {
        bf16_t* rb = R + (size_t)u.pm * BM * cfg::DM;
        const unsigned off0 = (unsigned)(wr * 64 + fr) * cfg::DM + (unsigned)(u.pn * BM + wc * 32 + 8 * fq);
        float sel[2] = {0.f, 0.f};
        u32x4 vq[4][2];
#define RES_LOAD(S, it_) do { const unsigned o_ = off0 + (unsigned)(((it_) >> 2) * HALF + ((it_) & 3) * 16) * cfg::DM; \
        vq[S][0] = *(const u32x4*)(rb + o_); vq[S][1] = *(const u32x4*)(rb + o_ + HALF); } while (0)
#define RES_DO(S, it_) do { const int ai = (it_) >> 2, m = (it_) & 3; const unsigned off = off0 + (unsigned)(ai * HALF + m * 16) * cfg::DM; float ss = 0.f; \
        _Pragma("unroll") for (int bj = 0; bj < 2; ++bj) { const f32x4 o0 = bf16x4_lo(vq[S][bj], 0) + acc[ai][bj][m][0] * alpha, o1 = bf16x4_lo(vq[S][bj], 1) + acc[ai][bj][m][1] * alpha; \
            ss += (o0[0] * o0[0] + o0[1] * o0[1]) + (o0[2] * o0[2] + o0[3] * o0[3]) + (o1[0] * o1[0] + o1[1] * o1[1]) + (o1[2] * o1[2] + o1[3] * o1[3]); \
            u32x4 w; w.x = cvt_pk_bf16(o0[0], o0[1]); w.y = cvt_pk_bf16(o0[2], o0[3]); w.z = cvt_pk_bf16(o1[0], o1[1]); w.w = cvt_pk_bf16(o1[2], o1[3]); \
            *(u32x4*)(rb + off + bj * HALF) = w; } \
        if (rssw) { ss += __shfl_xor(ss, 16); ss += __shfl_xor(ss, 32); if (fq == m) sel[ai] = ss; } } while (0)
        RES_LOAD(0, 0); RES_LOAD(1, 1); RES_LOAD(2, 2);
        RES_LOAD(3, 3); RES_DO(0, 0); asm volatile("" ::: "memory");
        RES_LOAD(0, 4); RES_DO(1, 1); asm volatile("" ::: "memory");
        RES_LOAD(1, 5); RES_DO(2, 2); asm volatile("" ::: "memory");
        RES_LOAD(2, 6); RES_DO(3, 3); asm volatile("" ::: "memory");
        RES_LOAD(3, 7); RES_DO(0, 4); asm volatile("" ::: "memory");
        RES_DO(1, 5); asm volatile("" ::: "memory");
        RES_DO(2, 6); asm volatile("" ::: "memory");
        RES_DO(3, 7); asm volatile("" ::: "memory");
#undef RES_LOAD
#undef RES_DO
        if (rssw) {
#pragma unroll
            for (int ai = 0; ai < 2; ++ai) atomicAdd(rssw + u.pm * BM + wr * 64 + ai * HALF + fq * 16 + fr, (unsigned long long)(sel[ai] * 4294967296.0f));
        }
    }
};
struct EpiWin {
    static constexpr bool PERM = true, AFTER_DRAIN = false, PROBE_TWICE = false;
    bf16_t* QKV; const float* gq; const float* gk; const unsigned long long* rss; unsigned* nrm2;
    __device__ __forceinline__ void operator()(const f32x4 (&acc)[2][2][4][2], const Unit& u, int wr, int wc, int fr, int fq) const {
        const int pn = u.pn;
        int kind = 0; float sc = 1.f;
        if (pn < 2) { kind = 1; sc = cfg::C2; }
        else if (pn == 2) { kind = (wc < 2) ? 2 : 0; }
        else if (pn == 3 || pn == 4 || pn == 9 || pn == 10 || pn == 15 || pn == 16) sc = cfg::C2;
        const int row0 = u.pm * BM + wr * 64 + fr;
        const int colb = pn * 256 + wc * 64 + 8 * fq;
        float rv[2][4];
#pragma unroll
        for (int ai = 0; ai < 2; ++ai)
#pragma unroll
            for (int m = 0; m < 4; ++m) rv[ai][m] = (float)rss[row0 + ai * HALF + m * 16] * 2.3283064365386963e-10f;
        if (kind == 0) {
            const bool want = (pn >= 3 && pn <= 6) || (pn >= 9 && pn <= 12) || (pn >= 15 && pn <= 18);
            float nmax = 0.f;
#pragma unroll
            for (int ai = 0; ai < 2; ++ai)
#pragma unroll
                for (int m = 0; m < 4; ++m) {
                    bf16_t* rowp = QKV + (unsigned)((row0 + ai * HALF + m * 16) * cfg::NIN + colb);
                    const float rs_ = __builtin_amdgcn_rsqf(rv[ai][m] * (1.0f / cfg::DM) + cfg::EPS) * sc;
                    float ss = 0.f;
#pragma unroll
                    for (int bj = 0; bj < 2; ++bj) { const f32x4 v0 = acc[ai][bj][m][0] * rs_, v1 = acc[ai][bj][m][1] * rs_;
                        ss += (v0[0] * v0[0] + v0[1] * v0[1]) + (v0[2] * v0[2] + v0[3] * v0[3]) + (v1[0] * v1[0] + v1[1] * v1[1]) + (v1[2] * v1[2] + v1[3] * v1[3]);
                        u32x4 w; w.x = cvt_pk_bf16(v0[0], v0[1]); w.y = cvt_pk_bf16(v0[2], v0[3]); w.z = cvt_pk_bf16(v1[0], v1[1]); w.w = cvt_pk_bf16(v1[2], v1[3]);
                        *(u32x4*)(rowp + 32 * bj) = w; }
                    if (want) { ss += __shfl_xor(ss, 16); ss += __shfl_xor(ss, 32); nmax = fmaxf(nmax, ss); }
                    asm volatile("" ::: "memory");
                }
            if (want) {
                float t = nmax;
                t = fmaxf(t, __shfl_xor(t, 1)); t = fmaxf(t, __shfl_xor(t, 2)); t = fmaxf(t, __shfl_xor(t, 4)); t = fmaxf(t, __shfl_xor(t, 8));
                const int rowt = u.pm * BM; const int seq = rowt < cfg::MP ? (rowt >> 14) : 2 + ((rowt - cfg::MP) >> 13);
                if ((fr | fq) == 0) atomicMax(nrm2 + (4 * pn + wc) * 4 + seq, __float_as_uint(t));
            }
        } else {
            const float* g = (kind == 1) ? gq : gk;
            float invrev[2][2];
#pragma unroll
            for (int n = 0; n < 2; ++n)
#pragma unroll
                for (int jj = 0; jj < 2; ++jj) invrev[n][jj] = __builtin_amdgcn_exp2f(-(float)(4 * fq + 2 * n + jj) * (13.287712379549449f / 16.0f)) * 0.15915494309189535f;
#pragma unroll
            for (int ai = 0; ai < 2; ++ai)
#pragma unroll
                for (int m = 0; m < 4; ++m) {
                    const int row = row0 + ai * HALF + m * 16;
                    const int t = (row < cfg::MP) ? (row & (cfg::TP - 1)) : (row & (cfg::TS - 1));
                    float prow = (float)(t >> 6), pcol = (float)(row & 63);
                    asm volatile("" : "+v"(prow), "+v"(pcol) :: "memory");
                    float ss = 0.f;
#pragma unroll
                    for (int bj = 0; bj < 2; ++bj)
#pragma unroll
                        for (int n = 0; n < 2; ++n) { const f32x4 v = acc[ai][bj][m][n]; ss += (v[0] * v[0] + v[1] * v[1]) + (v[2] * v[2] + v[3] * v[3]); }
                    ss += __shfl_xor(ss, 16); ss += __shfl_xor(ss, 32);
                    const float rw = __builtin_amdgcn_rsqf(rv[ai][m] * (1.0f / cfg::DM) + cfg::EPS);
                    const float rinv = rw * __builtin_amdgcn_rsqf(ss * rw * rw * (1.0f / 64.0f) + cfg::EPS);
                    bf16_t* rowp = QKV + (unsigned)(row * cfg::NIN + colb);
#pragma unroll
                    for (int bj = 0; bj < 2; ++bj) {
                        const float pos = bj ? pcol : prow;
                        float o[8];
#pragma unroll
                        for (int n = 0; n < 2; ++n) {
                            const f32x4 y = acc[ai][bj][m][n] * rinv * *(const f32x4*)(g + 32 * bj + 8 * fq + 4 * n);
#pragma unroll
                            for (int jj = 0; jj < 2; ++jj) {
                                const float rev = __builtin_amdgcn_fractf(pos * invrev[n][jj]);
                                const float sn = __builtin_amdgcn_sinf(rev), cs = __builtin_amdgcn_cosf(rev);
                                const float x1 = y[2 * jj], x2 = y[2 * jj + 1];
                                o[4 * n + 2 * jj] = (x1 * cs - x2 * sn) * sc; o[4 * n + 2 * jj + 1] = (x1 * sn + x2 * cs) * sc;
                            }
                        }
                        u32x4 w; w.x = cvt_pk_bf16(o[0], o[1]); w.y = cvt_pk_bf16(o[2], o[3]); w.z = cvt_pk_bf16(o[4], o[5]); w.w = cvt_pk_bf16(o[6], o[7]);
                        *(u32x4*)(rowp + 32 * bj) = w;
                        asm volatile("" ::: "memory");
                    }
                }
        }
    }
};

template <class Epi, class Sched, bool ALIGN_EPI = false, bool SP2 = false>
__device__ __forceinline__ void gemm_phase(PG8_LAS unsigned char* lds, const Gemm g, const Sched& S, const Epi& E) {
    int tid_ = threadIdx.x; asm volatile("" : "+v"(tid_));
    const int tid = tid_, wid = __builtin_amdgcn_readfirstlane(tid >> 6), lane = tid & 63, wr = wid >> 2, wc = wid & 3, fr = lane & 15, fq = lane >> 4;
    const int K = g.K, nt = K / BK;
    unsigned voffA[2], voffB[2];
#pragma unroll
    for (int i = 0; i < 2; ++i) { int R, C; stage_rc(tid * 16 + i * 8192, R, C); const int Rb = Epi::PERM ? ((R & ~31) + perm32(R & 31)) : R;
        voffA[i] = (unsigned)(R * K + C) * 2u; voffB[i] = (unsigned)(Rb * K + C) * 2u; }
    const size_t kstep = (size_t)(BK * 2);
    const size_t hstep = (size_t)HALF * K * 2;
    const size_t tstep = 2 * hstep;
    const unsigned ldsw = (unsigned)wid * 1024u;
    const int aoff = lds_byte(wr * 64 + fr, fq * 8), boff = lds_byte(wc * 32 + fr, fq * 8);
#define PG8_SA(b, h) (((b) * 2 + (h)) * HTB)
#define PG8_SB(b, h) ((4 + (b) * 2 + (h)) * HTB)
#define PG8_STAGE(bufoff, gbase, voff) do { _Pragma("unroll") for (int _i = 0; _i < 2; ++_i) \
        __builtin_amdgcn_global_load_lds((const unsigned*)((const char*)(gbase) + (voff)[_i]), (PG8_LAS unsigned*)(lds + (bufoff) + ldsw + _i * 8192), 16, 0, 0); } while (0)
#define PG8_LDA(dst, b, h) do { _Pragma("unroll") for (int m = 0; m < 4; ++m) _Pragma("unroll") for (int k = 0; k < 2; ++k) dst[m][k] = *(const PG8_LAS bf16x8*)(lds + PG8_SA(b, h) + aoff + m * 2048 + k * 1024); } while (0)
#define PG8_LDB(dst, b, h) do { _Pragma("unroll") for (int n = 0; n < 2; ++n) _Pragma("unroll") for (int k = 0; k < 2; ++k) dst[n][k] = *(const PG8_LAS bf16x8*)(lds + PG8_SB(b, h) + boff + n * 2048 + k * 1024); } while (0)
#define PG8_MMA(ai, bj, At, Bt) do { __builtin_amdgcn_s_setprio(1); _Pragma("unroll") for (int m = 0; m < 4; ++m) _Pragma("unroll") for (int n = 0; n < 2; ++n) _Pragma("unroll") for (int k = 0; k < 2; ++k) \
        acc[ai][bj][m][n] = __builtin_amdgcn_mfma_f32_16x16x32_bf16(Bt[n][k], At[m][k], acc[ai][bj][m][n], 0, 0, 0); __builtin_amdgcn_s_setprio(0); } while (0)
#define PG8_WAIT_V(n) asm volatile("s_waitcnt vmcnt(" #n ")" ::: "memory")
#define PG8_WAIT_L(n) asm volatile("s_waitcnt lgkmcnt(" #n ")" ::: "memory")
#define PG8_BAR __builtin_amdgcn_s_barrier()
#define PG8_SCHED __builtin_amdgcn_sched_barrier(0)
    Unit cur, nxt; int ui = 0;
    if (!S.next(0, cur)) return;
    f32x4 acc[2][2][4][2];
#pragma unroll
    for (int a = 0; a < 2; ++a)
#pragma unroll
        for (int b = 0; b < 2; ++b)
#pragma unroll
            for (int m = 0; m < 4; ++m)
#pragma unroll
                for (int n = 0; n < 2; ++n) acc[a][b][m][n] = (f32x4){0.f, 0.f, 0.f, 0.f};
    bf16x8 At[4][2], B0[2][2], B1[2][2];
    const char* cA = (const char*)g.A + (size_t)cur.pm * tstep; const char* cB = (const char*)g.Bt + (size_t)cur.pn * tstep;
    S.a_ready(cur);
    if constexpr (SP2) {
        PG8_STAGE(PG8_SB(0, 0), cB, voffB); PG8_STAGE(PG8_SB(0, 1), cB + hstep, voffB); PG8_STAGE(PG8_SA(0, 0), cA, voffA); PG8_STAGE(PG8_SA(0, 1), cA + hstep, voffA);
        if (wr == 1) PG8_BAR;
        PG8_WAIT_V(2); PG8_BAR;
        PG8_STAGE(PG8_SB(1, 0), cB + kstep, voffB); PG8_STAGE(PG8_SA(1, 0), cA + kstep, voffA); PG8_STAGE(PG8_SB(1, 1), cB + hstep + kstep, voffB);
        PG8_WAIT_V(6); PG8_BAR;
    } else {
        PG8_STAGE(PG8_SB(0, 0), cB, voffB); PG8_STAGE(PG8_SA(0, 0), cA, voffA); PG8_STAGE(PG8_SB(0, 1), cB + hstep, voffB); PG8_STAGE(PG8_SA(0, 1), cA + hstep, voffA);
        if (wr == 1) PG8_BAR;
        PG8_WAIT_V(4); PG8_BAR;
        PG8_STAGE(PG8_SB(1, 0), cB + kstep, voffB); PG8_STAGE(PG8_SA(1, 0), cA + kstep, voffA); PG8_STAGE(PG8_SB(1, 1), cB + hstep + kstep, voffB);
        PG8_WAIT_V(6); PG8_BAR;
    }
    for (;;) {
        const bool has_next = S.next(ui + 1, nxt);
        const char* nA = has_next ? (const char*)g.A + (size_t)nxt.pm * tstep : cA; const char* nB = has_next ? (const char*)g.Bt + (size_t)nxt.pn * tstep : cB;
        for (int t = 0; t < nt; t += 2) {
            const bool last = (t == nt - 2);
            const char* a1 = cA + (size_t)(t + 1) * kstep;
            const char* a2 = last ? nA : cA + (size_t)(t + 2) * kstep; const char* b2 = last ? nB : cB + (size_t)(t + 2) * kstep;
            const char* a3 = a2 + kstep; const char* b3 = b2 + kstep;
            if (last && has_next) S.a_ready(nxt);
            if constexpr (SP2) {
            PG8_LDB(B0, 0, 0); PG8_LDB(B1, 0, 1); PG8_SCHED; PG8_LDA(At, 0, 0); PG8_STAGE(PG8_SA(1, 1), a1 + hstep, voffA);
            PG8_WAIT_V(8); PG8_WAIT_L(0); PG8_BAR; PG8_MMA(0, 0, At, B0); PG8_MMA(0, 1, At, B1); PG8_BAR; PG8_SCHED;
            PG8_LDA(At, 0, 1); PG8_STAGE(PG8_SB(0, 0), b2, voffB); PG8_STAGE(PG8_SB(0, 1), b2 + hstep, voffB); PG8_STAGE(PG8_SA(0, 0), a2, voffA);
            PG8_WAIT_V(8); PG8_WAIT_L(0); PG8_BAR; PG8_MMA(1, 0, At, B0); PG8_MMA(1, 1, At, B1); PG8_BAR; PG8_SCHED;
            PG8_LDB(B0, 1, 0); PG8_LDB(B1, 1, 1); PG8_SCHED; PG8_LDA(At, 1, 0); PG8_STAGE(PG8_SA(0, 1), a2 + hstep, voffA);
            PG8_WAIT_V(8); PG8_WAIT_L(0); PG8_BAR; PG8_MMA(0, 0, At, B0); PG8_MMA(0, 1, At, B1); PG8_BAR; PG8_SCHED;
            PG8_LDA(At, 1, 1); PG8_STAGE(PG8_SB(1, 0), b3, voffB); PG8_STAGE(PG8_SB(1, 1), b3 + hstep, voffB); PG8_STAGE(PG8_SA(1, 0), a3, voffA);
            PG8_WAIT_V(8); PG8_WAIT_L(0); PG8_BAR; PG8_MMA(1, 0, At, B0); PG8_MMA(1, 1, At, B1); PG8_BAR; PG8_SCHED;
            } else {
            PG8_LDB(B0, 0, 0); PG8_SCHED; PG8_LDA(At, 0, 0); PG8_STAGE(PG8_SA(1, 1), a1 + hstep, voffA);
            PG8_WAIT_L(8); PG8_BAR; PG8_WAIT_L(0); PG8_MMA(0, 0, At, B0); PG8_BAR; PG8_SCHED;
            PG8_LDB(B1, 0, 1); PG8_STAGE(PG8_SB(0, 0), b2, voffB);
            PG8_BAR; PG8_WAIT_L(0); PG8_MMA(0, 1, At, B1); PG8_BAR;
            PG8_LDA(At, 0, 1); PG8_STAGE(PG8_SA(0, 0), a2, voffA);
            PG8_BAR; PG8_WAIT_L(0); PG8_MMA(1, 0, At, B0); PG8_BAR; PG8_SCHED;
            PG8_STAGE(PG8_SB(0, 1), b2 + hstep, voffB);
            PG8_WAIT_V(6); PG8_BAR; PG8_MMA(1, 1, At, B1); PG8_BAR;
            PG8_LDB(B0, 1, 0); PG8_SCHED; PG8_LDA(At, 1, 0); PG8_STAGE(PG8_SA(0, 1), a2 + hstep, voffA);
            PG8_WAIT_L(8); PG8_BAR; PG8_WAIT_L(0); PG8_MMA(0, 0, At, B0); PG8_BAR; PG8_SCHED;
            PG8_LDB(B1, 1, 1); PG8_STAGE(PG8_SB(1, 0), b3, voffB);
            PG8_BAR; PG8_WAIT_L(0); PG8_MMA(0, 1, At, B1); PG8_BAR;
            PG8_LDA(At, 1, 1); PG8_STAGE(PG8_SA(1, 0), a3, voffA);
            PG8_BAR; PG8_WAIT_L(0); PG8_MMA(1, 0, At, B0); PG8_BAR; PG8_SCHED;
            PG8_STAGE(PG8_SB(1, 1), b3 + hstep, voffB);
            PG8_WAIT_V(6); PG8_BAR; PG8_MMA(1, 1, At, B1); PG8_BAR;
            }
        }
        if constexpr (ALIGN_EPI) { if (wr == 0) PG8_BAR; }
        if constexpr (!Epi::AFTER_DRAIN) { E(acc, cur, wr, wc, fr, fq);
#if defined(PROBE_EPI2)
            if constexpr (Epi::PROBE_TWICE) { asm volatile("" ::: "memory"); E(acc, cur, wr, wc, fr, fq); }
#endif
            S.done(cur); }
        if (!has_next) break;
#pragma unroll
        for (int a = 0; a < 2; ++a)
#pragma unroll
            for (int b = 0; b < 2; ++b)
#pragma unroll
                for (int m = 0; m < 4; ++m)
#pragma unroll
                    for (int n = 0; n < 2; ++n) acc[a][b][m][n] = (f32x4){0.f, 0.f, 0.f, 0.f};
        cur = nxt; cA = nA; cB = nB; ++ui;
        if constexpr (ALIGN_EPI) { if (wr == 1) PG8_BAR; }
    }
    PG8_WAIT_V(0);
    if constexpr (!ALIGN_EPI) { if (wr == 0) PG8_BAR; }
    PG8_BAR;
    if constexpr (Epi::AFTER_DRAIN) { E.fused(acc, cur, wr, wc, fr, fq, lds, wid, lane); S.done(cur); }
#undef PG8_SA
#undef PG8_SB
#undef PG8_STAGE
#undef PG8_LDA
#undef PG8_LDB
#undef PG8_MMA
#undef PG8_WAIT_V
#undef PG8_WAIT_L
#undef PG8_BAR
#undef PG8_SCHED
}
}
namespace att {
#define ATT_LAS __attribute__((address_space(3)))
using bf16x8 = __attribute__((ext_vector_type(8))) short;
using s16x4  = __attribute__((ext_vector_type(4))) short;
using f32x16 = __attribute__((ext_vector_type(16))) float;
using u32x4  = __attribute__((ext_vector_type(4))) unsigned;
typedef unsigned short bf16_t;
typedef ATT_LAS char* lptr;
constexpr int PITCH = cfg::NIN, OPITCH = cfg::DM;
constexpr float LOG2E = cfg::LOG2E, NEG = -1e30f, THR = 8.f;
#ifndef ATT_RING
#define ATT_RING 0
#endif
#if ATT_RING
constexpr int L_K = 0, L_V = 49152, L_WS = 98304, L_LUT = 100352, L_OST = 65536, L_END = 112640;
#else
constexpr int L_K = 0, L_V = 32768, L_WS = 65536, L_LUT = 67584, L_OST = 81920, L_END = 114688;
#endif
constexpr int LUTB_R = 704, LUTD_R = 1344;
#define ATT_SBAR() __builtin_amdgcn_sched_barrier(0)
__device__ __forceinline__ int crow(int r, int hi) { return (r & 3) + 8 * (r >> 2) + 4 * hi; }
__device__ __forceinline__ unsigned cvtpk(float lo, float hi) { unsigned r; asm volatile("v_cvt_pk_bf16_f32 %0, %1, %2" : "=v"(r) : "v"(lo), "v"(hi)); return r; }
__device__ __forceinline__ float wave_sum(float v) {
#pragma unroll
    for (int o = 1; o < 64; o <<= 1) v += __shfl_xor(v, o);
    return v;
}
__device__ __forceinline__ int t5_bucket(int rel) {
    const int n = rel < 0 ? -rel : rel;
    int b = n;
    if (n >= 8) b = 8 + (n >= 15) + (n >= 27) + (n >= 50) + (n >= 91) + (n >= 166) + (n >= 305) + (n >= 559);
    return b + (rel > 0 ? 16 : 0);
}
template <int KC> __device__ __forceinline__ int kswz(int row, int colB) { return KC == 128 ? row * 256 + (colB ^ ((row & 7) << 4)) : row * 128 + (colB ^ (((row >> 1) & 7) << 4)); }
template <int NCB> __device__ __forceinline__ int v_st(int k, int c) { const int kk = k; return ((kk >> 3) * NCB + (c >> 5)) * 512 + ((kk & 7) * 32 + (c & 31)) * 2; }
__device__ __forceinline__ int v_rd_base(int lane) { return ((lane & 3) << 3) | (((lane >> 2) & 3) << 6) | (((lane >> 4) & 1) << 5) | (((lane >> 5) & 1) << 8); }
template <int OFF> __device__ __forceinline__ s16x4 tr_read(int vb) { s16x4 r; asm volatile("ds_read_b64_tr_b16 %0, %1 offset:%2" : "=&v"(r) : "v"(vb), "i"(OFF) : "memory"); return r; }
template <int NCB, int D0> __device__ __forceinline__ void pv_one(f32x16& od, int vb, bf16x8 pa0, bf16x8 pa1, bf16x8 pa2, bf16x8 pa3) {
#define ATT_VOFF(ks, half) (D0 * 512 + (ks) * (NCB * 1024) + (half) * (NCB * 512))
    const s16x4 l0 = tr_read<ATT_VOFF(0, 0)>(vb), h0 = tr_read<ATT_VOFF(0, 1)>(vb), l1 = tr_read<ATT_VOFF(1, 0)>(vb), h1 = tr_read<ATT_VOFF(1, 1)>(vb);
    const s16x4 l2 = tr_read<ATT_VOFF(2, 0)>(vb), h2 = tr_read<ATT_VOFF(2, 1)>(vb), l3 = tr_read<ATT_VOFF(3, 0)>(vb), h3 = tr_read<ATT_VOFF(3, 1)>(vb);
#undef ATT_VOFF
    asm volatile("s_waitcnt lgkmcnt(0)" ::: "memory"); ATT_SBAR();
#define ATT_PK(L, H) (bf16x8){L[0], L[1], L[2], L[3], H[0], H[1], H[2], H[3]}
    od = __builtin_amdgcn_mfma_f32_32x32x16_bf16(pa0, ATT_PK(l0, h0), od, 0, 0, 0);
    od = __builtin_amdgcn_mfma_f32_32x32x16_bf16(pa1, ATT_PK(l1, h1), od, 0, 0, 0);
    od = __builtin_amdgcn_mfma_f32_32x32x16_bf16(pa2, ATT_PK(l2, h2), od, 0, 0, 0);
    od = __builtin_amdgcn_mfma_f32_32x32x16_bf16(pa3, ATT_PK(l3, h3), od, 0, 0, 0);
#undef ATT_PK
}
template <int NCB, bool ONES> __device__ __forceinline__ void pv_all(f32x16* o, f32x16& lacc, int vb, bf16x8 pa0, bf16x8 pa1, bf16x8 pa2, bf16x8 pa3) {
    if constexpr (ONES) { const bf16x8 ones = {0x3F80, 0x3F80, 0x3F80, 0x3F80, 0x3F80, 0x3F80, 0x3F80, 0x3F80};
        lacc = __builtin_amdgcn_mfma_f32_32x32x16_bf16(pa0, ones, lacc, 0, 0, 0); lacc = __builtin_amdgcn_mfma_f32_32x32x16_bf16(pa1, ones, lacc, 0, 0, 0);
        lacc = __builtin_amdgcn_mfma_f32_32x32x16_bf16(pa2, ones, lacc, 0, 0, 0); lacc = __builtin_amdgcn_mfma_f32_32x32x16_bf16(pa3, ones, lacc, 0, 0, 0); }
    pv_one<NCB, 0>(o[0], vb, pa0, pa1, pa2, pa3); pv_one<NCB, 1>(o[1], vb, pa0, pa1, pa2, pa3);
    if constexpr (NCB == 4) { pv_one<NCB, 2>(o[2], vb, pa0, pa1, pa2, pa3); pv_one<NCB, 3>(o[3], vb, pa0, pa1, pa2, pa3); }
}
template <bool NOMAX> __device__ __forceinline__ void partialSM(f32x16& p0, f32x16& p1, float cb, float& m_reg, float& alpha) {
    if constexpr (NOMAX) { alpha = 1.f;
        (void)cb;
#pragma unroll
        for (int r = 0; r < 16; ++r) p0[r] = __builtin_amdgcn_exp2f(p0[r]);
        return; }
    float ma = fmaxf(p0[0], p0[1]), mb = fmaxf(p0[2], p0[3]), mc = fmaxf(p1[0], p1[1]), md = fmaxf(p1[2], p1[3]);
#pragma unroll
    for (int r = 4; r < 16; r += 4) { ma = fmaxf(fmaxf(ma, p0[r]), p0[r + 1]); mb = fmaxf(fmaxf(mb, p0[r + 2]), p0[r + 3]); mc = fmaxf(fmaxf(mc, p1[r]), p1[r + 1]); md = fmaxf(fmaxf(md, p1[r + 2]), p1[r + 3]); }
    float pmax = fmaxf(fmaxf(ma, mb), fmaxf(mc, md));
    { auto rr = __builtin_amdgcn_permlane32_swap(__float_as_uint(pmax), __float_as_uint(pmax), false, false); pmax = fmaxf(__uint_as_float(rr[0]), __uint_as_float(rr[1])); }
    pmax += cb;
    float mn;
    if (__builtin_expect(__all(pmax - m_reg <= THR), 1)) { mn = m_reg; alpha = 1.f; }
    else { mn = fmaxf(m_reg, pmax); alpha = __builtin_amdgcn_exp2f(m_reg - mn); m_reg = mn; }
    const float sub = cb - mn;
#pragma unroll
    for (int r = 0; r < 16; ++r) p0[r] += sub;
#pragma unroll
    for (int r = 0; r < 16; ++r) p1[r] += sub;
#pragma unroll
    for (int r = 0; r < 16; ++r) p0[r] = __builtin_amdgcn_exp2f(p0[r]);
}
template <bool ONES> __device__ __forceinline__ void finishSM(f32x16& p0, f32x16& p1, float alpha, float& l_reg, bf16x8& pa0, bf16x8& pa1, bf16x8& pa2, bf16x8& pa3) {
#pragma unroll
    for (int r = 0; r < 16; ++r) p1[r] = __builtin_amdgcn_exp2f(p1[r]);
    if constexpr (!ONES) {
    float sa = p0[0] + p0[1], sb = p0[2] + p0[3], sc_ = p1[0] + p1[1], sd = p1[2] + p1[3];
#pragma unroll
    for (int r = 4; r < 16; r += 4) { sa += p0[r]; sa += p0[r + 1]; sb += p0[r + 2]; sb += p0[r + 3]; sc_ += p1[r]; sc_ += p1[r + 1]; sd += p1[r + 2]; sd += p1[r + 3]; }
    float ps = (sa + sb) + (sc_ + sd);
    { auto rr = __builtin_amdgcn_permlane32_swap(__float_as_uint(ps), __float_as_uint(ps), false, false); ps = __uint_as_float(rr[0]) + __uint_as_float(rr[1]); }
    l_reg = l_reg * alpha + ps;
    }
#define ATT_PK4(P, BASE, OUT) do { unsigned a0 = cvtpk(P[BASE + 0], P[BASE + 1]), a1 = cvtpk(P[BASE + 2], P[BASE + 3]);   \
    unsigned b0 = cvtpk(P[BASE + 4], P[BASE + 5]), b1 = cvtpk(P[BASE + 6], P[BASE + 7]);                              \
    u32x4 w = {a0, a1, b0, b1}; OUT = __builtin_bit_cast(bf16x8, w); } while (0)
    ATT_PK4(p0, 0, pa0); ATT_PK4(p0, 8, pa1); ATT_PK4(p1, 0, pa2); ATT_PK4(p1, 8, pa3);
#undef ATT_PK4
}
template <int KC, bool USEC> __device__ __forceinline__ void qkt(f32x16& p0, f32x16& p1, lptr Ks, int cb0, const bf16x8* qr, const f32x16& c0, int r32, int hi) {
    if constexpr (!USEC) { p0 = f32x16{}; p1 = f32x16{}; }
#pragma unroll
    for (int d0 = 0; d0 < 4; ++d0) { const int cb = cb0 + d0 * 32 + hi * 16;
        const bf16x8 b0 = *(const ATT_LAS bf16x8*)(Ks + kswz<KC>(r32, cb));
        const bf16x8 b1 = *(const ATT_LAS bf16x8*)(Ks + kswz<KC>(32 + r32, cb));
        if (USEC && d0 == 0) { p0 = __builtin_amdgcn_mfma_f32_32x32x16_bf16(b0, qr[0], c0, 0, 0, 0); p1 = __builtin_amdgcn_mfma_f32_32x32x16_bf16(b1, qr[0], c0, 0, 0, 0); }
        else { p0 = __builtin_amdgcn_mfma_f32_32x32x16_bf16(b0, qr[d0], p0, 0, 0, 0); p1 = __builtin_amdgcn_mfma_f32_32x32x16_bf16(b1, qr[d0], p1, 0, 0, 0); } }
}
struct Aux { const float* t5; const float* rpb; const float* lam_p; const float* subln; float lam_init; };

template <int MODE, bool NOMAX = false>
__device__ __forceinline__ void attn_unit(const bf16_t* __restrict__ QKV, bf16_t* __restrict__ ATT, lptr lds, int row0, int T, int h, int qb, const Aux& ax) {
#ifndef ATT_ONES
#define ATT_ONES 1
#endif
    constexpr bool ONES = (ATT_ONES != 0) && (MODE != 1);
    constexpr int KC = (MODE == 1) ? 128 : 64, DV = (MODE == 1) ? 128 : 64, NCB = DV / 32, NR = KC / 64;
    constexpr int KBYTES = 64 * KC * 2, VBYTES = 64 * DV * 2, QROWS = (MODE == 1) ? 128 : 256;
    int tid_ = threadIdx.x; asm volatile("" : "+v"(tid_));
    const int tid = tid_, lane = tid & 63, r32 = lane & 31, hi = lane >> 5;
    const int wid = __builtin_amdgcn_readfirstlane(tid >> 6);
    const int map = (MODE == 1) ? (wid >> 2) : 0, wq = (MODE == 1) ? (wid & 3) : wid;
    const int q0 = qb * QROWS, qw = q0 + wq * 32, qpos = qw + r32;
    int qcol, kcol, vcol, ocol;
    if (MODE == 0)      { qcol = 64 * h;          kcol = 512 + 64 * (h >> 2); vcol = 640 + 64 * (h >> 2); ocol = 64 * h; }
    else if (MODE == 1) { qcol = 768 + 128 * h + 64 * map; kcol = 1280 + 128 * h; vcol = 1792 + 128 * h; ocol = 512 + 128 * h; }
    else if (MODE == 2) { qcol = 2304 + 64 * h;   kcol = 2816 + 64 * h;       vcol = 3328 + 64 * h;       ocol = 1024 + 64 * h; }
    else                { qcol = 3840 + 64 * h;   kcol = 4352 + 64 * h;       vcol = 4864 + 64 * h;       ocol = 1536 + 64 * h; }
    int tlo = 0, NT = T >> 6;
    if (MODE == 3) { int lo = q0 - 1024; lo = lo < 0 ? 0 : lo; int hi_k = q0 + 255 + 1024; hi_k = hi_k > T - 1 ? T - 1 : hi_k; int a = lo >> 6, b = hi_k >> 6;
        if (((b - a + 1) & 1) != 0) { if (a > 0) --a; else ++b; } tlo = a; NT = b - a + 1; }
    if (MODE == 2) { const int rows = T >> 6, R0 = 4 * qb; int a = R0 - 4; a = a < 0 ? 0 : (a > rows - 8 ? rows - 8 : a); int b = R0 - 1; b = b < 0 ? 0 : (b > rows - 8 ? rows - 8 : b); b += 7;
        if (((b - a + 1) & 1) != 0) { if (a > 0) --a; else ++b; } tlo = a; NT = b - a + 1; }
    const int sr = (KC == 128) ? (tid >> 4) : (tid >> 3), sc = (KC == 128) ? (tid & 15) * 8 : (tid & 7) * 8;
    const bf16_t* Kg = QKV + (size_t)(row0 + sr) * PITCH + kcol + sc;
    const bf16_t* Vg = QKV + (size_t)(row0 + sr) * PITCH + vcol + sc;
    const int kst0 = kswz<KC>(sr, sc * 2), kst1 = kswz<KC>(32 + sr, sc * 2), vst0 = v_st<NCB>(sr, sc), vst1 = v_st<NCB>(32 + sr, sc);
    const lptr K_lds = lds + L_K, V_lds = lds + L_V;
    const int vb0 = (int)(uintptr_t)V_lds + v_rd_base(lane);
    ATT_LAS float* wsf = (ATT_LAS float*)(lds + L_WS) + wid * 64; ATT_LAS float* li_l = wsf; ATT_LAS float* al_l = wsf + 32;
    struct { bf16x8 k[NR], v[NR]; } st_[2];
#define SLOAD(i, tt) do { const size_t ro_ = (size_t)((tlo + (tt)) * 64) * PITCH; st_[i].k[0] = *(const bf16x8*)(Kg + ro_); st_[i].v[0] = *(const bf16x8*)(Vg + ro_); \
        if constexpr (NR == 2) { st_[i].k[1] = *(const bf16x8*)(Kg + ro_ + (size_t)32 * PITCH); st_[i].v[1] = *(const bf16x8*)(Vg + ro_ + (size_t)32 * PITCH); } } while (0)
#define SWRITE(b, i) do { *(ATT_LAS bf16x8*)(K_lds + (b) * KBYTES + kst0) = st_[i].k[0]; *(ATT_LAS bf16x8*)(V_lds + (b) * VBYTES + vst0) = st_[i].v[0]; \
        if constexpr (NR == 2) { *(ATT_LAS bf16x8*)(K_lds + (b) * KBYTES + kst1) = st_[i].k[1]; *(ATT_LAS bf16x8*)(V_lds + (b) * VBYTES + vst1) = st_[i].v[1]; } } while (0)
#define SWAIT() do { if constexpr (NR == 2) asm volatile("s_waitcnt vmcnt(4)" ::: "memory"); else asm volatile("s_waitcnt vmcnt(2)" ::: "memory"); } while (0)
#define RESC(a) do { if (!NOMAX && __any((a) < 1.f)) { if (hi == 0) al_l[r32] = (a); asm volatile("s_waitcnt lgkmcnt(0)" ::: "memory"); \
        _Pragma("unroll") for (int r = 0; r < 16; ++r) { const float f_ = al_l[crow(r, hi)]; if (ONES) lacc[r] *= f_; _Pragma("unroll") for (int d = 0; d < NCB; ++d) o[d][r] *= f_; } } } while (0)
    SLOAD(0, 0); SLOAD(1, 1);
    bf16x8 qr[4];
    { const bf16_t* Qw = QKV + (size_t)(row0 + qpos) * PITCH + qcol + hi * 8;
#pragma unroll
      for (int d0 = 0; d0 < 4; ++d0) qr[d0] = *(const bf16x8*)(Qw + d0 * 16); }
    ATT_LAS float* lut = (ATT_LAS float*)(lds + L_LUT);
    if (MODE == 1) { for (int i = tid; i < 2 * LUTB_R + 1; i += 512) lut[i] = ax.t5[t5_bucket(i - LUTB_R) * 12 + h] * LOG2E; }
    if (MODE == 3) { for (int i = tid; i < 2 * LUTD_R + 1; i += 512) { const int rel = i - LUTD_R, n = rel < 0 ? -rel : rel;
            const int mult = (n <= 64 ? 1 : 0) + (((n & 3) == 0 && n <= 256) ? 1 : 0) + (((n & 15) == 0 && n <= 1024) ? 1 : 0);
            lut[i] = mult == 0 ? NEG : ax.t5[t5_bucket(rel) * 12 + 4 + h] * LOG2E + (mult == 1 ? 0.f : (mult == 2 ? 1.f : 1.5849625007211562f)); } }
    if (MODE == 2) { for (int i = tid; i < 15 * 128; i += 512) { const int dr = i >> 7, dc = (i & 127) - 48; lut[i] = (dc >= 0 && dc <= 30) ? ax.rpb[(h * 15 + dr) * 31 + dc] * LOG2E : NEG; } }
    float cL = 0.f, cR = 0.f; int c_cs = 0, c_rs = 0, c_R = 0, c_c = 0;
    if (MODE == 2) { const int rows = T >> 6; c_R = 4 * qb + (wid >> 1); c_c = 32 * (wid & 1) + r32; c_cs = c_c - 8; c_cs = c_cs < 0 ? 0 : (c_cs > 48 ? 48 : c_cs); c_rs = c_R - 4; c_rs = c_rs < 0 ? 0 : (c_rs > rows - 8 ? rows - 8 : c_rs); }
#define MODIFY(P0, P1, tt, CB) do { CB = 0.f; const int k0_ = (tlo + (tt)) * 64; \
        if constexpr (MODE == 1) { if (k0_ + 63 - qw <= -559) CB = cL; else if (k0_ - qw - 31 >= 559) CB = cR; else { const ATT_LAS float* lp_ = lut + (k0_ - qpos + LUTB_R + 4 * hi); \
            _Pragma("unroll") for (int r = 0; r < 16; ++r) { P0[r] += lp_[(r & 3) + 8 * (r >> 2)]; P1[r] += lp_[32 + (r & 3) + 8 * (r >> 2)]; } } } \
        if constexpr (MODE == 3) { const ATT_LAS float* lp_ = lut + (k0_ - qpos + LUTD_R + 4 * hi); \
            _Pragma("unroll") for (int r = 0; r < 16; ++r) { P0[r] += lp_[(r & 3) + 8 * (r >> 2)]; P1[r] += lp_[32 + (r & 3) + 8 * (r >> 2)]; } } \
        if constexpr (MODE == 2) { const int kr_ = tlo + (tt); if (kr_ < c_rs || kr_ > c_rs + 7) { _Pragma("unroll") for (int r = 0; r < 16; ++r) { P0[r] = NEG; P1[r] = NEG; } } \
            else { const ATT_LAS float* lp_ = lut + ((kr_ - c_R + 7) * 128 + 48 + 15 - c_c + 4 * hi); const int kb_ = 4 * hi - c_cs; \
              _Pragma("unroll") for (int r = 0; r < 16; ++r) { const int ko_ = (r & 3) + 8 * (r >> 2); const float a_ = lp_[ko_], b_ = lp_[32 + ko_]; \
                P0[r] = ((unsigned)(kb_ + ko_) <= 15u) ? P0[r] + a_ : NEG; P1[r] = ((unsigned)(kb_ + 32 + ko_) <= 15u) ? P1[r] + b_ : NEG; } } } \
    } while (0)
    __syncthreads();
    if (MODE == 1) { cL = lut[0]; cR = lut[2 * LUTB_R]; }
    constexpr bool USEC = false;
    float m_reg = NEG, l_reg = 0.f, cbcur = 0.f, cbacc = 0.f; f32x16 o[NCB], lacc = f32x16{}, cbt = f32x16{};
#define REGSC(CB) do { if constexpr (MODE == 1 && NOMAX) { if ((CB) != cbacc) { const float f_ = __builtin_amdgcn_exp2f(cbacc - (CB)); cbacc = (CB); l_reg *= f_; \
        _Pragma("unroll") for (int r = 0; r < 16; ++r) { if (ONES) lacc[r] *= f_; _Pragma("unroll") for (int d = 0; d < NCB; ++d) o[d][r] *= f_; } } } } while (0)
#define REGIONC(tt) do { if constexpr (USEC) { const int k0_ = (tlo + (tt)) * 64; const float cb_ = (k0_ + 63 - qw <= -559) ? cL : ((k0_ - qw - 31 >= 559) ? cR : 0.f); \
        if (cb_ != cbcur) { cbcur = cb_; _Pragma("unroll") for (int r = 0; r < 16; ++r) cbt[r] = cb_; } } } while (0)
#pragma unroll
    for (int d = 0; d < NCB; ++d) o[d] = f32x16{};
    f32x16 pA0, pA1, pB0, pB1; float alA, alB, cbA, cbB; bf16x8 pa0, pa1, pa2, pa3;
    const int cb0 = map * 128;
#if ATT_RING
    int s_prev = 2, s_cur = 0, s_next = 1;
#define ROT() do { const int t_ = s_prev; s_prev = s_cur; s_cur = s_next; s_next = t_; } while (0)
    asm volatile("s_waitcnt vmcnt(0)" ::: "memory"); SWRITE(0, 0); if (2 < NT) SLOAD(0, 2); __syncthreads();
    SWAIT(); SWRITE(1, 1); if (3 < NT) SLOAD(1, 3);
    REGIONC(0); qkt<KC, USEC>(pA0, pA1, K_lds, cb0, qr, cbt, r32, hi); MODIFY(pA0, pA1, 0, cbA); partialSM<NOMAX>(pA0, pA1, cbA, m_reg, alA);
    __syncthreads(); ROT();
    for (int j = 1; j + 1 < NT; j += 2) {
        SWAIT(); SWRITE(s_next, 0); if (j + 3 < NT) SLOAD(0, j + 3);
        REGIONC(j); ATT_SBAR(); qkt<KC, USEC>(pB0, pB1, K_lds + s_cur * KBYTES, cb0, qr, cbt, r32, hi);
        REGSC(cbA); finishSM<ONES>(pA0, pA1, alA, l_reg, pa0, pa1, pa2, pa3); ATT_SBAR();
        pv_all<NCB, ONES>(o, lacc, vb0 + s_prev * (int)VBYTES, pa0, pa1, pa2, pa3); MODIFY(pB0, pB1, j, cbB); partialSM<NOMAX>(pB0, pB1, cbB, m_reg, alB);
        RESC(alB); __syncthreads(); ROT();
        SWAIT(); SWRITE(s_next, 1); if (j + 4 < NT) SLOAD(1, j + 4);
        REGIONC(j + 1); ATT_SBAR(); qkt<KC, USEC>(pA0, pA1, K_lds + s_cur * KBYTES, cb0, qr, cbt, r32, hi);
        REGSC(cbB); finishSM<ONES>(pB0, pB1, alB, l_reg, pa0, pa1, pa2, pa3); ATT_SBAR();
        pv_all<NCB, ONES>(o, lacc, vb0 + s_prev * (int)VBYTES, pa0, pa1, pa2, pa3); MODIFY(pA0, pA1, j + 1, cbA); partialSM<NOMAX>(pA0, pA1, cbA, m_reg, alA);
        RESC(alA); __syncthreads(); ROT();
    }
    REGIONC(NT - 1); ATT_SBAR(); qkt<KC, USEC>(pB0, pB1, K_lds + s_cur * KBYTES, cb0, qr, cbt, r32, hi);
    REGSC(cbA); finishSM<ONES>(pA0, pA1, alA, l_reg, pa0, pa1, pa2, pa3); ATT_SBAR();
    pv_all<NCB, ONES>(o, lacc, vb0 + s_prev * (int)VBYTES, pa0, pa1, pa2, pa3); MODIFY(pB0, pB1, NT - 1, cbB); partialSM<NOMAX>(pB0, pB1, cbB, m_reg, alB);
    RESC(alB);
    REGSC(cbB); finishSM<ONES>(pB0, pB1, alB, l_reg, pa0, pa1, pa2, pa3); ATT_SBAR();
    pv_all<NCB, ONES>(o, lacc, vb0 + s_cur * (int)VBYTES, pa0, pa1, pa2, pa3);
    __syncthreads();
#undef ROT
#else
    asm volatile("s_waitcnt vmcnt(0)" ::: "memory"); SWRITE(0, 0); __syncthreads();
    REGIONC(0); qkt<KC, USEC>(pA0, pA1, K_lds, cb0, qr, cbt, r32, hi); MODIFY(pA0, pA1, 0, cbA); partialSM<NOMAX>(pA0, pA1, cbA, m_reg, alA);
    if (2 < NT) SLOAD(0, 2);
    SWAIT(); SWRITE(1, 1); __syncthreads();
    for (int j = 1; j + 1 < NT; j += 2) {
        REGIONC(j); ATT_SBAR(); qkt<KC, USEC>(pB0, pB1, K_lds + KBYTES, cb0, qr, cbt, r32, hi);
        REGSC(cbA); finishSM<ONES>(pA0, pA1, alA, l_reg, pa0, pa1, pa2, pa3); ATT_SBAR();
        SLOAD(1, j + 2); ATT_SBAR();
        pv_all<NCB, ONES>(o, lacc, vb0, pa0, pa1, pa2, pa3); MODIFY(pB0, pB1, j, cbB); partialSM<NOMAX>(pB0, pB1, cbB, m_reg, alB);
        __syncthreads(); SWAIT(); SWRITE(0, 0);
        RESC(alB); __syncthreads();
        REGIONC(j + 1); ATT_SBAR(); qkt<KC, USEC>(pA0, pA1, K_lds, cb0, qr, cbt, r32, hi);
        REGSC(cbB); finishSM<ONES>(pB0, pB1, alB, l_reg, pa0, pa1, pa2, pa3); ATT_SBAR();
        if (j + 3 < NT) SLOAD(0, j + 3); ATT_SBAR();
        pv_all<NCB, ONES>(o, lacc, vb0 + VBYTES, pa0, pa1, pa2, pa3); MODIFY(pA0, pA1, j + 1, cbA); partialSM<NOMAX>(pA0, pA1, cbA, m_reg, alA);
        __syncthreads(); SWAIT(); SWRITE(1, 1);
        RESC(alA); __syncthreads();
    }
    REGIONC(NT - 1); ATT_SBAR(); qkt<KC, USEC>(pB0, pB1, K_lds + KBYTES, cb0, qr, cbt, r32, hi);
    REGSC(cbA); finishSM<ONES>(pA0, pA1, alA, l_reg, pa0, pa1, pa2, pa3); ATT_SBAR();
    pv_all<NCB, ONES>(o, lacc, vb0, pa0, pa1, pa2, pa3); MODIFY(pB0, pB1, NT - 1, cbB); partialSM<NOMAX>(pB0, pB1, cbB, m_reg, alB);
    __syncthreads(); RESC(alB);
    REGSC(cbB); finishSM<ONES>(pB0, pB1, alB, l_reg, pa0, pa1, pa2, pa3); ATT_SBAR();
    pv_all<NCB, ONES>(o, lacc, vb0 + VBYTES, pa0, pa1, pa2, pa3);
#endif
    float rli[16];
    if constexpr (ONES) {
#pragma unroll
        for (int r = 0; r < 16; ++r) rli[r] = __builtin_amdgcn_rcpf(lacc[r]);
    } else {
        if (hi == 0) li_l[r32] = l_reg; asm volatile("s_waitcnt lgkmcnt(0)" ::: "memory");
#pragma unroll
        for (int r = 0; r < 16; ++r) rli[r] = __builtin_amdgcn_rcpf(li_l[crow(r, hi)]);
    }
    if constexpr (MODE != 1) {
        ATT_LAS bf16_t* stg = (ATT_LAS bf16_t*)(lds + L_OST) + wid * 2048;
#pragma unroll
        for (int r = 0; r < 16; ++r) { const int orow = crow(r, hi);
#pragma unroll
            for (int d0 = 0; d0 < 2; ++d0) stg[orow * 64 + d0 * 32 + r32] = (bf16_t)(cvtpk(o[d0][r] * rli[r], 0.f) & 0xffffu); }
        asm volatile("s_waitcnt lgkmcnt(0)" ::: "memory");
        bf16_t* Ow = ATT + (size_t)(row0 + q0 + wid * 32) * OPITCH + ocol;
#pragma unroll
        for (int i = 0; i < 4; ++i) { const int row = i * 8 + (lane >> 3), ch = lane & 7; const u32x4 v = *(const ATT_LAS u32x4*)(stg + row * 64 + ch * 8); *(u32x4*)(Ow + (size_t)row * OPITCH + ch * 8) = v; }
    } else {
        __syncthreads();
        ATT_LAS float* ex = (ATT_LAS float*)(lds + L_K) + (wid & 3) * 4096;
        if (map == 1) {
#pragma unroll
            for (int d0 = 0; d0 < 4; ++d0)
#pragma unroll
                for (int r = 0; r < 16; ++r) ex[(d0 * 16 + r) * 64 + lane] = o[d0][r] * rli[r];
        }
        __syncthreads();
        if (map == 0) {
            const float sa = wave_sum(ax.lam_p[lane] * ax.lam_p[64 + lane]), sb = wave_sum(ax.lam_p[128 + lane] * ax.lam_p[192 + lane]);
            const float lam = __builtin_amdgcn_exp2f(sa * LOG2E) - __builtin_amdgcn_exp2f(sb * LOG2E) + ax.lam_init;
            float ssq[16];
#pragma unroll
            for (int r = 0; r < 16; ++r) ssq[r] = 0.f;
#pragma unroll
            for (int d0 = 0; d0 < 4; ++d0)
#pragma unroll
                for (int r = 0; r < 16; ++r) { const float d = o[d0][r] * rli[r] - lam * ex[(d0 * 16 + r) * 64 + lane]; o[d0][r] = d; ssq[r] += d * d; }
#pragma unroll
            for (int r = 0; r < 16; ++r) { float s = ssq[r]; s += __shfl_xor(s, 1); s += __shfl_xor(s, 2); s += __shfl_xor(s, 4); s += __shfl_xor(s, 8); s += __shfl_xor(s, 16);
                ssq[r] = __builtin_amdgcn_rsqf(s * (1.0f / 128.0f) + cfg::EPS) * (1.0f - ax.lam_init); }
            float gsub[4];
#pragma unroll
            for (int d0 = 0; d0 < 4; ++d0) gsub[d0] = ax.subln[d0 * 32 + r32];
            ATT_LAS bf16_t* stg = (ATT_LAS bf16_t*)(lds + L_OST) + wid * 4096;
#pragma unroll
            for (int r = 0; r < 16; ++r) { const int orow = crow(r, hi);
#pragma unroll
                for (int d0 = 0; d0 < 4; ++d0) stg[orow * 128 + d0 * 32 + r32] = (bf16_t)(cvtpk(o[d0][r] * ssq[r] * gsub[d0], 0.f) & 0xffffu); }
            asm volatile("s_waitcnt lgkmcnt(0)" ::: "memory");
            bf16_t* Ow = ATT + (size_t)(row0 + q0 + wid * 32) * OPITCH + ocol;
#pragma unroll
            for (int i = 0; i < 8; ++i) { const int row = i * 4 + (lane >> 4), ch = lane & 15; const u32x4 v = *(const ATT_LAS u32x4*)(stg + row * 128 + ch * 8); *(u32x4*)(Ow + (size_t)row * OPITCH + ch * 8) = v; }
        }
    }
    __syncthreads();
#undef SLOAD
#undef SWRITE
#undef SWAIT
#undef RESC
#undef MODIFY
#undef REGIONC
#undef REGSC
}
#undef ATT_SBAR
}
#define GAS __attribute__((address_space(1)))
#define LAS __attribute__((address_space(3)))
typedef unsigned short bf16;
typedef unsigned v4u __attribute__((ext_vector_type(4)));
typedef float f32x4 __attribute__((ext_vector_type(4)));
typedef short bf16x8 __attribute__((ext_vector_type(8)));
typedef GAS unsigned gu32;
typedef GAS unsigned long long gu64;
#define RLX_AGENT __ATOMIC_RELAXED, __HIP_MEMORY_SCOPE_AGENT
#define LDS_WAIT() asm volatile("s_waitcnt lgkmcnt(0)" ::: "memory")
#define VM_WAIT() asm volatile("s_waitcnt vmcnt(0)" ::: "memory")
__device__ __forceinline__ unsigned long long rt() { return __builtin_amdgcn_s_memrealtime(); }
__device__ __forceinline__ unsigned f2bf(float f) { unsigned u = __builtin_bit_cast(unsigned, f); return (u + 0x7fffu + ((u >> 16) & 1u)) >> 16; }
__device__ __forceinline__ unsigned pk2(float lo, float hi) { return f2bf(lo) | (f2bf(hi) << 16); }

#define XB_TMO      128
#define XB_XCNT(j)  (256  + 64 * (j))
#define XB_XSUB(j)  (1280 + 64 * (j))
#define XB_XGEN(j)  (2304 + 64 * (j))
#define XB_TOP      3328
#define XB_TOPGEN   3392
#define XCD_BAR_WORDS 3456
#define XB_SPIN_CAP (1u << 18)

__device__ __forceinline__ unsigned xb_ld(unsigned* p)              { return __hip_atomic_load(p, __ATOMIC_RELAXED, __HIP_MEMORY_SCOPE_AGENT); }
__device__ __forceinline__ unsigned xb_add(unsigned* p, unsigned v) { return __hip_atomic_fetch_add(p, v, __ATOMIC_RELAXED, __HIP_MEMORY_SCOPE_AGENT); }
__device__ __forceinline__ unsigned xb_xcc_id() { return (unsigned)__builtin_amdgcn_s_getreg((3 << 11) | 20) & 0xFu; }
#define XB_SPIN(cond, bar) do { unsigned _sp = 0; while (cond) { __builtin_amdgcn_s_sleep(1); \
    if ((++_sp & 255u) == 0u) { if (xb_ld(&(bar)[XB_TMO])) break; if (_sp > XB_SPIN_CAP) { atomicAdd(&(bar)[XB_TMO], 1u); break; } } } } while (0)

struct XcdBarrier {
    unsigned* bar; unsigned x;
    volatile LAS unsigned* st;
};

__device__ __forceinline__ XcdBarrier xcd_barrier_post(unsigned* bar, volatile LAS unsigned* st) {
    XcdBarrier b; b.bar = bar; b.x = xb_xcc_id(); b.st = st;
    if (threadIdx.x == 0) (void)xb_add(&bar[XB_XCNT(b.x)], 1u);
    return b;
}
__device__ __forceinline__ void xcd_barrier_complete(unsigned* bar, unsigned x, unsigned& nloc, unsigned& nx) {
    const unsigned G = gridDim.x * gridDim.y * gridDim.z;
    unsigned sum, cnt, mine, sp = 0u;
    for (;;) {
        sum = 0u; cnt = 0u; mine = 0u;
#pragma unroll
        for (unsigned j = 0; j < 16; ++j) { const unsigned c = xb_ld(&bar[XB_XCNT(j)]); sum += c; cnt += (c > 0u) ? 1u : 0u; mine = (j == x) ? c : mine; }
        if (sum == G) break;
        __builtin_amdgcn_s_sleep(1);
        if ((++sp & 255u) == 0u) { if (xb_ld(&bar[XB_TMO])) break; if (sp > XB_SPIN_CAP) { atomicAdd(&bar[XB_TMO], 1u); break; } }
    }
    nloc = mine > 0u ? mine : 1u; nx = cnt > 0u ? cnt : 1u;
}

__device__ __forceinline__ void xcd_barrier(const XcdBarrier& b) {
    asm volatile("s_waitcnt vmcnt(0)" ::: "memory");
    __syncthreads();
    if (threadIdx.x == 0) {
        unsigned* bar = b.bar;
        __builtin_amdgcn_s_waitcnt(0);
        unsigned nloc = b.st[0], nx = b.st[1];
        if (nloc == 0u) { xcd_barrier_complete(bar, b.x, nloc, nx); b.st[0] = nloc; b.st[1] = nx; }
        const unsigned old = xb_add(&bar[XB_XSUB(b.x)], 1u);
        const unsigned gen = old / nloc;
        if (old + 1u == (gen + 1u) * nloc) {
            __builtin_amdgcn_fence(__ATOMIC_RELEASE, "agent");
            asm volatile("s_waitcnt vmcnt(0)" ::: "memory");
            const unsigned og = xb_add(&bar[XB_TOP], 1u);
            const unsigned tg = og / nx;
            if (og + 1u == (tg + 1u) * nx) xb_add(&bar[XB_TOPGEN], 1u);
            else XB_SPIN(xb_ld(&bar[XB_TOPGEN]) == tg, bar);
            __builtin_amdgcn_fence(__ATOMIC_ACQUIRE, "agent");
            xb_add(&bar[XB_XGEN(b.x)], 1u);
            asm volatile("s_waitcnt vmcnt(0)" ::: "memory");
        } else {
            XB_SPIN(xb_ld(&bar[XB_XGEN(b.x)]) == gen, bar);
            __builtin_amdgcn_fence(__ATOMIC_ACQUIRE, "agent");
            asm volatile("s_waitcnt vmcnt(0)" ::: "memory");
        }
    }
    __syncthreads();
}

__device__ __forceinline__ void xcd_local_barrier(const XcdBarrier& b) {
    asm volatile("s_waitcnt vmcnt(0)" ::: "memory");
    __syncthreads();
    if (threadIdx.x == 0) {
        unsigned* bar = b.bar;
        __builtin_amdgcn_s_waitcnt(0);
        unsigned nloc = b.st[0]; nloc = nloc ? nloc : 1u;
        const unsigned old = xb_add(&bar[XB_XSUB(b.x)], 1u);
        const unsigned gen = old / nloc;
        if (old + 1u == (gen + 1u) * nloc) xb_add(&bar[XB_XGEN(b.x)], 1u);
        else XB_SPIN(xb_ld(&bar[XB_XGEN(b.x)]) == gen, bar);
        __builtin_amdgcn_fence(__ATOMIC_ACQUIRE, "agent");
        asm volatile("s_waitcnt vmcnt(0)" ::: "memory");
    }
    __syncthreads();
}

constexpr int NWAVES = 8;
constexpr size_t MiB = 1u << 20;
constexpr size_t WS_CTL = 0, CTL_ZERO_BYTES = 1 * MiB;
constexpr size_t WS_WGU = 2 * MiB, WS_WD = 46 * MiB, WS_WIN = 68 * MiB, WS_WOUT = 89 * MiB;
constexpr size_t WS_R = 98 * MiB;
constexpr size_t WS_ATT = 290 * MiB;
constexpr size_t WS_BIG = 482 * MiB;
constexpr size_t WS_RSS = 1010 * MiB, RSS_BYTES = 3 * MiB;
constexpr size_t WS_END = 1013 * MiB;
static_assert(WS_WGU + (size_t)cfg::NGU * cfg::DM * 2 <= WS_WD && WS_WD + (size_t)cfg::DM * cfg::DFF * 2 <= WS_WIN && WS_WIN + (size_t)cfg::NIN * cfg::DM * 2 <= WS_WOUT &&
              WS_WOUT + (size_t)cfg::DM * cfg::DM * 2 <= WS_R && WS_R + (size_t)cfg::M * cfg::DM * 2 <= WS_ATT && WS_ATT + (size_t)cfg::M * cfg::DM * 2 <= WS_BIG && WS_BIG + (size_t)cfg::M * cfg::DFF * 2 <= WS_END, "d_ws map");
#ifndef WGM_DN
#define WGM_DN 4
#endif
#ifndef GEMM_SP2
#define GEMM_SP2 true
#endif
#ifndef GEMM_ALIGN
#define GEMM_ALIGN true
#endif
#ifndef WGM_GU
#define WGM_GU 8
#endif
constexpr int CW_BAR = 4096;
constexpr int CW_NRM = 8192;
constexpr int RING_OFF = 0, RING_BYTES = 131072, LDSCTL_OFF = RING_BYTES, MISC_OFF = LDSCTL_OFF + 320, LDS_BYTES = 147456;
static_assert(att::L_END <= RING_BYTES && MISC_OFF + 128 <= LDS_BYTES, "LDS map");

struct Frame {
    LAS unsigned char* lds; volatile LAS unsigned* MISC; int wave, vcu, G;
};
__device__ __forceinline__ float wave_sum_f(float v) {
#pragma unroll
    for (int o = 1; o < 64; o <<= 1) v += __shfl_xor(v, o);
    return v;
}
__device__ __forceinline__ void transpose_item(const float* W, int K, int N, bf16* WT, int k0, int n0, int rowbase, const float* gain, LAS float* scr, int lane) {
#pragma unroll 8
    for (int i = 0; i < 32; ++i) { const int kk = 2 * i + (lane >> 5); scr[kk * 33 + (lane & 31)] = W[(size_t)(k0 + kk) * N + n0 + (lane & 31)]; }
    LDS_WAIT(); asm volatile("" ::: "memory");
    const int c = lane & 7;
    f32x4 g0 = {1.f, 1.f, 1.f, 1.f}, g1 = g0;
    if (gain) { g0 = *(const f32x4*)(gain + k0 + 8 * c); g1 = *(const f32x4*)(gain + k0 + 8 * c + 4); }
#pragma unroll
    for (int j = 0; j < 4; ++j) { const int n = (lane >> 3) + 8 * j; const LAS float* s = scr + (8 * c) * 33 + n;
        v4u o; o.x = pk2(s[0 * 33] * g0[0], s[1 * 33] * g0[1]); o.y = pk2(s[2 * 33] * g0[2], s[3 * 33] * g0[3]); o.z = pk2(s[4 * 33] * g1[0], s[5 * 33] * g1[1]); o.w = pk2(s[6 * 33] * g1[2], s[7 * 33] * g1[3]);
        *(GAS v4u*)(WT + (size_t)(rowbase + n) * K + k0 + 8 * c) = o; }
    LDS_WAIT(); asm volatile("" ::: "memory");
}
__device__ __forceinline__ void conv_ffn(const Frame& F, const float* wg, const float* wu, const float* wd, const float* gain, unsigned char* ws) {
    using namespace cfg;
    { const GAS float *a = (const GAS float*)wg, *b = (const GAS float*)wu, *c = (const GAS float*)wd, *d = (const GAS float*)gain; asm volatile("" : "+s"(a), "+s"(b), "+s"(c), "+s"(d));
      wg = (const float*)a; wu = (const float*)b; wd = (const float*)c; gain = (const float*)d; }
    int lane = threadIdx.x; asm volatile("" : "+v"(lane)); lane &= 63;
    LAS float* scr = (LAS float*)(F.lds + RING_OFF + F.wave * 16384);
    const int gw = F.vcu * NWAVES + F.wave, NGW = F.G * NWAVES;
    constexpr int I_G = (DM / 64) * (DFF / 32), I_D = (DFF / 64) * (DM / 32);
    static_assert(I_G == I_D, "");
    for (int it = gw; it < 3 * I_G; it += NGW) {
        const int which = it / I_G, r = it - which * I_G;
        if (which < 2) { const int nblk = DFF / 32, kb = r / nblk, nb = r % nblk, n0 = 32 * nb;
            transpose_item(which ? wu : wg, DM, DFF, (bf16*)(ws + WS_WGU), 64 * kb, n0, 256 * (n0 >> 7) + 128 * which + (n0 & 127), gain, scr, lane); }
        else { const int nblk = DM / 32, kb = r / nblk, nb = r % nblk, n0 = 32 * nb;
            transpose_item(wd, DFF, DM, (bf16*)(ws + WS_WD), 64 * kb, n0, n0, nullptr, scr, lane); }
    }
}
__device__ __forceinline__ void conv_mix(const Frame& F, const float* win, const float* wout, const float* gain, unsigned char* ws) {
    using namespace cfg;
    { const GAS float *a = (const GAS float*)win, *b = (const GAS float*)wout, *d = (const GAS float*)gain; asm volatile("" : "+s"(a), "+s"(b), "+s"(d)); win = (const float*)a; wout = (const float*)b; gain = (const float*)d; }
    int lane = threadIdx.x; asm volatile("" : "+v"(lane)); lane &= 63;
    LAS float* scr = (LAS float*)(F.lds + RING_OFF + F.wave * 16384);
    const int gw = F.vcu * NWAVES + F.wave, NGW = F.G * NWAVES;
    constexpr int I_IN = (DM / 64) * (NIN / 32), I_O = (DM / 64) * (DM / 32);
    for (int it = gw; it < I_IN + I_O; it += NGW) {
        if (it < I_IN) { const int nblk = NIN / 32, kb = it / nblk, nb = it % nblk, n0 = 32 * nb;
            transpose_item(win, DM, NIN, (bf16*)(ws + WS_WIN), 64 * kb, n0, 256 * (n0 >> 8) + 128 * ((n0 & 63) >> 5) + 32 * ((n0 & 255) >> 6), gain, scr, lane); }
        else { const int r = it - I_IN, nblk = DM / 32, kb = r / nblk, nb = r % nblk, n0 = 32 * nb;
            transpose_item(wout, DM, DM, (bf16*)(ws + WS_WOUT), 64 * kb, n0, n0, nullptr, scr, lane); }
    }
}
template <bool FINAL>
__device__ __forceinline__ void row_phase(const Frame& F, const float* xp, const float* xs, float* out, const float* gain, bf16* R, unsigned long long* rss) {
    using namespace cfg;
    int lane = threadIdx.x; asm volatile("" : "+v"(lane)); lane &= 63;
    const int gw = F.vcu * NWAVES + F.wave, NGW = F.G * NWAVES;
    if constexpr (FINAL) {
        { const GAS float* a = (const GAS float*)gain; asm volatile("" : "+s"(a)); gain = (const float*)a; }
        f32x4 g[4][2];
#pragma unroll
        for (int k = 0; k < 4; ++k) { g[k][0] = ((const f32x4*)gain)[2 * (lane + 64 * k)]; g[k][1] = ((const f32x4*)gain)[2 * (lane + 64 * k) + 1]; }
        for (int m = gw; m < M; m += NGW) {
            const GAS v4u* xr = (const GAS v4u*)(R + (size_t)m * DM) + lane;
            v4u w[4]; f32x4 v[4][2]; float s = 0.f;
#pragma unroll
            for (int k = 0; k < 4; ++k) w[k] = xr[64 * k];
#pragma unroll
            for (int k = 0; k < 4; ++k) { v[k][0] = (f32x4){__uint_as_float(w[k].x << 16), __uint_as_float(w[k].x & 0xffff0000u), __uint_as_float(w[k].y << 16), __uint_as_float(w[k].y & 0xffff0000u)};
                v[k][1] = (f32x4){__uint_as_float(w[k].z << 16), __uint_as_float(w[k].z & 0xffff0000u), __uint_as_float(w[k].w << 16), __uint_as_float(w[k].w & 0xffff0000u)};
#pragma unroll
                for (int e = 0; e < 2; ++e) s += (v[k][e].x * v[k][e].x + v[k][e].y * v[k][e].y) + (v[k][e].z * v[k][e].z + v[k][e].w * v[k][e].w); }
            const float rinv = 1.0f / sqrtf(wave_sum_f(s) * (1.0f / DM) + EPS);
            GAS f32x4* o = (GAS f32x4*)(out + (size_t)m * DM);
#pragma unroll
            for (int k = 0; k < 4; ++k) { o[2 * (lane + 64 * k)] = v[k][0] * rinv * g[k][0]; o[2 * (lane + 64 * k) + 1] = v[k][1] * rinv * g[k][1]; }
        }
    } else {
        for (int m = gw; m < M; m += NGW) {
            const float* xrow = m < MP ? xp + (size_t)m * DM : xs + (size_t)(m - MP) * DM;
            const GAS f32x4* xr = (const GAS f32x4*)xrow + lane;
            f32x4 v[8]; float s = 0.f;
#pragma unroll
            for (int j = 0; j < 8; ++j) { v[j] = xr[64 * j]; s += (v[j].x * v[j].x + v[j].y * v[j].y) + (v[j].z * v[j].z + v[j].w * v[j].w); }
            const float ssum = wave_sum_f(s);
            GAS unsigned long long* o8 = (GAS unsigned long long*)(R + (size_t)m * DM) + lane;
#pragma unroll
            for (int j = 0; j < 8; ++j) o8[64 * j] = (unsigned long long)pk2(v[j].x, v[j].y) | ((unsigned long long)pk2(v[j].z, v[j].w) << 32);
            if (lane == 0) ((GAS unsigned long long*)rss)[m] = (unsigned long long)(ssum * 4294967296.0f);
        }
    }
}

struct Args { const float* in[20]; float* out; unsigned char* ws; int ph_lo, ph_hi, pad0, pad1; };
__global__ void __launch_bounds__(NWAVES * 64, 2) mk_fwd(Args args) {
    using namespace cfg;
    extern __shared__ __attribute__((aligned(16))) unsigned char lds[];
    Frame F;
    F.lds = (LAS unsigned char*)lds; F.MISC = (volatile LAS unsigned*)(F.lds + MISC_OFF);
    F.wave = __builtin_amdgcn_readfirstlane((int)threadIdx.x >> 6);
    F.G = gridDim.x; { const int bx = blockIdx.x; F.vcu = (F.G % 8 == 0) ? (bx % 8) * (F.G / 8) + bx / 8 : bx; }
    unsigned char* ws = args.ws; gu32* ctl = (gu32*)(ws + WS_CTL);
    const float* const p_xp = args.in[0]; const float* const p_xs = args.in[1]; const float* const p_f1n = args.in[2]; const float* const p_f1g = args.in[3]; const float* const p_f1u = args.in[4];
    const float* const p_f1d = args.in[5]; const float* const p_mixn = args.in[6]; const float* const p_win = args.in[7]; const float* const p_aqn = args.in[8]; const float* const p_akn = args.in[9];
    const float* const p_blam = args.in[10]; const float* const p_bsub = args.in[11]; const float* const p_crpb = args.in[12]; const float* const p_wout = args.in[13]; const float* const p_f2n = args.in[14];
    const float* const p_f2g = args.in[15]; const float* const p_f2u = args.in[16]; const float* const p_f2d = args.in[17]; const float* const p_t5 = args.in[18]; const float* const p_fin = args.in[19];
    float* out = args.out;
    bf16* RS = (bf16*)(ws + WS_R); bf16* ATB = (bf16*)(ws + WS_ATT); bf16* BIG = (bf16*)(ws + WS_BIG);
    for (int u = threadIdx.x; u < (LDS_BYTES - LDSCTL_OFF) / 4; u += NWAVES * 64) ((LAS unsigned*)(F.lds + LDSCTL_OFF))[u] = 0u;
    __syncthreads();
    XcdBarrier bar; bar.bar = (unsigned*)(ctl + CW_BAR); bar.x = 0; bar.st = nullptr;
    if (!MK_PER_PHASE) bar = xcd_barrier_post((unsigned*)(ctl + CW_BAR), F.MISC + 8);
    const int lo = args.ph_lo, hi = args.ph_hi;
    int ph = 0;
#define IN(k) (lo <= (k) && (k) < hi)
#define FRESH() GAS float* out_g = (GAS float*)out; GAS unsigned char* ws_g = (GAS unsigned char*)ws; GAS bf16* R_g = (GAS bf16*)RS; GAS bf16* BIG_g = (GAS bf16*)BIG; GAS bf16* AT_g = (GAS bf16*)ATB; const GAS float* xp_g = (const GAS float*)p_xp; const GAS float* xs_g = (const GAS float*)p_xs; \
    asm volatile("" : "+s"(out_g), "+s"(ws_g), "+s"(R_g), "+s"(BIG_g), "+s"(AT_g), "+s"(xp_g), "+s"(xs_g)); \
    float* out_ = (float*)out_g; unsigned char* ws_ = (unsigned char*)ws_g; bf16* R_ = (bf16*)R_g; bf16* BIG_ = (bf16*)BIG_g; bf16* ATB_ = (bf16*)AT_g; const float* xp_ = (const float*)xp_g; const float* xs_ = (const float*)xs_g; (void)ATB_; (void)BIG_; (void)R_; (void)xp_; (void)xs_; (void)out_
#define SEAM() do { if (IN(ph) && IN(ph + 1)) { if (MK_PER_PHASE) { if (threadIdx.x == 0) __hip_atomic_store(ctl, 0xBADBA0u, RLX_AGENT); } else xcd_barrier(bar); } ++ph; } while (0)

    for (int L = 0; L < 2; ++L) {
        unsigned long long* const rssA = (unsigned long long*)(ws + WS_RSS) + (size_t)(L == 0 ? 0 : 3) * M;
        unsigned long long* const rssB = (unsigned long long*)(ws + WS_RSS) + (size_t)(L == 0 ? 1 : 4) * M;
        unsigned long long* const rssC = (unsigned long long*)(ws + WS_RSS) + (size_t)(L == 0 ? 2 : 5) * M;
        if (IN(ph)) { FRESH();
            conv_ffn(F, p_f1g + (size_t)L * DM * DFF, p_f1u + (size_t)L * DM * DFF, p_f1d + (size_t)L * DM * DFF, p_f1n + L * DM, ws_);
            conv_mix(F, p_win + (size_t)L * DM * NIN, p_wout + (size_t)L * DM * DM, p_mixn + L * DM, ws_);
            if (L == 0) row_phase<false>(F, xp_, xs_, out_, nullptr, R_, rssA);
        }
        SEAM();
        if (IN(ph)) { FRESH();
            pg8::Gemm g{R_, (const bf16*)(ws_ + WS_WGU), M, NGU, DM}; pg8::StaticOrder S; S.init(M, NGU, F.G, (int)blockIdx.x, WGM_GU);
            pg8::EpiSwiglu E{BIG_, rssA};
#ifndef NO_GU
            pg8::gemm_phase<pg8::EpiSwiglu, pg8::StaticOrder, GEMM_ALIGN, GEMM_SP2>(F.lds + RING_OFF, g, S, E);
#endif
        }
        SEAM();
        if (IN(ph)) { FRESH();
            pg8::Gemm g{BIG_, (const bf16*)(ws_ + WS_WD), M, DM, DFF}; pg8::StaticOrder S; S.init(M, DM, F.G, (int)blockIdx.x, WGM_DN);
            pg8::EpiResid E{R_, 0.5f, rssB};
#ifndef NO_RES
            pg8::gemm_phase<pg8::EpiResid, pg8::StaticOrder, GEMM_ALIGN, GEMM_SP2>(F.lds + RING_OFF, g, S, E);
#endif
        }
        SEAM();
        if (IN(ph)) { FRESH();
            conv_ffn(F, p_f2g + (size_t)L * DM * DFF, p_f2u + (size_t)L * DM * DFF, p_f2d + (size_t)L * DM * DFF, p_f2n + L * DM, ws_);
            __syncthreads();
            pg8::Gemm g{R_, (const bf16*)(ws_ + WS_WIN), M, NIN, DM}; pg8::StaticOrder S; S.init(M, NIN, F.G, (int)blockIdx.x, WGM_GU);
            pg8::EpiWin E{BIG_, p_aqn + L * 64, p_akn + L * 64, rssB, (unsigned*)(ctl + CW_NRM + L * 336)};
#ifndef NO_WIN
            pg8::gemm_phase<pg8::EpiWin, pg8::StaticOrder, GEMM_ALIGN, GEMM_SP2>(F.lds + RING_OFF, g, S, E);
#endif
        }
        SEAM();
        if (IN(ph)) { FRESH(); bf16* const QKV_ = BIG_; bf16* const ATT_ = ATB_;
                att::Aux ax{p_t5, p_crpb + (size_t)L * 8 * 15 * 31, p_blam + L * 256, p_bsub + L * 128, (L == 0 ? 0.2f : 0.35550906759f)};
                const att::lptr al = (att::lptr)(F.lds + RING_OFF);
#ifdef ATT_PRIO
                if (F.wave >= 4) __builtin_amdgcn_s_setprio(1);
#endif
#ifndef PROBE_ATT_REP
#define PROBE_ATT_REP 1
#endif
                for (int rep_ = 0; rep_ < PROBE_ATT_REP; ++rep_) {
#ifndef REP_B
#define REP_B 1
#endif
#ifndef REP_A
#define REP_A 1
#endif
#ifndef REP_D
#define REP_D 1
#endif
#ifndef REP_C
#define REP_C 1
#endif
                float t5max = 0.f, rpbmax = 0.f;
                { int ln = threadIdx.x; asm volatile("" : "+v"(ln)); ln &= 63;
#pragma unroll
                  for (int k_ = 0; k_ < 6; ++k_) t5max = fmaxf(t5max, fabsf(p_t5[ln + 64 * k_]));
                  for (int k_ = 0; k_ < 59; ++k_) { const int ix = ln + 64 * k_; if (ix < 8 * 15 * 31) rpbmax = fmaxf(rpbmax, fabsf(ax.rpb[ix])); }
#pragma unroll
                  for (int o_ = 1; o_ < 64; o_ <<= 1) { t5max = fmaxf(t5max, __shfl_xor(t5max, o_)); rpbmax = fmaxf(rpbmax, __shfl_xor(rpbmax, o_)); } }
                t5max = __uint_as_float(__builtin_amdgcn_readfirstlane(__float_as_uint(t5max))); rpbmax = __uint_as_float(__builtin_amdgcn_readfirstlane(__float_as_uint(rpbmax)));
                const GAS unsigned* nrm2 = (const GAS unsigned*)(ctl + CW_NRM + L * 336);
#define SEQ_OF(r0_) ((r0_) < MP ? ((r0_) >> 14) : 2 + (((r0_) - MP) >> 13))
#define NRM(blk_, sq_) __uint_as_float(nrm2[(blk_) * 4 + (sq_)])
                for (int rb_ = 0; rb_ < REP_B; ++rb_)
                for (int u = F.vcu; u < 1536; u += F.G) {
#ifndef NO_ATT1
                    int r0, T, h, qb;
                    if (u < 1024) { r0 = (u >> 9) * TP; T = TP; h = (u >> 7) & 3; qb = u & 127; } else { const int v = u - 1024; r0 = MP + (v >> 8) * TS; T = TS; h = (v >> 6) & 3; qb = v & 63; }
                    const int sq = SEQ_OF(r0);
                    const float bnd = sqrtf(fmaxf(NRM(12 + 2 * h, sq), NRM(13 + 2 * h, sq)) * fmaxf(NRM(20 + 2 * h, sq), NRM(21 + 2 * h, sq))) * 1.01f + t5max * LOG2E;
                    if (__builtin_amdgcn_readfirstlane((int)(bnd <= 80.0f))) att::attn_unit<1, true>(QKV_, ATT_, al, r0, T, h, qb, ax); else att::attn_unit<1, false>(QKV_, ATT_, al, r0, T, h, qb, ax);
#endif
                }
                bool a_nomax;
                { int ln_ = threadIdx.x; asm volatile("" : "+v"(ln_)); ln_ &= 63; float gq = fabsf(p_aqn[L * 64 + ln_]), gk = fabsf(p_akn[L * 64 + ln_]);
#pragma unroll
                  for (int o_ = 1; o_ < 64; o_ <<= 1) { gq = fmaxf(gq, __shfl_xor(gq, o_)); gk = fmaxf(gk, __shfl_xor(gk, o_)); }
                  const float bound = 8.0f * LOG2E * gq * gk * 1.01f; a_nomax = __builtin_amdgcn_readfirstlane((int)(bound <= 80.0f)) != 0; }
                for (int ra_ = 0; ra_ < REP_A; ++ra_)
                for (int u = F.vcu; u < 1536; u += F.G) {
#ifndef NO_ATT0
                    int r0, T, h, qb;
                    if (u < 1024) { r0 = (u >> 9) * TP; T = TP; h = (u >> 6) & 7; qb = u & 63; } else { const int v = u - 1024; r0 = MP + (v >> 8) * TS; T = TS; h = (v >> 5) & 7; qb = v & 31; }
                    if (a_nomax) att::attn_unit<0, true>(QKV_, ATT_, al, r0, T, h, qb, ax); else att::attn_unit<0, false>(QKV_, ATT_, al, r0, T, h, qb, ax);
#endif
                }
                for (int rd_ = 0; rd_ < REP_D; ++rd_)
                for (int u = F.vcu; u < 1536; u += F.G) {
                    const int h = u / 192, qg = u % 192; int r0, T, qb;
                    if (qg < 128) { r0 = (qg >> 6) * TP; T = TP; qb = qg & 63; } else { r0 = MP + ((qg - 128) >> 5) * TS; T = TS; qb = (qg - 128) & 31; }
#ifndef NO_ATT3
                    { const int sq = SEQ_OF(r0); const float bnd = sqrtf(NRM(60 + h, sq) * NRM(68 + h, sq)) * 1.01f + t5max * LOG2E + 1.6f;
                      if (__builtin_amdgcn_readfirstlane((int)(bnd <= 80.0f))) att::attn_unit<3, true>(QKV_, ATT_, al, r0, T, h, qb, ax); else att::attn_unit<3, false>(QKV_, ATT_, al, r0, T, h, qb, ax); }
#endif
                }
                for (int rc_ = 0; rc_ < REP_C; ++rc_)
                for (int u = F.vcu; u < 1536; u += F.G) {
                    const int h = u / 192, qg = u % 192; int r0, T, qb;
                    if (qg < 128) { r0 = (qg >> 6) * TP; T = TP; qb = qg & 63; } else { r0 = MP + ((qg - 128) >> 5) * TS; T = TS; qb = (qg - 128) & 31; }
#ifndef NO_ATT2
                    { const int sq = SEQ_OF(r0); const float bnd = sqrtf(NRM(36 + h, sq) * NRM(44 + h, sq)) * 1.01f + rpbmax * LOG2E;
                      if (__builtin_amdgcn_readfirstlane((int)(bnd <= 80.0f))) att::attn_unit<2, true>(QKV_, ATT_, al, r0, T, h, qb, ax); else att::attn_unit<2, false>(QKV_, ATT_, al, r0, T, h, qb, ax); }
#endif
                }
                }
                    }
        SEAM();
        if (IN(ph)) { FRESH();
            pg8::Gemm g{ATB_, (const bf16*)(ws_ + WS_WOUT), M, DM, DM}; pg8::StaticOrder S; S.init(M, DM, F.G, (int)blockIdx.x, WGM_DN);
            pg8::EpiResid E{R_, 1.0f, rssC};
#ifndef NO_RES
            pg8::gemm_phase<pg8::EpiResid, pg8::StaticOrder, GEMM_ALIGN, GEMM_SP2>(F.lds + RING_OFF, g, S, E);
#endif
        }
        SEAM();
        if (IN(ph)) { FRESH();
            pg8::Gemm g{R_, (const bf16*)(ws_ + WS_WGU), M, NGU, DM}; pg8::StaticOrder S; S.init(M, NGU, F.G, (int)blockIdx.x, WGM_GU);
            pg8::EpiSwiglu E{BIG_, rssC};
#ifndef NO_GU
            pg8::gemm_phase<pg8::EpiSwiglu, pg8::StaticOrder, GEMM_ALIGN, GEMM_SP2>(F.lds + RING_OFF, g, S, E);
#endif
        }
        SEAM();
        if (IN(ph)) { FRESH();
            pg8::Gemm g{BIG_, (const bf16*)(ws_ + WS_WD), M, DM, DFF}; pg8::StaticOrder S; S.init(M, DM, F.G, (int)blockIdx.x, WGM_DN);
            pg8::EpiResid E{R_, 0.5f, L == 0 ? (unsigned long long*)(ws + WS_RSS) + (size_t)3 * M : (unsigned long long*)nullptr};
#ifndef NO_RES
            pg8::gemm_phase<pg8::EpiResid, pg8::StaticOrder, GEMM_ALIGN, GEMM_SP2>(F.lds + RING_OFF, g, S, E);
#endif
        }
        SEAM();
    }
    if (IN(ph)) { FRESH(); row_phase<true>(F, xp_, xs_, out_, p_fin, R_, nullptr); }
#undef IN
#undef SEAM
}
constexpr int N_PHASES = 17;

extern "C" void kernel_launch(void* const* d_in, const int* in_sizes, int n_in, void* d_out, int out_size, void* d_ws, size_t ws_size, hipStream_t stream) {
    static int grid = 0;
    if (grid == 0) {
        if (n_in != 20 || in_sizes[0] != cfg::MP * cfg::DM || in_sizes[1] != cfg::MS * cfg::DM || out_size != cfg::M * cfg::DM || ws_size < WS_END) {
            fprintf(stderr, "kernel_launch: shape mismatch (n_in %d, in0 %d, in1 %d, out %d, ws %zu need %zu); nothing launched\n", n_in, n_in > 0 ? in_sizes[0] : -1, n_in > 1 ? in_sizes[1] : -1, out_size, ws_size, (size_t)WS_END); grid = -1; return; }
        int dev = 0, cus = 0, per_cu = 0;
        if (hipGetDevice(&dev) != hipSuccess || hipDeviceGetAttribute(&cus, hipDeviceAttributeMultiprocessorCount, dev) != hipSuccess) { fprintf(stderr, "kernel_launch: device query failed\n"); grid = -1; return; }
        if (hipFuncSetAttribute((const void*)mk_fwd, hipFuncAttributeMaxDynamicSharedMemorySize, LDS_BYTES) != hipSuccess) { fprintf(stderr, "kernel_launch: hipFuncSetAttribute failed\n"); grid = -1; return; }
        if (hipOccupancyMaxActiveBlocksPerMultiprocessor(&per_cu, (const void*)mk_fwd, NWAVES * 64, LDS_BYTES) != hipSuccess || per_cu < 1) {
            fprintf(stderr, "kernel_launch: occupancy query reports %d workgroups per CU; nothing launched\n", per_cu); (void)hipGetLastError(); grid = -1; return; }
        (void)hipGetLastError();
        grid = cus;
    }
    if (grid < 0) return;
    if (hipMemsetAsync((char*)d_ws + WS_CTL, 0, CTL_ZERO_BYTES, stream) != hipSuccess || hipMemsetAsync((char*)d_ws + WS_RSS, 0, RSS_BYTES, stream) != hipSuccess) { fprintf(stderr, "kernel_launch: memset failed\n"); return; }
    Args a{};
    for (int i = 0; i < 20; ++i) a.in[i] = (const float*)d_in[i];
    a.out = (float*)d_out; a.ws = (unsigned char*)d_ws;
#if MK_PER_PHASE
    for (int p = 0; p < N_PHASES; ++p) { a.ph_lo = p; a.ph_hi = p + 1; hipLaunchKernelGGL(mk_fwd, dim3(grid), dim3(NWAVES * 64), LDS_BYTES, stream, a); }
#else
    a.ph_lo = 0; a.ph_hi = N_PHASES;
    hipLaunchKernelGGL(mk_fwd, dim3(grid), dim3(NWAVES * 64), LDS_BYTES, stream, a);
#endif
    const hipError_t le = hipPeekAtLastError();
    if (le != hipSuccess) fprintf(stderr, "kernel_launch: launch failed: %s\n", hipGetErrorName(le));
}
```

```cpp
#include <hip/hip_runtime.h>
#include <cstdio>
#include <cstdint>

#ifndef MK_PER_PHASE
#define MK_PER_PHASE 0
#endif

namespace cfg {
constexpr int DM = 2048, DFF = 5632, NIN = 5376, NGU = 2 * DFF;
constexpr int TP = 16384, TS = 8192, MP = 2 * TP, MS = 2 * TS, M = MP + MS;
constexpr float EPS = 1e-6f;
constexpr float LOG2E = 1.4426950408889634f;
constexpr float C2 = 0.125f * LOG2E;
}
namespace pg8 {
#define PG8_LAS __attribute__((address_space(3)))
typedef unsigned short bf16_t;
typedef short bf16x8 __attribute__((ext_vector_type(8)));
typedef float f32x4 __attribute__((ext_vector_type(4)));
typedef unsigned u32x4 __attribute__((ext_vector_type(4)));
constexpr int BM = 256, BK = 64, HALF = 128, HTB = HALF * BK * 2  , STAGE_BYTES = 8 * HTB, NXCD = 8, WGM = 8;

__host__ __device__ __forceinline__ int lds_byte(int r, int c) { const int st = (r >> 4) * 2 + (c >> 5), rr = r & 15, cc = c & 31, ob = rr * 64 + cc * 2; return st * 1024 + (ob ^ (((ob >> 9) & 1) << 5)); }
__host__ __device__ __forceinline__ void stage_rc(int b, int& R, int& C) { const int st = b / 1024, sb = b % 1024, swz = sb ^ (((sb >> 9) & 1) << 5); R = (st >> 1) * 16 + swz / 64; C = (st & 1) * 32 + (swz % 64) / 2; }
__host__ __device__ __forceinline__ int perm32(int rho) { const int n = rho >> 4, i = rho & 15; return 8 * (i >> 2) + 4 * n + (i & 3); }

struct Unit { int pm, pn; };
struct Gemm { const bf16_t* A; const bf16_t* Bt; int M, N, K; };

struct StaticOrder {
    int nM, nN, nwg, G, c, wgm;
    __host__ __device__ void init(int M, int N, int G_, int c_, int wgm_ = WGM) { nM = M / BM; nN = N / BM; nwg = nM * nN; G = G_; c = c_; wgm = wgm_; }
    __host__ __device__ bool next(int i, Unit& u) const {
        const long L = (long)i * G + c; if (L >= nwg) return false;
        int wgid = (int)L; { const int q = nwg / NXCD, r = nwg % NXCD, xcd = wgid % NXCD, off = wgid / NXCD; wgid = (xcd < r ? xcd * (q + 1) : r * (q + 1) + (xcd - r) * q) + off; }
        const int nig = wgm * nN, gid = wgid / nig, fm = gid * wgm, gsz = (nM - fm) < wgm ? (nM - fm) : wgm;
        u.pm = fm + ((wgid % nig) % gsz); u.pn = (wgid % nig) / gsz; return true;
    }
    __device__ __forceinline__ void a_ready(const Unit&) const {}
    __device__ __forceinline__ void done(const Unit&) const {}
};

__device__ __forceinline__ unsigned cvt_pk_bf16(float lo, float hi) { unsigned r; asm volatile("v_cvt_pk_bf16_f32 %0, %1, %2" : "=v"(r) : "v"(lo), "v"(hi)); return r; }
typedef float f32x2 __attribute__((ext_vector_type(2)));

struct EpiSwiglu {
    static constexpr bool PERM = true, AFTER_DRAIN = false, PROBE_TWICE = true;
    bf16_t* H; const unsigned long long* rss;
    __device__ __forceinline__ void operator()(const f32x4 (&acc)[2][2][4][2], const Unit& u, int wr, int wc, int fr, int fq) const {
        const int row0 = u.pm * BM + wr * 64 + fr, col0 = u.pn * 128 + wc * 32 + 8 * fq;
        float rv[2][4];
#pragma unroll
        for (int ai = 0; ai < 2; ++ai)
#pragma unroll
            for (int m = 0; m < 4; ++m) rv[ai][m] = (float)rss[row0 + ai * HALF + m * 16] * 2.3283064365386963e-10f;
#pragma unroll
        for (int ai = 0; ai < 2; ++ai)
#pragma unroll
            for (int m = 0; m < 4; ++m) {
                bf16_t* rowp = H + (unsigned)((row0 + ai * HALF + m * 16) * cfg::DFF + col0);
                const float rinv = __builtin_amdgcn_rsqf(rv[ai][m] * (1.0f / cfg::DM) + cfg::EPS);
                float hv[8];
#pragma unroll
                for (int n = 0; n < 2; ++n)
#pragma unroll
                    for (int j = 0; j < 4; ++j) {
                        const float g = acc[ai][0][m][n][j] * rinv, up = acc[ai][1][m][n][j] * rinv;
                        const float e = __builtin_amdgcn_exp2f(-g * cfg::LOG2E);
                        hv[n * 4 + j] = (g * up) * __builtin_amdgcn_rcpf(1.0f + e);
                    }
                u32x4 w; w.x = cvt_pk_bf16(hv[0], hv[1]); w.y = cvt_pk_bf16(hv[2], hv[3]); w.z = cvt_pk_bf16(hv[4], hv[5]); w.w = cvt_pk_bf16(hv[6], hv[7]);
                *(u32x4*)rowp = w;
                asm volatile("" ::: "memory");
            }
    }
};
__device__ __forceinline__ f32x4 bf16x4_lo(u32x4 w, int h) { f32x4 r; const unsigned a = h ? w.z : w.x, b = h ? w.w : w.y;
    r[0] = __uint_as_float(a << 16); r[1] = __uint_as_float(a & 0xffff0000u); r[2] = __uint_as_float(b << 16); r[3] = __uint_as_float(b & 0xffff0000u); return r; }
struct EpiResid {
    static constexpr bool PERM = true, AFTER_DRAIN = false, PROBE_TWICE = false;
    bf16_t* R; float alpha; unsigned long long* rssw;
    __device__ __forceinline__ void operator()(const f32x4 (&acc)[2][2][4][2], const Unit& u, int wr, int wc, int fr, int fq) const {
        bf16_t* rb = R + (size_t)u.pm * BM * cfg::DM;
        const unsigned off0 = (unsigned)(wr * 64 + fr) * cfg::DM + (unsigned)(u.pn * BM + wc * 32 + 8 * fq);
        float sel[2] = {0.f, 0.f};
        u32x4 vq[4][2];
#define RES_LOAD(S, it_) do { const unsigned o_ = off0 + (unsigned)(((it_) >> 2) * HALF + ((it_) & 3) * 16) * cfg::DM; \
        vq[S][0] = *(const u32x4*)(rb + o_); vq[S][1] = *(const u32x4*)(rb + o_ + HALF); } while (0)
#define RES_DO(S, it_) do { const int ai = (it_) >> 2, m = (it_) & 3; const unsigned off = off0 + (unsigned)(ai * HALF + m * 16) * cfg::DM; float ss = 0.f; \
        _Pragma("unroll") for (int bj = 0; bj < 2; ++bj) { const f32x4 o0 = bf16x4_lo(vq[S][bj], 0) + acc[ai][bj][m][0] * alpha, o1 = bf16x4_lo(vq[S][bj], 1) + acc[ai][bj][m][1] * alpha; \
            ss += (o0[0] * o0[0] + o0[1] * o0[1]) + (o0[2] * o0[2] + o0[3] * o0[3]) + (o1[0] * o1[0] + o1[1] * o1[1]) + (o1[2] * o1[2] + o1[3] * o1[3]); \
            u32x4 w; w.x = cvt_pk_bf16(o0[0], o0[1]); w.y = cvt_pk_bf16(o0[2], o0[3]); w.z = cvt_pk_bf16(o1[0], o1[1]); w.w = cvt_pk_bf16(o1[2], o1[3]); \
            *(u32x4*)(rb + off + bj * HALF) = w; } \
        if (rssw) { ss += __shfl_xor(ss, 16); ss += __shfl_xor(ss, 32); if (fq == m) sel[ai] = ss; } } while (0)
        RES_LOAD(0, 0); RES_LOAD(1, 1); RES_LOAD(2, 2);
        RES_LOAD(3, 3); RES_DO(0, 0); asm volatile("" ::: "memory");
        RES_LOAD(0, 4); RES_DO(1, 1); asm volatile("" ::: "memory");
        RES_LOAD(1, 5); RES_DO(2, 2); asm volatile("" ::: "memory");
        RES_LOAD(2, 6); RES_DO(3, 3); asm volatile("" ::: "memory");
        RES_LOAD(3, 7); RES_DO(0, 4); asm volatile("" ::: "memory");
        RES_DO(1, 5); asm volatile("" ::: "memory");
        RES_DO(2, 6); asm volatile("" ::: "memory");
        RES_DO(3, 7); asm volatile("" ::: "memory");
#undef RES_LOAD
#undef RES_DO
        if (rssw) {
#pragma unroll
            for (int ai = 0; ai < 2; ++ai) atomicAdd(rssw + u.pm * BM + wr * 64 + ai * HALF + fq * 16 + fr, (unsigned long long)(sel[ai] * 4294967296.0f));
        }
    }
};
struct EpiWin {
    static constexpr bool PERM = true, AFTER_DRAIN = false, PROBE_TWICE = false;
    bf16_t* QKV; const float* gq; const float* gk; const unsigned long long* rss; unsigned* nrm2;
    __device__ __forceinline__ void operator()(const f32x4 (&acc)[2][2][4][2], const Unit& u, int wr, int wc, int fr, int fq) const {
        const int pn = u.pn;
        int kind = 0; float sc = 1.f;
        if (pn < 2) { kind = 1; sc = cfg::C2; }
        else if (pn == 2) { kind = (wc < 2) ? 2 : 0; }
        else if (pn == 3 || pn == 4 || pn == 9 || pn == 10 || pn == 15 || pn == 16) sc = cfg::C2;
        const int row0 = u.pm * BM + wr * 64 + fr;
        const int colb = pn * 256 + wc * 64 + 8 * fq;
        float rv[2][4];
#pragma unroll
        for (int ai = 0; ai < 2; ++ai)
#pragma unroll
            for (int m = 0; m < 4; ++m) rv[ai][m] = (float)rss[row0 + ai * HALF + m * 16] * 2.3283064365386963e-10f;
        if (kind == 0) {
            const bool want = (pn >= 3 && pn <= 6) || (pn >= 9 && pn <= 12) || (pn >= 15 && pn <= 18);
            float nmax = 0.f;
#pragma unroll
            for (int ai = 0; ai < 2; ++ai)
#pragma unroll
                for (int m = 0; m < 4; ++m) {
                    bf16_t* rowp = QKV + (unsigned)((row0 + ai * HALF + m * 16) * cfg::NIN + colb);
                    const float rs_ = __builtin_amdgcn_rsqf(rv[ai][m] * (1.0f / cfg::DM) + cfg::EPS) * sc;
                    float ss = 0.f;
#pragma unroll
                    for (int bj = 0; bj < 2; ++bj) { const f32x4 v0 = acc[ai][bj][m][0] * rs_, v1 = acc[ai][bj][m][1] * rs_;
                        ss += (v0[0] * v0[0] + v0[1] * v0[1]) + (v0[2] * v0[2] + v0[3] * v0[3]) + (v1[0] * v1[0] + v1[1] * v1[1]) + (v1[2] * v1[2] + v1[3] * v1[3]);
                        u32x4 w; w.x = cvt_pk_bf16(v0[0], v0[1]); w.y = cvt_pk_bf16(v0[2], v0[3]); w.z = cvt_pk_bf16(v1[0], v1[1]); w.w = cvt_pk_bf16(v1[2], v1[3]);
                        *(u32x4*)(rowp + 32 * bj) = w; }
                    if (want) { ss += __shfl_xor(ss, 16); ss += __shfl_xor(ss, 32); nmax = fmaxf(nmax, ss); }
                    asm volatile("" ::: "memory");
                }
            if (want) {
                float t = nmax;
                t = fmaxf(t, __shfl_xor(t, 1)); t = fmaxf(t, __shfl_xor(t, 2)); t = fmaxf(t, __shfl_xor(t, 4)); t = fmaxf(t, __shfl_xor(t, 8));
                const int rowt = u.pm * BM; const int seq = rowt < cfg::MP ? (rowt >> 14) : 2 + ((rowt - cfg::MP) >> 13);
                if ((fr | fq) == 0) atomicMax(nrm2 + (4 * pn + wc) * 4 + seq, __float_as_uint(t));
            }
        } else {
            const float* g = (kind == 1) ? gq : gk;
            float invrev[2][2];
#pragma unroll
            for (int n = 0; n < 2; ++n)
#pragma unroll
                for (int jj = 0; jj < 2; ++jj) invrev[n][jj] = __builtin_amdgcn_exp2f(-(float)(4 * fq + 2 * n + jj) * (13.287712379549449f / 16.0f)) * 0.15915494309189535f;
#pragma unroll
            for (int ai = 0; ai < 2; ++ai)
#pragma unroll
                for (int m = 0; m < 4; ++m) {
                    const int row = row0 + ai * HALF + m * 16;
                    const int t = (row < cfg::MP) ? (row & (cfg::TP - 1)) : (row & (cfg::TS - 1));
                    float prow = (float)(t >> 6), pcol = (float)(row & 63);
                    asm volatile("" : "+v"(prow), "+v"(pcol) :: "memory");
                    float ss = 0.f;
#pragma unroll
                    for (int bj = 0; bj < 2; ++bj)
#pragma unroll
                        for (int n = 0; n < 2; ++n) { const f32x4 v = acc[ai][bj][m][n]; ss += (v[0] * v[0] + v[1] * v[1]) + (v[2] * v[2] + v[3] * v[3]); }
                    ss += __shfl_xor(ss, 16); ss += __shfl_xor(ss, 32);
                    const float rw = __builtin_amdgcn_rsqf(rv[ai][m] * (1.0f / cfg::DM) + cfg::EPS);
                    const float rinv = rw * __builtin_amdgcn_rsqf(ss * rw * rw * (1.0f / 64.0f) + cfg::EPS);
                    bf16_t* rowp = QKV + (unsigned)(row * cfg::NIN + colb);
#pragma unroll
                    for (int bj = 0; bj < 2; ++bj) {
                        const float pos = bj ? pcol : prow;
                        float o[8];
#pragma unroll
                        for (int n = 0; n < 2; ++n) {
                            const f32x4 y = acc[ai][bj][m][n] * rinv * *(const f32x4*)(g + 32 * bj + 8 * fq + 4 * n);
#pragma unroll
                            for (int jj = 0; jj < 2; ++jj) {
                                const float rev = __builtin_amdgcn_fractf(pos * invrev[n][jj]);
                                const float sn = __builtin_amdgcn_sinf(rev), cs = __builtin_amdgcn_cosf(rev);
                                const float x1 = y[2 * jj], x2 = y[2 * jj + 1];
                                o[4 * n + 2 * jj] = (x1 * cs - x2 * sn) * sc; o[4 * n + 2 * jj + 1] = (x1 * sn + x2 * cs) * sc;
                            }
                        }
                        u32x4 w; w.x = cvt_pk_bf16(o[0], o[1]); w.y = cvt_pk_bf16(o[2], o[3]); w.z = cvt_pk_bf16(o[4], o[5]); w.w = cvt_pk_bf16(o[6], o[7]);
                        *(u32x4*)(rowp + 32 * bj) = w;
                        asm volatile("" ::: "memory");
                    }
                }
        }
    }
};

template <class Epi, class Sched, bool ALIGN_EPI = false, bool SP2 = false>
__device__ __forceinline__ void gemm_phase(PG8_LAS unsigned char* lds, const Gemm g, const Sched& S, const Epi& E) {
    int tid_ = threadIdx.x; asm volatile("" : "+v"(tid_));
    const int tid = tid_, wid = __builtin_amdgcn_readfirstlane(tid >> 6), lane = tid & 63, wr = wid >> 2, wc = wid & 3, fr = lane & 15, fq = lane >> 4;
    const int K = g.K, nt = K / BK;
    unsigned voffA[2], voffB[2];
#pragma unroll
    for (int i = 0; i < 2; ++i) { int R, C; stage_rc(tid * 16 + i * 8192, R, C); const int Rb = Epi::PERM ? ((R & ~31) + perm32(R & 31)) : R;
        voffA[i] = (unsigned)(R * K + C) * 2u; voffB[i] = (unsigned)(Rb * K + C) * 2u; }
    const size_t kstep = (size_t)(BK * 2);
    const size_t hstep = (size_t)HALF * K * 2;
    const size_t tstep = 2 * hstep;
    const unsigned ldsw = (unsigned)wid * 1024u;
    const int aoff = lds_byte(wr * 64 + fr, fq * 8), boff = lds_byte(wc * 32 + fr, fq * 8);
#define PG8_SA(b, h) (((b) * 2 + (h)) * HTB)
#define PG8_SB(b, h) ((4 + (b) * 2 + (h)) * HTB)
#define PG8_STAGE(bufoff, gbase, voff) do { _Pragma("unroll") for (int _i = 0; _i < 2; ++_i) \
        __builtin_amdgcn_global_load_lds((const unsigned*)((const char*)(gbase) + (voff)[_i]), (PG8_LAS unsigned*)(lds + (bufoff) + ldsw + _i * 8192), 16, 0, 0); } while (0)
#define PG8_LDA(dst, b, h) do { _Pragma("unroll") for (int m = 0; m < 4; ++m) _Pragma("unroll") for (int k = 0; k < 2; ++k) dst[m][k] = *(const PG8_LAS bf16x8*)(lds + PG8_SA(b, h) + aoff + m * 2048 + k * 1024); } while (0)
#define PG8_LDB(dst, b, h) do { _Pragma("unroll") for (int n = 0; n < 2; ++n) _Pragma("unroll") for (int k = 0; k < 2; ++k) dst[n][k] = *(const PG8_LAS bf16x8*)(lds + PG8_SB(b, h) + boff + n * 2048 + k * 1024); } while (0)
#define PG8_MMA(ai, bj, At, Bt) do { __builtin_amdgcn_s_setprio(1); _Pragma("unroll") for (int m = 0; m < 4; ++m) _Pragma("unroll") for (int n = 0; n < 2; ++n) _Pragma("unroll") for (int k = 0; k < 2; ++k) \
        acc[ai][bj][m][n] = __builtin_amdgcn_mfma_f32_16x16x32_bf16(Bt[n][k], At[m][k], acc[ai][bj][m][n], 0, 0, 0); __builtin_amdgcn_s_setprio(0); } while (0)
#define PG8_WAIT_V(n) asm volatile("s_waitcnt vmcnt(" #n ")" ::: "memory")
#define PG8_WAIT_L(n) asm volatile("s_waitcnt lgkmcnt(" #n ")" ::: "memory")
#define PG8_BAR __builtin_amdgcn_s_barrier()
#define PG8_SCHED __builtin_amdgcn_sched_barrier(0)
    Unit cur, nxt; int ui = 0;
    if (!S.next(0, cur)) return;
    f32x4 acc[2][2][4][2];
#pragma unroll
    for (int a = 0; a < 2; ++a)
#pragma unroll
        for (int b = 0; b < 2; ++b)
#pragma unroll
            for (int m = 0; m < 4; ++m)
#pragma unroll
                for (int n = 0; n < 2; ++n) acc[a][b][m][n] = (f32x4){0.f, 0.f, 0.f, 0.f};
    bf16x8 At[4][2], B0[2][2], B1[2][2];
    const char* cA = (const char*)g.A + (size_t)cur.pm * tstep; const char* cB = (const char*)g.Bt + (size_t)cur.pn * tstep;
    S.a_ready(cur);
    if constexpr (SP2) {
        PG8_STAGE(PG8_SB(0, 0), cB, voffB); PG8_STAGE(PG8_SB(0, 1), cB + hstep, voffB); PG8_STAGE(PG8_SA(0, 0), cA, voffA); PG8_STAGE(PG8_SA(0, 1), cA + hstep, voffA);
        if (wr == 1) PG8_BAR;
        PG8_WAIT_V(2); PG8_BAR;
        PG8_STAGE(PG8_SB(1, 0), cB + kstep, voffB); PG8_STAGE(PG8_SA(1, 0), cA + kstep, voffA); PG8_STAGE(PG8_SB(1, 1), cB + hstep + kstep, voffB);
        PG8_WAIT_V(6); PG8_BAR;
    } else {
        PG8_STAGE(PG8_SB(0, 0), cB, voffB); PG8_STAGE(PG8_SA(0, 0), cA, voffA); PG8_STAGE(PG8_SB(0, 1), cB + hstep, voffB); PG8_STAGE(PG8_SA(0, 1), cA + hstep, voffA);
        if (wr == 1) PG8_BAR;
        PG8_WAIT_V(4); PG8_BAR;
        PG8_STAGE(PG8_SB(1, 0), cB + kstep, voffB); PG8_STAGE(PG8_SA(1, 0), cA + kstep, voffA); PG8_STAGE(PG8_SB(1, 1), cB + hstep + kstep, voffB);
        PG8_WAIT_V(6); PG8_BAR;
    }
    for (;;) {
        const bool has_next = S.next(ui + 1, nxt);
        const char* nA = has_next ? (const char*)g.A + (size_t)nxt.pm * tstep : cA; const char* nB = has_next ? (const char*)g.Bt + (size_t)nxt.pn * tstep : cB;
        for (int t = 0; t < nt; t += 2) {
            const bool last = (t == nt - 2);
            const char* a1 = cA + (size_t)(t + 1) * kstep;
            const char* a2 = last ? nA : cA + (size_t)(t + 2) * kstep; const char* b2 = last ? nB : cB + (size_t)(t + 2) * kstep;
            const char* a3 = a2 + kstep; const char* b3 = b2 + kstep;
            if (last && has_next) S.a_ready(nxt);
            if constexpr (SP2) {
            PG8_LDB(B0, 0, 0); PG8_LDB(B1, 0, 1); PG8_SCHED; PG8_LDA(At, 0, 0); PG8_STAGE(PG8_SA(1, 1), a1 + hstep, voffA);
            PG8_WAIT_V(8); PG8_WAIT_L(0); PG8_BAR; PG8_MMA(0, 0, At, B0); PG8_MMA(0, 1, At, B1); PG8_BAR; PG8_SCHED;
            PG8_LDA(At, 0, 1); PG8_STAGE(PG8_SB(0, 0), b2, voffB); PG8_STAGE(PG8_SB(0, 1), b2 + hstep, voffB); PG8_STAGE(PG8_SA(0, 0), a2, voffA);
            PG8_WAIT_V(8); PG8_WAIT_L(0); PG8_BAR; PG8_MMA(1, 0, At, B0); PG8_MMA(1, 1, At, B1); PG8_BAR; PG8_SCHED;
            PG8_LDB(B0, 1, 0); PG8_LDB(B1, 1, 1); PG8_SCHED; PG8_LDA(At, 1, 0); PG8_STAGE(PG8_SA(0, 1), a2 + hstep, voffA);
            PG8_WAIT_V(8); PG8_WAIT_L(0); PG8_BAR; PG8_MMA(0, 0, At, B0); PG8_MMA(0, 1, At, B1); PG8_BAR; PG8_SCHED;
            PG8_LDA(At, 1, 1); PG8_STAGE(PG8_SB(1, 0), b3, voffB); PG8_STAGE(PG8_SB(1, 1), b3 + hstep, voffB); PG8_STAGE(PG8_SA(1, 0), a3, voffA);
            PG8_WAIT_V(8); PG8_WAIT_L(0); PG8_BAR; PG8_MMA(1, 0, At, B0); PG8_MMA(1, 1, At, B1); PG8_BAR; PG8_SCHED;
            } else {
            PG8_LDB(B0, 0, 0); PG8_SCHED; PG8_LDA(At, 0, 0); PG8_STAGE(PG8_SA(1, 1), a1 + hstep, voffA);
            PG8_WAIT_L(8); PG8_BAR; PG8_WAIT_L(0); PG8_MMA(0, 0, At, B0); PG8_BAR; PG8_SCHED;
            PG8_LDB(B1, 0, 1); PG8_STAGE(PG8_SB(0, 0), b2, voffB);
            PG8_BAR; PG8_WAIT_L(0); PG8_MMA(0, 1, At, B1); PG8_BAR;
            PG8_LDA(At, 0, 1); PG8_STAGE(PG8_SA(0, 0), a2, voffA);
            PG8_BAR; PG8_WAIT_L(0); PG8_MMA(1, 0, At, B0); PG8_BAR; PG8_SCHED;
            PG8_STAGE(PG8_SB(0, 1), b2 + hstep, voffB);
            PG8_WAIT_V(6); PG8_BAR; PG8_MMA(1, 1, At, B1); PG8_BAR;
            PG8_LDB(B0, 1, 0); PG8_SCHED; PG8_LDA(At, 1, 0); PG8_STAGE(PG8_SA(0, 1), a2 + hstep, voffA);
            PG8_WAIT_L(8); PG8_BAR; PG8_WAIT_L(0); PG8_MMA(0, 0, At, B0); PG8_BAR; PG8_SCHED;
            PG8_LDB(B1, 1, 1); PG8_STAGE(PG8_SB(1, 0), b3, voffB);
            PG8_BAR; PG8_WAIT_L(0); PG8_MMA(0, 1, At, B1); PG8_BAR;
            PG8_LDA(At, 1, 1); PG8_STAGE(PG8_SA(1, 0), a3, voffA);
            PG8_BAR; PG8_WAIT_L(0); PG8_MMA(1, 0, At, B0); PG8_BAR; PG8_SCHED;
            PG8_STAGE(PG8_SB(1, 1), b3 + hstep, voffB);
            PG8_WAIT_V(6); PG8_BAR; PG8_MMA(1, 1, At, B1); PG8_BAR;
            }
        }
        if constexpr (ALIGN_EPI) { if (wr == 0) PG8_BAR; }
        if constexpr (!Epi::AFTER_DRAIN) { E(acc, cur, wr, wc, fr, fq);
#if defined(PROBE_EPI2)
            if constexpr (Epi::PROBE_TWICE) { asm volatile("" ::: "memory"); E(acc, cur, wr, wc, fr, fq); }
#endif
            S.done(cur); }
        if (!has_next) break;
#pragma unroll
        for (int a = 0; a < 2; ++a)
#pragma unroll
            for (int b = 0; b < 2; ++b)
#pragma unroll
                for (int m = 0; m < 4; ++m)
#pragma unroll
                    for (int n = 0; n < 2; ++n) acc[a][b][m][n] = (f32x4){0.f, 0.f, 0.f, 0.f};
        cur = nxt; cA = nA; cB = nB; ++ui;
        if constexpr (ALIGN_EPI) { if (wr == 1) PG8_BAR; }
    }
    PG8_WAIT_V(0);
    if constexpr (!ALIGN_EPI) { if (wr == 0) PG8_BAR; }
    PG8_BAR;
    if constexpr (Epi::AFTER_DRAIN) { E.fused(acc, cur, wr, wc, fr, fq, lds, wid, lane); S.done(cur); }
#undef PG8_SA
#undef PG8_SB
#undef PG8_STAGE
#undef PG8_LDA
#undef PG8_LDB
#undef PG8_MMA
#undef PG8_WAIT_V
#undef PG8_WAIT_L
#undef PG8_BAR
#undef PG8_SCHED
}
}
namespace att {
#define ATT_LAS __attribute__((address_space(3)))
using bf16x8 = __attribute__((ext_vector_type(8))) short;
using s16x4  = __attribute__((ext_vector_type(4))) short;
using f32x16 = __attribute__((ext_vector_type(16))) float;
using u32x4  = __attribute__((ext_vector_type(4))) unsigned;
typedef unsigned short bf16_t;
typedef ATT_LAS char* lptr;
constexpr int PITCH = cfg::NIN, OPITCH = cfg::DM;
constexpr float LOG2E = cfg::LOG2E, NEG = -1e30f, THR = 8.f;
#ifndef ATT_RING_B
#define ATT_RING_B 1
#endif
template <bool RING> struct Map { static constexpr int L_K = 0, L_V = RING ? 49152 : 32768, L_WS = RING ? 98304 : 65536, L_LUT = RING ? 100352 : 67584, L_OST = RING ? 65536 : 81920, L_END = RING ? 112640 : 114688; };
constexpr int L_END = 114688;
constexpr int LUTB_R = 704, LUTD_R = 1344;
#define ATT_SBAR() __builtin_amdgcn_sched_barrier(0)
__device__ __forceinline__ int crow(int r, int hi) { return (r & 3) + 8 * (r >> 2) + 4 * hi; }
__device__ __forceinline__ unsigned cvtpk(float lo, float hi) { unsigned r; asm volatile("v_cvt_pk_bf16_f32 %0, %1, %2" : "=v"(r) : "v"(lo), "v"(hi)); return r; }
__device__ __forceinline__ float wave_sum(float v) {
#pragma unroll
    for (int o = 1; o < 64; o <<= 1) v += __shfl_xor(v, o);
    return v;
}
__device__ __forceinline__ int t5_bucket(int rel) {
    const int n = rel < 0 ? -rel : rel;
    int b = n;
    if (n >= 8) b = 8 + (n >= 15) + (n >= 27) + (n >= 50) + (n >= 91) + (n >= 166) + (n >= 305) + (n >= 559);
    return b + (rel > 0 ? 16 : 0);
}
template <int KC> __device__ __forceinline__ int kswz(int row, int colB) { return KC == 128 ? row * 256 + (colB ^ ((row & 7) << 4)) : row * 128 + (colB ^ (((row >> 1) & 7) << 4)); }
template <int NCB> __device__ __forceinline__ int v_st(int k, int c) { const int kk = k; return ((kk >> 3) * NCB + (c >> 5)) * 512 + ((kk & 7) * 32 + (c & 31)) * 2; }
__device__ __forceinline__ int v_rd_base(int lane) { return ((lane & 3) << 3) | (((lane >> 2) & 3) << 6) | (((lane >> 4) & 1) << 5) | (((lane >> 5) & 1) << 8); }
template <int OFF> __device__ __forceinline__ s16x4 tr_read(int vb) { s16x4 r; asm volatile("ds_read_b64_tr_b16 %0, %1 offset:%2" : "=&v"(r) : "v"(vb), "i"(OFF) : "memory"); return r; }
template <int NCB, int D0> __device__ __forceinline__ void pv_one(f32x16& od, int vb, bf16x8 pa0, bf16x8 pa1, bf16x8 pa2, bf16x8 pa3) {
#define ATT_VOFF(ks, half) (D0 * 512 + (ks) * (NCB * 1024) + (half) * (NCB * 512))
    const s16x4 l0 = tr_read<ATT_VOFF(0, 0)>(vb), h0 = tr_read<ATT_VOFF(0, 1)>(vb), l1 = tr_read<ATT_VOFF(1, 0)>(vb), h1 = tr_read<ATT_VOFF(1, 1)>(vb);
    const s16x4 l2 = tr_read<ATT_VOFF(2, 0)>(vb), h2 = tr_read<ATT_VOFF(2, 1)>(vb), l3 = tr_read<ATT_VOFF(3, 0)>(vb), h3 = tr_read<ATT_VOFF(3, 1)>(vb);
#undef ATT_VOFF
    asm volatile("s_waitcnt lgkmcnt(0)" ::: "memory"); ATT_SBAR();
#define ATT_PK(L, H) (bf16x8){L[0], L[1], L[2], L[3], H[0], H[1], H[2], H[3]}
    od = __builtin_amdgcn_mfma_f32_32x32x16_bf16(pa0, ATT_PK(l0, h0), od, 0, 0, 0);
    od = __builtin_amdgcn_mfma_f32_32x32x16_bf16(pa1, ATT_PK(l1, h1), od, 0, 0, 0);
    od = __builtin_amdgcn_mfma_f32_32x32x16_bf16(pa2, ATT_PK(l2, h2), od, 0, 0, 0);
    od = __builtin_amdgcn_mfma_f32_32x32x16_bf16(pa3, ATT_PK(l3, h3), od, 0, 0, 0);
#undef ATT_PK
}
template <int NCB, bool ONES> __device__ __forceinline__ void pv_all(f32x16* o, f32x16& lacc, int vb, bf16x8 pa0, bf16x8 pa1, bf16x8 pa2, bf16x8 pa3) {
    if constexpr (ONES) { const bf16x8 ones = {0x3F80, 0x3F80, 0x3F80, 0x3F80, 0x3F80, 0x3F80, 0x3F80, 0x3F80};
        lacc = __builtin_amdgcn_mfma_f32_32x32x16_bf16(pa0, ones, lacc, 0, 0, 0); lacc = __builtin_amdgcn_mfma_f32_32x32x16_bf16(pa1, ones, lacc, 0, 0, 0);
        lacc = __builtin_amdgcn_mfma_f32_32x32x16_bf16(pa2, ones, lacc, 0, 0, 0); lacc = __builtin_amdgcn_mfma_f32_32x32x16_bf16(pa3, ones, lacc, 0, 0, 0); }
    pv_one<NCB, 0>(o[0], vb, pa0, pa1, pa2, pa3); pv_one<NCB, 1>(o[1], vb, pa0, pa1, pa2, pa3);
    if constexpr (NCB == 4) { pv_one<NCB, 2>(o[2], vb, pa0, pa1, pa2, pa3); pv_one<NCB, 3>(o[3], vb, pa0, pa1, pa2, pa3); }
}
template <bool NOMAX> __device__ __forceinline__ void partialSM(f32x16& p0, f32x16& p1, float cb, float& m_reg, float& alpha) {
    if constexpr (NOMAX) { alpha = 1.f;
        (void)cb;
#pragma unroll
        for (int r = 0; r < 16; ++r) p0[r] = __builtin_amdgcn_exp2f(p0[r]);
        return; }
    float ma = fmaxf(p0[0], p0[1]), mb = fmaxf(p0[2], p0[3]), mc = fmaxf(p1[0], p1[1]), md = fmaxf(p1[2], p1[3]);
#pragma unroll
    for (int r = 4; r < 16; r += 4) { ma = fmaxf(fmaxf(ma, p0[r]), p0[r + 1]); mb = fmaxf(fmaxf(mb, p0[r + 2]), p0[r + 3]); mc = fmaxf(fmaxf(mc, p1[r]), p1[r + 1]); md = fmaxf(fmaxf(md, p1[r + 2]), p1[r + 3]); }
    float pmax = fmaxf(fmaxf(ma, mb), fmaxf(mc, md));
    { auto rr = __builtin_amdgcn_permlane32_swap(__float_as_uint(pmax), __float_as_uint(pmax), false, false); pmax = fmaxf(__uint_as_float(rr[0]), __uint_as_float(rr[1])); }
    pmax += cb;
    float mn;
    if (__builtin_expect(__all(pmax - m_reg <= THR), 1)) { mn = m_reg; alpha = 1.f; }
    else { mn = fmaxf(m_reg, pmax); alpha = __builtin_amdgcn_exp2f(m_reg - mn); m_reg = mn; }
    const float sub = cb - mn;
#pragma unroll
    for (int r = 0; r < 16; ++r) p0[r] += sub;
#pragma unroll
    for (int r = 0; r < 16; ++r) p1[r] += sub;
#pragma unroll
    for (int r = 0; r < 16; ++r) p0[r] = __builtin_amdgcn_exp2f(p0[r]);
}
template <bool ONES> __device__ __forceinline__ void finishSM(f32x16& p0, f32x16& p1, float alpha, float& l_reg, bf16x8& pa0, bf16x8& pa1, bf16x8& pa2, bf16x8& pa3) {
#pragma unroll
    for (int r = 0; r < 16; ++r) p1[r] = __builtin_amdgcn_exp2f(p1[r]);
    if constexpr (!ONES) {
    float sa = p0[0] + p0[1], sb = p0[2] + p0[3], sc_ = p1[0] + p1[1], sd = p1[2] + p1[3];
#pragma unroll
    for (int r = 4; r < 16; r += 4) { sa += p0[r]; sa += p0[r + 1]; sb += p0[r + 2]; sb += p0[r + 3]; sc_ += p1[r]; sc_ += p1[r + 1]; sd += p1[r + 2]; sd += p1[r + 3]; }
    float ps = (sa + sb) + (sc_ + sd);
    { auto rr = __builtin_amdgcn_permlane32_swap(__float_as_uint(ps), __float_as_uint(ps), false, false); ps = __uint_as_float(rr[0]) + __uint_as_float(rr[1]); }
    l_reg = l_reg * alpha + ps;
    }
#define ATT_PK4(P, BASE, OUT) do { unsigned a0 = cvtpk(P[BASE + 0], P[BASE + 1]), a1 = cvtpk(P[BASE + 2], P[BASE + 3]);   \
    unsigned b0 = cvtpk(P[BASE + 4], P[BASE + 5]), b1 = cvtpk(P[BASE + 6], P[BASE + 7]);                              \
    u32x4 w = {a0, a1, b0, b1}; OUT = __builtin_bit_cast(bf16x8, w); } while (0)
    ATT_PK4(p0, 0, pa0); ATT_PK4(p0, 8, pa1); ATT_PK4(p1, 0, pa2); ATT_PK4(p1, 8, pa3);
#undef ATT_PK4
}
template <int KC, bool USEC> __device__ __forceinline__ void qkt(f32x16& p0, f32x16& p1, lptr Ks, int cb0, const bf16x8* qr, const f32x16& c0, int r32, int hi) {
    if constexpr (!USEC) { p0 = f32x16{}; p1 = f32x16{}; }
#pragma unroll
    for (int d0 = 0; d0 < 4; ++d0) { const int cb = cb0 + d0 * 32 + hi * 16;
        const bf16x8 b0 = *(const ATT_LAS bf16x8*)(Ks + kswz<KC>(r32, cb));
        const bf16x8 b1 = *(const ATT_LAS bf16x8*)(Ks + kswz<KC>(32 + r32, cb));
        if (USEC && d0 == 0) { p0 = __builtin_amdgcn_mfma_f32_32x32x16_bf16(b0, qr[0], c0, 0, 0, 0); p1 = __builtin_amdgcn_mfma_f32_32x32x16_bf16(b1, qr[0], c0, 0, 0, 0); }
        else { p0 = __builtin_amdgcn_mfma_f32_32x32x16_bf16(b0, qr[d0], p0, 0, 0, 0); p1 = __builtin_amdgcn_mfma_f32_32x32x16_bf16(b1, qr[d0], p1, 0, 0, 0); } }
}
struct Aux { const float* t5; const float* rpb; const float* lam_p; const float* subln; float lam_init; };

template <int MODE, bool NOMAX = false>
__device__ __forceinline__ void attn_unit(const bf16_t* __restrict__ QKV, bf16_t* __restrict__ ATT, lptr lds, int row0, int T, int h, int qb, const Aux& ax) {
#ifndef ATT_ONES
#define ATT_ONES 1
#endif
    constexpr bool ONES = (ATT_ONES != 0) && (MODE != 1);
    constexpr bool RING = (MODE == 1) && (ATT_RING_B != 0);
    constexpr int L_K = Map<RING>::L_K, L_V = Map<RING>::L_V, L_WS = Map<RING>::L_WS, L_LUT = Map<RING>::L_LUT, L_OST = Map<RING>::L_OST;
    constexpr int KC = (MODE == 1) ? 128 : 64, DV = (MODE == 1) ? 128 : 64, NCB = DV / 32, NR = KC / 64;
    constexpr int KBYTES = 64 * KC * 2, VBYTES = 64 * DV * 2, QROWS = (MODE == 1) ? 128 : 256;
    int tid_ = threadIdx.x; asm volatile("" : "+v"(tid_));
    const int tid = tid_, lane = tid & 63, r32 = lane & 31, hi = lane >> 5;
    const int wid = __builtin_amdgcn_readfirstlane(tid >> 6);
    const int map = (MODE == 1) ? (wid >> 2) : 0, wq = (MODE == 1) ? (wid & 3) : wid;
    const int q0 = qb * QROWS, qw = q0 + wq * 32, qpos = qw + r32;
    int qcol, kcol, vcol, ocol;
    if (MODE == 0)      { qcol = 64 * h;          kcol = 512 + 64 * (h >> 2); vcol = 640 + 64 * (h >> 2); ocol = 64 * h; }
    else if (MODE == 1) { qcol = 768 + 128 * h + 64 * map; kcol = 1280 + 128 * h; vcol = 1792 + 128 * h; ocol = 512 + 128 * h; }
    else if (MODE == 2) { qcol = 2304 + 64 * h;   kcol = 2816 + 64 * h;       vcol = 3328 + 64 * h;       ocol = 1024 + 64 * h; }
    else                { qcol = 3840 + 64 * h;   kcol = 4352 + 64 * h;       vcol = 4864 + 64 * h;       ocol = 1536 + 64 * h; }
    int tlo = 0, NT = T >> 6;
    if (MODE == 3) { int lo = q0 - 1024; lo = lo < 0 ? 0 : lo; int hi_k = q0 + 255 + 1024; hi_k = hi_k > T - 1 ? T - 1 : hi_k; int a = lo >> 6, b = hi_k >> 6;
        if (((b - a + 1) & 1) != 0) { if (a > 0) --a; else ++b; } tlo = a; NT = b - a + 1; }
    if (MODE == 2) { const int rows = T >> 6, R0 = 4 * qb; int a = R0 - 4; a = a < 0 ? 0 : (a > rows - 8 ? rows - 8 : a); int b = R0 - 1; b = b < 0 ? 0 : (b > rows - 8 ? rows - 8 : b); b += 7;
        if (((b - a + 1) & 1) != 0) { if (a > 0) --a; else ++b; } tlo = a; NT = b - a + 1; }
    const int sr = (KC == 128) ? (tid >> 4) : (tid >> 3), sc = (KC == 128) ? (tid & 15) * 8 : (tid & 7) * 8;
    const bf16_t* Kg = QKV + (size_t)(row0 + sr) * PITCH + kcol + sc;
    const bf16_t* Vg = QKV + (size_t)(row0 + sr) * PITCH + vcol + sc;
    const int kst0 = kswz<KC>(sr, sc * 2), kst1 = kswz<KC>(32 + sr, sc * 2), vst0 = v_st<NCB>(sr, sc), vst1 = v_st<NCB>(32 + sr, sc);
    const lptr K_lds = lds + L_K, V_lds = lds + L_V;
    const int vb0 = (int)(uintptr_t)V_lds + v_rd_base(lane);
    ATT_LAS float* wsf = (ATT_LAS float*)(lds + L_WS) + wid * 64; ATT_LAS float* li_l = wsf; ATT_LAS float* al_l = wsf + 32;
    struct { bf16x8 k[NR], v[NR]; } st_[2];
#define SLOAD(i, tt) do { const size_t ro_ = (size_t)((tlo + (tt)) * 64) * PITCH; st_[i].k[0] = *(const bf16x8*)(Kg + ro_); st_[i].v[0] = *(const bf16x8*)(Vg + ro_); \
        if constexpr (NR == 2) { st_[i].k[1] = *(const bf16x8*)(Kg + ro_ + (size_t)32 * PITCH); st_[i].v[1] = *(const bf16x8*)(Vg + ro_ + (size_t)32 * PITCH); } } while (0)
#define SWRITE(b, i) do { *(ATT_LAS bf16x8*)(K_lds + (b) * KBYTES + kst0) = st_[i].k[0]; *(ATT_LAS bf16x8*)(V_lds + (b) * VBYTES + vst0) = st_[i].v[0]; \
        if constexpr (NR == 2) { *(ATT_LAS bf16x8*)(K_lds + (b) * KBYTES + kst1) = st_[i].k[1]; *(ATT_LAS bf16x8*)(V_lds + (b) * VBYTES + vst1) = st_[i].v[1]; } } while (0)
#define SWAIT() do { if constexpr (NR == 2) asm volatile("s_waitcnt vmcnt(4)" ::: "memory"); else asm volatile("s_waitcnt vmcnt(2)" ::: "memory"); } while (0)
#define RESC(a) do { if (!NOMAX && __any((a) < 1.f)) { if (hi == 0) al_l[r32] = (a); asm volatile("s_waitcnt lgkmcnt(0)" ::: "memory"); \
        _Pragma("unroll") for (int r = 0; r < 16; ++r) { const float f_ = al_l[crow(r, hi)]; if (ONES) lacc[r] *= f_; _Pragma("unroll") for (int d = 0; d < NCB; ++d) o[d][r] *= f_; } } } while (0)
    SLOAD(0, 0); SLOAD(1, 1);
    bf16x8 qr[4];
    { const bf16_t* Qw = QKV + (size_t)(row0 + qpos) * PITCH + qcol + hi * 8;
#pragma unroll
      for (int d0 = 0; d0 < 4; ++d0) qr[d0] = *(const bf16x8*)(Qw + d0 * 16); }
    ATT_LAS float* lut = (ATT_LAS float*)(lds + L_LUT);
    if (MODE == 1) { for (int i = tid; i < 2 * LUTB_R + 1; i += 512) lut[i] = ax.t5[t5_bucket(i - LUTB_R) * 12 + h] * LOG2E; }
    if (MODE == 3) { for (int i = tid; i < 2 * LUTD_R + 1; i += 512) { const int rel = i - LUTD_R, n = rel < 0 ? -rel : rel;
            const int mult = (n <= 64 ? 1 : 0) + (((n & 3) == 0 && n <= 256) ? 1 : 0) + (((n & 15) == 0 && n <= 1024) ? 1 : 0);
            lut[i] = mult == 0 ? NEG : ax.t5[t5_bucket(rel) * 12 + 4 + h] * LOG2E + (mult == 1 ? 0.f : (mult == 2 ? 1.f : 1.5849625007211562f)); } }
    if (MODE == 2) { for (int i = tid; i < 15 * 128; i += 512) { const int dr = i >> 7, dc = (i & 127) - 48; lut[i] = (dc >= 0 && dc <= 30) ? ax.rpb[(h * 15 + dr) * 31 + dc] * LOG2E : NEG; } }
    float cL = 0.f, cR = 0.f; int c_cs = 0, c_rs = 0, c_R = 0, c_c = 0;
    if (MODE == 2) { const int rows = T >> 6; c_R = 4 * qb + (wid >> 1); c_c = 32 * (wid & 1) + r32; c_cs = c_c - 8; c_cs = c_cs < 0 ? 0 : (c_cs > 48 ? 48 : c_cs); c_rs = c_R - 4; c_rs = c_rs < 0 ? 0 : (c_rs > rows - 8 ? rows - 8 : c_rs); }
#define MODIFY(P0, P1, tt, CB) do { CB = 0.f; const int k0_ = (tlo + (tt)) * 64; \
        if constexpr (MODE == 1) { if (k0_ + 63 - qw <= -559) CB = cL; else if (k0_ - qw - 31 >= 559) CB = cR; else { const ATT_LAS float* lp_ = lut + (k0_ - qpos + LUTB_R + 4 * hi); \
            _Pragma("unroll") for (int r = 0; r < 16; ++r) { P0[r] += lp_[(r & 3) + 8 * (r >> 2)]; P1[r] += lp_[32 + (r & 3) + 8 * (r >> 2)]; } } } \
        if constexpr (MODE == 3) { const ATT_LAS float* lp_ = lut + (k0_ - qpos + LUTD_R + 4 * hi); \
            _Pragma("unroll") for (int r = 0; r < 16; ++r) { P0[r] += lp_[(r & 3) + 8 * (r >> 2)]; P1[r] += lp_[32 + (r & 3) + 8 * (r >> 2)]; } } \
        if constexpr (MODE == 2) { const int kr_ = tlo + (tt); if (kr_ < c_rs || kr_ > c_rs + 7) { _Pragma("unroll") for (int r = 0; r < 16; ++r) { P0[r] = NEG; P1[r] = NEG; } } \
            else { const ATT_LAS float* lp_ = lut + ((kr_ - c_R + 7) * 128 + 48 + 15 - c_c + 4 * hi); const int kb_ = 4 * hi - c_cs; \
              _Pragma("unroll") for (int r = 0; r < 16; ++r) { const int ko_ = (r & 3) + 8 * (r >> 2); const float a_ = lp_[ko_], b_ = lp_[32 + ko_]; \
                P0[r] = ((unsigned)(kb_ + ko_) <= 15u) ? P0[r] + a_ : NEG; P1[r] = ((unsigned)(kb_ + 32 + ko_) <= 15u) ? P1[r] + b_ : NEG; } } } \
    } while (0)
    __syncthreads();
    if (MODE == 1) { cL = lut[0]; cR = lut[2 * LUTB_R]; }
    constexpr bool USEC = false;
    float m_reg = NEG, l_reg = 0.f, cbcur = 0.f, cbacc = 0.f; f32x16 o[NCB], lacc = f32x16{}, cbt = f32x16{};
#define REGSC(CB) do { if constexpr (MODE == 1 && NOMAX) { if ((CB) != cbacc) { const float f_ = __builtin_amdgcn_exp2f(cbacc - (CB)); cbacc = (CB); l_reg *= f_; \
        _Pragma("unroll") for (int r = 0; r < 16; ++r) { if (ONES) lacc[r] *= f_; _Pragma("unroll") for (int d = 0; d < NCB; ++d) o[d][r] *= f_; } } } } while (0)
#define REGIONC(tt) do { if constexpr (USEC) { const int k0_ = (tlo + (tt)) * 64; const float cb_ = (k0_ + 63 - qw <= -559) ? cL : ((k0_ - qw - 31 >= 559) ? cR : 0.f); \
        if (cb_ != cbcur) { cbcur = cb_; _Pragma("unroll") for (int r = 0; r < 16; ++r) cbt[r] = cb_; } } } while (0)
#pragma unroll
    for (int d = 0; d < NCB; ++d) o[d] = f32x16{};
    f32x16 pA0, pA1, pB0, pB1; float alA, alB, cbA, cbB; bf16x8 pa0, pa1, pa2, pa3;
    const int cb0 = map * 128;
    if constexpr (RING) {
    int s_prev = 2, s_cur = 0, s_next = 1;
#define ROT() do { const int t_ = s_prev; s_prev = s_cur; s_cur = s_next; s_next = t_; } while (0)
    asm volatile("s_waitcnt vmcnt(0)" ::: "memory"); SWRITE(0, 0); if (2 < NT) SLOAD(0, 2); __syncthreads();
    SWAIT(); SWRITE(1, 1); if (3 < NT) SLOAD(1, 3);
    REGIONC(0); qkt<KC, USEC>(pA0, pA1, K_lds, cb0, qr, cbt, r32, hi); MODIFY(pA0, pA1, 0, cbA); partialSM<NOMAX>(pA0, pA1, cbA, m_reg, alA);
    __syncthreads(); ROT();
    for (int j = 1; j + 1 < NT; j += 2) {
        SWAIT(); SWRITE(s_next, 0); if (j + 3 < NT) SLOAD(0, j + 3);
        REGIONC(j); ATT_SBAR(); qkt<KC, USEC>(pB0, pB1, K_lds + s_cur * KBYTES, cb0, qr, cbt, r32, hi);
        REGSC(cbA); finishSM<ONES>(pA0, pA1, alA, l_reg, pa0, pa1, pa2, pa3); ATT_SBAR();
        pv_all<NCB, ONES>(o, lacc, vb0 + s_prev * (int)VBYTES, pa0, pa1, pa2, pa3); MODIFY(pB0, pB1, j, cbB); partialSM<NOMAX>(pB0, pB1, cbB, m_reg, alB);
        RESC(alB); __syncthreads(); ROT();
        SWAIT(); SWRITE(s_next, 1); if (j + 4 < NT) SLOAD(1, j + 4);
        REGIONC(j + 1); ATT_SBAR(); qkt<KC, USEC>(pA0, pA1, K_lds + s_cur * KBYTES, cb0, qr, cbt, r32, hi);
        REGSC(cbB); finishSM<ONES>(pB0, pB1, alB, l_reg, pa0, pa1, pa2, pa3); ATT_SBAR();
        pv_all<NCB, ONES>(o, lacc, vb0 + s_prev * (int)VBYTES, pa0, pa1, pa2, pa3); MODIFY(pA0, pA1, j + 1, cbA); partialSM<NOMAX>(pA0, pA1, cbA, m_reg, alA);
        RESC(alA); __syncthreads(); ROT();
    }
    REGIONC(NT - 1); ATT_SBAR(); qkt<KC, USEC>(pB0, pB1, K_lds + s_cur * KBYTES, cb0, qr, cbt, r32, hi);
    REGSC(cbA); finishSM<ONES>(pA0, pA1, alA, l_reg, pa0, pa1, pa2, pa3); ATT_SBAR();
    pv_all<NCB, ONES>(o, lacc, vb0 + s_prev * (int)VBYTES, pa0, pa1, pa2, pa3); MODIFY(pB0, pB1, NT - 1, cbB); partialSM<NOMAX>(pB0, pB1, cbB, m_reg, alB);
    RESC(alB);
    REGSC(cbB); finishSM<ONES>(pB0, pB1, alB, l_reg, pa0, pa1, pa2, pa3); ATT_SBAR();
    pv_all<NCB, ONES>(o, lacc, vb0 + s_cur * (int)VBYTES, pa0, pa1, pa2, pa3);
    __syncthreads();
#undef ROT
    } else {
    asm volatile("s_waitcnt vmcnt(0)" ::: "memory"); SWRITE(0, 0); __syncthreads();
    REGIONC(0); qkt<KC, USEC>(pA0, pA1, K_lds, cb0, qr, cbt, r32, hi); MODIFY(pA0, pA1, 0, cbA); partialSM<NOMAX>(pA0, pA1, cbA, m_reg, alA);
    if (2 < NT) SLOAD(0, 2);
    SWAIT(); SWRITE(1, 1); __syncthreads();
    for (int j = 1; j + 1 < NT; j += 2) {
        REGIONC(j); ATT_SBAR(); qkt<KC, USEC>(pB0, pB1, K_lds + KBYTES, cb0, qr, cbt, r32, hi);
        REGSC(cbA); finishSM<ONES>(pA0, pA1, alA, l_reg, pa0, pa1, pa2, pa3); ATT_SBAR();
        SLOAD(1, j + 2); ATT_SBAR();
        pv_all<NCB, ONES>(o, lacc, vb0, pa0, pa1, pa2, pa3); MODIFY(pB0, pB1, j, cbB); partialSM<NOMAX>(pB0, pB1, cbB, m_reg, alB);
        __syncthreads(); SWAIT(); SWRITE(0, 0);
        RESC(alB); __syncthreads();
        REGIONC(j + 1); ATT_SBAR(); qkt<KC, USEC>(pA0, pA1, K_lds, cb0, qr, cbt, r32, hi);
        REGSC(cbB); finishSM<ONES>(pB0, pB1, alB, l_reg, pa0, pa1, pa2, pa3); ATT_SBAR();
        if (j + 3 < NT) SLOAD(0, j + 3); ATT_SBAR();
        pv_all<NCB, ONES>(o, lacc, vb0 + VBYTES, pa0, pa1, pa2, pa3); MODIFY(pA0, pA1, j + 1, cbA); partialSM<NOMAX>(pA0, pA1, cbA, m_reg, alA);
        __syncthreads(); SWAIT(); SWRITE(1, 1);
        RESC(alA); __syncthreads();
    }
    REGIONC(NT - 1); ATT_SBAR(); qkt<KC, USEC>(pB0, pB1, K_lds + KBYTES, cb0, qr, cbt, r32, hi);
    REGSC(cbA); finishSM<ONES>(pA0, pA1, alA, l_reg, pa0, pa1, pa2, pa3); ATT_SBAR();
    pv_all<NCB, ONES>(o, lacc, vb0, pa0, pa1, pa2, pa3); MODIFY(pB0, pB1, NT - 1, cbB); partialSM<NOMAX>(pB0, pB1, cbB, m_reg, alB);
    __syncthreads(); RESC(alB);
    REGSC(cbB); finishSM<ONES>(pB0, pB1, alB, l_reg, pa0, pa1, pa2, pa3); ATT_SBAR();
    pv_all<NCB, ONES>(o, lacc, vb0 + VBYTES, pa0, pa1, pa2, pa3);
    }
    float rli[16];
    if constexpr (ONES) {
#pragma unroll
        for (int r = 0; r < 16; ++r) rli[r] = __builtin_amdgcn_rcpf(lacc[r]);
    } else {
        if (hi == 0) li_l[r32] = l_reg; asm volatile("s_waitcnt lgkmcnt(0)" ::: "memory");
#pragma unroll
        for (int r = 0; r < 16; ++r) rli[r] = __builtin_amdgcn_rcpf(li_l[crow(r, hi)]);
    }
    if constexpr (MODE != 1) {
        ATT_LAS bf16_t* stg = (ATT_LAS bf16_t*)(lds + L_OST) + wid * 2048;
#pragma unroll
        for (int r = 0; r < 16; ++r) { const int orow = crow(r, hi);
#pragma unroll
            for (int d0 = 0; d0 < 2; ++d0) stg[orow * 64 + d0 * 32 + r32] = (bf16_t)(cvtpk(o[d0][r] * rli[r], 0.f) & 0xffffu); }
        asm volatile("s_waitcnt lgkmcnt(0)" ::: "memory");
        bf16_t* Ow = ATT + (size_t)(row0 + q0 + wid * 32) * OPITCH + ocol;
#pragma unroll
        for (int i = 0; i < 4; ++i) { const int row = i * 8 + (lane >> 3), ch = lane & 7; const u32x4 v = *(const ATT_LAS u32x4*)(stg + row * 64 + ch * 8); *(u32x4*)(Ow + (size_t)row * OPITCH + ch * 8) = v; }
    } else {
        __syncthreads();
        ATT_LAS float* ex = (ATT_LAS float*)(lds + L_K) + (wid & 3) * 4096;
        if (map == 1) {
#pragma unroll
            for (int d0 = 0; d0 < 4; ++d0)
#pragma unroll
                for (int r = 0; r < 16; ++r) ex[(d0 * 16 + r) * 64 + lane] = o[d0][r] * rli[r];
        }
        __syncthreads();
        if (map == 0) {
            const float sa = wave_sum(ax.lam_p[lane] * ax.lam_p[64 + lane]), sb = wave_sum(ax.lam_p[128 + lane] * ax.lam_p[192 + lane]);
            const float lam = __builtin_amdgcn_exp2f(sa * LOG2E) - __builtin_amdgcn_exp2f(sb * LOG2E) + ax.lam_init;
            float ssq[16];
#pragma unroll
            for (int r = 0; r < 16; ++r) ssq[r] = 0.f;
#pragma unroll
            for (int d0 = 0; d0 < 4; ++d0)
#pragma unroll
                for (int r = 0; r < 16; ++r) { const float d = o[d0][r] * rli[r] - lam * ex[(d0 * 16 + r) * 64 + lane]; o[d0][r] = d; ssq[r] += d * d; }
#pragma unroll
            for (int r = 0; r < 16; ++r) { float s = ssq[r]; s += __shfl_xor(s, 1); s += __shfl_xor(s, 2); s += __shfl_xor(s, 4); s += __shfl_xor(s, 8); s += __shfl_xor(s, 16);
                ssq[r] = __builtin_amdgcn_rsqf(s * (1.0f / 128.0f) + cfg::EPS) * (1.0f - ax.lam_init); }
            float gsub[4];
#pragma unroll
            for (int d0 = 0; d0 < 4; ++d0) gsub[d0] = ax.subln[d0 * 32 + r32];
            ATT_LAS bf16_t* stg = (ATT_LAS bf16_t*)(lds + L_OST) + wid * 4096;
#pragma unroll
            for (int r = 0; r < 16; ++r) { const int orow = crow(r, hi);
#pragma unroll
                for (int d0 = 0; d0 < 4; ++d0) stg[orow * 128 + d0 * 32 + r32] = (bf16_t)(cvtpk(o[d0][r] * ssq[r] * gsub[d0], 0.f) & 0xffffu); }
            asm volatile("s_waitcnt lgkmcnt(0)" ::: "memory");
            bf16_t* Ow = ATT + (size_t)(row0 + q0 + wid * 32) * OPITCH + ocol;
#pragma unroll
            for (int i = 0; i < 8; ++i) { const int row = i * 4 + (lane >> 4), ch = lane & 15; const u32x4 v = *(const ATT_LAS u32x4*)(stg + row * 128 + ch * 8); *(u32x4*)(Ow + (size_t)row * OPITCH + ch * 8) = v; }
        }
    }
    __syncthreads();
#undef SLOAD
#undef SWRITE
#undef SWAIT
#undef RESC
#undef MODIFY
#undef REGIONC
#undef REGSC
}
#undef ATT_SBAR
}
#define GAS __attribute__((address_space(1)))
#define LAS __attribute__((address_space(3)))
typedef unsigned short bf16;
typedef unsigned v4u __attribute__((ext_vector_type(4)));
typedef float f32x4 __attribute__((ext_vector_type(4)));
typedef short bf16x8 __attribute__((ext_vector_type(8)));
typedef GAS unsigned gu32;
typedef GAS unsigned long long gu64;
#define RLX_AGENT __ATOMIC_RELAXED, __HIP_MEMORY_SCOPE_AGENT
#define LDS_WAIT() asm volatile("s_waitcnt lgkmcnt(0)" ::: "memory")
#define VM_WAIT() asm volatile("s_waitcnt vmcnt(0)" ::: "memory")
__device__ __forceinline__ unsigned long long rt() { return __builtin_amdgcn_s_memrealtime(); }
__device__ __forceinline__ unsigned f2bf(float f) { unsigned u = __builtin_bit_cast(unsigned, f); return (u + 0x7fffu + ((u >> 16) & 1u)) >> 16; }
__device__ __forceinline__ unsigned pk2(float lo, float hi) { return f2bf(lo) | (f2bf(hi) << 16); }

#define XB_TMO      128
#define XB_XCNT(j)  (256  + 64 * (j))
#define XB_XSUB(j)  (1280 + 64 * (j))
#define XB_XGEN(j)  (2304 + 64 * (j))
#define XB_TOP      3328
#define XB_TOPGEN   3392
#define XCD_BAR_WORDS 3456
#define XB_SPIN_CAP (1u << 18)

__device__ __forceinline__ unsigned xb_ld(unsigned* p)              { return __hip_atomic_load(p, __ATOMIC_RELAXED, __HIP_MEMORY_SCOPE_AGENT); }
__device__ __forceinline__ unsigned xb_add(unsigned* p, unsigned v) { return __hip_atomic_fetch_add(p, v, __ATOMIC_RELAXED, __HIP_MEMORY_SCOPE_AGENT); }
__device__ __forceinline__ unsigned xb_xcc_id() { return (unsigned)__builtin_amdgcn_s_getreg((3 << 11) | 20) & 0xFu; }
#define XB_SPIN(cond, bar) do { unsigned _sp = 0; while (cond) { __builtin_amdgcn_s_sleep(1); \
    if ((++_sp & 255u) == 0u) { if (xb_ld(&(bar)[XB_TMO])) break; if (_sp > XB_SPIN_CAP) { atomicAdd(&(bar)[XB_TMO], 1u); break; } } } } while (0)

struct XcdBarrier {
    unsigned* bar; unsigned x;
    volatile LAS unsigned* st;
};

__device__ __forceinline__ XcdBarrier xcd_barrier_post(unsigned* bar, volatile LAS unsigned* st) {
    XcdBarrier b; b.bar = bar; b.x = xb_xcc_id(); b.st = st;
    if (threadIdx.x == 0) (void)xb_add(&bar[XB_XCNT(b.x)], 1u);
    return b;
}
__device__ __forceinline__ void xcd_barrier_complete(unsigned* bar, unsigned x, unsigned& nloc, unsigned& nx) {
    const unsigned G = gridDim.x * gridDim.y * gridDim.z;
    unsigned sum, cnt, mine, sp = 0u;
    for (;;) {
        sum = 0u; cnt = 0u; mine = 0u;
#pragma unroll
        for (unsigned j = 0; j < 16; ++j) { const unsigned c = xb_ld(&bar[XB_XCNT(j)]); sum += c; cnt += (c > 0u) ? 1u : 0u; mine = (j == x) ? c : mine; }
        if (sum == G) break;
        __builtin_amdgcn_s_sleep(1);
        if ((++sp & 255u) == 0u) { if (xb_ld(&bar[XB_TMO])) break; if (sp > XB_SPIN_CAP) { atomicAdd(&bar[XB_TMO], 1u); break; } }
    }
    nloc = mine > 0u ? mine : 1u; nx = cnt > 0u ? cnt : 1u;
}

__device__ __forceinline__ void xcd_barrier(const XcdBarrier& b) {
    asm volatile("s_waitcnt vmcnt(0)" ::: "memory");
    __syncthreads();
    if (threadIdx.x == 0) {
        unsigned* bar = b.bar;
        __builtin_amdgcn_s_waitcnt(0);
        unsigned nloc = b.st[0], nx = b.st[1];
        if (nloc == 0u) { xcd_barrier_complete(bar, b.x, nloc, nx); b.st[0] = nloc; b.st[1] = nx; }
        const unsigned old = xb_add(&bar[XB_XSUB(b.x)], 1u);
        const unsigned gen = old / nloc;
        if (old + 1u == (gen + 1u) * nloc) {
            __builtin_amdgcn_fence(__ATOMIC_RELEASE, "agent");
            asm volatile("s_waitcnt vmcnt(0)" ::: "memory");
            const unsigned og = xb_add(&bar[XB_TOP], 1u);
            const unsigned tg = og / nx;
            if (og + 1u == (tg + 1u) * nx) xb_add(&bar[XB_TOPGEN], 1u);
            else XB_SPIN(xb_ld(&bar[XB_TOPGEN]) == tg, bar);
            __builtin_amdgcn_fence(__ATOMIC_ACQUIRE, "agent");
            xb_add(&bar[XB_XGEN(b.x)], 1u);
            asm volatile("s_waitcnt vmcnt(0)" ::: "memory");
        } else {
            XB_SPIN(xb_ld(&bar[XB_XGEN(b.x)]) == gen, bar);
            __builtin_amdgcn_fence(__ATOMIC_ACQUIRE, "agent");
            asm volatile("s_waitcnt vmcnt(0)" ::: "memory");
        }
    }
    __syncthreads();
}

__device__ __forceinline__ void xcd_local_barrier(const XcdBarrier& b) {
    asm volatile("s_waitcnt vmcnt(0)" ::: "memory");
    __syncthreads();
    if (threadIdx.x == 0) {
        unsigned* bar = b.bar;
        __builtin_amdgcn_s_waitcnt(0);
        unsigned nloc = b.st[0]; nloc = nloc ? nloc : 1u;
        const unsigned old = xb_add(&bar[XB_XSUB(b.x)], 1u);
        const unsigned gen = old / nloc;
        if (old + 1u == (gen + 1u) * nloc) xb_add(&bar[XB_XGEN(b.x)], 1u);
        else XB_SPIN(xb_ld(&bar[XB_XGEN(b.x)]) == gen, bar);
        __builtin_amdgcn_fence(__ATOMIC_ACQUIRE, "agent");
        asm volatile("s_waitcnt vmcnt(0)" ::: "memory");
    }
    __syncthreads();
}

constexpr int NWAVES = 8;
constexpr size_t MiB = 1u << 20;
constexpr size_t WS_CTL = 0, CTL_ZERO_BYTES = 1 * MiB;
constexpr size_t WS_WGU = 2 * MiB, WS_WD = 46 * MiB, WS_WIN = 68 * MiB, WS_WOUT = 89 * MiB;
constexpr size_t WS_R = 98 * MiB;
constexpr size_t WS_ATT = 290 * MiB;
constexpr size_t WS_BIG = 482 * MiB;
constexpr size_t WS_RSS = 1010 * MiB, RSS_BYTES = 3 * MiB;
constexpr size_t WS_END = 1013 * MiB;
static_assert(WS_WGU + (size_t)cfg::NGU * cfg::DM * 2 <= WS_WD && WS_WD + (size_t)cfg::DM * cfg::DFF * 2 <= WS_WIN && WS_WIN + (size_t)cfg::NIN * cfg::DM * 2 <= WS_WOUT &&
              WS_WOUT + (size_t)cfg::DM * cfg::DM * 2 <= WS_R && WS_R + (size_t)cfg::M * cfg::DM * 2 <= WS_ATT && WS_ATT + (size_t)cfg::M * cfg::DM * 2 <= WS_BIG && WS_BIG + (size_t)cfg::M * cfg::DFF * 2 <= WS_END, "d_ws map");
#ifndef WGM_DN
#define WGM_DN 4
#endif
#ifndef GEMM_SP2
#define GEMM_SP2 true
#endif
#ifndef GEMM_ALIGN
#define GEMM_ALIGN true
#endif
#ifndef WGM_GU
#define WGM_GU 8
#endif
constexpr int CW_BAR = 4096;
constexpr int CW_NRM = 8192;
constexpr int RING_OFF = 0, RING_BYTES = 131072, LDSCTL_OFF = RING_BYTES, MISC_OFF = LDSCTL_OFF + 320, LDS_BYTES = 147456;
static_assert(att::L_END <= RING_BYTES && MISC_OFF + 128 <= LDS_BYTES, "LDS map");

struct Frame {
    LAS unsigned char* lds; volatile LAS unsigned* MISC; int wave, vcu, G;
};
__device__ __forceinline__ float wave_sum_f(float v) {
#pragma unroll
    for (int o = 1; o < 64; o <<= 1) v += __shfl_xor(v, o);
    return v;
}
__device__ __forceinline__ void transpose_item(const float* W, int K, int N, bf16* WT, int k0, int n0, int rowbase, const float* gain, LAS float* scr, int lane) {
#pragma unroll 8
    for (int i = 0; i < 32; ++i) { const int kk = 2 * i + (lane >> 5); scr[kk * 33 + (lane & 31)] = W[(size_t)(k0 + kk) * N + n0 + (lane & 31)]; }
    LDS_WAIT(); asm volatile("" ::: "memory");
    const int c = lane & 7;
    f32x4 g0 = {1.f, 1.f, 1.f, 1.f}, g1 = g0;
    if (gain) { g0 = *(const f32x4*)(gain + k0 + 8 * c); g1 = *(const f32x4*)(gain + k0 + 8 * c + 4); }
#pragma unroll
    for (int j = 0; j < 4; ++j) { const int n = (lane >> 3) + 8 * j; const LAS float* s = scr + (8 * c) * 33 + n;
        v4u o; o.x = pk2(s[0 * 33] * g0[0], s[1 * 33] * g0[1]); o.y = pk2(s[2 * 33] * g0[2], s[3 * 33] * g0[3]); o.z = pk2(s[4 * 33] * g1[0], s[5 * 33] * g1[1]); o.w = pk2(s[6 * 33] * g1[2], s[7 * 33] * g1[3]);
        *(GAS v4u*)(WT + (size_t)(rowbase + n) * K + k0 + 8 * c) = o; }
    LDS_WAIT(); asm volatile("" ::: "memory");
}
__device__ __forceinline__ void conv_ffn(const Frame& F, const float* wg, const float* wu, const float* wd, const float* gain, unsigned char* ws) {
    using namespace cfg;
    { const GAS float *a = (const GAS float*)wg, *b = (const GAS float*)wu, *c = (const GAS float*)wd, *d = (const GAS float*)gain; asm volatile("" : "+s"(a), "+s"(b), "+s"(c), "+s"(d));
      wg = (const float*)a; wu = (const float*)b; wd = (const float*)c; gain = (const float*)d; }
    int lane = threadIdx.x; asm volatile("" : "+v"(lane)); lane &= 63;
    LAS float* scr = (LAS float*)(F.lds + RING_OFF + F.wave * 16384);
    const int gw = F.vcu * NWAVES + F.wave, NGW = F.G * NWAVES;
    constexpr int I_G = (DM / 64) * (DFF / 32), I_D = (DFF / 64) * (DM / 32);
    static_assert(I_G == I_D, "");
    for (int it = gw; it < 3 * I_G; it += NGW) {
        const int which = it / I_G, r = it - which * I_G;
        if (which < 2) { const int nblk = DFF / 32, kb = r / nblk, nb = r % nblk, n0 = 32 * nb;
            transpose_item(which ? wu : wg, DM, DFF, (bf16*)(ws + WS_WGU), 64 * kb, n0, 256 * (n0 >> 7) + 128 * which + (n0 & 127), gain, scr, lane); }
        else { const int nblk = DM / 32, kb = r / nblk, nb = r % nblk, n0 = 32 * nb;
            transpose_item(wd, DFF, DM, (bf16*)(ws + WS_WD), 64 * kb, n0, n0, nullptr, scr, lane); }
    }
}
__device__ __forceinline__ void conv_mix(const Frame& F, const float* win, const float* wout, const float* gain, unsigned char* ws) {
    using namespace cfg;
    { const GAS float *a = (const GAS float*)win, *b = (const GAS float*)wout, *d = (const GAS float*)gain; asm volatile("" : "+s"(a), "+s"(b), "+s"(d)); win = (const float*)a; wout = (const float*)b; gain = (const float*)d; }
    int lane = threadIdx.x; asm volatile("" : "+v"(lane)); lane &= 63;
    LAS float* scr = (LAS float*)(F.lds + RING_OFF + F.wave * 16384);
    const int gw = F.vcu * NWAVES + F.wave, NGW = F.G * NWAVES;
    constexpr int I_IN = (DM / 64) * (NIN / 32), I_O = (DM / 64) * (DM / 32);
    for (int it = gw; it < I_IN + I_O; it += NGW) {
        if (it < I_IN) { const int nblk = NIN / 32, kb = it / nblk, nb = it % nblk, n0 = 32 * nb;
            transpose_item(win, DM, NIN, (bf16*)(ws + WS_WIN), 64 * kb, n0, 256 * (n0 >> 8) + 128 * ((n0 & 63) >> 5) + 32 * ((n0 & 255) >> 6), gain, scr, lane); }
        else { const int r = it - I_IN, nblk = DM / 32, kb = r / nblk, nb = r % nblk, n0 = 32 * nb;
            transpose_item(wout, DM, DM, (bf16*)(ws + WS_WOUT), 64 * kb, n0, n0, nullptr, scr, lane); }
    }
}
template <bool FINAL>
__device__ __forceinline__ void row_phase(const Frame& F, const float* xp, const float* xs, float* out, const float* gain, bf16* R, unsigned long long* rss) {
    using namespace cfg;
    int lane = threadIdx.x; asm volatile("" : "+v"(lane)); lane &= 63;
    const int gw = F.vcu * NWAVES + F.wave, NGW = F.G * NWAVES;
    if constexpr (FINAL) {
        { const GAS float* a = (const GAS float*)gain; asm volatile("" : "+s"(a)); gain = (const float*)a; }
        f32x4 g[4][2];
#pragma unroll
        for (int k = 0; k < 4; ++k) { g[k][0] = ((const f32x4*)gain)[2 * (lane + 64 * k)]; g[k][1] = ((const f32x4*)gain)[2 * (lane + 64 * k) + 1]; }
        for (int m = gw; m < M; m += NGW) {
            const GAS v4u* xr = (const GAS v4u*)(R + (size_t)m * DM) + lane;
            v4u w[4]; f32x4 v[4][2]; float s = 0.f;
#pragma unroll
            for (int k = 0; k < 4; ++k) w[k] = xr[64 * k];
#pragma unroll
            for (int k = 0; k < 4; ++k) { v[k][0] = (f32x4){__uint_as_float(w[k].x << 16), __uint_as_float(w[k].x & 0xffff0000u), __uint_as_float(w[k].y << 16), __uint_as_float(w[k].y & 0xffff0000u)};
                v[k][1] = (f32x4){__uint_as_float(w[k].z << 16), __uint_as_float(w[k].z & 0xffff0000u), __uint_as_float(w[k].w << 16), __uint_as_float(w[k].w & 0xffff0000u)};
#pragma unroll
                for (int e = 0; e < 2; ++e) s += (v[k][e].x * v[k][e].x + v[k][e].y * v[k][e].y) + (v[k][e].z * v[k][e].z + v[k][e].w * v[k][e].w); }
            const float rinv = 1.0f / sqrtf(wave_sum_f(s) * (1.0f / DM) + EPS);
            GAS f32x4* o = (GAS f32x4*)(out + (size_t)m * DM);
#pragma unroll
            for (int k = 0; k < 4; ++k) { o[2 * (lane + 64 * k)] = v[k][0] * rinv * g[k][0]; o[2 * (lane + 64 * k) + 1] = v[k][1] * rinv * g[k][1]; }
        }
    } else {
        for (int m = gw; m < M; m += NGW) {
            const float* xrow = m < MP ? xp + (size_t)m * DM : xs + (size_t)(m - MP) * DM;
            const GAS f32x4* xr = (const GAS f32x4*)xrow + lane;
            f32x4 v[8]; float s = 0.f;
#pragma unroll
            for (int j = 0; j < 8; ++j) { v[j] = xr[64 * j]; s += (v[j].x * v[j].x + v[j].y * v[j].y) + (v[j].z * v[j].z + v[j].w * v[j].w); }
            const float ssum = wave_sum_f(s);
            GAS unsigned long long* o8 = (GAS unsigned long long*)(R + (size_t)m * DM) + lane;
#pragma unroll
            for (int j = 0; j < 8; ++j) o8[64 * j] = (unsigned long long)pk2(v[j].x, v[j].y) | ((unsigned long long)pk2(v[j].z, v[j].w) << 32);
            if (lane == 0) ((GAS unsigned long long*)rss)[m] = (unsigned long long)(ssum * 4294967296.0f);
        }
    }
}

struct Args { const float* in[20]; float* out; unsigned char* ws; int ph_lo, ph_hi, pad0, pad1; };
__global__ void __launch_bounds__(NWAVES * 64, 2) mk_fwd(Args args) {
    using namespace cfg;
    extern __shared__ __attribute__((aligned(16))) unsigned char lds[];
    Frame F;
    F.lds = (LAS unsigned char*)lds; F.MISC = (volatile LAS unsigned*)(F.lds + MISC_OFF);
    F.wave = __builtin_amdgcn_readfirstlane((int)threadIdx.x >> 6);
    F.G = gridDim.x; { const int bx = blockIdx.x; F.vcu = (F.G % 8 == 0) ? (bx % 8) * (F.G / 8) + bx / 8 : bx; }
    unsigned char* ws = args.ws; gu32* ctl = (gu32*)(ws + WS_CTL);
    const float* const p_xp = args.in[0]; const float* const p_xs = args.in[1]; const float* const p_f1n = args.in[2]; const float* const p_f1g = args.in[3]; const float* const p_f1u = args.in[4];
    const float* const p_f1d = args.in[5]; const float* const p_mixn = args.in[6]; const float* const p_win = args.in[7]; const float* const p_aqn = args.in[8]; const float* const p_akn = args.in[9];
    const float* const p_blam = args.in[10]; const float* const p_bsub = args.in[11]; const float* const p_crpb = args.in[12]; const float* const p_wout = args.in[13]; const float* const p_f2n = args.in[14];
    const float* const p_f2g = args.in[15]; const float* const p_f2u = args.in[16]; const float* const p_f2d = args.in[17]; const float* const p_t5 = args.in[18]; const float* const p_fin = args.in[19];
    float* out = args.out;
    bf16* RS = (bf16*)(ws + WS_R); bf16* ATB = (bf16*)(ws + WS_ATT); bf16* BIG = (bf16*)(ws + WS_BIG);
    for (int u = threadIdx.x; u < (LDS_BYTES - LDSCTL_OFF) / 4; u += NWAVES * 64) ((LAS unsigned*)(F.lds + LDSCTL_OFF))[u] = 0u;
    __syncthreads();
    XcdBarrier bar; bar.bar = (unsigned*)(ctl + CW_BAR); bar.x = 0; bar.st = nullptr;
    if (!MK_PER_PHASE) bar = xcd_barrier_post((unsigned*)(ctl + CW_BAR), F.MISC + 8);
    const int lo = args.ph_lo, hi = args.ph_hi;
    int ph = 0;
#define IN(k) (lo <= (k) && (k) < hi)
#define FRESH() GAS float* out_g = (GAS float*)out; GAS unsigned char* ws_g = (GAS unsigned char*)ws; GAS bf16* R_g = (GAS bf16*)RS; GAS bf16* BIG_g = (GAS bf16*)BIG; GAS bf16* AT_g = (GAS bf16*)ATB; const GAS float* xp_g = (const GAS float*)p_xp; const GAS float* xs_g = (const GAS float*)p_xs; \
    asm volatile("" : "+s"(out_g), "+s"(ws_g), "+s"(R_g), "+s"(BIG_g), "+s"(AT_g), "+s"(xp_g), "+s"(xs_g)); \
    float* out_ = (float*)out_g; unsigned char* ws_ = (unsigned char*)ws_g; bf16* R_ = (bf16*)R_g; bf16* BIG_ = (bf16*)BIG_g; bf16* ATB_ = (bf16*)AT_g; const float* xp_ = (const float*)xp_g; const float* xs_ = (const float*)xs_g; (void)ATB_; (void)BIG_; (void)R_; (void)xp_; (void)xs_; (void)out_
#define SEAM() do { if (IN(ph) && IN(ph + 1)) { if (MK_PER_PHASE) { if (threadIdx.x == 0) __hip_atomic_store(ctl, 0xBADBA0u, RLX_AGENT); } else xcd_barrier(bar); } ++ph; } while (0)

    for (int L = 0; L < 2; ++L) {
        unsigned long long* const rssA = (unsigned long long*)(ws + WS_RSS) + (size_t)(L == 0 ? 0 : 3) * M;
        unsigned long long* const rssB = (unsigned long long*)(ws + WS_RSS) + (size_t)(L == 0 ? 1 : 4) * M;
        unsigned long long* const rssC = (unsigned long long*)(ws + WS_RSS) + (size_t)(L == 0 ? 2 : 5) * M;
        if (IN(ph)) { FRESH();
            conv_ffn(F, p_f1g + (size_t)L * DM * DFF, p_f1u + (size_t)L * DM * DFF, p_f1d + (size_t)L * DM * DFF, p_f1n + L * DM, ws_);
            conv_mix(F, p_win + (size_t)L * DM * NIN, p_wout + (size_t)L * DM * DM, p_mixn + L * DM, ws_);
            if (L == 0) row_phase<false>(F, xp_, xs_, out_, nullptr, R_, rssA);
        }
        SEAM();
        if (IN(ph)) { FRESH();
            pg8::Gemm g{R_, (const bf16*)(ws_ + WS_WGU), M, NGU, DM}; pg8::StaticOrder S; S.init(M, NGU, F.G, (int)blockIdx.x, WGM_GU);
            pg8::EpiSwiglu E{BIG_, rssA};
#ifndef NO_GU
            pg8::gemm_phase<pg8::EpiSwiglu, pg8::StaticOrder, GEMM_ALIGN, GEMM_SP2>(F.lds + RING_OFF, g, S, E);
#endif
        }
        SEAM();
        if (IN(ph)) { FRESH();
            pg8::Gemm g{BIG_, (const bf16*)(ws_ + WS_WD), M, DM, DFF}; pg8::StaticOrder S; S.init(M, DM, F.G, (int)blockIdx.x, WGM_DN);
            pg8::EpiResid E{R_, 0.5f, rssB};
#ifndef NO_RES
            pg8::gemm_phase<pg8::EpiResid, pg8::StaticOrder, GEMM_ALIGN, GEMM_SP2>(F.lds + RING_OFF, g, S, E);
#endif
        }
        SEAM();
        if (IN(ph)) { FRESH();
            conv_ffn(F, p_f2g + (size_t)L * DM * DFF, p_f2u + (size_t)L * DM * DFF, p_f2d + (size_t)L * DM * DFF, p_f2n + L * DM, ws_);
            __syncthreads();
            pg8::Gemm g{R_, (const bf16*)(ws_ + WS_WIN), M, NIN, DM}; pg8::StaticOrder S; S.init(M, NIN, F.G, (int)blockIdx.x, WGM_GU);
            pg8::EpiWin E{BIG_, p_aqn + L * 64, p_akn + L * 64, rssB, (unsigned*)(ctl + CW_NRM + L * 336)};
#ifndef NO_WIN
            pg8::gemm_phase<pg8::EpiWin, pg8::StaticOrder, GEMM_ALIGN, GEMM_SP2>(F.lds + RING_OFF, g, S, E);
#endif
        }
        SEAM();
        if (IN(ph)) { FRESH(); bf16* const QKV_ = BIG_; bf16* const ATT_ = ATB_;
                att::Aux ax{p_t5, p_crpb + (size_t)L * 8 * 15 * 31, p_blam + L * 256, p_bsub + L * 128, (L == 0 ? 0.2f : 0.35550906759f)};
                const att::lptr al = (att::lptr)(F.lds + RING_OFF);
#ifdef ATT_PRIO
                if (F.wave >= 4) __builtin_amdgcn_s_setprio(1);
#endif
#ifndef PROBE_ATT_REP
#define PROBE_ATT_REP 1
#endif
                for (int rep_ = 0; rep_ < PROBE_ATT_REP; ++rep_) {
#ifndef REP_B
#define REP_B 1
#endif
#ifndef REP_A
#define REP_A 1
#endif
#ifndef REP_D
#define REP_D 1
#endif
#ifndef REP_C
#define REP_C 1
#endif
                float t5max = 0.f, rpbmax = 0.f;
                { int ln = threadIdx.x; asm volatile("" : "+v"(ln)); ln &= 63;
#pragma unroll
                  for (int k_ = 0; k_ < 6; ++k_) t5max = fmaxf(t5max, fabsf(p_t5[ln + 64 * k_]));
                  for (int k_ = 0; k_ < 59; ++k_) { const int ix = ln + 64 * k_; if (ix < 8 * 15 * 31) rpbmax = fmaxf(rpbmax, fabsf(ax.rpb[ix])); }
#pragma unroll
                  for (int o_ = 1; o_ < 64; o_ <<= 1) { t5max = fmaxf(t5max, __shfl_xor(t5max, o_)); rpbmax = fmaxf(rpbmax, __shfl_xor(rpbmax, o_)); } }
                t5max = __uint_as_float(__builtin_amdgcn_readfirstlane(__float_as_uint(t5max))); rpbmax = __uint_as_float(__builtin_amdgcn_readfirstlane(__float_as_uint(rpbmax)));
                const GAS unsigned* nrm2 = (const GAS unsigned*)(ctl + CW_NRM + L * 336);
#define SEQ_OF(r0_) ((r0_) < MP ? ((r0_) >> 14) : 2 + (((r0_) - MP) >> 13))
#define NRM(blk_, sq_) __uint_as_float(nrm2[(blk_) * 4 + (sq_)])
                for (int rb_ = 0; rb_ < REP_B; ++rb_)
                for (int u = F.vcu; u < 1536; u += F.G) {
#ifndef NO_ATT1
                    int r0, T, h, qb;
                    if (u < 1024) { r0 = (u >> 9) * TP; T = TP; h = (u >> 7) & 3; qb = u & 127; } else { const int v = u - 1024; r0 = MP + (v >> 8) * TS; T = TS; h = (v >> 6) & 3; qb = v & 63; }
                    const int sq = SEQ_OF(r0);
                    const float bnd = sqrtf(fmaxf(NRM(12 + 2 * h, sq), NRM(13 + 2 * h, sq)) * fmaxf(NRM(20 + 2 * h, sq), NRM(21 + 2 * h, sq))) * 1.01f + t5max * LOG2E;
                    if (__builtin_amdgcn_readfirstlane((int)(bnd <= 80.0f))) att::attn_unit<1, true>(QKV_, ATT_, al, r0, T, h, qb, ax); else att::attn_unit<1, false>(QKV_, ATT_, al, r0, T, h, qb, ax);
#endif
                }
                bool a_nomax;
                { int ln_ = threadIdx.x; asm volatile("" : "+v"(ln_)); ln_ &= 63; float gq = fabsf(p_aqn[L * 64 + ln_]), gk = fabsf(p_akn[L * 64 + ln_]);
#pragma unroll
                  for (int o_ = 1; o_ < 64; o_ <<= 1) { gq = fmaxf(gq, __shfl_xor(gq, o_)); gk = fmaxf(gk, __shfl_xor(gk, o_)); }
                  const float bound = 8.0f * LOG2E * gq * gk * 1.01f; a_nomax = __builtin_amdgcn_readfirstlane((int)(bound <= 80.0f)) != 0; }
                for (int ra_ = 0; ra_ < REP_A; ++ra_)
                for (int u = F.vcu; u < 1536; u += F.G) {
#ifndef NO_ATT0
                    int r0, T, h, qb;
                    if (u < 1024) { r0 = (u >> 9) * TP; T = TP; h = (u >> 6) & 7; qb = u & 63; } else { const int v = u - 1024; r0 = MP + (v >> 8) * TS; T = TS; h = (v >> 5) & 7; qb = v & 31; }
                    if (a_nomax) att::attn_unit<0, true>(QKV_, ATT_, al, r0, T, h, qb, ax); else att::attn_unit<0, false>(QKV_, ATT_, al, r0, T, h, qb, ax);
#endif
                }
                for (int rd_ = 0; rd_ < REP_D; ++rd_)
                for (int u = F.vcu; u < 1536; u += F.G) {
                    const int h = u / 192, qg = u % 192; int r0, T, qb;
                    if (qg < 128) { r0 = (qg >> 6) * TP; T = TP; qb = qg & 63; } else { r0 = MP + ((qg - 128) >> 5) * TS; T = TS; qb = (qg - 128) & 31; }
#ifndef NO_ATT3
                    { const int sq = SEQ_OF(r0); const float bnd = sqrtf(NRM(60 + h, sq) * NRM(68 + h, sq)) * 1.01f + t5max * LOG2E + 1.6f;
                      if (__builtin_amdgcn_readfirstlane((int)(bnd <= 80.0f))) att::attn_unit<3, true>(QKV_, ATT_, al, r0, T, h, qb, ax); else att::attn_unit<3, false>(QKV_, ATT_, al, r0, T, h, qb, ax); }
#endif
                }
                for (int rc_ = 0; rc_ < REP_C; ++rc_)
                for (int u = F.vcu; u < 1536; u += F.G) {
                    const int h = u / 192, qg = u % 192; int r0, T, qb;
                    if (qg < 128) { r0 = (qg >> 6) * TP; T = TP; qb = qg & 63; } else { r0 = MP + ((qg - 128) >> 5) * TS; T = TS; qb = (qg - 128) & 31; }
#ifndef NO_ATT2
                    { const int sq = SEQ_OF(r0); const float bnd = sqrtf(NRM(36 + h, sq) * NRM(44 + h, sq)) * 1.01f + rpbmax * LOG2E;
                      if (__builtin_amdgcn_readfirstlane((int)(bnd <= 80.0f))) att::attn_unit<2, true>(QKV_, ATT_, al, r0, T, h, qb, ax); else att::attn_unit<2, false>(QKV_, ATT_, al, r0, T, h, qb, ax); }
#endif
                }
                }
                    }
        SEAM();
        if (IN(ph)) { FRESH();
            pg8::Gemm g{ATB_, (const bf16*)(ws_ + WS_WOUT), M, DM, DM}; pg8::StaticOrder S; S.init(M, DM, F.G, (int)blockIdx.x, WGM_DN);
            pg8::EpiResid E{R_, 1.0f, rssC};
#ifndef NO_RES
            pg8::gemm_phase<pg8::EpiResid, pg8::StaticOrder, GEMM_ALIGN, GEMM_SP2>(F.lds + RING_OFF, g, S, E);
#endif
        }
        SEAM();
        if (IN(ph)) { FRESH();
            pg8::Gemm g{R_, (const bf16*)(ws_ + WS_WGU), M, NGU, DM}; pg8::StaticOrder S; S.init(M, NGU, F.G, (int)blockIdx.x, WGM_GU);
            pg8::EpiSwiglu E{BIG_, rssC};
#ifndef NO_GU
            pg8::gemm_phase<pg8::EpiSwiglu, pg8::StaticOrder, GEMM_ALIGN, GEMM_SP2>(F.lds + RING_OFF, g, S, E);
#endif
        }
        SEAM();
        if (IN(ph)) { FRESH();
            pg8::Gemm g{BIG_, (const bf16*)(ws_ + WS_WD), M, DM, DFF}; pg8::StaticOrder S; S.init(M, DM, F.G, (int)blockIdx.x, WGM_DN);
            pg8::EpiResid E{R_, 0.5f, L == 0 ? (unsigned long long*)(ws + WS_RSS) + (size_t)3 * M : (unsigned long long*)nullptr};
#ifndef NO_RES
            pg8::gemm_phase<pg8::EpiResid, pg8::StaticOrder, GEMM_ALIGN, GEMM_SP2>(F.lds + RING_OFF, g, S, E);
#endif
        }
        SEAM();
    }
    if (IN(ph)) { FRESH(); row_phase<true>(F, xp_, xs_, out_, p_fin, R_, nullptr); }
#undef IN
#undef SEAM
}
constexpr int N_PHASES = 17;

extern "C" void kernel_launch(void* const* d_in, const int* in_sizes, int n_in, void* d_out, int out_size, void* d_ws, size_t ws_size, hipStream_t stream) {
    static int grid = 0;
    if (grid == 0) {
        if (n_in != 20 || in_sizes[0] != cfg::MP * cfg::DM || in_sizes[1] != cfg::MS * cfg::DM || out_size != cfg::M * cfg::DM || ws_size < WS_END) {
            fprintf(stderr, "kernel_launch: shape mismatch (n_in %d, in0 %d, in1 %d, out %d, ws %zu need %zu); nothing launched\n", n_in, n_in > 0 ? in_sizes[0] : -1, n_in > 1 ? in_sizes[1] : -1, out_size, ws_size, (size_t)WS_END); grid = -1; return; }
        int dev = 0, cus = 0, per_cu = 0;
        if (hipGetDevice(&dev) != hipSuccess || hipDeviceGetAttribute(&cus, hipDeviceAttributeMultiprocessorCount, dev) != hipSuccess) { fprintf(stderr, "kernel_launch: device query failed\n"); grid = -1; return; }
        if (hipFuncSetAttribute((const void*)mk_fwd, hipFuncAttributeMaxDynamicSharedMemorySize, LDS_BYTES) != hipSuccess) { fprintf(stderr, "kernel_launch: hipFuncSetAttribute failed\n"); grid = -1; return; }
        if (hipOccupancyMaxActiveBlocksPerMultiprocessor(&per_cu, (const void*)mk_fwd, NWAVES * 64, LDS_BYTES) != hipSuccess || per_cu < 1) {
            fprintf(stderr, "kernel_launch: occupancy query reports %d workgroups per CU; nothing launched\n", per_cu); (void)hipGetLastError(); grid = -1; return; }
        (void)hipGetLastError();
        grid = cus;
    }
    if (grid < 0) return;
    if (hipMemsetAsync((char*)d_ws + WS_CTL, 0, CTL_ZERO_BYTES, stream) != hipSuccess || hipMemsetAsync((char*)d_ws + WS_RSS, 0, RSS_BYTES, stream) != hipSuccess) { fprintf(stderr, "kernel_launch: memset failed\n"); return; }
    Args a{};
    for (int i = 0; i < 20; ++i) a.in[i] = (const float*)d_in[i];
    a.out = (float*)d_out; a.ws = (unsigned char*)d_ws;
#if MK_PER_PHASE
    for (int p = 0; p < N_PHASES; ++p) { a.ph_lo = p; a.ph_hi = p + 1; hipLaunchKernelGGL(mk_fwd, dim3(grid), dim3(NWAVES * 64), LDS_BYTES, stream, a); }
#else
    a.ph_lo = 0; a.ph_hi = N_PHASES;
    hipLaunchKernelGGL(mk_fwd, dim3(grid), dim3(NWAVES * 64), LDS_BYTES, stream, a);
#endif
    const hipError_t le = hipPeekAtLastError();
    if (le != hipSuccess) fprintf(stderr, "kernel_launch: launch failed: %s\n", hipGetErrorName(le));
}
```

```cpp
#include <hip/hip_runtime.h>
#include <cstdio>
#include <cstdint>

#ifndef MK_PER_PHASE
#define MK_PER_PHASE 0
#endif

namespace cfg {
constexpr int DM = 2048, DFF = 5632, NIN = 5376, NGU = 2 * DFF;
constexpr int TP = 16384, TS = 8192, MP = 2 * TP, MS = 2 * TS, M = MP + MS;
constexpr float EPS = 1e-6f;
constexpr float LOG2E = 1.4426950408889634f;
constexpr float C2 = 0.125f * LOG2E;
}
namespace pg8 {
#define PG8_LAS __attribute__((address_space(3)))
typedef unsigned short bf16_t;
typedef short bf16x8 __attribute__((ext_vector_type(8)));
typedef float f32x4 __attribute__((ext_vector_type(4)));
typedef unsigned u32x4 __attribute__((ext_vector_type(4)));
constexpr int BM = 256, BK = 64, HALF = 128, HTB = HALF * BK * 2  , STAGE_BYTES = 8 * HTB, NXCD = 8, WGM = 8;

__host__ __device__ __forceinline__ int lds_byte(int r, int c) { const int st = (r >> 4) * 2 + (c >> 5), rr = r & 15, cc = c & 31, ob = rr * 64 + cc * 2; return st * 1024 + (ob ^ (((ob >> 9) & 1) << 5)); }
__host__ __device__ __forceinline__ void stage_rc(int b, int& R, int& C) { const int st = b / 1024, sb = b % 1024, swz = sb ^ (((sb >> 9) & 1) << 5); R = (st >> 1) * 16 + swz / 64; C = (st & 1) * 32 + (swz % 64) / 2; }
__host__ __device__ __forceinline__ int perm32(int rho) { const int n = rho >> 4, i = rho & 15; return 8 * (i >> 2) + 4 * n + (i & 3); }

struct Unit { int pm, pn; };
struct Gemm { const bf16_t* A; const bf16_t* Bt; int M, N, K; };

struct StaticOrder {
    int nM, nN, nwg, G, c, wgm;
    __host__ __device__ void init(int M, int N, int G_, int c_, int wgm_ = WGM) { nM = M / BM; nN = N / BM; nwg = nM * nN; G = G_; c = c_; wgm = wgm_; }
    __host__ __device__ bool next(int i, Unit& u) const {
        const long L = (long)i * G + c; if (L >= nwg) return false;
        int wgid = (int)L; { const int q = nwg / NXCD, r = nwg % NXCD, xcd = wgid % NXCD, off = wgid / NXCD; wgid = (xcd < r ? xcd * (q + 1) : r * (q + 1) + (xcd - r) * q) + off; }
        const int nig = wgm * nN, gid = wgid / nig, fm = gid * wgm, gsz = (nM - fm) < wgm ? (nM - fm) : wgm;
        u.pm = fm + ((wgid % nig) % gsz); u.pn = (wgid % nig) / gsz; return true;
    }
    __device__ __forceinline__ void a_ready(const Unit&) const {}
    __device__ __forceinline__ void done(const Unit&) const {}
};

__device__ __forceinline__ unsigned cvt_pk_bf16(float lo, float hi) { unsigned r; asm volatile("v_cvt_pk_bf16_f32 %0, %1, %2" : "=v"(r) : "v"(lo), "v"(hi)); return r; }
typedef float f32x2 __attribute__((ext_vector_type(2)));

struct EpiSwiglu {
    static constexpr bool PERM = true, AFTER_DRAIN = false, PROBE_TWICE = true;
    bf16_t* H; const unsigned long long* rss;
    __device__ __forceinline__ void operator()(const f32x4 (&acc)[2][2][4][2], const Unit& u, int wr, int wc, int fr, int fq) const {
        const int row0 = u.pm * BM + wr * 64 + fr, col0 = u.pn * 128 + wc * 32 + 8 * fq;
        float rv[2][4];
#pragma unroll
        for (int ai = 0; ai < 2; ++ai)
#pragma unroll
            for (int m = 0; m < 4; ++m) rv[ai][m] = (float)rss[row0 + ai * HALF + m * 16] * 2.3283064365386963e-10f;
#pragma unroll
        for (int ai = 0; ai < 2; ++ai)
#pragma unroll
            for (int m = 0; m < 4; ++m) {
                bf16_t* rowp = H + (unsigned)((row0 + ai * HALF + m * 16) * cfg::DFF + col0);
                const float rinv = __builtin_amdgcn_rsqf(rv[ai][m] * (1.0f / cfg::DM) + cfg::EPS);
                float hv[8];
#pragma unroll
                for (int n = 0; n < 2; ++n)
#pragma unroll
                    for (int j = 0; j < 4; ++j) {
                        const float g = acc[ai][0][m][n][j] * rinv, up = acc[ai][1][m][n][j] * rinv;
                        const float e = __builtin_amdgcn_exp2f(-g * cfg::LOG2E);
                        hv[n * 4 + j] = (g * up) * __builtin_amdgcn_rcpf(1.0f + e);
                    }
                u32x4 w; w.x = cvt_pk_bf16(hv[0], hv[1]); w.y = cvt_pk_bf16(hv[2], hv[3]); w.z = cvt_pk_bf16(hv[4], hv[5]); w.w = cvt_pk_bf16(hv[6], hv[7]);
                *(u32x4*)rowp = w;
                asm volatile("" ::: "memory");
            }
    }
};
__device__ __forceinline__ f32x4 bf16x4_lo(u32x4 w, int h) { f32x4 r; const unsigned a = h ? w.z : w.x, b = h ? w.w : w.y;
    r[0] = __uint_as_float(a << 16); r[1] = __uint_as_float(a & 0xffff0000u); r[2] = __uint_as_float(b << 16); r[3] = __uint_as_float(b & 0xffff0000u); return r; }
struct EpiResid {
    static constexpr bool PERM = true, AFTER_DRAIN = false, PROBE_TWICE = false;
    bf16_t* R; float alpha; unsigned long long* rssw;
    __device__ __forceinline__ void operator()(const f32x4 (&acc)[2][2][4][2], const Unit& u, int wr, int wc, int fr, int fq) const {
        bf16_t* rb = R + (size_t)u.pm * BM * cfg::DM;
        const unsigned off0 = (unsigned)(wr * 64 + fr) * cfg::DM + (unsigned)(u.pn * BM + wc * 32 + 8 * fq);
        float sel[2] = {0.f, 0.f};
        u32x4 vq[4][2];
#define RES_LOAD(S, it_) do { const unsigned o_ = off0 + (unsigned)(((it_) >> 2) * HALF + ((it_) & 3) * 16) * cfg::DM; \
        vq[S][0] = *(const u32x4*)(rb + o_); vq[S][1] = *(const u32x4*)(rb + o_ + HALF); } while (0)
#define RES_DO(S, it_) do { const int ai = (it_) >> 2, m = (it_) & 3; const unsigned off = off0 + (unsigned)(ai * HALF + m * 16) * cfg::DM; float ss = 0.f; \
        _Pragma("unroll") for (int bj = 0; bj < 2; ++bj) { const f32x4 o0 = bf16x4_lo(vq[S][bj], 0) + acc[ai][bj][m][0] * alpha, o1 = bf16x4_lo(vq[S][bj], 1) + acc[ai][bj][m][1] * alpha; \
            ss += (o0[0] * o0[0] + o0[1] * o0[1]) + (o0[2] * o0[2] + o0[3] * o0[3]) + (o1[0] * o1[0] + o1[1] * o1[1]) + (o1[2] * o1[2] + o1[3] * o1[3]); \
            u32x4 w; w.x = cvt_pk_bf16(o0[0], o0[1]); w.y = cvt_pk_bf16(o0[2], o0[3]); w.z = cvt_pk_bf16(o1[0], o1[1]); w.w = cvt_pk_bf16(o1[2], o1[3]); \
            *(u32x4*)(rb + off + bj * HALF) = w; } \
        if (rssw) { ss += __shfl_xor(ss, 16); ss += __shfl_xor(ss, 32); if (fq == m) sel[ai] = ss; } } while (0)
        RES_LOAD(0, 0); RES_LOAD(1, 1); RES_LOAD(2, 2);
        RES_LOAD(3, 3); RES_DO(0, 0); asm volatile("" ::: "memory");
        RES_LOAD(0, 4); RES_DO(1, 1); asm volatile("" ::: "memory");
        RES_LOAD(1, 5); RES_DO(2, 2); asm volatile("" ::: "memory");
        RES_LOAD(2, 6); RES_DO(3, 3); asm volatile("" ::: "memory");
        RES_LOAD(3, 7); RES_DO(0, 4); asm volatile("" ::: "memory");
        RES_DO(1, 5); asm volatile("" ::: "memory");
        RES_DO(2, 6); asm volatile("" ::: "memory");
        RES_DO(3, 7); asm volatile("" ::: "memory");
#undef RES_LOAD
#undef RES_DO
        if (rssw) {
#pragma unroll
            for (int ai = 0; ai < 2; ++ai) atomicAdd(rssw + u.pm * BM + wr * 64 + ai * HALF + fq * 16 + fr, (unsigned long long)(sel[ai] * 4294967296.0f));
        }
    }
};
struct EpiWin {
    static constexpr bool PERM = true, AFTER_DRAIN = false, PROBE_TWICE = false;
    bf16_t* QKV; const float* gq; const float* gk; const unsigned long long* rss; unsigned* nrm2;
    __device__ __forceinline__ void operator()(const f32x4 (&acc)[2][2][4][2], const Unit& u, int wr, int wc, int fr, int fq) const {
        const int pn = u.pn;
        int kind = 0; float sc = 1.f;
        if (pn < 2) { kind = 1; sc = cfg::C2; }
        else if (pn == 2) { kind = (wc < 2) ? 2 : 0; }
        else if (pn == 3 || pn == 4 || pn == 9 || pn == 10 || pn == 15 || pn == 16) sc = cfg::C2;
        const int row0 = u.pm * BM + wr * 64 + fr;
        const int colb = pn * 256 + wc * 64 + 8 * fq;
        float rv[2][4];
#pragma unroll
        for (int ai = 0; ai < 2; ++ai)
#pragma unroll
            for (int m = 0; m < 4; ++m) rv[ai][m] = (float)rss[row0 + ai * HALF + m * 16] * 2.3283064365386963e-10f;
        if (kind == 0) {
            const bool want = (pn >= 3 && pn <= 6) || (pn >= 9 && pn <= 12) || (pn >= 15 && pn <= 18);
            float nmax = 0.f;
#pragma unroll
            for (int ai = 0; ai < 2; ++ai)
#pragma unroll
                for (int m = 0; m < 4; ++m) {
                    bf16_t* rowp = QKV + (unsigned)((row0 + ai * HALF + m * 16) * cfg::NIN + colb);
                    const float rs_ = __builtin_amdgcn_rsqf(rv[ai][m] * (1.0f / cfg::DM) + cfg::EPS) * sc;
                    float ss = 0.f;
#pragma unroll
                    for (int bj = 0; bj < 2; ++bj) { const f32x4 v0 = acc[ai][bj][m][0] * rs_, v1 = acc[ai][bj][m][1] * rs_;
                        ss += (v0[0] * v0[0] + v0[1] * v0[1]) + (v0[2] * v0[2] + v0[3] * v0[3]) + (v1[0] * v1[0] + v1[1] * v1[1]) + (v1[2] * v1[2] + v1[3] * v1[3]);
                        u32x4 w; w.x = cvt_pk_bf16(v0[0], v0[1]); w.y = cvt_pk_bf16(v0[2], v0[3]); w.z = cvt_pk_bf16(v1[0], v1[1]); w.w = cvt_pk_bf16(v1[2], v1[3]);
                        *(u32x4*)(rowp + 32 * bj) = w; }
                    if (want) { ss += __shfl_xor(ss, 16); ss += __shfl_xor(ss, 32); nmax = fmaxf(nmax, ss); }
                    asm volatile("" ::: "memory");
                }
            if (want) {
                float t = nmax;
                t = fmaxf(t, __shfl_xor(t, 1)); t = fmaxf(t, __shfl_xor(t, 2)); t = fmaxf(t, __shfl_xor(t, 4)); t = fmaxf(t, __shfl_xor(t, 8));
                const int rowt = u.pm * BM; const int seq = rowt < cfg::MP ? (rowt >> 14) : 2 + ((rowt - cfg::MP) >> 13);
                if ((fr | fq) == 0) atomicMax(nrm2 + (4 * pn + wc) * 4 + seq, __float_as_uint(t));
            }
        } else {
            const float* g = (kind == 1) ? gq : gk;
            float invrev[2][2];
#pragma unroll
            for (int n = 0; n < 2; ++n)
#pragma unroll
                for (int jj = 0; jj < 2; ++jj) invrev[n][jj] = __builtin_amdgcn_exp2f(-(float)(4 * fq + 2 * n + jj) * (13.287712379549449f / 16.0f)) * 0.15915494309189535f;
#pragma unroll
            for (int ai = 0; ai < 2; ++ai)
#pragma unroll
                for (int m = 0; m < 4; ++m) {
                    const int row = row0 + ai * HALF + m * 16;
                    const int t = (row < cfg::MP) ? (row & (cfg::TP - 1)) : (row & (cfg::TS - 1));
                    float prow = (float)(t >> 6), pcol = (float)(row & 63);
                    asm volatile("" : "+v"(prow), "+v"(pcol) :: "memory");
                    float ss = 0.f;
#pragma unroll
                    for (int bj = 0; bj < 2; ++bj)
#pragma unroll
                        for (int n = 0; n < 2; ++n) { const f32x4 v = acc[ai][bj][m][n]; ss += (v[0] * v[0] + v[1] * v[1]) + (v[2] * v[2] + v[3] * v[3]); }
                    ss += __shfl_xor(ss, 16); ss += __shfl_xor(ss, 32);
                    const float rw = __builtin_amdgcn_rsqf(rv[ai][m] * (1.0f / cfg::DM) + cfg::EPS);
                    const float rinv = rw * __builtin_amdgcn_rsqf(ss * rw * rw * (1.0f / 64.0f) + cfg::EPS);
                    bf16_t* rowp = QKV + (unsigned)(row * cfg::NIN + colb);
#pragma unroll
                    for (int bj = 0; bj < 2; ++bj) {
                        const float pos = bj ? pcol : prow;
                        float o[8];
#pragma unroll
                        for (int n = 0; n < 2; ++n) {
                            const f32x4 y = acc[ai][bj][m][n] * rinv * *(const f32x4*)(g + 32 * bj + 8 * fq + 4 * n);
#pragma unroll
                            for (int jj = 0; jj < 2; ++jj) {
                                const float rev = __builtin_amdgcn_fractf(pos * invrev[n][jj]);
                                const float sn = __builtin_amdgcn_sinf(rev), cs = __builtin_amdgcn_cosf(rev);
                                const float x1 = y[2 * jj], x2 = y[2 * jj + 1];
                                o[4 * n + 2 * jj] = (x1 * cs - x2 * sn) * sc; o[4 * n + 2 * jj + 1] = (x1 * sn + x2 * cs) * sc;
                            }
                        }
                        u32x4 w; w.x = cvt_pk_bf16(o[0], o[1]); w.y = cvt_pk_bf16(o[2], o[3]); w.z = cvt_pk_bf16(o[4], o[5]); w.w = cvt_pk_bf16(o[6], o[7]);
                        *(u32x4*)(rowp + 32 * bj) = w;
                        asm volatile("" ::: "memory");
                    }
                }
        }
    }
};

template <class Epi, class Sched, bool ALIGN_EPI = false, bool SP2 = false>
__device__ __forceinline__ void gemm_phase(PG8_LAS unsigned char* lds, const Gemm g, const Sched& S, const Epi& E) {
    int tid_ = threadIdx.x; asm volatile("" : "+v"(tid_));
    const int tid = tid_, wid = __builtin_amdgcn_readfirstlane(tid >> 6), lane = tid & 63, wr = wid >> 2, wc = wid & 3, fr = lane & 15, fq = lane >> 4;
    const int K = g.K, nt = K / BK;
    unsigned voffA[2], voffB[2];
#pragma unroll
    for (int i = 0; i < 2; ++i) { int R, C; stage_rc(tid * 16 + i * 8192, R, C); const int Rb = Epi::PERM ? ((R & ~31) + perm32(R & 31)) : R;
        voffA[i] = (unsigned)(R * K + C) * 2u; voffB[i] = (unsigned)(Rb * K + C) * 2u; }
    const size_t kstep = (size_t)(BK * 2);
    const size_t hstep = (size_t)HALF * K * 2;
    const size_t tstep = 2 * hstep;
    const unsigned ldsw = (unsigned)wid * 1024u;
    const int aoff = lds_byte(wr * 64 + fr, fq * 8), boff = lds_byte(wc * 32 + fr, fq * 8);
#define PG8_SA(b, h) (((b) * 2 + (h)) * HTB)
#define PG8_SB(b, h) ((4 + (b) * 2 + (h)) * HTB)
#define PG8_STAGE(bufoff, gbase, voff) do { _Pragma("unroll") for (int _i = 0; _i < 2; ++_i) \
        __builtin_amdgcn_global_load_lds((const unsigned*)((const char*)(gbase) + (voff)[_i]), (PG8_LAS unsigned*)(lds + (bufoff) + ldsw + _i * 8192), 16, 0, 0); } while (0)
#define PG8_LDA(dst, b, h) do { _Pragma("unroll") for (int m = 0; m < 4; ++m) _Pragma("unroll") for (int k = 0; k < 2; ++k) dst[m][k] = *(const PG8_LAS bf16x8*)(lds + PG8_SA(b, h) + aoff + m * 2048 + k * 1024); } while (0)
#define PG8_LDB(dst, b, h) do { _Pragma("unroll") for (int n = 0; n < 2; ++n) _Pragma("unroll") for (int k = 0; k < 2; ++k) dst[n][k] = *(const PG8_LAS bf16x8*)(lds + PG8_SB(b, h) + boff + n * 2048 + k * 1024); } while (0)
#define PG8_MMA(ai, bj, At, Bt) do { __builtin_amdgcn_s_setprio(1); _Pragma("unroll") for (int m = 0; m < 4; ++m) _Pragma("unroll") for (int n = 0; n < 2; ++n) _Pragma("unroll") for (int k = 0; k < 2; ++k) \
        acc[ai][bj][m][n] = __builtin_amdgcn_mfma_f32_16x16x32_bf16(Bt[n][k], At[m][k], acc[ai][bj][m][n], 0, 0, 0); __builtin_amdgcn_s_setprio(0); } while (0)
#define PG8_WAIT_V(n) asm volatile("s_waitcnt vmcnt(" #n ")" ::: "memory")
#define PG8_WAIT_L(n) asm volatile("s_waitcnt lgkmcnt(" #n ")" ::: "memory")
#define PG8_BAR __builtin_amdgcn_s_barrier()
#define PG8_SCHED __builtin_amdgcn_sched_barrier(0)
    Unit cur, nxt; int ui = 0;
    if (!S.next(0, cur)) return;
    f32x4 acc[2][2][4][2];
#pragma unroll
    for (int a = 0; a < 2; ++a)
#pragma unroll
        for (int b = 0; b < 2; ++b)
#pragma unroll
            for (int m = 0; m < 4; ++m)
#pragma unroll
                for (int n = 0; n < 2; ++n) acc[a][b][m][n] = (f32x4){0.f, 0.f, 0.f, 0.f};
    bf16x8 At[4][2], B0[2][2], B1[2][2];
    const char* cA = (const char*)g.A + (size_t)cur.pm * tstep; const char* cB = (const char*)g.Bt + (size_t)cur.pn * tstep;
    S.a_ready(cur);
    if constexpr (SP2) {
        PG8_STAGE(PG8_SB(0, 0), cB, voffB); PG8_STAGE(PG8_SB(0, 1), cB + hstep, voffB); PG8_STAGE(PG8_SA(0, 0), cA, voffA); PG8_STAGE(PG8_SA(0, 1), cA + hstep, voffA);
        if (wr == 1) PG8_BAR;
        PG8_WAIT_V(2); PG8_BAR;
        PG8_STAGE(PG8_SB(1, 0), cB + kstep, voffB); PG8_STAGE(PG8_SA(1, 0), cA + kstep, voffA); PG8_STAGE(PG8_SB(1, 1), cB + hstep + kstep, voffB);
        PG8_WAIT_V(6); PG8_BAR;
    } else {
        PG8_STAGE(PG8_SB(0, 0), cB, voffB); PG8_STAGE(PG8_SA(0, 0), cA, voffA); PG8_STAGE(PG8_SB(0, 1), cB + hstep, voffB); PG8_STAGE(PG8_SA(0, 1), cA + hstep, voffA);
        if (wr == 1) PG8_BAR;
        PG8_WAIT_V(4); PG8_BAR;
        PG8_STAGE(PG8_SB(1, 0), cB + kstep, voffB); PG8_STAGE(PG8_SA(1, 0), cA + kstep, voffA); PG8_STAGE(PG8_SB(1, 1), cB + hstep + kstep, voffB);
        PG8_WAIT_V(6); PG8_BAR;
    }
    for (;;) {
        const bool has_next = S.next(ui + 1, nxt);
        const char* nA = has_next ? (const char*)g.A + (size_t)nxt.pm * tstep : cA; const char* nB = has_next ? (const char*)g.Bt + (size_t)nxt.pn * tstep : cB;
        for (int t = 0; t < nt; t += 2) {
            const bool last = (t == nt - 2);
            const char* a1 = cA + (size_t)(t + 1) * kstep;
            const char* a2 = last ? nA : cA + (size_t)(t + 2) * kstep; const char* b2 = last ? nB : cB + (size_t)(t + 2) * kstep;
            const char* a3 = a2 + kstep; const char* b3 = b2 + kstep;
            if (last && has_next) S.a_ready(nxt);
            if constexpr (SP2) {
            PG8_LDB(B0, 0, 0); PG8_LDB(B1, 0, 1); PG8_SCHED; PG8_LDA(At, 0, 0); PG8_STAGE(PG8_SA(1, 1), a1 + hstep, voffA);
            PG8_WAIT_V(8); PG8_WAIT_L(0); PG8_BAR; PG8_MMA(0, 0, At, B0); PG8_MMA(0, 1, At, B1); PG8_BAR; PG8_SCHED;
            PG8_LDA(At, 0, 1); PG8_STAGE(PG8_SB(0, 0), b2, voffB); PG8_STAGE(PG8_SB(0, 1), b2 + hstep, voffB); PG8_STAGE(PG8_SA(0, 0), a2, voffA);
            PG8_WAIT_V(8); PG8_WAIT_L(0); PG8_BAR; PG8_MMA(1, 0, At, B0); PG8_MMA(1, 1, At, B1); PG8_BAR; PG8_SCHED;
            PG8_LDB(B0, 1, 0); PG8_LDB(B1, 1, 1); PG8_SCHED; PG8_LDA(At, 1, 0); PG8_STAGE(PG8_SA(0, 1), a2 + hstep, voffA);
            PG8_WAIT_V(8); PG8_WAIT_L(0); PG8_BAR; PG8_MMA(0, 0, At, B0); PG8_MMA(0, 1, At, B1); PG8_BAR; PG8_SCHED;
            PG8_LDA(At, 1, 1); PG8_STAGE(PG8_SB(1, 0), b3, voffB); PG8_STAGE(PG8_SB(1, 1), b3 + hstep, voffB); PG8_STAGE(PG8_SA(1, 0), a3, voffA);
            PG8_WAIT_V(8); PG8_WAIT_L(0); PG8_BAR; PG8_MMA(1, 0, At, B0); PG8_MMA(1, 1, At, B1); PG8_BAR; PG8_SCHED;
            } else {
            PG8_LDB(B0, 0, 0); PG8_SCHED; PG8_LDA(At, 0, 0); PG8_STAGE(PG8_SA(1, 1), a1 + hstep, voffA);
            PG8_WAIT_L(8); PG8_BAR; PG8_WAIT_L(0); PG8_MMA(0, 0, At, B0); PG8_BAR; PG8_SCHED;
            PG8_LDB(B1, 0, 1); PG8_STAGE(PG8_SB(0, 0), b2, voffB);
            PG8_BAR; PG8_WAIT_L(0); PG8_MMA(0, 1, At, B1); PG8_BAR;
            PG8_LDA(At, 0, 1); PG8_STAGE(PG8_SA(0, 0), a2, voffA);
            PG8_BAR; PG8_WAIT_L(0); PG8_MMA(1, 0, At, B0); PG8_BAR; PG8_SCHED;
            PG8_STAGE(PG8_SB(0, 1), b2 + hstep, voffB);
            PG8_WAIT_V(6); PG8_BAR; PG8_MMA(1, 1, At, B1); PG8_BAR;
            PG8_LDB(B0, 1, 0); PG8_SCHED; PG8_LDA(At, 1, 0); PG8_STAGE(PG8_SA(0, 1), a2 + hstep, voffA);
            PG8_WAIT_L(8); PG8_BAR; PG8_WAIT_L(0); PG8_MMA(0, 0, At, B0); PG8_BAR; PG8_SCHED;
            PG8_LDB(B1, 1, 1); PG8_STAGE(PG8_SB(1, 0), b3, voffB);
            PG8_BAR; PG8_WAIT_L(0); PG8_MMA(0, 1, At, B1); PG8_BAR;
            PG8_LDA(At, 1, 1); PG8_STAGE(PG8_SA(1, 0), a3, voffA);
            PG8_BAR; PG8_WAIT_L(0); PG8_MMA(1, 0, At, B0); PG8_BAR; PG8_SCHED;
            PG8_STAGE(PG8_SB(1, 1), b3 + hstep, voffB);
            PG8_WAIT_V(6); PG8_BAR; PG8_MMA(1, 1, At, B1); PG8_BAR;
            }
        }
        if constexpr (ALIGN_EPI) { if (wr == 0) PG8_BAR; }
        if constexpr (!Epi::AFTER_DRAIN) { E(acc, cur, wr, wc, fr, fq);
#if defined(PROBE_EPI2)
            if constexpr (Epi::PROBE_TWICE) { asm volatile("" ::: "memory"); E(acc, cur, wr, wc, fr, fq); }
#endif
            S.done(cur); }
        if (!has_next) break;
#pragma unroll
        for (int a = 0; a < 2; ++a)
#pragma unroll
            for (int b = 0; b < 2; ++b)
#pragma unroll
                for (int m = 0; m < 4; ++m)
#pragma unroll
                    for (int n = 0; n < 2; ++n) acc[a][b][m][n] = (f32x4){0.f, 0.f, 0.f, 0.f};
        cur = nxt; cA = nA; cB = nB; ++ui;
        if constexpr (ALIGN_EPI) { if (wr == 1) PG8_BAR; }
    }
    PG8_WAIT_V(0);
    if constexpr (!ALIGN_EPI) { if (wr == 0) PG8_BAR; }
    PG8_BAR;
    if constexpr (Epi::AFTER_DRAIN) { E.fused(acc, cur, wr, wc, fr, fq, lds, wid, lane); S.done(cur); }
#undef PG8_SA
#undef PG8_SB
#undef PG8_STAGE
#undef PG8_LDA
#undef PG8_LDB
#undef PG8_MMA
#undef PG8_WAIT_V
#undef PG8_WAIT_L
#undef PG8_BAR
#undef PG8_SCHED
}
}
namespace att {
#define ATT_LAS __attribute__((address_space(3)))
using bf16x8 = __attribute__((ext_vector_type(8))) short;
using s16x4  = __attribute__((ext_vector_type(4))) short;
using f32x16 = __attribute__((ext_vector_type(16))) float;
using u32x4  = __attribute__((ext_vector_type(4))) unsigned;
typedef unsigned short bf16_t;
typedef ATT_LAS char* lptr;
constexpr int PITCH = cfg::NIN, OPITCH = cfg::DM;
constexpr float LOG2E = cfg::LOG2E, NEG = -1e30f, THR = 8.f;
#ifndef ATT_RING_B
#define ATT_RING_B 1
#endif
template <bool RING> struct Map { static constexpr int L_K = 0, L_V = RING ? 49152 : 32768, L_WS = RING ? 98304 : 65536, L_LUT = RING ? 100352 : 67584, L_OST = RING ? 65536 : 81920, L_END = RING ? 112640 : 114688; };
constexpr int L_END = 114688;
constexpr int LUTB_R = 704, LUTD_R = 1344;
#define ATT_SBAR() __builtin_amdgcn_sched_barrier(0)
__device__ __forceinline__ int crow(int r, int hi) { return (r & 3) + 8 * (r >> 2) + 4 * hi; }
__device__ __forceinline__ unsigned cvtpk(float lo, float hi) { unsigned r; asm volatile("v_cvt_pk_bf16_f32 %0, %1, %2" : "=v"(r) : "v"(lo), "v"(hi)); return r; }
__device__ __forceinline__ float wave_sum(float v) {
#pragma unroll
    for (int o = 1; o < 64; o <<= 1) v += __shfl_xor(v, o);
    return v;
}
__device__ __forceinline__ int t5_bucket(int rel) {
    const int n = rel < 0 ? -rel : rel;
    int b = n;
    if (n >= 8) b = 8 + (n >= 15) + (n >= 27) + (n >= 50) + (n >= 91) + (n >= 166) + (n >= 305) + (n >= 559);
    return b + (rel > 0 ? 16 : 0);
}
template <int KC> __device__ __forceinline__ int kswz(int row, int colB) { return KC == 128 ? row * 256 + (colB ^ ((row & 7) << 4)) : row * 128 + (colB ^ (((row >> 1) & 7) << 4)); }
template <int NCB> __device__ __forceinline__ int v_st(int k, int c) { const int kk = k; return ((kk >> 3) * NCB + (c >> 5)) * 512 + ((kk & 7) * 32 + (c & 31)) * 2; }
__device__ __forceinline__ int v_rd_base(int lane) { return ((lane & 3) << 3) | (((lane >> 2) & 3) << 6) | (((lane >> 4) & 1) << 5) | (((lane >> 5) & 1) << 8); }
template <int OFF> __device__ __forceinline__ s16x4 tr_read(int vb) { s16x4 r; asm volatile("ds_read_b64_tr_b16 %0, %1 offset:%2" : "=&v"(r) : "v"(vb), "i"(OFF) : "memory"); return r; }
template <int NCB, int D0> __device__ __forceinline__ void pv_one(f32x16& od, int vb, bf16x8 pa0, bf16x8 pa1, bf16x8 pa2, bf16x8 pa3) {
#define ATT_VOFF(ks, half) (D0 * 512 + (ks) * (NCB * 1024) + (half) * (NCB * 512))
    const s16x4 l0 = tr_read<ATT_VOFF(0, 0)>(vb), h0 = tr_read<ATT_VOFF(0, 1)>(vb), l1 = tr_read<ATT_VOFF(1, 0)>(vb), h1 = tr_read<ATT_VOFF(1, 1)>(vb);
    const s16x4 l2 = tr_read<ATT_VOFF(2, 0)>(vb), h2 = tr_read<ATT_VOFF(2, 1)>(vb), l3 = tr_read<ATT_VOFF(3, 0)>(vb), h3 = tr_read<ATT_VOFF(3, 1)>(vb);
#undef ATT_VOFF
    asm volatile("s_waitcnt lgkmcnt(0)" ::: "memory"); ATT_SBAR();
#define ATT_PK(L, H) (bf16x8){L[0], L[1], L[2], L[3], H[0], H[1], H[2], H[3]}
    od = __builtin_amdgcn_mfma_f32_32x32x16_bf16(pa0, ATT_PK(l0, h0), od, 0, 0, 0);
    od = __builtin_amdgcn_mfma_f32_32x32x16_bf16(pa1, ATT_PK(l1, h1), od, 0, 0, 0);
    od = __builtin_amdgcn_mfma_f32_32x32x16_bf16(pa2, ATT_PK(l2, h2), od, 0, 0, 0);
    od = __builtin_amdgcn_mfma_f32_32x32x16_bf16(pa3, ATT_PK(l3, h3), od, 0, 0, 0);
#undef ATT_PK
}
template <int NCB, bool ONES> __device__ __forceinline__ void pv_all(f32x16* o, f32x16& lacc, int vb, bf16x8 pa0, bf16x8 pa1, bf16x8 pa2, bf16x8 pa3) {
    if constexpr (ONES) { const bf16x8 ones = {0x3F80, 0x3F80, 0x3F80, 0x3F80, 0x3F80, 0x3F80, 0x3F80, 0x3F80};
        lacc = __builtin_amdgcn_mfma_f32_32x32x16_bf16(pa0, ones, lacc, 0, 0, 0); lacc = __builtin_amdgcn_mfma_f32_32x32x16_bf16(pa1, ones, lacc, 0, 0, 0);
        lacc = __builtin_amdgcn_mfma_f32_32x32x16_bf16(pa2, ones, lacc, 0, 0, 0); lacc = __builtin_amdgcn_mfma_f32_32x32x16_bf16(pa3, ones, lacc, 0, 0, 0); }
    pv_one<NCB, 0>(o[0], vb, pa0, pa1, pa2, pa3); pv_one<NCB, 1>(o[1], vb, pa0, pa1, pa2, pa3);
    if constexpr (NCB == 4) { pv_one<NCB, 2>(o[2], vb, pa0, pa1, pa2, pa3); pv_one<NCB, 3>(o[3], vb, pa0, pa1, pa2, pa3); }
}
template <bool NOMAX> __device__ __forceinline__ void partialSM(f32x16& p0, f32x16& p1, float cb, float& m_reg, float& alpha) {
    if constexpr (NOMAX) { alpha = 1.f;
        (void)cb;
#pragma unroll
        for (int r = 0; r < 16; ++r) p0[r] = __builtin_amdgcn_exp2f(p0[r]);
        return; }
    float ma = fmaxf(p0[0], p0[1]), mb = fmaxf(p0[2], p0[3]), mc = fmaxf(p1[0], p1[1]), md = fmaxf(p1[2], p1[3]);
#pragma unroll
    for (int r = 4; r < 16; r += 4) { ma = fmaxf(fmaxf(ma, p0[r]), p0[r + 1]); mb = fmaxf(fmaxf(mb, p0[r + 2]), p0[r + 3]); mc = fmaxf(fmaxf(mc, p1[r]), p1[r + 1]); md = fmaxf(fmaxf(md, p1[r + 2]), p1[r + 3]); }
    float pmax = fmaxf(fmaxf(ma, mb), fmaxf(mc, md));
    { auto rr = __builtin_amdgcn_permlane32_swap(__float_as_uint(pmax), __float_as_uint(pmax), false, false); pmax = fmaxf(__uint_as_float(rr[0]), __uint_as_float(rr[1])); }
    pmax += cb;
    float mn;
    if (__builtin_expect(__all(pmax - m_reg <= THR), 1)) { mn = m_reg; alpha = 1.f; }
    else { mn = fmaxf(m_reg, pmax); alpha = __builtin_amdgcn_exp2f(m_reg - mn); m_reg = mn; }
    const float sub = cb - mn;
#pragma unroll
    for (int r = 0; r < 16; ++r) p0[r] += sub;
#pragma unroll
    for (int r = 0; r < 16; ++r) p1[r] += sub;
#pragma unroll
    for (int r = 0; r < 16; ++r) p0[r] = __builtin_amdgcn_exp2f(p0[r]);
}
template <bool ONES> __device__ __forceinline__ void finishSM(f32x16& p0, f32x16& p1, float alpha, float& l_reg, bf16x8& pa0, bf16x8& pa1, bf16x8& pa2, bf16x8& pa3) {
#pragma unroll
    for (int r = 0; r < 16; ++r) p1[r] = __builtin_amdgcn_exp2f(p1[r]);
    if constexpr (!ONES) {
    float sa = p0[0] + p0[1], sb = p0[2] + p0[3], sc_ = p1[0] + p1[1], sd = p1[2] + p1[3];
#pragma unroll
    for (int r = 4; r < 16; r += 4) { sa += p0[r]; sa += p0[r + 1]; sb += p0[r + 2]; sb += p0[r + 3]; sc_ += p1[r]; sc_ += p1[r + 1]; sd += p1[r + 2]; sd += p1[r + 3]; }
    float ps = (sa + sb) + (sc_ + sd);
    { auto rr = __builtin_amdgcn_permlane32_swap(__float_as_uint(ps), __float_as_uint(ps), false, false); ps = __uint_as_float(rr[0]) + __uint_as_float(rr[1]); }
    l_reg = l_reg * alpha + ps;
    }
#define ATT_PK4(P, BASE, OUT) do { unsigned a0 = cvtpk(P[BASE + 0], P[BASE + 1]), a1 = cvtpk(P[BASE + 2], P[BASE + 3]);   \
    unsigned b0 = cvtpk(P[BASE + 4], P[BASE + 5]), b1 = cvtpk(P[BASE + 6], P[BASE + 7]);                              \
    u32x4 w = {a0, a1, b0, b1}; OUT = __builtin_bit_cast(bf16x8, w); } while (0)
    ATT_PK4(p0, 0, pa0); ATT_PK4(p0, 8, pa1); ATT_PK4(p1, 0, pa2); ATT_PK4(p1, 8, pa3);
#undef ATT_PK4
}
template <int KC, bool USEC> __device__ __forceinline__ void qkt(f32x16& p0, f32x16& p1, lptr Ks, int cb0, const bf16x8* qr, const f32x16& c0, int r32, int hi) {
    if constexpr (!USEC) { p0 = f32x16{}; p1 = f32x16{}; }
#pragma unroll
    for (int d0 = 0; d0 < 4; ++d0) { const int cb = cb0 + d0 * 32 + hi * 16;
        const bf16x8 b0 = *(const ATT_LAS bf16x8*)(Ks + kswz<KC>(r32, cb));
        const bf16x8 b1 = *(const ATT_LAS bf16x8*)(Ks + kswz<KC>(32 + r32, cb));
        if (USEC && d0 == 0) { p0 = __builtin_amdgcn_mfma_f32_32x32x16_bf16(b0, qr[0], c0, 0, 0, 0); p1 = __builtin_amdgcn_mfma_f32_32x32x16_bf16(b1, qr[0], c0, 0, 0, 0); }
        else { p0 = __builtin_amdgcn_mfma_f32_32x32x16_bf16(b0, qr[d0], p0, 0, 0, 0); p1 = __builtin_amdgcn_mfma_f32_32x32x16_bf16(b1, qr[d0], p1, 0, 0, 0); } }
}
struct Aux { const float* t5; const float* rpb; const float* lam_p; const float* subln; float lam_init; };

template <int MODE, bool NOMAX = false>
__device__ __forceinline__ void attn_unit(const bf16_t* __restrict__ QKV, bf16_t* __restrict__ ATT, lptr lds, int row0, int T, int h, int qb, const Aux& ax) {
#ifndef ATT_ONES
#define ATT_ONES 1
#endif
    constexpr bool ONES = (ATT_ONES != 0) && (MODE != 1);
    constexpr bool RING = (MODE != 0) && (ATT_RING_B != 0);
    constexpr int L_K = Map<RING>::L_K, L_V = Map<RING>::L_V, L_WS = Map<RING>::L_WS, L_LUT = Map<RING>::L_LUT, L_OST = Map<RING>::L_OST;
    constexpr int KC = (MODE == 1) ? 128 : 64, DV = (MODE == 1) ? 128 : 64, NCB = DV / 32, NR = KC / 64;
    constexpr int KBYTES = 64 * KC * 2, VBYTES = 64 * DV * 2, QROWS = (MODE == 1) ? 128 : 256;
    int tid_ = threadIdx.x; asm volatile("" : "+v"(tid_));
    const int tid = tid_, lane = tid & 63, r32 = lane & 31, hi = lane >> 5;
    const int wid = __builtin_amdgcn_readfirstlane(tid >> 6);
    const int map = (MODE == 1) ? (wid >> 2) : 0, wq = (MODE == 1) ? (wid & 3) : wid;
    const int q0 = qb * QROWS, qw = q0 + wq * 32, qpos = qw + r32;
    int qcol, kcol, vcol, ocol;
    if (MODE == 0)      { qcol = 64 * h;          kcol = 512 + 64 * (h >> 2); vcol = 640 + 64 * (h >> 2); ocol = 64 * h; }
    else if (MODE == 1) { qcol = 768 + 128 * h + 64 * map; kcol = 1280 + 128 * h; vcol = 1792 + 128 * h; ocol = 512 + 128 * h; }
    else if (MODE == 2) { qcol = 2304 + 64 * h;   kcol = 2816 + 64 * h;       vcol = 3328 + 64 * h;       ocol = 1024 + 64 * h; }
    else                { qcol = 3840 + 64 * h;   kcol = 4352 + 64 * h;       vcol = 4864 + 64 * h;       ocol = 1536 + 64 * h; }
    int tlo = 0, NT = T >> 6;
    if (MODE == 3) { int lo = q0 - 1024; lo = lo < 0 ? 0 : lo; int hi_k = q0 + 255 + 1024; hi_k = hi_k > T - 1 ? T - 1 : hi_k; int a = lo >> 6, b = hi_k >> 6;
        if (((b - a + 1) & 1) != 0) { if (a > 0) --a; else ++b; } tlo = a; NT = b - a + 1; }
    if (MODE == 2) { const int rows = T >> 6, R0 = 4 * qb; int a = R0 - 4; a = a < 0 ? 0 : (a > rows - 8 ? rows - 8 : a); int b = R0 - 1; b = b < 0 ? 0 : (b > rows - 8 ? rows - 8 : b); b += 7;
        if (((b - a + 1) & 1) != 0) { if (a > 0) --a; else ++b; } tlo = a; NT = b - a + 1; }
    const int sr = (KC == 128) ? (tid >> 4) : (tid >> 3), sc = (KC == 128) ? (tid & 15) * 8 : (tid & 7) * 8;
    const bf16_t* Kg = QKV + (size_t)(row0 + sr) * PITCH + kcol + sc;
    const bf16_t* Vg = QKV + (size_t)(row0 + sr) * PITCH + vcol + sc;
    const int kst0 = kswz<KC>(sr, sc * 2), kst1 = kswz<KC>(32 + sr, sc * 2), vst0 = v_st<NCB>(sr, sc), vst1 = v_st<NCB>(32 + sr, sc);
    const lptr K_lds = lds + L_K, V_lds = lds + L_V;
    const int vb0 = (int)(uintptr_t)V_lds + v_rd_base(lane);
    ATT_LAS float* wsf = (ATT_LAS float*)(lds + L_WS) + wid * 64; ATT_LAS float* li_l = wsf; ATT_LAS float* al_l = wsf + 32;
    struct { bf16x8 k[NR], v[NR]; } st_[2];
#define SLOAD(i, tt) do { const size_t ro_ = (size_t)((tlo + (tt)) * 64) * PITCH; st_[i].k[0] = *(const bf16x8*)(Kg + ro_); st_[i].v[0] = *(const bf16x8*)(Vg + ro_); \
        if constexpr (NR == 2) { st_[i].k[1] = *(const bf16x8*)(Kg + ro_ + (size_t)32 * PITCH); st_[i].v[1] = *(const bf16x8*)(Vg + ro_ + (size_t)32 * PITCH); } } while (0)
#define SWRITE(b, i) do { *(ATT_LAS bf16x8*)(K_lds + (b) * KBYTES + kst0) = st_[i].k[0]; *(ATT_LAS bf16x8*)(V_lds + (b) * VBYTES + vst0) = st_[i].v[0]; \
        if constexpr (NR == 2) { *(ATT_LAS bf16x8*)(K_lds + (b) * KBYTES + kst1) = st_[i].k[1]; *(ATT_LAS bf16x8*)(V_lds + (b) * VBYTES + vst1) = st_[i].v[1]; } } while (0)
#define SWAIT() do { if constexpr (NR == 2) asm volatile("s_waitcnt vmcnt(4)" ::: "memory"); else asm volatile("s_waitcnt vmcnt(2)" ::: "memory"); } while (0)
#define RESC(a) do { if (!NOMAX && __any((a) < 1.f)) { if (hi == 0) al_l[r32] = (a); asm volatile("s_waitcnt lgkmcnt(0)" ::: "memory"); \
        _Pragma("unroll") for (int r = 0; r < 16; ++r) { const float f_ = al_l[crow(r, hi)]; if (ONES) lacc[r] *= f_; _Pragma("unroll") for (int d = 0; d < NCB; ++d) o[d][r] *= f_; } } } while (0)
    SLOAD(0, 0); SLOAD(1, 1);
    bf16x8 qr[4];
    { const bf16_t* Qw = QKV + (size_t)(row0 + qpos) * PITCH + qcol + hi * 8;
#pragma unroll
      for (int d0 = 0; d0 < 4; ++d0) qr[d0] = *(const bf16x8*)(Qw + d0 * 16); }
    ATT_LAS float* lut = (ATT_LAS float*)(lds + L_LUT);
    if (MODE == 1) { for (int i = tid; i < 2 * LUTB_R + 1; i += 512) lut[i] = ax.t5[t5_bucket(i - LUTB_R) * 12 + h] * LOG2E; }
    if (MODE == 3) { for (int i = tid; i < 2 * LUTD_R + 1; i += 512) { const int rel = i - LUTD_R, n = rel < 0 ? -rel : rel;
            const int mult = (n <= 64 ? 1 : 0) + (((n & 3) == 0 && n <= 256) ? 1 : 0) + (((n & 15) == 0 && n <= 1024) ? 1 : 0);
            lut[i] = mult == 0 ? NEG : ax.t5[t5_bucket(rel) * 12 + 4 + h] * LOG2E + (mult == 1 ? 0.f : (mult == 2 ? 1.f : 1.5849625007211562f)); } }
    if (MODE == 2) { for (int i = tid; i < 15 * 128; i += 512) { const int dr = i >> 7, dc = (i & 127) - 48; lut[i] = (dc >= 0 && dc <= 30) ? ax.rpb[(h * 15 + dr) * 31 + dc] * LOG2E : NEG; } }
    float cL = 0.f, cR = 0.f; int c_cs = 0, c_rs = 0, c_R = 0, c_c = 0;
    if (MODE == 2) { const int rows = T >> 6; c_R = 4 * qb + (wid >> 1); c_c = 32 * (wid & 1) + r32; c_cs = c_c - 8; c_cs = c_cs < 0 ? 0 : (c_cs > 48 ? 48 : c_cs); c_rs = c_R - 4; c_rs = c_rs < 0 ? 0 : (c_rs > rows - 8 ? rows - 8 : c_rs); }
#define MODIFY(P0, P1, tt, CB) do { CB = 0.f; const int k0_ = (tlo + (tt)) * 64; \
        if constexpr (MODE == 1) { if (k0_ + 63 - qw <= -559) CB = cL; else if (k0_ - qw - 31 >= 559) CB = cR; else { const ATT_LAS float* lp_ = lut + (k0_ - qpos + LUTB_R + 4 * hi); \
            _Pragma("unroll") for (int r = 0; r < 16; ++r) { P0[r] += lp_[(r & 3) + 8 * (r >> 2)]; P1[r] += lp_[32 + (r & 3) + 8 * (r >> 2)]; } } } \
        if constexpr (MODE == 3) { const ATT_LAS float* lp_ = lut + (k0_ - qpos + LUTD_R + 4 * hi); \
            _Pragma("unroll") for (int r = 0; r < 16; ++r) { P0[r] += lp_[(r & 3) + 8 * (r >> 2)]; P1[r] += lp_[32 + (r & 3) + 8 * (r >> 2)]; } } \
        if constexpr (MODE == 2) { const int kr_ = tlo + (tt); if (kr_ < c_rs || kr_ > c_rs + 7) { _Pragma("unroll") for (int r = 0; r < 16; ++r) { P0[r] = NEG; P1[r] = NEG; } } \
            else { const ATT_LAS float* lp_ = lut + ((kr_ - c_R + 7) * 128 + 48 + 15 - c_c + 4 * hi); const int kb_ = 4 * hi - c_cs; \
              _Pragma("unroll") for (int r = 0; r < 16; ++r) { const int ko_ = (r & 3) + 8 * (r >> 2); const float a_ = lp_[ko_], b_ = lp_[32 + ko_]; \
                P0[r] = ((unsigned)(kb_ + ko_) <= 15u) ? P0[r] + a_ : NEG; P1[r] = ((unsigned)(kb_ + 32 + ko_) <= 15u) ? P1[r] + b_ : NEG; } } } \
    } while (0)
    __syncthreads();
    if (MODE == 1) { cL = lut[0]; cR = lut[2 * LUTB_R]; }
    constexpr bool USEC = false;
    float m_reg = NEG, l_reg = 0.f, cbcur = 0.f, cbacc = 0.f; f32x16 o[NCB], lacc = f32x16{}, cbt = f32x16{};
#define REGSC(CB) do { if constexpr (MODE == 1 && NOMAX) { if ((CB) != cbacc) { const float f_ = __builtin_amdgcn_exp2f(cbacc - (CB)); cbacc = (CB); l_reg *= f_; \
        _Pragma("unroll") for (int r = 0; r < 16; ++r) { if (ONES) lacc[r] *= f_; _Pragma("unroll") for (int d = 0; d < NCB; ++d) o[d][r] *= f_; } } } } while (0)
#define REGIONC(tt) do { if constexpr (USEC) { const int k0_ = (tlo + (tt)) * 64; const float cb_ = (k0_ + 63 - qw <= -559) ? cL : ((k0_ - qw - 31 >= 559) ? cR : 0.f); \
        if (cb_ != cbcur) { cbcur = cb_; _Pragma("unroll") for (int r = 0; r < 16; ++r) cbt[r] = cb_; } } } while (0)
#pragma unroll
    for (int d = 0; d < NCB; ++d) o[d] = f32x16{};
    f32x16 pA0, pA1, pB0, pB1; float alA, alB, cbA, cbB; bf16x8 pa0, pa1, pa2, pa3;
    const int cb0 = map * 128;
    if constexpr (RING) {
    int s_prev = 2, s_cur = 0, s_next = 1;
#define ROT() do { const int t_ = s_prev; s_prev = s_cur; s_cur = s_next; s_next = t_; } while (0)
    asm volatile("s_waitcnt vmcnt(0)" ::: "memory"); SWRITE(0, 0); if (2 < NT) SLOAD(0, 2); __syncthreads();
    SWAIT(); SWRITE(1, 1); if (3 < NT) SLOAD(1, 3);
    REGIONC(0); qkt<KC, USEC>(pA0, pA1, K_lds, cb0, qr, cbt, r32, hi); MODIFY(pA0, pA1, 0, cbA); partialSM<NOMAX>(pA0, pA1, cbA, m_reg, alA);
    __syncthreads(); ROT();
    for (int j = 1; j + 1 < NT; j += 2) {
        SWAIT(); SWRITE(s_next, 0); if (j + 3 < NT) SLOAD(0, j + 3);
        REGIONC(j); ATT_SBAR(); qkt<KC, USEC>(pB0, pB1, K_lds + s_cur * KBYTES, cb0, qr, cbt, r32, hi);
        REGSC(cbA); finishSM<ONES>(pA0, pA1, alA, l_reg, pa0, pa1, pa2, pa3); ATT_SBAR();
        pv_all<NCB, ONES>(o, lacc, vb0 + s_prev * (int)VBYTES, pa0, pa1, pa2, pa3); MODIFY(pB0, pB1, j, cbB); partialSM<NOMAX>(pB0, pB1, cbB, m_reg, alB);
        RESC(alB); __syncthreads(); ROT();
        SWAIT(); SWRITE(s_next, 1); if (j + 4 < NT) SLOAD(1, j + 4);
        REGIONC(j + 1); ATT_SBAR(); qkt<KC, USEC>(pA0, pA1, K_lds + s_cur * KBYTES, cb0, qr, cbt, r32, hi);
        REGSC(cbB); finishSM<ONES>(pB0, pB1, alB, l_reg, pa0, pa1, pa2, pa3); ATT_SBAR();
        pv_all<NCB, ONES>(o, lacc, vb0 + s_prev * (int)VBYTES, pa0, pa1, pa2, pa3); MODIFY(pA0, pA1, j + 1, cbA); partialSM<NOMAX>(pA0, pA1, cbA, m_reg, alA);
        RESC(alA); __syncthreads(); ROT();
    }
    REGIONC(NT - 1); ATT_SBAR(); qkt<KC, USEC>(pB0, pB1, K_lds + s_cur * KBYTES, cb0, qr, cbt, r32, hi);
    REGSC(cbA); finishSM<ONES>(pA0, pA1, alA, l_reg, pa0, pa1, pa2, pa3); ATT_SBAR();
    pv_all<NCB, ONES>(o, lacc, vb0 + s_prev * (int)VBYTES, pa0, pa1, pa2, pa3); MODIFY(pB0, pB1, NT - 1, cbB); partialSM<NOMAX>(pB0, pB1, cbB, m_reg, alB);
    RESC(alB);
    REGSC(cbB); finishSM<ONES>(pB0, pB1, alB, l_reg, pa0, pa1, pa2, pa3); ATT_SBAR();
    pv_all<NCB, ONES>(o, lacc, vb0 + s_cur * (int)VBYTES, pa0, pa1, pa2, pa3);
    __syncthreads();
#undef ROT
    } else {
    asm volatile("s_waitcnt vmcnt(0)" ::: "memory"); SWRITE(0, 0); __syncthreads();
    REGIONC(0); qkt<KC, USEC>(pA0, pA1, K_lds, cb0, qr, cbt, r32, hi); MODIFY(pA0, pA1, 0, cbA); partialSM<NOMAX>(pA0, pA1, cbA, m_reg, alA);
    if (2 < NT) SLOAD(0, 2);
    SWAIT(); SWRITE(1, 1); __syncthreads();
    for (int j = 1; j + 1 < NT; j += 2) {
        REGIONC(j); ATT_SBAR(); qkt<KC, USEC>(pB0, pB1, K_lds + KBYTES, cb0, qr, cbt, r32, hi);
        REGSC(cbA); finishSM<ONES>(pA0, pA1, alA, l_reg, pa0, pa1, pa2, pa3); ATT_SBAR();
        SLOAD(1, j + 2); ATT_SBAR();
        pv_all<NCB, ONES>(o, lacc, vb0, pa0, pa1, pa2, pa3); MODIFY(pB0, pB1, j, cbB); partialSM<NOMAX>(pB0, pB1, cbB, m_reg, alB);
        __syncthreads(); SWAIT(); SWRITE(0, 0);
        RESC(alB); __syncthreads();
        REGIONC(j + 1); ATT_SBAR(); qkt<KC, USEC>(pA0, pA1, K_lds, cb0, qr, cbt, r32, hi);
        REGSC(cbB); finishSM<ONES>(pB0, pB1, alB, l_reg, pa0, pa1, pa2, pa3); ATT_SBAR();
        if (j + 3 < NT) SLOAD(0, j + 3); ATT_SBAR();
        pv_all<NCB, ONES>(o, lacc, vb0 + VBYTES, pa0, pa1, pa2, pa3); MODIFY(pA0, pA1, j + 1, cbA); partialSM<NOMAX>(pA0, pA1, cbA, m_reg, alA);
        __syncthreads(); SWAIT(); SWRITE(1, 1);
        RESC(alA); __syncthreads();
    }
    REGIONC(NT - 1); ATT_SBAR(); qkt<KC, USEC>(pB0, pB1, K_lds + KBYTES, cb0, qr, cbt, r32, hi);
    REGSC(cbA); finishSM<ONES>(pA0, pA1, alA, l_reg, pa0, pa1, pa2, pa3); ATT_SBAR();
    pv_all<NCB, ONES>(o, lacc, vb0, pa0, pa1, pa2, pa3); MODIFY(pB0, pB1, NT - 1, cbB); partialSM<NOMAX>(pB0, pB1, cbB, m_reg, alB);
    __syncthreads(); RESC(alB);
    REGSC(cbB); finishSM<ONES>(pB0, pB1, alB, l_reg, pa0, pa1, pa2, pa3); ATT_SBAR();
    pv_all<NCB, ONES>(o, lacc, vb0 + VBYTES, pa0, pa1, pa2, pa3);
    }
    float rli[16];
    if constexpr (ONES) {
#pragma unroll
        for (int r = 0; r < 16; ++r) rli[r] = __builtin_amdgcn_rcpf(lacc[r]);
    } else {
        if (hi == 0) li_l[r32] = l_reg; asm volatile("s_waitcnt lgkmcnt(0)" ::: "memory");
#pragma unroll
        for (int r = 0; r < 16; ++r) rli[r] = __builtin_amdgcn_rcpf(li_l[crow(r, hi)]);
    }
    if constexpr (MODE != 1) {
        ATT_LAS bf16_t* stg = (ATT_LAS bf16_t*)(lds + L_OST) + wid * 2048;
#pragma unroll
        for (int r = 0; r < 16; ++r) { const int orow = crow(r, hi);
#pragma unroll
            for (int d0 = 0; d0 < 2; ++d0) stg[orow * 64 + d0 * 32 + r32] = (bf16_t)(cvtpk(o[d0][r] * rli[r], 0.f) & 0xffffu); }
        asm volatile("s_waitcnt lgkmcnt(0)" ::: "memory");
        bf16_t* Ow = ATT + (size_t)(row0 + q0 + wid * 32) * OPITCH + ocol;
#pragma unroll
        for (int i = 0; i < 4; ++i) { const int row = i * 8 + (lane >> 3), ch = lane & 7; const u32x4 v = *(const ATT_LAS u32x4*)(stg + row * 64 + ch * 8); *(u32x4*)(Ow + (size_t)row * OPITCH + ch * 8) = v; }
    } else {
        __syncthreads();
        ATT_LAS float* ex = (ATT_LAS float*)(lds + L_K) + (wid & 3) * 4096;
        if (map == 1) {
#pragma unroll
            for (int d0 = 0; d0 < 4; ++d0)
#pragma unroll
                for (int r = 0; r < 16; ++r) ex[(d0 * 16 + r) * 64 + lane] = o[d0][r] * rli[r];
        }
        __syncthreads();
        if (map == 0) {
            const float sa = wave_sum(ax.lam_p[lane] * ax.lam_p[64 + lane]), sb = wave_sum(ax.lam_p[128 + lane] * ax.lam_p[192 + lane]);
            const float lam = __builtin_amdgcn_exp2f(sa * LOG2E) - __builtin_amdgcn_exp2f(sb * LOG2E) + ax.lam_init;
            float ssq[16];
#pragma unroll
            for (int r = 0; r < 16; ++r) ssq[r] = 0.f;
#pragma unroll
            for (int d0 = 0; d0 < 4; ++d0)
#pragma unroll
                for (int r = 0; r < 16; ++r) { const float d = o[d0][r] * rli[r] - lam * ex[(d0 * 16 + r) * 64 + lane]; o[d0][r] = d; ssq[r] += d * d; }
#pragma unroll
            for (int r = 0; r < 16; ++r) { float s = ssq[r]; s += __shfl_xor(s, 1); s += __shfl_xor(s, 2); s += __shfl_xor(s, 4); s += __shfl_xor(s, 8); s += __shfl_xor(s, 16);
                ssq[r] = __builtin_amdgcn_rsqf(s * (1.0f / 128.0f) + cfg::EPS) * (1.0f - ax.lam_init); }
            float gsub[4];
#pragma unroll
            for (int d0 = 0; d0 < 4; ++d0) gsub[d0] = ax.subln[d0 * 32 + r32];
            ATT_LAS bf16_t* stg = (ATT_LAS bf16_t*)(lds + L_OST) + wid * 4096;
#pragma unroll
            for (int r = 0; r < 16; ++r) { const int orow = crow(r, hi);
#pragma unroll
                for (int d0 = 0; d0 < 4; ++d0) stg[orow * 128 + d0 * 32 + r32] = (bf16_t)(cvtpk(o[d0][r] * ssq[r] * gsub[d0], 0.f) & 0xffffu); }
            asm volatile("s_waitcnt lgkmcnt(0)" ::: "memory");
            bf16_t* Ow = ATT + (size_t)(row0 + q0 + wid * 32) * OPITCH + ocol;
#pragma unroll
            for (int i = 0; i < 8; ++i) { const int row = i * 4 + (lane >> 4), ch = lane & 15; const u32x4 v = *(const ATT_LAS u32x4*)(stg + row * 128 + ch * 8); *(u32x4*)(Ow + (size_t)row * OPITCH + ch * 8) = v; }
        }
    }
    __syncthreads();
#undef SLOAD
#undef SWRITE
#undef SWAIT
#undef RESC
#undef MODIFY
#undef REGIONC
#undef REGSC
}
#undef ATT_SBAR
}
#define GAS __attribute__((address_space(1)))
#define LAS __attribute__((address_space(3)))
typedef unsigned short bf16;
typedef unsigned v4u __attribute__((ext_vector_type(4)));
typedef float f32x4 __attribute__((ext_vector_type(4)));
typedef short bf16x8 __attribute__((ext_vector_type(8)));
typedef GAS unsigned gu32;
typedef GAS unsigned long long gu64;
#define RLX_AGENT __ATOMIC_RELAXED, __HIP_MEMORY_SCOPE_AGENT
#define LDS_WAIT() asm volatile("s_waitcnt lgkmcnt(0)" ::: "memory")
#define VM_WAIT() asm volatile("s_waitcnt vmcnt(0)" ::: "memory")
__device__ __forceinline__ unsigned long long rt() { return __builtin_amdgcn_s_memrealtime(); }
__device__ __forceinline__ unsigned f2bf(float f) { unsigned u = __builtin_bit_cast(unsigned, f); return (u + 0x7fffu + ((u >> 16) & 1u)) >> 16; }
__device__ __forceinline__ unsigned pk2(float lo, float hi) { return f2bf(lo) | (f2bf(hi) << 16); }

#define XB_TMO      128
#define XB_XCNT(j)  (256  + 64 * (j))
#define XB_XSUB(j)  (1280 + 64 * (j))
#define XB_XGEN(j)  (2304 + 64 * (j))
#define XB_TOP      3328
#define XB_TOPGEN   3392
#define XCD_BAR_WORDS 3456
#define XB_SPIN_CAP (1u << 18)

__device__ __forceinline__ unsigned xb_ld(unsigned* p)              { return __hip_atomic_load(p, __ATOMIC_RELAXED, __HIP_MEMORY_SCOPE_AGENT); }
__device__ __forceinline__ unsigned xb_add(unsigned* p, unsigned v) { return __hip_atomic_fetch_add(p, v, __ATOMIC_RELAXED, __HIP_MEMORY_SCOPE_AGENT); }
__device__ __forceinline__ unsigned xb_xcc_id() { return (unsigned)__builtin_amdgcn_s_getreg((3 << 11) | 20) & 0xFu; }
#define XB_SPIN(cond, bar) do { unsigned _sp = 0; while (cond) { __builtin_amdgcn_s_sleep(1); \
    if ((++_sp & 255u) == 0u) { if (xb_ld(&(bar)[XB_TMO])) break; if (_sp > XB_SPIN_CAP) { atomicAdd(&(bar)[XB_TMO], 1u); break; } } } } while (0)

struct XcdBarrier {
    unsigned* bar; unsigned x;
    volatile LAS unsigned* st;
};

__device__ __forceinline__ XcdBarrier xcd_barrier_post(unsigned* bar, volatile LAS unsigned* st) {
    XcdBarrier b; b.bar = bar; b.x = xb_xcc_id(); b.st = st;
    if (threadIdx.x == 0) (void)xb_add(&bar[XB_XCNT(b.x)], 1u);
    return b;
}
__device__ __forceinline__ void xcd_barrier_complete(unsigned* bar, unsigned x, unsigned& nloc, unsigned& nx) {
    const unsigned G = gridDim.x * gridDim.y * gridDim.z;
    unsigned sum, cnt, mine, sp = 0u;
    for (;;) {
        sum = 0u; cnt = 0u; mine = 0u;
#pragma unroll
        for (unsigned j = 0; j < 16; ++j) { const unsigned c = xb_ld(&bar[XB_XCNT(j)]); sum += c; cnt += (c > 0u) ? 1u : 0u; mine = (j == x) ? c : mine; }
        if (sum == G) break;
        __builtin_amdgcn_s_sleep(1);
        if ((++sp & 255u) == 0u) { if (xb_ld(&bar[XB_TMO])) break; if (sp > XB_SPIN_CAP) { atomicAdd(&bar[XB_TMO], 1u); break; } }
    }
    nloc = mine > 0u ? mine : 1u; nx = cnt > 0u ? cnt : 1u;
}

__device__ __forceinline__ void xcd_barrier(const XcdBarrier& b) {
    asm volatile("s_waitcnt vmcnt(0)" ::: "memory");
    __syncthreads();
    if (threadIdx.x == 0) {
        unsigned* bar = b.bar;
        __builtin_amdgcn_s_waitcnt(0);
        unsigned nloc = b.st[0], nx = b.st[1];
        if (nloc == 0u) { xcd_barrier_complete(bar, b.x, nloc, nx); b.st[0] = nloc; b.st[1] = nx; }
        const unsigned old = xb_add(&bar[XB_XSUB(b.x)], 1u);
        const unsigned gen = old / nloc;
        if (old + 1u == (gen + 1u) * nloc) {
            __builtin_amdgcn_fence(__ATOMIC_RELEASE, "agent");
            asm volatile("s_waitcnt vmcnt(0)" ::: "memory");
            const unsigned og = xb_add(&bar[XB_TOP], 1u);
            const unsigned tg = og / nx;
            if (og + 1u == (tg + 1u) * nx) xb_add(&bar[XB_TOPGEN], 1u);
            else XB_SPIN(xb_ld(&bar[XB_TOPGEN]) == tg, bar);
            __builtin_amdgcn_fence(__ATOMIC_ACQUIRE, "agent");
            xb_add(&bar[XB_XGEN(b.x)], 1u);
            asm volatile("s_waitcnt vmcnt(0)" ::: "memory");
        } else {
            XB_SPIN(xb_ld(&bar[XB_XGEN(b.x)]) == gen, bar);
            __builtin_amdgcn_fence(__ATOMIC_ACQUIRE, "agent");
            asm volatile("s_waitcnt vmcnt(0)" ::: "memory");
        }
    }
    __syncthreads();
}

__device__ __forceinline__ void xcd_local_barrier(const XcdBarrier& b) {
    asm volatile("s_waitcnt vmcnt(0)" ::: "memory");
    __syncthreads();
    if (threadIdx.x == 0) {
        unsigned* bar = b.bar;
        __builtin_amdgcn_s_waitcnt(0);
        unsigned nloc = b.st[0]; nloc = nloc ? nloc : 1u;
        const unsigned old = xb_add(&bar[XB_XSUB(b.x)], 1u);
        const unsigned gen = old / nloc;
        if (old + 1u == (gen + 1u) * nloc) xb_add(&bar[XB_XGEN(b.x)], 1u);
        else XB_SPIN(xb_ld(&bar[XB_XGEN(b.x)]) == gen, bar);
        __builtin_amdgcn_fence(__ATOMIC_ACQUIRE, "agent");
        asm volatile("s_waitcnt vmcnt(0)" ::: "memory");
    }
    __syncthreads();
}

constexpr int NWAVES = 8;
constexpr size_t MiB = 1u << 20;
constexpr size_t WS_CTL = 0, CTL_ZERO_BYTES = 1 * MiB;
constexpr size_t WS_WGU = 2 * MiB, WS_WD = 46 * MiB, WS_WIN = 68 * MiB, WS_WOUT = 89 * MiB;
constexpr size_t WS_R = 98 * MiB;
constexpr size_t WS_ATT = 290 * MiB;
constexpr size_t WS_BIG = 482 * MiB;
constexpr size_t WS_RSS = 1010 * MiB, RSS_BYTES = 3 * MiB;
constexpr size_t WS_END = 1013 * MiB;
static_assert(WS_WGU + (size_t)cfg::NGU * cfg::DM * 2 <= WS_WD && WS_WD + (size_t)cfg::DM * cfg::DFF * 2 <= WS_WIN && WS_WIN + (size_t)cfg::NIN * cfg::DM * 2 <= WS_WOUT &&
              WS_WOUT + (size_t)cfg::DM * cfg::DM * 2 <= WS_R && WS_R + (size_t)cfg::M * cfg::DM * 2 <= WS_ATT && WS_ATT + (size_t)cfg::M * cfg::DM * 2 <= WS_BIG && WS_BIG + (size_t)cfg::M * cfg::DFF * 2 <= WS_END, "d_ws map");
#ifndef WGM_DN
#define WGM_DN 4
#endif
#ifndef GEMM_SP2
#define GEMM_SP2 true
#endif
#ifndef GEMM_ALIGN
#define GEMM_ALIGN true
#endif
#ifndef WGM_GU
#define WGM_GU 8
#endif
constexpr int CW_BAR = 4096;
constexpr int CW_NRM = 8192;
constexpr int RING_OFF = 0, RING_BYTES = 131072, LDSCTL_OFF = RING_BYTES, MISC_OFF = LDSCTL_OFF + 320, LDS_BYTES = 147456;
static_assert(att::L_END <= RING_BYTES && MISC_OFF + 128 <= LDS_BYTES, "LDS map");

struct Frame {
    LAS unsigned char* lds; volatile LAS unsigned* MISC; int wave, vcu, G;
};
__device__ __forceinline__ float wave_sum_f(float v) {
#pragma unroll
    for (int o = 1; o < 64; o <<= 1) v += __shfl_xor(v, o);
    return v;
}
__device__ __forceinline__ void transpose_item(const float* W, int K, int N, bf16* WT, int k0, int n0, int rowbase, const float* gain, LAS float* scr, int lane) {
#pragma unroll 8
    for (int i = 0; i < 32; ++i) { const int kk = 2 * i + (lane >> 5); scr[kk * 33 + (lane & 31)] = W[(size_t)(k0 + kk) * N + n0 + (lane & 31)]; }
    LDS_WAIT(); asm volatile("" ::: "memory");
    const int c = lane & 7;
    f32x4 g0 = {1.f, 1.f, 1.f, 1.f}, g1 = g0;
    if (gain) { g0 = *(const f32x4*)(gain + k0 + 8 * c); g1 = *(const f32x4*)(gain + k0 + 8 * c + 4); }
#pragma unroll
    for (int j = 0; j < 4; ++j) { const int n = (lane >> 3) + 8 * j; const LAS float* s = scr + (8 * c) * 33 + n;
        v4u o; o.x = pk2(s[0 * 33] * g0[0], s[1 * 33] * g0[1]); o.y = pk2(s[2 * 33] * g0[2], s[3 * 33] * g0[3]); o.z = pk2(s[4 * 33] * g1[0], s[5 * 33] * g1[1]); o.w = pk2(s[6 * 33] * g1[2], s[7 * 33] * g1[3]);
        *(GAS v4u*)(WT + (size_t)(rowbase + n) * K + k0 + 8 * c) = o; }
    LDS_WAIT(); asm volatile("" ::: "memory");
}
__device__ __forceinline__ void conv_ffn(const Frame& F, const float* wg, const float* wu, const float* wd, const float* gain, unsigned char* ws) {
    using namespace cfg;
    { const GAS float *a = (const GAS float*)wg, *b = (const GAS float*)wu, *c = (const GAS float*)wd, *d = (const GAS float*)gain; asm volatile("" : "+s"(a), "+s"(b), "+s"(c), "+s"(d));
      wg = (const float*)a; wu = (const float*)b; wd = (const float*)c; gain = (const float*)d; }
    int lane = threadIdx.x; asm volatile("" : "+v"(lane)); lane &= 63;
    LAS float* scr = (LAS float*)(F.lds + RING_OFF + F.wave * 16384);
    const int gw = F.vcu * NWAVES + F.wave, NGW = F.G * NWAVES;
    constexpr int I_G = (DM / 64) * (DFF / 32), I_D = (DFF / 64) * (DM / 32);
    static_assert(I_G == I_D, "");
    for (int it = gw; it < 3 * I_G; it += NGW) {
        const int which = it / I_G, r = it - which * I_G;
        if (which < 2) { const int nblk = DFF / 32, kb = r / nblk, nb = r % nblk, n0 = 32 * nb;
            transpose_item(which ? wu : wg, DM, DFF, (bf16*)(ws + WS_WGU), 64 * kb, n0, 256 * (n0 >> 7) + 128 * which + (n0 & 127), gain, scr, lane); }
        else { const int nblk = DM / 32, kb = r / nblk, nb = r % nblk, n0 = 32 * nb;
            transpose_item(wd, DFF, DM, (bf16*)(ws + WS_WD), 64 * kb, n0, n0, nullptr, scr, lane); }
    }
}
__device__ __forceinline__ void conv_mix(const Frame& F, const float* win, const float* wout, const float* gain, unsigned char* ws) {
    using namespace cfg;
    { const GAS float *a = (const GAS float*)win, *b = (const GAS float*)wout, *d = (const GAS float*)gain; asm volatile("" : "+s"(a), "+s"(b), "+s"(d)); win = (const float*)a; wout = (const float*)b; gain = (const float*)d; }
    int lane = threadIdx.x; asm volatile("" : "+v"(lane)); lane &= 63;
    LAS float* scr = (LAS float*)(F.lds + RING_OFF + F.wave * 16384);
    const int gw = F.vcu * NWAVES + F.wave, NGW = F.G * NWAVES;
    constexpr int I_IN = (DM / 64) * (NIN / 32), I_O = (DM / 64) * (DM / 32);
    for (int it = gw; it < I_IN + I_O; it += NGW) {
        if (it < I_IN) { const int nblk = NIN / 32, kb = it / nblk, nb = it % nblk, n0 = 32 * nb;
            transpose_item(win, DM, NIN, (bf16*)(ws + WS_WIN), 64 * kb, n0, 256 * (n0 >> 8) + 128 * ((n0 & 63) >> 5) + 32 * ((n0 & 255) >> 6), gain, scr, lane); }
        else { const int r = it - I_IN, nblk = DM / 32, kb = r / nblk, nb = r % nblk, n0 = 32 * nb;
            transpose_item(wout, DM, DM, (bf16*)(ws + WS_WOUT), 64 * kb, n0, n0, nullptr, scr, lane); }
    }
}
template <bool FINAL>
__device__ __forceinline__ void row_phase(const Frame& F, const float* xp, const float* xs, float* out, const float* gain, bf16* R, unsigned long long* rss) {
    using namespace cfg;
    int lane = threadIdx.x; asm volatile("" : "+v"(lane)); lane &= 63;
    const int gw = F.vcu * NWAVES + F.wave, NGW = F.G * NWAVES;
    if constexpr (FINAL) {
        { const GAS float* a = (const GAS float*)gain; asm volatile("" : "+s"(a)); gain = (const float*)a; }
        f32x4 g[4][2];
#pragma unroll
        for (int k = 0; k < 4; ++k) { g[k][0] = ((const f32x4*)gain)[2 * (lane + 64 * k)]; g[k][1] = ((const f32x4*)gain)[2 * (lane + 64 * k) + 1]; }
        for (int m = gw; m < M; m += NGW) {
            const GAS v4u* xr = (const GAS v4u*)(R + (size_t)m * DM) + lane;
            v4u w[4]; f32x4 v[4][2]; float s = 0.f;
#pragma unroll
            for (int k = 0; k < 4; ++k) w[k] = xr[64 * k];
#pragma unroll
            for (int k = 0; k < 4; ++k) { v[k][0] = (f32x4){__uint_as_float(w[k].x << 16), __uint_as_float(w[k].x & 0xffff0000u), __uint_as_float(w[k].y << 16), __uint_as_float(w[k].y & 0xffff0000u)};
                v[k][1] = (f32x4){__uint_as_float(w[k].z << 16), __uint_as_float(w[k].z & 0xffff0000u), __uint_as_float(w[k].w << 16), __uint_as_float(w[k].w & 0xffff0000u)};
#pragma unroll
                for (int e = 0; e < 2; ++e) s += (v[k][e].x * v[k][e].x + v[k][e].y * v[k][e].y) + (v[k][e].z * v[k][e].z + v[k][e].w * v[k][e].w); }
            const float rinv = 1.0f / sqrtf(wave_sum_f(s) * (1.0f / DM) + EPS);
            GAS f32x4* o = (GAS f32x4*)(out + (size_t)m * DM);
#pragma unroll
            for (int k = 0; k < 4; ++k) { o[2 * (lane + 64 * k)] = v[k][0] * rinv * g[k][0]; o[2 * (lane + 64 * k) + 1] = v[k][1] * rinv * g[k][1]; }
        }
    } else {
        for (int m = gw; m < M; m += NGW) {
            const float* xrow = m < MP ? xp + (size_t)m * DM : xs + (size_t)(m - MP) * DM;
            const GAS f32x4* xr = (const GAS f32x4*)xrow + lane;
            f32x4 v[8]; float s = 0.f;
#pragma unroll
            for (int j = 0; j < 8; ++j) { v[j] = xr[64 * j]; s += (v[j].x * v[j].x + v[j].y * v[j].y) + (v[j].z * v[j].z + v[j].w * v[j].w); }
            const float ssum = wave_sum_f(s);
            GAS unsigned long long* o8 = (GAS unsigned long long*)(R + (size_t)m * DM) + lane;
#pragma unroll
            for (int j = 0; j < 8; ++j) o8[64 * j] = (unsigned long long)pk2(v[j].x, v[j].y) | ((unsigned long long)pk2(v[j].z, v[j].w) << 32);
            if (lane == 0) ((GAS unsigned long long*)rss)[m] = (unsigned long long)(ssum * 4294967296.0f);
        }
    }
}

struct Args { const float* in[20]; float* out; unsigned char* ws; int ph_lo, ph_hi, pad0, pad1; };
__global__ void __launch_bounds__(NWAVES * 64, 2) mk_fwd(Args args) {
    using namespace cfg;
    extern __shared__ __attribute__((aligned(16))) unsigned char lds[];
    Frame F;
    F.lds = (LAS unsigned char*)lds; F.MISC = (volatile LAS unsigned*)(F.lds + MISC_OFF);
    F.wave = __builtin_amdgcn_readfirstlane((int)threadIdx.x >> 6);
    F.G = gridDim.x; { const int bx = blockIdx.x; F.vcu = (F.G % 8 == 0) ? (bx % 8) * (F.G / 8) + bx / 8 : bx; }
    unsigned char* ws = args.ws; gu32* ctl = (gu32*)(ws + WS_CTL);
    const float* const p_xp = args.in[0]; const float* const p_xs = args.in[1]; const float* const p_f1n = args.in[2]; const float* const p_f1g = args.in[3]; const float* const p_f1u = args.in[4];
    const float* const p_f1d = args.in[5]; const float* const p_mixn = args.in[6]; const float* const p_win = args.in[7]; const float* const p_aqn = args.in[8]; const float* const p_akn = args.in[9];
    const float* const p_blam = args.in[10]; const float* const p_bsub = args.in[11]; const float* const p_crpb = args.in[12]; const float* const p_wout = args.in[13]; const float* const p_f2n = args.in[14];
    const float* const p_f2g = args.in[15]; const float* const p_f2u = args.in[16]; const float* const p_f2d = args.in[17]; const float* const p_t5 = args.in[18]; const float* const p_fin = args.in[19];
    float* out = args.out;
    bf16* RS = (bf16*)(ws + WS_R); bf16* ATB = (bf16*)(ws + WS_ATT); bf16* BIG = (bf16*)(ws + WS_BIG);
    for (int u = threadIdx.x; u < (LDS_BYTES - LDSCTL_OFF) / 4; u += NWAVES * 64) ((LAS unsigned*)(F.lds + LDSCTL_OFF))[u] = 0u;
    __syncthreads();
    XcdBarrier bar; bar.bar = (unsigned*)(ctl + CW_BAR); bar.x = 0; bar.st = nullptr;
    if (!MK_PER_PHASE) bar = xcd_barrier_post((unsigned*)(ctl + CW_BAR), F.MISC + 8);
    const int lo = args.ph_lo, hi = args.ph_hi;
    int ph = 0;
#define IN(k) (lo <= (k) && (k) < hi)
#define FRESH() GAS float* out_g = (GAS float*)out; GAS unsigned char* ws_g = (GAS unsigned char*)ws; GAS bf16* R_g = (GAS bf16*)RS; GAS bf16* BIG_g = (GAS bf16*)BIG; GAS bf16* AT_g = (GAS bf16*)ATB; const GAS float* xp_g = (const GAS float*)p_xp; const GAS float* xs_g = (const GAS float*)p_xs; \
    asm volatile("" : "+s"(out_g), "+s"(ws_g), "+s"(R_g), "+s"(BIG_g), "+s"(AT_g), "+s"(xp_g), "+s"(xs_g)); \
    float* out_ = (float*)out_g; unsigned char* ws_ = (unsigned char*)ws_g; bf16* R_ = (bf16*)R_g; bf16* BIG_ = (bf16*)BIG_g; bf16* ATB_ = (bf16*)AT_g; const float* xp_ = (const float*)xp_g; const float* xs_ = (const float*)xs_g; (void)ATB_; (void)BIG_; (void)R_; (void)xp_; (void)xs_; (void)out_
#define SEAM() do { if (IN(ph) && IN(ph + 1)) { if (MK_PER_PHASE) { if (threadIdx.x == 0) __hip_atomic_store(ctl, 0xBADBA0u, RLX_AGENT); } else xcd_barrier(bar); } ++ph; } while (0)

    for (int L = 0; L < 2; ++L) {
        unsigned long long* const rssA = (unsigned long long*)(ws + WS_RSS) + (size_t)(L == 0 ? 0 : 3) * M;
        unsigned long long* const rssB = (unsigned long long*)(ws + WS_RSS) + (size_t)(L == 0 ? 1 : 4) * M;
        unsigned long long* const rssC = (unsigned long long*)(ws + WS_RSS) + (size_t)(L == 0 ? 2 : 5) * M;
        if (IN(ph)) { FRESH();
            conv_ffn(F, p_f1g + (size_t)L * DM * DFF, p_f1u + (size_t)L * DM * DFF, p_f1d + (size_t)L * DM * DFF, p_f1n + L * DM, ws_);
            conv_mix(F, p_win + (size_t)L * DM * NIN, p_wout + (size_t)L * DM * DM, p_mixn + L * DM, ws_);
            if (L == 0) row_phase<false>(F, xp_, xs_, out_, nullptr, R_, rssA);
        }
        SEAM();
        if (IN(ph)) { FRESH();
            pg8::Gemm g{R_, (const bf16*)(ws_ + WS_WGU), M, NGU, DM}; pg8::StaticOrder S; S.init(M, NGU, F.G, (int)blockIdx.x, WGM_GU);
            pg8::EpiSwiglu E{BIG_, rssA};
#ifndef NO_GU
            pg8::gemm_phase<pg8::EpiSwiglu, pg8::StaticOrder, GEMM_ALIGN, GEMM_SP2>(F.lds + RING_OFF, g, S, E);
#endif
        }
        SEAM();
        if (IN(ph)) { FRESH();
            pg8::Gemm g{BIG_, (const bf16*)(ws_ + WS_WD), M, DM, DFF}; pg8::StaticOrder S; S.init(M, DM, F.G, (int)blockIdx.x, WGM_DN);
            pg8::EpiResid E{R_, 0.5f, rssB};
#ifndef NO_RES
            pg8::gemm_phase<pg8::EpiResid, pg8::StaticOrder, GEMM_ALIGN, GEMM_SP2>(F.lds + RING_OFF, g, S, E);
#endif
        }
        SEAM();
        if (IN(ph)) { FRESH();
            conv_ffn(F, p_f2g + (size_t)L * DM * DFF, p_f2u + (size_t)L * DM * DFF, p_f2d + (size_t)L * DM * DFF, p_f2n + L * DM, ws_);
            __syncthreads();
            pg8::Gemm g{R_, (const bf16*)(ws_ + WS_WIN), M, NIN, DM}; pg8::StaticOrder S; S.init(M, NIN, F.G, (int)blockIdx.x, WGM_GU);
            pg8::EpiWin E{BIG_, p_aqn + L * 64, p_akn + L * 64, rssB, (unsigned*)(ctl + CW_NRM + L * 336)};
#ifndef NO_WIN
            pg8::gemm_phase<pg8::EpiWin, pg8::StaticOrder, GEMM_ALIGN, GEMM_SP2>(F.lds + RING_OFF, g, S, E);
#endif
        }
        SEAM();
        if (IN(ph)) { FRESH(); bf16* const QKV_ = BIG_; bf16* const ATT_ = ATB_;
                att::Aux ax{p_t5, p_crpb + (size_t)L * 8 * 15 * 31, p_blam + L * 256, p_bsub + L * 128, (L == 0 ? 0.2f : 0.35550906759f)};
                const att::lptr al = (att::lptr)(F.lds + RING_OFF);
#ifdef ATT_PRIO
                if (F.wave >= 4) __builtin_amdgcn_s_setprio(1);
#endif
#ifndef PROBE_ATT_REP
#define PROBE_ATT_REP 1
#endif
                for (int rep_ = 0; rep_ < PROBE_ATT_REP; ++rep_) {
#ifndef REP_B
#define REP_B 1
#endif
#ifndef REP_A
#define REP_A 1
#endif
#ifndef REP_D
#define REP_D 1
#endif
#ifndef REP_C
#define REP_C 1
#endif
                float t5max = 0.f, rpbmax = 0.f;
                { int ln = threadIdx.x; asm volatile("" : "+v"(ln)); ln &= 63;
#pragma unroll
                  for (int k_ = 0; k_ < 6; ++k_) t5max = fmaxf(t5max, fabsf(p_t5[ln + 64 * k_]));
                  for (int k_ = 0; k_ < 59; ++k_) { const int ix = ln + 64 * k_; if (ix < 8 * 15 * 31) rpbmax = fmaxf(rpbmax, fabsf(ax.rpb[ix])); }
#pragma unroll
                  for (int o_ = 1; o_ < 64; o_ <<= 1) { t5max = fmaxf(t5max, __shfl_xor(t5max, o_)); rpbmax = fmaxf(rpbmax, __shfl_xor(rpbmax, o_)); } }
                t5max = __uint_as_float(__builtin_amdgcn_readfirstlane(__float_as_uint(t5max))); rpbmax = __uint_as_float(__builtin_amdgcn_readfirstlane(__float_as_uint(rpbmax)));
                const GAS unsigned* nrm2 = (const GAS unsigned*)(ctl + CW_NRM + L * 336);
#define SEQ_OF(r0_) ((r0_) < MP ? ((r0_) >> 14) : 2 + (((r0_) - MP) >> 13))
#define NRM(blk_, sq_) __uint_as_float(nrm2[(blk_) * 4 + (sq_)])
                for (int rb_ = 0; rb_ < REP_B; ++rb_)
                for (int u = F.vcu; u < 1536; u += F.G) {
#ifndef NO_ATT1
                    int r0, T, h, qb;
                    if (u < 1024) { r0 = (u >> 9) * TP; T = TP; h = (u >> 7) & 3; qb = u & 127; } else { const int v = u - 1024; r0 = MP + (v >> 8) * TS; T = TS; h = (v >> 6) & 3; qb = v & 63; }
                    const int sq = SEQ_OF(r0);
                    const float bnd = sqrtf(fmaxf(NRM(12 + 2 * h, sq), NRM(13 + 2 * h, sq)) * fmaxf(NRM(20 + 2 * h, sq), NRM(21 + 2 * h, sq))) * 1.01f + t5max * LOG2E;
                    if (__builtin_amdgcn_readfirstlane((int)(bnd <= 80.0f))) att::attn_unit<1, true>(QKV_, ATT_, al, r0, T, h, qb, ax); else att::attn_unit<1, false>(QKV_, ATT_, al, r0, T, h, qb, ax);
#endif
                }
                bool a_nomax;
                { int ln_ = threadIdx.x; asm volatile("" : "+v"(ln_)); ln_ &= 63; float gq = fabsf(p_aqn[L * 64 + ln_]), gk = fabsf(p_akn[L * 64 + ln_]);
#pragma unroll
                  for (int o_ = 1; o_ < 64; o_ <<= 1) { gq = fmaxf(gq, __shfl_xor(gq, o_)); gk = fmaxf(gk, __shfl_xor(gk, o_)); }
                  const float bound = 8.0f * LOG2E * gq * gk * 1.01f; a_nomax = __builtin_amdgcn_readfirstlane((int)(bound <= 80.0f)) != 0; }
                for (int ra_ = 0; ra_ < REP_A; ++ra_)
                for (int u = F.vcu; u < 1536; u += F.G) {
#ifndef NO_ATT0
                    int r0, T, h, qb;
                    if (u < 1024) { r0 = (u >> 9) * TP; T = TP; h = (u >> 6) & 7; qb = u & 63; } else { const int v = u - 1024; r0 = MP + (v >> 8) * TS; T = TS; h = (v >> 5) & 7; qb = v & 31; }
                    if (a_nomax) att::attn_unit<0, true>(QKV_, ATT_, al, r0, T, h, qb, ax); else att::attn_unit<0, false>(QKV_, ATT_, al, r0, T, h, qb, ax);
#endif
                }
                for (int rd_ = 0; rd_ < REP_D; ++rd_)
                for (int u = F.vcu; u < 1536; u += F.G) {
                    const int h = u / 192, qg = u % 192; int r0, T, qb;
                    if (qg < 128) { r0 = (qg >> 6) * TP; T = TP; qb = qg & 63; } else { r0 = MP + ((qg - 128) >> 5) * TS; T = TS; qb = (qg - 128) & 31; }
#ifndef NO_ATT3
                    { const int sq = SEQ_OF(r0); const float bnd = sqrtf(NRM(60 + h, sq) * NRM(68 + h, sq)) * 1.01f + t5max * LOG2E + 1.6f;
                      if (__builtin_amdgcn_readfirstlane((int)(bnd <= 80.0f))) att::attn_unit<3, true>(QKV_, ATT_, al, r0, T, h, qb, ax); else att::attn_unit<3, false>(QKV_, ATT_, al, r0, T, h, qb, ax); }
#endif
                }
                for (int rc_ = 0; rc_ < REP_C; ++rc_)
                for (int u = F.vcu; u < 1536; u += F.G) {
                    const int h = u / 192, qg = u % 192; int r0, T, qb;
                    if (qg < 128) { r0 = (qg >> 6) * TP; T = TP; qb = qg & 63; } else { r0 = MP + ((qg - 128) >> 5) * TS; T = TS; qb = (qg - 128) & 31; }
#ifndef NO_ATT2
                    { const int sq = SEQ_OF(r0); const float bnd = sqrtf(NRM(36 + h, sq) * NRM(44 + h, sq)) * 1.01f + rpbmax * LOG2E;
                      if (__builtin_amdgcn_readfirstlane((int)(bnd <= 80.0f))) att::attn_unit<2, true>(QKV_, ATT_, al, r0, T, h, qb, ax); else att::attn_unit<2, false>(QKV_, ATT_, al, r0, T, h, qb, ax); }
#endif
                }
                }
                    }
        SEAM();
        if (IN(ph)) { FRESH();
            pg8::Gemm g{ATB_, (const bf16*)(ws_ + WS_WOUT), M, DM, DM}; pg8::StaticOrder S; S.init(M, DM, F.G, (int)blockIdx.x, WGM_DN);
            pg8::EpiResid E{R_, 1.0f, rssC};
#ifndef NO_RES
            pg8::gemm_phase<pg8::EpiResid, pg8::StaticOrder, GEMM_ALIGN, GEMM_SP2>(F.lds + RING_OFF, g, S, E);
#endif
        }
        SEAM();
        if (IN(ph)) { FRESH();
            pg8::Gemm g{R_, (const bf16*)(ws_ + WS_WGU), M, NGU, DM}; pg8::StaticOrder S; S.init(M, NGU, F.G, (int)blockIdx.x, WGM_GU);
            pg8::EpiSwiglu E{BIG_, rssC};
#ifndef NO_GU
            pg8::gemm_phase<pg8::EpiSwiglu, pg8::StaticOrder, GEMM_ALIGN, GEMM_SP2>(F.lds + RING_OFF, g, S, E);
#endif
        }
        SEAM();
        if (IN(ph)) { FRESH();
            pg8::Gemm g{BIG_, (const bf16*)(ws_ + WS_WD), M, DM, DFF}; pg8::StaticOrder S; S.init(M, DM, F.G, (int)blockIdx.x, WGM_DN);
            pg8::EpiResid E{R_, 0.5f, L == 0 ? (unsigned long long*)(ws + WS_RSS) + (size_t)3 * M : (unsigned long long*)nullptr};
#ifndef NO_RES
            pg8::gemm_phase<pg8::EpiResid, pg8::StaticOrder, GEMM_ALIGN, GEMM_SP2>(F.lds + RING_OFF, g, S, E);
#endif
        }
        SEAM();
    }
    if (IN(ph)) { FRESH(); row_phase<true>(F, xp_, xs_, out_, p_fin, R_, nullptr); }
#undef IN
#undef SEAM
}
constexpr int N_PHASES = 17;

extern "C" void kernel_launch(void* const* d_in, const int* in_sizes, int n_in, void* d_out, int out_size, void* d_ws, size_t ws_size, hipStream_t stream) {
    static int grid = 0;
    if (grid == 0) {
        if (n_in != 20 || in_sizes[0] != cfg::MP * cfg::DM || in_sizes[1] != cfg::MS * cfg::DM || out_size != cfg::M * cfg::DM || ws_size < WS_END) {
            fprintf(stderr, "kernel_launch: shape mismatch (n_in %d, in0 %d, in1 %d, out %d, ws %zu need %zu); nothing launched\n", n_in, n_in > 0 ? in_sizes[0] : -1, n_in > 1 ? in_sizes[1] : -1, out_size, ws_size, (size_t)WS_END); grid = -1; return; }
        int dev = 0, cus = 0, per_cu = 0;
        if (hipGetDevice(&dev) != hipSuccess || hipDeviceGetAttribute(&cus, hipDeviceAttributeMultiprocessorCount, dev) != hipSuccess) { fprintf(stderr, "kernel_launch: device query failed\n"); grid = -1; return; }
        if (hipFuncSetAttribute((const void*)mk_fwd, hipFuncAttributeMaxDynamicSharedMemorySize, LDS_BYTES) != hipSuccess) { fprintf(stderr, "kernel_launch: hipFuncSetAttribute failed\n"); grid = -1; return; }
        if (hipOccupancyMaxActiveBlocksPerMultiprocessor(&per_cu, (const void*)mk_fwd, NWAVES * 64, LDS_BYTES) != hipSuccess || per_cu < 1) {
            fprintf(stderr, "kernel_launch: occupancy query reports %d workgroups per CU; nothing launched\n", per_cu); (void)hipGetLastError(); grid = -1; return; }
        (void)hipGetLastError();
        grid = cus;
    }
    if (grid < 0) return;
    if (hipMemsetAsync((char*)d_ws + WS_CTL, 0, CTL_ZERO_BYTES, stream) != hipSuccess || hipMemsetAsync((char*)d_ws + WS_RSS, 0, RSS_BYTES, stream) != hipSuccess) { fprintf(stderr, "kernel_launch: memset failed\n"); return; }
    Args a{};
    for (int i = 0; i < 20; ++i) a.in[i] = (const float*)d_in[i];
    a.out = (float*)d_out; a.ws = (unsigned char*)d_ws;
#if MK_PER_PHASE
    for (int p = 0; p < N_PHASES; ++p) { a.ph_lo = p; a.ph_hi = p + 1; hipLaunchKernelGGL(mk_fwd, dim3(grid), dim3(NWAVES * 64), LDS_BYTES, stream, a); }
#else
    a.ph_lo = 0; a.ph_hi = N_PHASES;
    hipLaunchKernelGGL(mk_fwd, dim3(grid), dim3(NWAVES * 64), LDS_BYTES, stream, a);
#endif
    const hipError_t le = hipPeekAtLastError();
    if (le != hipSuccess) fprintf(stderr, "kernel_launch: launch failed: %s\n", hipGetErrorName(le));
}
```

```cpp
#include <hip/hip_runtime.h>
#include <cstdio>
#include <cstdint>

#ifndef MK_PER_PHASE
#define MK_PER_PHASE 0
#endif

namespace cfg {
constexpr int DM = 2048, DFF = 5632, NIN = 5376, NGU = 2 * DFF;
constexpr int TP = 16384, TS = 8192, MP = 2 * TP, MS = 2 * TS, M = MP + MS;
constexpr float EPS = 1e-6f;
constexpr float LOG2E = 1.4426950408889634f;
constexpr float C2 = 0.125f * LOG2E;
}
namespace pg8 {
#define PG8_LAS __attribute__((address_space(3)))
typedef unsigned short bf16_t;
typedef short bf16x8 __attribute__((ext_vector_type(8)));
typedef float f32x4 __attribute__((ext_vector_type(4)));
typedef unsigned u32x4 __attribute__((ext_vector_type(4)));
constexpr int BM = 256, BK = 64, HALF = 128, HTB = HALF * BK * 2  , STAGE_BYTES = 8 * HTB, NXCD = 8, WGM = 8;

__host__ __device__ __forceinline__ int lds_byte(int r, int c) { const int st = (r >> 4) * 2 + (c >> 5), rr = r & 15, cc = c & 31, ob = rr * 64 + cc * 2; return st * 1024 + (ob ^ (((ob >> 9) & 1) << 5)); }
__host__ __device__ __forceinline__ void stage_rc(int b, int& R, int& C) { const int st = b / 1024, sb = b % 1024, swz = sb ^ (((sb >> 9) & 1) << 5); R = (st >> 1) * 16 + swz / 64; C = (st & 1) * 32 + (swz % 64) / 2; }
__host__ __device__ __forceinline__ int perm32(int rho) { const int n = rho >> 4, i = rho & 15; return 8 * (i >> 2) + 4 * n + (i & 3); }

struct Unit { int pm, pn; };
struct Gemm { const bf16_t* A; const bf16_t* Bt; int M, N, K; };

struct StaticOrder {
    int nM, nN, nwg, G, c, wgm;
    __host__ __device__ void init(int M, int N, int G_, int c_, int wgm_ = WGM) { nM = M / BM; nN = N / BM; nwg = nM * nN; G = G_; c = c_; wgm = wgm_; }
    __host__ __device__ bool next(int i, Unit& u) const {
        const long L = (long)i * G + c; if (L >= nwg) return false;
        int wgid = (int)L; { const int q = nwg / NXCD, r = nwg % NXCD, xcd = wgid % NXCD, off = wgid / NXCD; wgid = (xcd < r ? xcd * (q + 1) : r * (q + 1) + (xcd - r) * q) + off; }
        const int nig = wgm * nN, gid = wgid / nig, fm = gid * wgm, gsz = (nM - fm) < wgm ? (nM - fm) : wgm;
        u.pm = fm + ((wgid % nig) % gsz); u.pn = (wgid % nig) / gsz; return true;
    }
    __device__ __forceinline__ void a_ready(const Unit&) const {}
    __device__ __forceinline__ void done(const Unit&) const {}
};

__device__ __forceinline__ unsigned cvt_pk_bf16(float lo, float hi) { unsigned r; asm volatile("v_cvt_pk_bf16_f32 %0, %1, %2" : "=v"(r) : "v"(lo), "v"(hi)); return r; }
typedef float f32x2 __attribute__((ext_vector_type(2)));

struct EpiSwiglu {
    static constexpr bool PERM = true, AFTER_DRAIN = false, PROBE_TWICE = true;
    bf16_t* H; const unsigned long long* rss;
    __device__ __forceinline__ void operator()(const f32x4 (&acc)[2][2][4][2], const Unit& u, int wr, int wc, int fr, int fq) const {
        const int row0 = u.pm * BM + wr * 64 + fr, col0 = u.pn * 128 + wc * 32 + 8 * fq;
        float rv[2][4];
#pragma unroll
        for (int ai = 0; ai < 2; ++ai)
#pragma unroll
            for (int m = 0; m < 4; ++m) rv[ai][m] = (float)rss[row0 + ai * HALF + m * 16] * 2.3283064365386963e-10f;
#pragma unroll
        for (int ai = 0; ai < 2; ++ai)
#pragma unroll
            for (int m = 0; m < 4; ++m) {
                bf16_t* rowp = H + (unsigned)((row0 + ai * HALF + m * 16) * cfg::DFF + col0);
                const float rinv = __builtin_amdgcn_rsqf(rv[ai][m] * (1.0f / cfg::DM) + cfg::EPS);
                float hv[8];
#pragma unroll
                for (int n = 0; n < 2; ++n)
#pragma unroll
                    for (int j = 0; j < 4; ++j) {
                        const float g = acc[ai][0][m][n][j] * rinv, up = acc[ai][1][m][n][j] * rinv;
                        const float e = __builtin_amdgcn_exp2f(-g * cfg::LOG2E);
                        hv[n * 4 + j] = (g * up) * __builtin_amdgcn_rcpf(1.0f + e);
                    }
                u32x4 w; w.x = cvt_pk_bf16(hv[0], hv[1]); w.y = cvt_pk_bf16(hv[2], hv[3]); w.z = cvt_pk_bf16(hv[4], hv[5]); w.w = cvt_pk_bf16(hv[6], hv[7]);
                *(u32x4*)rowp = w;
                asm volatile("" ::: "memory");
            }
    }
};
__device__ __forceinline__ f32x4 bf16x4_lo(u32x4 w, int h) { f32x4 r; const unsigned a = h ? w.z : w.x, b = h ? w.w : w.y;
    r[0] = __uint_as_float(a << 16); r[1] = __uint_as_float(a & 0xffff0000u); r[2] = __uint_as_float(b << 16); r[3] = __uint_as_float(b & 0xffff0000u); return r; }
struct EpiResid {
    static constexpr bool PERM = true, AFTER_DRAIN = false, PROBE_TWICE = false;
    bf16_t* R; float alpha; unsigned long long* rssw;
    __device__ __forceinline__ void operator()(const f32x4 (&acc)[2][2][4][2], const Unit& u, int wr, int wc, int fr, int fq) const {
        bf16_t* rb = R + (size_t)u.pm * BM * cfg::DM;
        const unsigned off0 = (unsigned)(wr * 64 + fr) * cfg::DM + (unsigned)(u.pn * BM + wc * 32 + 8 * fq);
        float sel[2] = {0.f, 0.f};
        u32x4 vq[4][2];
#define RES_LOAD(S, it_) do { const unsigned o_ = off0 + (unsigned)(((it_) >> 2) * HALF + ((it_) & 3) * 16) * cfg::DM; \
        vq[S][0] = *(const u32x4*)(rb + o_); vq[S][1] = *(const u32x4*)(rb + o_ + HALF); } while (0)
#define RES_DO(S, it_) do { const int ai = (it_) >> 2, m = (it_) & 3; const unsigned off = off0 + (unsigned)(ai * HALF + m * 16) * cfg::DM; float ss = 0.f; \
        _Pragma("unroll") for (int bj = 0; bj < 2; ++bj) { const f32x4 o0 = bf16x4_lo(vq[S][bj], 0) + acc[ai][bj][m][0] * alpha, o1 = bf16x4_lo(vq[S][bj], 1) + acc[ai][bj][m][1] * alpha; \
            ss += (o0[0] * o0[0] + o0[1] * o0[1]) + (o0[2] * o0[2] + o0[3] * o0[3]) + (o1[0] * o1[0] + o1[1] * o1[1]) + (o1[2] * o1[2] + o1[3] * o1[3]); \
            u32x4 w; w.x = cvt_pk_bf16(o0[0], o0[1]); w.y = cvt_pk_bf16(o0[2], o0[3]); w.z = cvt_pk_bf16(o1[0], o1[1]); w.w = cvt_pk_bf16(o1[2], o1[3]); \
            *(u32x4*)(rb + off + bj * HALF) = w; } \
        if (rssw) { ss += __shfl_xor(ss, 16); ss += __shfl_xor(ss, 32); if (fq == m) sel[ai] = ss; } } while (0)
        RES_LOAD(0, 0); RES_LOAD(1, 1); RES_LOAD(2, 2);
        RES_LOAD(3, 3); RES_DO(0, 0); asm volatile("" ::: "memory");
        RES_LOAD(0, 4); RES_DO(1, 1); asm volatile("" ::: "memory");
        RES_LOAD(1, 5); RES_DO(2, 2); asm volatile("" ::: "memory");
        RES_LOAD(2, 6); RES_DO(3, 3); asm volatile("" ::: "memory");
        RES_LOAD(3, 7); RES_DO(0, 4); asm volatile("" ::: "memory");
        RES_DO(1, 5); asm volatile("" ::: "memory");
        RES_DO(2, 6); asm volatile("" ::: "memory");
        RES_DO(3, 7); asm volatile("" ::: "memory");
#undef RES_LOAD
#undef RES_DO
        if (rssw) {
#pragma unroll
            for (int ai = 0; ai < 2; ++ai) atomicAdd(rssw + u.pm * BM + wr * 64 + ai * HALF + fq * 16 + fr, (unsigned long long)(sel[ai] * 4294967296.0f));
        }
    }
};
struct EpiWin {
    static constexpr bool PERM = true, AFTER_DRAIN = false, PROBE_TWICE = false;
    bf16_t* QKV; const float* gq; const float* gk; const unsigned long long* rss; unsigned* nrm2;
    __device__ __forceinline__ void operator()(const f32x4 (&acc)[2][2][4][2], const Unit& u, int wr, int wc, int fr, int fq) const {
        const int pn = u.pn;
        int kind = 0; float sc = 1.f;
        if (pn < 2) { kind = 1; sc = cfg::C2; }
        else if (pn == 2) { kind = (wc < 2) ? 2 : 0; }
        else if (pn == 3 || pn == 4 || pn == 9 || pn == 10 || pn == 15 || pn == 16) sc = cfg::C2;
        const int row0 = u.pm * BM + wr * 64 + fr;
        const int colb = pn * 256 + wc * 64 + 8 * fq;
        float rv[2][4];
#pragma unroll
        for (int ai = 0; ai < 2; ++ai)
#pragma unroll
            for (int m = 0; m < 4; ++m) rv[ai][m] = (float)rss[row0 + ai * HALF + m * 16] * 2.3283064365386963e-10f;
        if (kind == 0) {
            const bool want = (pn >= 3 && pn <= 6) || (pn >= 9 && pn <= 12) || (pn >= 15 && pn <= 18);
            float nmax = 0.f;
#pragma unroll
            for (int ai = 0; ai < 2; ++ai)
#pragma unroll
                for (int m = 0; m < 4; ++m) {
                    bf16_t* rowp = QKV + (unsigned)((row0 + ai * HALF + m * 16) * cfg::NIN + colb);
                    const float rs_ = __builtin_amdgcn_rsqf(rv[ai][m] * (1.0f / cfg::DM) + cfg::EPS) * sc;
                    float ss = 0.f;
#pragma unroll
                    for (int bj = 0; bj < 2; ++bj) { const f32x4 v0 = acc[ai][bj][m][0] * rs_, v1 = acc[ai][bj][m][1] * rs_;
                        ss += (v0[0] * v0[0] + v0[1] * v0[1]) + (v0[2] * v0[2] + v0[3] * v0[3]) + (v1[0] * v1[0] + v1[1] * v1[1]) + (v1[2] * v1[2] + v1[3] * v1[3]);
                        u32x4 w; w.x = cvt_pk_bf16(v0[0], v0[1]); w.y = cvt_pk_bf16(v0[2], v0[3]); w.z = cvt_pk_bf16(v1[0], v1[1]); w.w = cvt_pk_bf16(v1[2], v1[3]);
                        *(u32x4*)(rowp + 32 * bj) = w; }
                    if (want) { ss += __shfl_xor(ss, 16); ss += __shfl_xor(ss, 32); nmax = fmaxf(nmax, ss); }
                    asm volatile("" ::: "memory");
                }
            if (want) {
                float t = nmax;
                t = fmaxf(t, __shfl_xor(t, 1)); t = fmaxf(t, __shfl_xor(t, 2)); t = fmaxf(t, __shfl_xor(t, 4)); t = fmaxf(t, __shfl_xor(t, 8));
                const int rowt = u.pm * BM; const int seq = rowt < cfg::MP ? (rowt >> 14) : 2 + ((rowt - cfg::MP) >> 13);
                if ((fr | fq) == 0) atomicMax(nrm2 + (4 * pn + wc) * 4 + seq, __float_as_uint(t));
            }
        } else {
            const float* g = (kind == 1) ? gq : gk;
            float invrev[2][2];
#pragma unroll
            for (int n = 0; n < 2; ++n)
#pragma unroll
                for (int jj = 0; jj < 2; ++jj) invrev[n][jj] = __builtin_amdgcn_exp2f(-(float)(4 * fq + 2 * n + jj) * (13.287712379549449f / 16.0f)) * 0.15915494309189535f;
#pragma unroll
            for (int ai = 0; ai < 2; ++ai)
#pragma unroll
                for (int m = 0; m < 4; ++m) {
                    const int row = row0 + ai * HALF + m * 16;
                    const int t = (row < cfg::MP) ? (row & (cfg::TP - 1)) : (row & (cfg::TS - 1));
                    float prow = (float)(t >> 6), pcol = (float)(row & 63);
                    asm volatile("" : "+v"(prow), "+v"(pcol) :: "memory");
                    float ss = 0.f;
#pragma unroll
                    for (int bj = 0; bj < 2; ++bj)
#pragma unroll
                        for (int n = 0; n < 2; ++n) { const f32x4 v = acc[ai][bj][m][n]; ss += (v[0] * v[0] + v[1] * v[1]) + (v[2] * v[2] + v[3] * v[3]); }
                    ss += __shfl_xor(ss, 16); ss += __shfl_xor(ss, 32);
                    const float rw = __builtin_amdgcn_rsqf(rv[ai][m] * (1.0f / cfg::DM) + cfg::EPS);
                    const float rinv = rw * __builtin_amdgcn_rsqf(ss * rw * rw * (1.0f / 64.0f) + cfg::EPS);
                    bf16_t* rowp = QKV + (unsigned)(row * cfg::NIN + colb);
#pragma unroll
                    for (int bj = 0; bj < 2; ++bj) {
                        const float pos = bj ? pcol : prow;
                        float o[8];
#pragma unroll
                        for (int n = 0; n < 2; ++n) {
                            const f32x4 y = acc[ai][bj][m][n] * rinv * *(const f32x4*)(g + 32 * bj + 8 * fq + 4 * n);
#pragma unroll
                            for (int jj = 0; jj < 2; ++jj) {
                                const float rev = __builtin_amdgcn_fractf(pos * invrev[n][jj]);
                                const float sn = __builtin_amdgcn_sinf(rev), cs = __builtin_amdgcn_cosf(rev);
                                const float x1 = y[2 * jj], x2 = y[2 * jj + 1];
                                o[4 * n + 2 * jj] = (x1 * cs - x2 * sn) * sc; o[4 * n + 2 * jj + 1] = (x1 * sn + x2 * cs) * sc;
                            }
                        }
                        u32x4 w; w.x = cvt_pk_bf16(o[0], o[1]); w.y = cvt_pk_bf16(o[2], o[3]); w.z = cvt_pk_bf16(o[4], o[5]); w.w = cvt_pk_bf16(o[6], o[7]);
                        *(u32x4*)(rowp + 32 * bj) = w;
                        asm volatile("" ::: "memory");
                    }
                }
        }
    }
};

template <class Epi, class Sched, bool ALIGN_EPI = false, bool SP2 = false>
__device__ __forceinline__ void gemm_phase(PG8_LAS unsigned char* lds, const Gemm g, const Sched& S, const Epi& E) {
    int tid_ = threadIdx.x; asm volatile("" : "+v"(tid_));
    const int tid = tid_, wid = __builtin_amdgcn_readfirstlane(tid >> 6), lane = tid & 63, wr = wid >> 2, wc = wid & 3, fr = lane & 15, fq = lane >> 4;
    const int K = g.K, nt = K / BK;
    unsigned voffA[2], voffB[2];
#pragma unroll
    for (int i = 0; i < 2; ++i) { int R, C; stage_rc(tid * 16 + i * 8192, R, C); const int Rb = Epi::PERM ? ((R & ~31) + perm32(R & 31)) : R;
        voffA[i] = (unsigned)(R * K + C) * 2u; voffB[i] = (unsigned)(Rb * K + C) * 2u; }
    const size_t kstep = (size_t)(BK * 2);
    const size_t hstep = (size_t)HALF * K * 2;
    const size_t tstep = 2 * hstep;
    const unsigned ldsw = (unsigned)wid * 1024u;
    const int aoff = lds_byte(wr * 64 + fr, fq * 8), boff = lds_byte(wc * 32 + fr, fq * 8);
#define PG8_SA(b, h) (((b) * 2 + (h)) * HTB)
#define PG8_SB(b, h) ((4 + (b) * 2 + (h)) * HTB)
#define PG8_STAGE(bufoff, gbase, voff) do { _Pragma("unroll") for (int _i = 0; _i < 2; ++_i) \
        __builtin_amdgcn_global_load_lds((const unsigned*)((const char*)(gbase) + (voff)[_i]), (PG8_LAS unsigned*)(lds + (bufoff) + ldsw + _i * 8192), 16, 0, 0); } while (0)
#define PG8_LDA(dst, b, h) do { _Pragma("unroll") for (int m = 0; m < 4; ++m) _Pragma("unroll") for (int k = 0; k < 2; ++k) dst[m][k] = *(const PG8_LAS bf16x8*)(lds + PG8_SA(b, h) + aoff + m * 2048 + k * 1024); } while (0)
#define PG8_LDB(dst, b, h) do { _Pragma("unroll") for (int n = 0; n < 2; ++n) _Pragma("unroll") for (int k = 0; k < 2; ++k) dst[n][k] = *(const PG8_LAS bf16x8*)(lds + PG8_SB(b, h) + boff + n * 2048 + k * 1024); } while (0)
#define PG8_MMA(ai, bj, At, Bt) do { __builtin_amdgcn_s_setprio(1); _Pragma("unroll") for (int m = 0; m < 4; ++m) _Pragma("unroll") for (int n = 0; n < 2; ++n) _Pragma("unroll") for (int k = 0; k < 2; ++k) \
        acc[ai][bj][m][n] = __builtin_amdgcn_mfma_f32_16x16x32_bf16(Bt[n][k], At[m][k], acc[ai][bj][m][n], 0, 0, 0); __builtin_amdgcn_s_setprio(0); } while (0)
#define PG8_WAIT_V(n) asm volatile("s_waitcnt vmcnt(" #n ")" ::: "memory")
#define PG8_WAIT_L(n) asm volatile("s_waitcnt lgkmcnt(" #n ")" ::: "memory")
#define PG8_BAR __builtin_amdgcn_s_barrier()
#define PG8_SCHED __builtin_amdgcn_sched_barrier(0)
    Unit cur, nxt; int ui = 0;
    if (!S.next(0, cur)) return;
    f32x4 acc[2][2][4][2];
#pragma unroll
    for (int a = 0; a < 2; ++a)
#pragma unroll
        for (int b = 0; b < 2; ++b)
#pragma unroll
            for (int m = 0; m < 4; ++m)
#pragma unroll
                for (int n = 0; n < 2; ++n) acc[a][b][m][n] = (f32x4){0.f, 0.f, 0.f, 0.f};
    bf16x8 At[4][2], B0[2][2], B1[2][2];
    const char* cA = (const char*)g.A + (size_t)cur.pm * tstep; const char* cB = (const char*)g.Bt + (size_t)cur.pn * tstep;
    S.a_ready(cur);
    if constexpr (SP2) {
        PG8_STAGE(PG8_SB(0, 0), cB, voffB); PG8_STAGE(PG8_SB(0, 1), cB + hstep, voffB); PG8_STAGE(PG8_SA(0, 0), cA, voffA); PG8_STAGE(PG8_SA(0, 1), cA + hstep, voffA);
        if (wr == 1) PG8_BAR;
        PG8_WAIT_V(2); PG8_BAR;
        PG8_STAGE(PG8_SB(1, 0), cB + kstep, voffB); PG8_STAGE(PG8_SA(1, 0), cA + kstep, voffA); PG8_STAGE(PG8_SB(1, 1), cB + hstep + kstep, voffB);
        PG8_WAIT_V(6); PG8_BAR;
    } else {
        PG8_STAGE(PG8_SB(0, 0), cB, voffB); PG8_STAGE(PG8_SA(0, 0), cA, voffA); PG8_STAGE(PG8_SB(0, 1), cB + hstep, voffB); PG8_STAGE(PG8_SA(0, 1), cA + hstep, voffA);
        if (wr == 1) PG8_BAR;
        PG8_WAIT_V(4); PG8_BAR;
        PG8_STAGE(PG8_SB(1, 0), cB + kstep, voffB); PG8_STAGE(PG8_SA(1, 0), cA + kstep, voffA); PG8_STAGE(PG8_SB(1, 1), cB + hstep + kstep, voffB);
        PG8_WAIT_V(6); PG8_BAR;
    }
    for (;;) {
        const bool has_next = S.next(ui + 1, nxt);
        const char* nA = has_next ? (const char*)g.A + (size_t)nxt.pm * tstep : cA; const char* nB = has_next ? (const char*)g.Bt + (size_t)nxt.pn * tstep : cB;
        for (int t = 0; t < nt; t += 2) {
            const bool last = (t == nt - 2);
            const char* a1 = cA + (size_t)(t + 1) * kstep;
            const char* a2 = last ? nA : cA + (size_t)(t + 2) * kstep; const char* b2 = last ? nB : cB + (size_t)(t + 2) * kstep;
            const char* a3 = a2 + kstep; const char* b3 = b2 + kstep;
            if (last && has_next) S.a_ready(nxt);
            if constexpr (SP2) {
            PG8_LDB(B0, 0, 0); PG8_LDB(B1, 0, 1); PG8_SCHED; PG8_LDA(At, 0, 0); PG8_STAGE(PG8_SA(1, 1), a1 + hstep, voffA);
            PG8_WAIT_V(8); PG8_WAIT_L(0); PG8_BAR; PG8_MMA(0, 0, At, B0); PG8_MMA(0, 1, At, B1); PG8_BAR; PG8_SCHED;
            PG8_LDA(At, 0, 1); PG8_STAGE(PG8_SB(0, 0), b2, voffB); PG8_STAGE(PG8_SB(0, 1), b2 + hstep, voffB); PG8_STAGE(PG8_SA(0, 0), a2, voffA);
            PG8_WAIT_V(8); PG8_WAIT_L(0); PG8_BAR; PG8_MMA(1, 0, At, B0); PG8_MMA(1, 1, At, B1); PG8_BAR; PG8_SCHED;
            PG8_LDB(B0, 1, 0); PG8_LDB(B1, 1, 1); PG8_SCHED; PG8_LDA(At, 1, 0); PG8_STAGE(PG8_SA(0, 1), a2 + hstep, voffA);
            PG8_WAIT_V(8); PG8_WAIT_L(0); PG8_BAR; PG8_MMA(0, 0, At, B0); PG8_MMA(0, 1, At, B1); PG8_BAR; PG8_SCHED;
            PG8_LDA(At, 1, 1); PG8_STAGE(PG8_SB(1, 0), b3, voffB); PG8_STAGE(PG8_SB(1, 1), b3 + hstep, voffB); PG8_STAGE(PG8_SA(1, 0), a3, voffA);
            PG8_WAIT_V(8); PG8_WAIT_L(0); PG8_BAR; PG8_MMA(1, 0, At, B0); PG8_MMA(1, 1, At, B1); PG8_BAR; PG8_SCHED;
            } else {
            PG8_LDB(B0, 0, 0); PG8_SCHED; PG8_LDA(At, 0, 0); PG8_STAGE(PG8_SA(1, 1), a1 + hstep, voffA);
            PG8_WAIT_L(8); PG8_BAR; PG8_WAIT_L(0); PG8_MMA(0, 0, At, B0); PG8_BAR; PG8_SCHED;
            PG8_LDB(B1, 0, 1); PG8_STAGE(PG8_SB(0, 0), b2, voffB);
            PG8_BAR; PG8_WAIT_L(0); PG8_MMA(0, 1, At, B1); PG8_BAR;
            PG8_LDA(At, 0, 1); PG8_STAGE(PG8_SA(0, 0), a2, voffA);
            PG8_BAR; PG8_WAIT_L(0); PG8_MMA(1, 0, At, B0); PG8_BAR; PG8_SCHED;
            PG8_STAGE(PG8_SB(0, 1), b2 + hstep, voffB);
            PG8_WAIT_V(6); PG8_BAR; PG8_MMA(1, 1, At, B1); PG8_BAR;
            PG8_LDB(B0, 1, 0); PG8_SCHED; PG8_LDA(At, 1, 0); PG8_STAGE(PG8_SA(0, 1), a2 + hstep, voffA);
            PG8_WAIT_L(8); PG8_BAR; PG8_WAIT_L(0); PG8_MMA(0, 0, At, B0); PG8_BAR; PG8_SCHED;
            PG8_LDB(B1, 1, 1); PG8_STAGE(PG8_SB(1, 0), b3, voffB);
            PG8_BAR; PG8_WAIT_L(0); PG8_MMA(0, 1, At, B1); PG8_BAR;
            PG8_LDA(At, 1, 1); PG8_STAGE(PG8_SA(1, 0), a3, voffA);
            PG8_BAR; PG8_WAIT_L(0); PG8_MMA(1, 0, At, B0); PG8_BAR; PG8_SCHED;
            PG8_STAGE(PG8_SB(1, 1), b3 + hstep, voffB);
            PG8_WAIT_V(6); PG8_BAR; PG8_MMA(1, 1, At, B1); PG8_BAR;
            }
        }
        if constexpr (ALIGN_EPI) { if (wr == 0) PG8_BAR; }
        if constexpr (!Epi::AFTER_DRAIN) { E(acc, cur, wr, wc, fr, fq);
#if defined(PROBE_EPI2)
            if constexpr (Epi::PROBE_TWICE) { asm volatile("" ::: "memory"); E(acc, cur, wr, wc, fr, fq); }
#endif
            S.done(cur); }
        if (!has_next) break;
#pragma unroll
        for (int a = 0; a < 2; ++a)
#pragma unroll
            for (int b = 0; b < 2; ++b)
#pragma unroll
                for (int m = 0; m < 4; ++m)
#pragma unroll
                    for (int n = 0; n < 2; ++n) acc[a][b][m][n] = (f32x4){0.f, 0.f, 0.f, 0.f};
        cur = nxt; cA = nA; cB = nB; ++ui;
        if constexpr (ALIGN_EPI) { if (wr == 1) PG8_BAR; }
    }
    PG8_WAIT_V(0);
    if constexpr (!ALIGN_EPI) { if (wr == 0) PG8_BAR; }
    PG8_BAR;
    if constexpr (Epi::AFTER_DRAIN) { E.fused(acc, cur, wr, wc, fr, fq, lds, wid, lane); S.done(cur); }
#undef PG8_SA
#undef PG8_SB
#undef PG8_STAGE
#undef PG8_LDA
#undef PG8_LDB
#undef PG8_MMA
#undef PG8_WAIT_V
#undef PG8_WAIT_L
#undef PG8_BAR
#undef PG8_SCHED
}
}
namespace att {
#define ATT_LAS __attribute__((address_space(3)))
using bf16x8 = __attribute__((ext_vector_type(8))) short;
using s16x4  = __attribute__((ext_vector_type(4))) short;
using f32x16 = __attribute__((ext_vector_type(16))) float;
using u32x4  = __attribute__((ext_vector_type(4))) unsigned;
typedef unsigned short bf16_t;
typedef ATT_LAS char* lptr;
constexpr int PITCH = cfg::NIN, OPITCH = cfg::DM;
constexpr float LOG2E = cfg::LOG2E, NEG = -1e30f, THR = 8.f;
#ifndef ATT_RING_B
#define ATT_RING_B 1
#endif
template <bool RING> struct Map { static constexpr int L_K = 0, L_V = RING ? 49152 : 32768, L_WS = RING ? 98304 : 65536, L_LUT = RING ? 100352 : 67584, L_OST = RING ? 65536 : 81920, L_END = RING ? 112640 : 114688; };
constexpr int L_END = 114688;
constexpr int LUTB_R = 704, LUTD_R = 1344;
#define ATT_SBAR() __builtin_amdgcn_sched_barrier(0)
__device__ __forceinline__ int crow(int r, int hi) { return (r & 3) + 8 * (r >> 2) + 4 * hi; }
__device__ __forceinline__ unsigned cvtpk(float lo, float hi) { unsigned r; asm volatile("v_cvt_pk_bf16_f32 %0, %1, %2" : "=v"(r) : "v"(lo), "v"(hi)); return r; }
__device__ __forceinline__ float wave_sum(float v) {
#pragma unroll
    for (int o = 1; o < 64; o <<= 1) v += __shfl_xor(v, o);
    return v;
}
__device__ __forceinline__ int t5_bucket(int rel) {
    const int n = rel < 0 ? -rel : rel;
    int b = n;
    if (n >= 8) b = 8 + (n >= 15) + (n >= 27) + (n >= 50) + (n >= 91) + (n >= 166) + (n >= 305) + (n >= 559);
    return b + (rel > 0 ? 16 : 0);
}
template <int KC> __device__ __forceinline__ int kswz(int row, int colB) { return KC == 128 ? row * 256 + (colB ^ ((row & 7) << 4)) : row * 128 + (colB ^ (((row >> 1) & 7) << 4)); }
template <int NCB> __device__ __forceinline__ int v_st(int k, int c) { const int kk = k; return ((kk >> 3) * NCB + (c >> 5)) * 512 + ((kk & 7) * 32 + (c & 31)) * 2; }
__device__ __forceinline__ int v_rd_base(int lane) { return ((lane & 3) << 3) | (((lane >> 2) & 3) << 6) | (((lane >> 4) & 1) << 5) | (((lane >> 5) & 1) << 8); }
template <int OFF> __device__ __forceinline__ s16x4 tr_read(int vb) { s16x4 r; asm volatile("ds_read_b64_tr_b16 %0, %1 offset:%2" : "=&v"(r) : "v"(vb), "i"(OFF) : "memory"); return r; }
template <int NCB, int D0> __device__ __forceinline__ void pv_one(f32x16& od, int vb, bf16x8 pa0, bf16x8 pa1, bf16x8 pa2, bf16x8 pa3) {
#define ATT_VOFF(ks, half) (D0 * 512 + (ks) * (NCB * 1024) + (half) * (NCB * 512))
    const s16x4 l0 = tr_read<ATT_VOFF(0, 0)>(vb), h0 = tr_read<ATT_VOFF(0, 1)>(vb), l1 = tr_read<ATT_VOFF(1, 0)>(vb), h1 = tr_read<ATT_VOFF(1, 1)>(vb);
    const s16x4 l2 = tr_read<ATT_VOFF(2, 0)>(vb), h2 = tr_read<ATT_VOFF(2, 1)>(vb), l3 = tr_read<ATT_VOFF(3, 0)>(vb), h3 = tr_read<ATT_VOFF(3, 1)>(vb);
#undef ATT_VOFF
    asm volatile("s_waitcnt lgkmcnt(0)" ::: "memory"); ATT_SBAR();
#define ATT_PK(L, H) (bf16x8){L[0], L[1], L[2], L[3], H[0], H[1], H[2], H[3]}
    od = __builtin_amdgcn_mfma_f32_32x32x16_bf16(pa0, ATT_PK(l0, h0), od, 0, 0, 0);
    od = __builtin_amdgcn_mfma_f32_32x32x16_bf16(pa1, ATT_PK(l1, h1), od, 0, 0, 0);
    od = __builtin_amdgcn_mfma_f32_32x32x16_bf16(pa2, ATT_PK(l2, h2), od, 0, 0, 0);
    od = __builtin_amdgcn_mfma_f32_32x32x16_bf16(pa3, ATT_PK(l3, h3), od, 0, 0, 0);
#undef ATT_PK
}
template <int NCB, bool ONES> __device__ __forceinline__ void pv_all(f32x16* o, f32x16& lacc, int vb, bf16x8 pa0, bf16x8 pa1, bf16x8 pa2, bf16x8 pa3) {
    if constexpr (ONES) { const bf16x8 ones = {0x3F80, 0x3F80, 0x3F80, 0x3F80, 0x3F80, 0x3F80, 0x3F80, 0x3F80};
        lacc = __builtin_amdgcn_mfma_f32_32x32x16_bf16(pa0, ones, lacc, 0, 0, 0); lacc = __builtin_amdgcn_mfma_f32_32x32x16_bf16(pa1, ones, lacc, 0, 0, 0);
        lacc = __builtin_amdgcn_mfma_f32_32x32x16_bf16(pa2, ones, lacc, 0, 0, 0); lacc = __builtin_amdgcn_mfma_f32_32x32x16_bf16(pa3, ones, lacc, 0, 0, 0); }
    pv_one<NCB, 0>(o[0], vb, pa0, pa1, pa2, pa3); pv_one<NCB, 1>(o[1], vb, pa0, pa1, pa2, pa3);
    if constexpr (NCB == 4) { pv_one<NCB, 2>(o[2], vb, pa0, pa1, pa2, pa3); pv_one<NCB, 3>(o[3], vb, pa0, pa1, pa2, pa3); }
}
template <bool NOMAX> __device__ __forceinline__ void partialSM(f32x16& p0, f32x16& p1, float cb, float& m_reg, float& alpha) {
    if constexpr (NOMAX) { alpha = 1.f;
        (void)cb;
#pragma unroll
        for (int r = 0; r < 16; ++r) p0[r] = __builtin_amdgcn_exp2f(p0[r]);
        return; }
    float ma = fmaxf(p0[0], p0[1]), mb = fmaxf(p0[2], p0[3]), mc = fmaxf(p1[0], p1[1]), md = fmaxf(p1[2], p1[3]);
#pragma unroll
    for (int r = 4; r < 16; r += 4) { ma = fmaxf(fmaxf(ma, p0[r]), p0[r + 1]); mb = fmaxf(fmaxf(mb, p0[r + 2]), p0[r + 3]); mc = fmaxf(fmaxf(mc, p1[r]), p1[r + 1]); md = fmaxf(fmaxf(md, p1[r + 2]), p1[r + 3]); }
    float pmax = fmaxf(fmaxf(ma, mb), fmaxf(mc, md));
    { auto rr = __builtin_amdgcn_permlane32_swap(__float_as_uint(pmax), __float_as_uint(pmax), false, false); pmax = fmaxf(__uint_as_float(rr[0]), __uint_as_float(rr[1])); }
    pmax += cb;
    float mn;
    if (__builtin_expect(__all(pmax - m_reg <= THR), 1)) { mn = m_reg; alpha = 1.f; }
    else { mn = fmaxf(m_reg, pmax); alpha = __builtin_amdgcn_exp2f(m_reg - mn); m_reg = mn; }
    const float sub = cb - mn;
#pragma unroll
    for (int r = 0; r < 16; ++r) p0[r] += sub;
#pragma unroll
    for (int r = 0; r < 16; ++r) p1[r] += sub;
#pragma unroll
    for (int r = 0; r < 16; ++r) p0[r] = __builtin_amdgcn_exp2f(p0[r]);
}
template <bool ONES> __device__ __forceinline__ void finishSM(f32x16& p0, f32x16& p1, float alpha, float& l_reg, bf16x8& pa0, bf16x8& pa1, bf16x8& pa2, bf16x8& pa3) {
#pragma unroll
    for (int r = 0; r < 16; ++r) p1[r] = __builtin_amdgcn_exp2f(p1[r]);
    if constexpr (!ONES) {
    float sa = p0[0] + p0[1], sb = p0[2] + p0[3], sc_ = p1[0] + p1[1], sd = p1[2] + p1[3];
#pragma unroll
    for (int r = 4; r < 16; r += 4) { sa += p0[r]; sa += p0[r + 1]; sb += p0[r + 2]; sb += p0[r + 3]; sc_ += p1[r]; sc_ += p1[r + 1]; sd += p1[r + 2]; sd += p1[r + 3]; }
    float ps = (sa + sb) + (sc_ + sd);
    { auto rr = __builtin_amdgcn_permlane32_swap(__float_as_uint(ps), __float_as_uint(ps), false, false); ps = __uint_as_float(rr[0]) + __uint_as_float(rr[1]); }
    l_reg = l_reg * alpha + ps;
    }
#define ATT_PK4(P, BASE, OUT) do { unsigned a0 = cvtpk(P[BASE + 0], P[BASE + 1]), a1 = cvtpk(P[BASE + 2], P[BASE + 3]);   \
    unsigned b0 = cvtpk(P[BASE + 4], P[BASE + 5]), b1 = cvtpk(P[BASE + 6], P[BASE + 7]);                              \
    u32x4 w = {a0, a1, b0, b1}; OUT = __builtin_bit_cast(bf16x8, w); } while (0)
    ATT_PK4(p0, 0, pa0); ATT_PK4(p0, 8, pa1); ATT_PK4(p1, 0, pa2); ATT_PK4(p1, 8, pa3);
#undef ATT_PK4
}
template <int KC, bool USEC> __device__ __forceinline__ void qkt(f32x16& p0, f32x16& p1, lptr Ks, int cb0, const bf16x8* qr, const f32x16& c0, int r32, int hi) {
    if constexpr (!USEC) { p0 = f32x16{}; p1 = f32x16{}; }
#pragma unroll
    for (int d0 = 0; d0 < 4; ++d0) { const int cb = cb0 + d0 * 32 + hi * 16;
        const bf16x8 b0 = *(const ATT_LAS bf16x8*)(Ks + kswz<KC>(r32, cb));
        const bf16x8 b1 = *(const ATT_LAS bf16x8*)(Ks + kswz<KC>(32 + r32, cb));
        if (USEC && d0 == 0) { p0 = __builtin_amdgcn_mfma_f32_32x32x16_bf16(b0, qr[0], c0, 0, 0, 0); p1 = __builtin_amdgcn_mfma_f32_32x32x16_bf16(b1, qr[0], c0, 0, 0, 0); }
        else { p0 = __builtin_amdgcn_mfma_f32_32x32x16_bf16(b0, qr[d0], p0, 0, 0, 0); p1 = __builtin_amdgcn_mfma_f32_32x32x16_bf16(b1, qr[d0], p1, 0, 0, 0); } }
}
struct Aux { const float* t5; const float* rpb; const float* lam_p; const float* subln; float lam_init; };

template <int MODE, bool NOMAX = false>
__device__ __forceinline__ void attn_unit(const bf16_t* __restrict__ QKV, bf16_t* __restrict__ ATT, lptr lds, int row0, int T, int h, int qb, const Aux& ax) {
#ifndef ATT_ONES
#define ATT_ONES 1
#endif
    constexpr bool ONES = (ATT_ONES != 0) && (MODE != 1);
    constexpr bool RING = (MODE != 0) && (ATT_RING_B != 0);
    constexpr int L_K = Map<RING>::L_K, L_V = Map<RING>::L_V, L_WS = Map<RING>::L_WS, L_LUT = Map<RING>::L_LUT, L_OST = Map<RING>::L_OST;
    constexpr int KC = (MODE == 1) ? 128 : 64, DV = (MODE == 1) ? 128 : 64, NCB = DV / 32, NR = KC / 64;
    constexpr int KBYTES = 64 * KC * 2, VBYTES = 64 * DV * 2, QROWS = (MODE == 1) ? 128 : 256;
    int tid_ = threadIdx.x; asm volatile("" : "+v"(tid_));
    const int tid = tid_, lane = tid & 63, r32 = lane & 31, hi = lane >> 5;
    const int wid = __builtin_amdgcn_readfirstlane(tid >> 6);
    const int map = (MODE == 1) ? (wid >> 2) : 0, wq = (MODE == 1) ? (wid & 3) : wid;
    const int q0 = qb * QROWS, qw = q0 + wq * 32, qpos = qw + r32;
    int qcol, kcol, vcol, ocol;
    if (MODE == 0)      { qcol = 64 * h;          kcol = 512 + 64 * (h >> 2); vcol = 640 + 64 * (h >> 2); ocol = 64 * h; }
    else if (MODE == 1) { qcol = 768 + 128 * h + 64 * map; kcol = 1280 + 128 * h; vcol = 1792 + 128 * h; ocol = 512 + 128 * h; }
    else if (MODE == 2) { qcol = 2304 + 64 * h;   kcol = 2816 + 64 * h;       vcol = 3328 + 64 * h;       ocol = 1024 + 64 * h; }
    else                { qcol = 3840 + 64 * h;   kcol = 4352 + 64 * h;       vcol = 4864 + 64 * h;       ocol = 1536 + 64 * h; }
    int tlo = 0, NT = T >> 6;
    if (MODE == 3) { int lo = q0 - 1024; lo = lo < 0 ? 0 : lo; int hi_k = q0 + 255 + 1024; hi_k = hi_k > T - 1 ? T - 1 : hi_k; int a = lo >> 6, b = hi_k >> 6;
        if (((b - a + 1) & 1) != 0) { if (a > 0) --a; else ++b; } tlo = a; NT = b - a + 1; }
    if (MODE == 2) { const int rows = T >> 6, R0 = 4 * qb; int a = R0 - 4; a = a < 0 ? 0 : (a > rows - 8 ? rows - 8 : a); int b = R0 - 1; b = b < 0 ? 0 : (b > rows - 8 ? rows - 8 : b); b += 7;
        if (((b - a + 1) & 1) != 0) { if (a > 0) --a; else ++b; } tlo = a; NT = b - a + 1; }
    const int sr = (KC == 128) ? (tid >> 4) : (tid >> 3), sc = (KC == 128) ? (tid & 15) * 8 : (tid & 7) * 8;
    const bf16_t* Kg = QKV + (size_t)(row0 + sr) * PITCH + kcol + sc;
    const bf16_t* Vg = QKV + (size_t)(row0 + sr) * PITCH + vcol + sc;
    const int kst0 = kswz<KC>(sr, sc * 2), kst1 = kswz<KC>(32 + sr, sc * 2), vst0 = v_st<NCB>(sr, sc), vst1 = v_st<NCB>(32 + sr, sc);
    const lptr K_lds = lds + L_K, V_lds = lds + L_V;
    const int vb0 = (int)(uintptr_t)V_lds + v_rd_base(lane);
    ATT_LAS float* wsf = (ATT_LAS float*)(lds + L_WS) + wid * 64; ATT_LAS float* li_l = wsf; ATT_LAS float* al_l = wsf + 32;
    struct { bf16x8 k[NR], v[NR]; } st_[2];
#define SLOAD(i, tt) do { const size_t ro_ = (size_t)((tlo + (tt)) * 64) * PITCH; st_[i].k[0] = *(const bf16x8*)(Kg + ro_); st_[i].v[0] = *(const bf16x8*)(Vg + ro_); \
        if constexpr (NR == 2) { st_[i].k[1] = *(const bf16x8*)(Kg + ro_ + (size_t)32 * PITCH); st_[i].v[1] = *(const bf16x8*)(Vg + ro_ + (size_t)32 * PITCH); } } while (0)
#define SWRITE(b, i) do { *(ATT_LAS bf16x8*)(K_lds + (b) * KBYTES + kst0) = st_[i].k[0]; *(ATT_LAS bf16x8*)(V_lds + (b) * VBYTES + vst0) = st_[i].v[0]; \
        if constexpr (NR == 2) { *(ATT_LAS bf16x8*)(K_lds + (b) * KBYTES + kst1) = st_[i].k[1]; *(ATT_LAS bf16x8*)(V_lds + (b) * VBYTES + vst1) = st_[i].v[1]; } } while (0)
#define SWAIT() do { if constexpr (NR == 2) asm volatile("s_waitcnt vmcnt(4)" ::: "memory"); else asm volatile("s_waitcnt vmcnt(2)" ::: "memory"); } while (0)
#define RESC(a) do { if (!NOMAX && __any((a) < 1.f)) { if (hi == 0) al_l[r32] = (a); asm volatile("s_waitcnt lgkmcnt(0)" ::: "memory"); \
        _Pragma("unroll") for (int r = 0; r < 16; ++r) { const float f_ = al_l[crow(r, hi)]; if (ONES) lacc[r] *= f_; _Pragma("unroll") for (int d = 0; d < NCB; ++d) o[d][r] *= f_; } } } while (0)
    SLOAD(0, 0); SLOAD(1, 1);
    bf16x8 qr[4];
    { const bf16_t* Qw = QKV + (size_t)(row0 + qpos) * PITCH + qcol + hi * 8;
#pragma unroll
      for (int d0 = 0; d0 < 4; ++d0) qr[d0] = *(const bf16x8*)(Qw + d0 * 16); }
    ATT_LAS float* lut = (ATT_LAS float*)(lds + L_LUT);
    if (MODE == 1) { for (int i = tid; i < 2 * LUTB_R + 1; i += 512) lut[i] = ax.t5[t5_bucket(i - LUTB_R) * 12 + h] * LOG2E; }
    if (MODE == 3) { for (int i = tid; i < 2 * LUTD_R + 1; i += 512) { const int rel = i - LUTD_R, n = rel < 0 ? -rel : rel;
            const int mult = (n <= 64 ? 1 : 0) + (((n & 3) == 0 && n <= 256) ? 1 : 0) + (((n & 15) == 0 && n <= 1024) ? 1 : 0);
            lut[i] = mult == 0 ? NEG : ax.t5[t5_bucket(rel) * 12 + 4 + h] * LOG2E + (mult == 1 ? 0.f : (mult == 2 ? 1.f : 1.5849625007211562f)); } }
    if (MODE == 2) { for (int i = tid; i < 15 * 128; i += 512) { const int dr = i >> 7, dc = (i & 127) - 48; lut[i] = (dc >= 0 && dc <= 30) ? ax.rpb[(h * 15 + dr) * 31 + dc] * LOG2E : NEG; } }
    float cL = 0.f, cR = 0.f; int c_cs = 0, c_rs = 0, c_R = 0, c_c = 0;
    if (MODE == 2) { const int rows = T >> 6; c_R = 4 * qb + (wid >> 1); c_c = 32 * (wid & 1) + r32; c_cs = c_c - 8; c_cs = c_cs < 0 ? 0 : (c_cs > 48 ? 48 : c_cs); c_rs = c_R - 4; c_rs = c_rs < 0 ? 0 : (c_rs > rows - 8 ? rows - 8 : c_rs); }
#define MODIFY(P0, P1, tt, CB) do { CB = 0.f; const int k0_ = (tlo + (tt)) * 64; \
        if constexpr (MODE == 1) { if (k0_ + 63 - qw <= -559) CB = cL; else if (k0_ - qw - 31 >= 559) CB = cR; else { const ATT_LAS float* lp_ = lut + (k0_ - qpos + LUTB_R + 4 * hi); \
            _Pragma("unroll") for (int r = 0; r < 16; ++r) { P0[r] += lp_[(r & 3) + 8 * (r >> 2)]; P1[r] += lp_[32 + (r & 3) + 8 * (r >> 2)]; } } } \
        if constexpr (MODE == 3) { const ATT_LAS float* lp_ = lut + (k0_ - qpos + LUTD_R + 4 * hi); \
            _Pragma("unroll") for (int r = 0; r < 16; ++r) { P0[r] += lp_[(r & 3) + 8 * (r >> 2)]; P1[r] += lp_[32 + (r & 3) + 8 * (r >> 2)]; } } \
        if constexpr (MODE == 2) { const int kr_ = tlo + (tt); if (kr_ < c_rs || kr_ > c_rs + 7) { _Pragma("unroll") for (int r = 0; r < 16; ++r) { P0[r] = NEG; P1[r] = NEG; } } \
            else { const ATT_LAS float* lp_ = lut + ((kr_ - c_R + 7) * 128 + 48 + 15 - c_c + 4 * hi); const int kb_ = 4 * hi - c_cs; \
              _Pragma("unroll") for (int r = 0; r < 16; ++r) { const int ko_ = (r & 3) + 8 * (r >> 2); const float a_ = lp_[ko_], b_ = lp_[32 + ko_]; \
                P0[r] = ((unsigned)(kb_ + ko_) <= 15u) ? P0[r] + a_ : NEG; P1[r] = ((unsigned)(kb_ + 32 + ko_) <= 15u) ? P1[r] + b_ : NEG; } } } \
    } while (0)
    __syncthreads();
    if (MODE == 1) { cL = lut[0]; cR = lut[2 * LUTB_R]; }
    constexpr bool USEC = false;
    float m_reg = NEG, l_reg = 0.f, cbcur = 0.f, cbacc = 0.f; f32x16 o[NCB], lacc = f32x16{}, cbt = f32x16{};
#define REGSC(CB) do { if constexpr (MODE == 1 && NOMAX) { if ((CB) != cbacc) { const float f_ = __builtin_amdgcn_exp2f(cbacc - (CB)); cbacc = (CB); l_reg *= f_; \
        _Pragma("unroll") for (int r = 0; r < 16; ++r) { if (ONES) lacc[r] *= f_; _Pragma("unroll") for (int d = 0; d < NCB; ++d) o[d][r] *= f_; } } } } while (0)
#define REGIONC(tt) do { if constexpr (USEC) { const int k0_ = (tlo + (tt)) * 64; const float cb_ = (k0_ + 63 - qw <= -559) ? cL : ((k0_ - qw - 31 >= 559) ? cR : 0.f); \
        if (cb_ != cbcur) { cbcur = cb_; _Pragma("unroll") for (int r = 0; r < 16; ++r) cbt[r] = cb_; } } } while (0)
#pragma unroll
    for (int d = 0; d < NCB; ++d) o[d] = f32x16{};
    f32x16 pA0, pA1, pB0, pB1; float alA, alB, cbA, cbB; bf16x8 pa0, pa1, pa2, pa3;
    const int cb0 = map * 128;
    if constexpr (RING) {
    int s_prev = 2, s_cur = 0, s_next = 1;
#define ROT() do { const int t_ = s_prev; s_prev = s_cur; s_cur = s_next; s_next = t_; } while (0)
    asm volatile("s_waitcnt vmcnt(0)" ::: "memory"); SWRITE(0, 0); if (2 < NT) SLOAD(0, 2); __syncthreads();
    SWAIT(); SWRITE(1, 1); if (3 < NT) SLOAD(1, 3);
    REGIONC(0); qkt<KC, USEC>(pA0, pA1, K_lds, cb0, qr, cbt, r32, hi); MODIFY(pA0, pA1, 0, cbA); partialSM<NOMAX>(pA0, pA1, cbA, m_reg, alA);
    __syncthreads(); ROT();
    for (int j = 1; j + 1 < NT; j += 2) {
        REGIONC(j); ATT_SBAR(); qkt<KC, USEC>(pB0, pB1, K_lds + s_cur * KBYTES, cb0, qr, cbt, r32, hi);
        REGSC(cbA); finishSM<ONES>(pA0, pA1, alA, l_reg, pa0, pa1, pa2, pa3); ATT_SBAR();
        SWAIT(); SWRITE(s_next, 0); if (j + 3 < NT) SLOAD(0, j + 3); ATT_SBAR();
        pv_all<NCB, ONES>(o, lacc, vb0 + s_prev * (int)VBYTES, pa0, pa1, pa2, pa3); MODIFY(pB0, pB1, j, cbB); partialSM<NOMAX>(pB0, pB1, cbB, m_reg, alB);
        RESC(alB); __syncthreads(); ROT();
        REGIONC(j + 1); ATT_SBAR(); qkt<KC, USEC>(pA0, pA1, K_lds + s_cur * KBYTES, cb0, qr, cbt, r32, hi);
        REGSC(cbB); finishSM<ONES>(pB0, pB1, alB, l_reg, pa0, pa1, pa2, pa3); ATT_SBAR();
        SWAIT(); SWRITE(s_next, 1); if (j + 4 < NT) SLOAD(1, j + 4); ATT_SBAR();
        pv_all<NCB, ONES>(o, lacc, vb0 + s_prev * (int)VBYTES, pa0, pa1, pa2, pa3); MODIFY(pA0, pA1, j + 1, cbA); partialSM<NOMAX>(pA0, pA1, cbA, m_reg, alA);
        RESC(alA); __syncthreads(); ROT();
    }
    REGIONC(NT - 1); ATT_SBAR(); qkt<KC, USEC>(pB0, pB1, K_lds + s_cur * KBYTES, cb0, qr, cbt, r32, hi);
    REGSC(cbA); finishSM<ONES>(pA0, pA1, alA, l_reg, pa0, pa1, pa2, pa3); ATT_SBAR();
    pv_all<NCB, ONES>(o, lacc, vb0 + s_prev * (int)VBYTES, pa0, pa1, pa2, pa3); MODIFY(pB0, pB1, NT - 1, cbB); partialSM<NOMAX>(pB0, pB1, cbB, m_reg, alB);
    RESC(alB);
    REGSC(cbB); finishSM<ONES>(pB0, pB1, alB, l_reg, pa0, pa1, pa2, pa3); ATT_SBAR();
    pv_all<NCB, ONES>(o, lacc, vb0 + s_cur * (int)VBYTES, pa0, pa1, pa2, pa3);
    __syncthreads();
#undef ROT
    } else {
    asm volatile("s_waitcnt vmcnt(0)" ::: "memory"); SWRITE(0, 0); __syncthreads();
    REGIONC(0); qkt<KC, USEC>(pA0, pA1, K_lds, cb0, qr, cbt, r32, hi); MODIFY(pA0, pA1, 0, cbA); partialSM<NOMAX>(pA0, pA1, cbA, m_reg, alA);
    if (2 < NT) SLOAD(0, 2);
    SWAIT(); SWRITE(1, 1); __syncthreads();
    for (int j = 1; j + 1 < NT; j += 2) {
        REGIONC(j); ATT_SBAR(); qkt<KC, USEC>(pB0, pB1, K_lds + KBYTES, cb0, qr, cbt, r32, hi);
        REGSC(cbA); finishSM<ONES>(pA0, pA1, alA, l_reg, pa0, pa1, pa2, pa3); ATT_SBAR();
        SLOAD(1, j + 2); ATT_SBAR();
        pv_all<NCB, ONES>(o, lacc, vb0, pa0, pa1, pa2, pa3); MODIFY(pB0, pB1, j, cbB); partialSM<NOMAX>(pB0, pB1, cbB, m_reg, alB);
        __syncthreads(); SWAIT(); SWRITE(0, 0);
        RESC(alB); __syncthreads();
        REGIONC(j + 1); ATT_SBAR(); qkt<KC, USEC>(pA0, pA1, K_lds, cb0, qr, cbt, r32, hi);
        REGSC(cbB); finishSM<ONES>(pB0, pB1, alB, l_reg, pa0, pa1, pa2, pa3); ATT_SBAR();
        if (j + 3 < NT) SLOAD(0, j + 3); ATT_SBAR();
        pv_all<NCB, ONES>(o, lacc, vb0 + VBYTES, pa0, pa1, pa2, pa3); MODIFY(pA0, pA1, j + 1, cbA); partialSM<NOMAX>(pA0, pA1, cbA, m_reg, alA);
        __syncthreads(); SWAIT(); SWRITE(1, 1);
        RESC(alA); __syncthreads();
    }
    REGIONC(NT - 1); ATT_SBAR(); qkt<KC, USEC>(pB0, pB1, K_lds + KBYTES, cb0, qr, cbt, r32, hi);
    REGSC(cbA); finishSM<ONES>(pA0, pA1, alA, l_reg, pa0, pa1, pa2, pa3); ATT_SBAR();
    pv_all<NCB, ONES>(o, lacc, vb0, pa0, pa1, pa2, pa3); MODIFY(pB0, pB1, NT - 1, cbB); partialSM<NOMAX>(pB0, pB1, cbB, m_reg, alB);
    __syncthreads(); RESC(alB);
    REGSC(cbB); finishSM<ONES>(pB0, pB1, alB, l_reg, pa0, pa1, pa2, pa3); ATT_SBAR();
    pv_all<NCB, ONES>(o, lacc, vb0 + VBYTES, pa0, pa1, pa2, pa3);
    }
    float rli[16];
    if constexpr (ONES) {
#pragma unroll
        for (int r = 0; r < 16; ++r) rli[r] = __builtin_amdgcn_rcpf(lacc[r]);
    } else {
        if (hi == 0) li_l[r32] = l_reg; asm volatile("s_waitcnt lgkmcnt(0)" ::: "memory");
#pragma unroll
        for (int r = 0; r < 16; ++r) rli[r] = __builtin_amdgcn_rcpf(li_l[crow(r, hi)]);
    }
    if constexpr (MODE != 1) {
        ATT_LAS bf16_t* stg = (ATT_LAS bf16_t*)(lds + L_OST) + wid * 2048;
#pragma unroll
        for (int r = 0; r < 16; ++r) { const int orow = crow(r, hi);
#pragma unroll
            for (int d0 = 0; d0 < 2; ++d0) stg[orow * 64 + d0 * 32 + r32] = (bf16_t)(cvtpk(o[d0][r] * rli[r], 0.f) & 0xffffu); }
        asm volatile("s_waitcnt lgkmcnt(0)" ::: "memory");
        bf16_t* Ow = ATT + (size_t)(row0 + q0 + wid * 32) * OPITCH + ocol;
#pragma unroll
        for (int i = 0; i < 4; ++i) { const int row = i * 8 + (lane >> 3), ch = lane & 7; const u32x4 v = *(const ATT_LAS u32x4*)(stg + row * 64 + ch * 8); *(u32x4*)(Ow + (size_t)row * OPITCH + ch * 8) = v; }
    } else {
        __syncthreads();
        ATT_LAS float* ex = (ATT_LAS float*)(lds + L_K) + (wid & 3) * 4096;
        if (map == 1) {
#pragma unroll
            for (int d0 = 0; d0 < 4; ++d0)
#pragma unroll
                for (int r = 0; r < 16; ++r) ex[(d0 * 16 + r) * 64 + lane] = o[d0][r] * rli[r];
        }
        __syncthreads();
        if (map == 0) {
            const float sa = wave_sum(ax.lam_p[lane] * ax.lam_p[64 + lane]), sb = wave_sum(ax.lam_p[128 + lane] * ax.lam_p[192 + lane]);
            const float lam = __builtin_amdgcn_exp2f(sa * LOG2E) - __builtin_amdgcn_exp2f(sb * LOG2E) + ax.lam_init;
            float ssq[16];
#pragma unroll
            for (int r = 0; r < 16; ++r) ssq[r] = 0.f;
#pragma unroll
            for (int d0 = 0; d0 < 4; ++d0)
#pragma unroll
                for (int r = 0; r < 16; ++r) { const float d = o[d0][r] * rli[r] - lam * ex[(d0 * 16 + r) * 64 + lane]; o[d0][r] = d; ssq[r] += d * d; }
#pragma unroll
            for (int r = 0; r < 16; ++r) { float s = ssq[r]; s += __shfl_xor(s, 1); s += __shfl_xor(s, 2); s += __shfl_xor(s, 4); s += __shfl_xor(s, 8); s += __shfl_xor(s, 16);
                ssq[r] = __builtin_amdgcn_rsqf(s * (1.0f / 128.0f) + cfg::EPS) * (1.0f - ax.lam_init); }
            float gsub[4];
#pragma unroll
            for (int d0 = 0; d0 < 4; ++d0) gsub[d0] = ax.subln[d0 * 32 + r32];
            ATT_LAS bf16_t* stg = (ATT_LAS bf16_t*)(lds + L_OST) + wid * 4096;
#pragma unroll
            for (int r = 0; r < 16; ++r) { const int orow = crow(r, hi);
#pragma unroll
                for (int d0 = 0; d0 < 4; ++d0) stg[orow * 128 + d0 * 32 + r32] = (bf16_t)(cvtpk(o[d0][r] * ssq[r] * gsub[d0], 0.f) & 0xffffu); }
            asm volatile("s_waitcnt lgkmcnt(0)" ::: "memory");
            bf16_t* Ow = ATT + (size_t)(row0 + q0 + wid * 32) * OPITCH + ocol;
#pragma unroll
            for (int i = 0; i < 8; ++i) { const int row = i * 4 + (lane >> 4), ch = lane & 15; const u32x4 v = *(const ATT_LAS u32x4*)(stg + row * 128 + ch * 8); *(u32x4*)(Ow + (size_t)row * OPITCH + ch * 8) = v; }
        }
    }
    __syncthreads();
#undef SLOAD
#undef SWRITE
#undef SWAIT
#undef RESC
#undef MODIFY
#undef REGIONC
#undef REGSC
}
#undef ATT_SBAR
}
#define GAS __attribute__((address_space(1)))
#define LAS __attribute__((address_space(3)))
typedef unsigned short bf16;
typedef unsigned v4u __attribute__((ext_vector_type(4)));
typedef float f32x4 __attribute__((ext_vector_type(4)));
typedef short bf16x8 __attribute__((ext_vector_type(8)));
typedef GAS unsigned gu32;
typedef GAS unsigned long long gu64;
#define RLX_AGENT __ATOMIC_RELAXED, __HIP_MEMORY_SCOPE_AGENT
#define LDS_WAIT() asm volatile("s_waitcnt lgkmcnt(0)" ::: "memory")
#define VM_WAIT() asm volatile("s_waitcnt vmcnt(0)" ::: "memory")
__device__ __forceinline__ unsigned long long rt() { return __builtin_amdgcn_s_memrealtime(); }
__device__ __forceinline__ unsigned f2bf(float f) { unsigned u = __builtin_bit_cast(unsigned, f); return (u + 0x7fffu + ((u >> 16) & 1u)) >> 16; }
__device__ __forceinline__ unsigned pk2(float lo, float hi) { return f2bf(lo) | (f2bf(hi) << 16); }

#define XB_TMO      128
#define XB_XCNT(j)  (256  + 64 * (j))
#define XB_XSUB(j)  (1280 + 64 * (j))
#define XB_XGEN(j)  (2304 + 64 * (j))
#define XB_TOP      3328
#define XB_TOPGEN   3392
#define XCD_BAR_WORDS 3456
#define XB_SPIN_CAP (1u << 18)

__device__ __forceinline__ unsigned xb_ld(unsigned* p)              { return __hip_atomic_load(p, __ATOMIC_RELAXED, __HIP_MEMORY_SCOPE_AGENT); }
__device__ __forceinline__ unsigned xb_add(unsigned* p, unsigned v) { return __hip_atomic_fetch_add(p, v, __ATOMIC_RELAXED, __HIP_MEMORY_SCOPE_AGENT); }
__device__ __forceinline__ unsigned xb_xcc_id() { return (unsigned)__builtin_amdgcn_s_getreg((3 << 11) | 20) & 0xFu; }
#define XB_SPIN(cond, bar) do { unsigned _sp = 0; while (cond) { __builtin_amdgcn_s_sleep(1); \
    if ((++_sp & 255u) == 0u) { if (xb_ld(&(bar)[XB_TMO])) break; if (_sp > XB_SPIN_CAP) { atomicAdd(&(bar)[XB_TMO], 1u); break; } } } } while (0)

struct XcdBarrier {
    unsigned* bar; unsigned x;
    volatile LAS unsigned* st;
};

__device__ __forceinline__ XcdBarrier xcd_barrier_post(unsigned* bar, volatile LAS unsigned* st) {
    XcdBarrier b; b.bar = bar; b.x = xb_xcc_id(); b.st = st;
    if (threadIdx.x == 0) (void)xb_add(&bar[XB_XCNT(b.x)], 1u);
    return b;
}
__device__ __forceinline__ void xcd_barrier_complete(unsigned* bar, unsigned x, unsigned& nloc, unsigned& nx) {
    const unsigned G = gridDim.x * gridDim.y * gridDim.z;
    unsigned sum, cnt, mine, sp = 0u;
    for (;;) {
        sum = 0u; cnt = 0u; mine = 0u;
#pragma unroll
        for (unsigned j = 0; j < 16; ++j) { const unsigned c = xb_ld(&bar[XB_XCNT(j)]); sum += c; cnt += (c > 0u) ? 1u : 0u; mine = (j == x) ? c : mine; }
        if (sum == G) break;
        __builtin_amdgcn_s_sleep(1);
        if ((++sp & 255u) == 0u) { if (xb_ld(&bar[XB_TMO])) break; if (sp > XB_SPIN_CAP) { atomicAdd(&bar[XB_TMO], 1u); break; } }
    }
    nloc = mine > 0u ? mine : 1u; nx = cnt > 0u ? cnt : 1u;
}

__device__ __forceinline__ void xcd_barrier(const XcdBarrier& b) {
    asm volatile("s_waitcnt vmcnt(0)" ::: "memory");
    __syncthreads();
    if (threadIdx.x == 0) {
        unsigned* bar = b.bar;
        __builtin_amdgcn_s_waitcnt(0);
        unsigned nloc = b.st[0], nx = b.st[1];
        if (nloc == 0u) { xcd_barrier_complete(bar, b.x, nloc, nx); b.st[0] = nloc; b.st[1] = nx; }
        const unsigned old = xb_add(&bar[XB_XSUB(b.x)], 1u);
        const unsigned gen = old / nloc;
        if (old + 1u == (gen + 1u) * nloc) {
            __builtin_amdgcn_fence(__ATOMIC_RELEASE, "agent");
            asm volatile("s_waitcnt vmcnt(0)" ::: "memory");
            const unsigned og = xb_add(&bar[XB_TOP], 1u);
            const unsigned tg = og / nx;
            if (og + 1u == (tg + 1u) * nx) xb_add(&bar[XB_TOPGEN], 1u);
            else XB_SPIN(xb_ld(&bar[XB_TOPGEN]) == tg, bar);
            __builtin_amdgcn_fence(__ATOMIC_ACQUIRE, "agent");
            xb_add(&bar[XB_XGEN(b.x)], 1u);
            asm volatile("s_waitcnt vmcnt(0)" ::: "memory");
        } else {
            XB_SPIN(xb_ld(&bar[XB_XGEN(b.x)]) == gen, bar);
            __builtin_amdgcn_fence(__ATOMIC_ACQUIRE, "agent");
            asm volatile("s_waitcnt vmcnt(0)" ::: "memory");
        }
    }
    __syncthreads();
}

__device__ __forceinline__ void xcd_local_barrier(const XcdBarrier& b) {
    asm volatile("s_waitcnt vmcnt(0)" ::: "memory");
    __syncthreads();
    if (threadIdx.x == 0) {
        unsigned* bar = b.bar;
        __builtin_amdgcn_s_waitcnt(0);
        unsigned nloc = b.st[0]; nloc = nloc ? nloc : 1u;
        const unsigned old = xb_add(&bar[XB_XSUB(b.x)], 1u);
        const unsigned gen = old / nloc;
        if (old + 1u == (gen + 1u) * nloc) xb_add(&bar[XB_XGEN(b.x)], 1u);
        else XB_SPIN(xb_ld(&bar[XB_XGEN(b.x)]) == gen, bar);
        __builtin_amdgcn_fence(__ATOMIC_ACQUIRE, "agent");
        asm volatile("s_waitcnt vmcnt(0)" ::: "memory");
    }
    __syncthreads();
}

constexpr int NWAVES = 8;
constexpr size_t MiB = 1u << 20;
constexpr size_t WS_CTL = 0, CTL_ZERO_BYTES = 1 * MiB;
constexpr size_t WS_WGU = 2 * MiB, WS_WD = 46 * MiB, WS_WIN = 68 * MiB, WS_WOUT = 89 * MiB;
constexpr size_t WS_R = 98 * MiB;
constexpr size_t WS_ATT = 290 * MiB;
constexpr size_t WS_BIG = 482 * MiB;
constexpr size_t WS_RSS = 1010 * MiB, RSS_BYTES = 3 * MiB;
constexpr size_t WS_END = 1013 * MiB;
static_assert(WS_WGU + (size_t)cfg::NGU * cfg::DM * 2 <= WS_WD && WS_WD + (size_t)cfg::DM * cfg::DFF * 2 <= WS_WIN && WS_WIN + (size_t)cfg::NIN * cfg::DM * 2 <= WS_WOUT &&
              WS_WOUT + (size_t)cfg::DM * cfg::DM * 2 <= WS_R && WS_R + (size_t)cfg::M * cfg::DM * 2 <= WS_ATT && WS_ATT + (size_t)cfg::M * cfg::DM * 2 <= WS_BIG && WS_BIG + (size_t)cfg::M * cfg::DFF * 2 <= WS_END, "d_ws map");
#ifndef WGM_DN
#define WGM_DN 4
#endif
#ifndef GEMM_SP2
#define GEMM_SP2 true
#endif
#ifndef GEMM_ALIGN
#define GEMM_ALIGN true
#endif
#ifndef WGM_GU
#define WGM_GU 8
#endif
constexpr int CW_BAR = 4096;
constexpr int CW_NRM = 8192;
constexpr int RING_OFF = 0, RING_BYTES = 131072, LDSCTL_OFF = RING_BYTES, MISC_OFF = LDSCTL_OFF + 320, LDS_BYTES = 147456;
static_assert(att::L_END <= RING_BYTES && MISC_OFF + 128 <= LDS_BYTES, "LDS map");

struct Frame {
    LAS unsigned char* lds; volatile LAS unsigned* MISC; int wave, vcu, G;
};
__device__ __forceinline__ float wave_sum_f(float v) {
#pragma unroll
    for (int o = 1; o < 64; o <<= 1) v += __shfl_xor(v, o);
    return v;
}
__device__ __forceinline__ void transpose_item(const float* W, int K, int N, bf16* WT, int k0, int n0, int rowbase, const float* gain, LAS float* scr, int lane) {
#pragma unroll 8
    for (int i = 0; i < 32; ++i) { const int kk = 2 * i + (lane >> 5); scr[kk * 33 + (lane & 31)] = W[(size_t)(k0 + kk) * N + n0 + (lane & 31)]; }
    LDS_WAIT(); asm volatile("" ::: "memory");
    const int c = lane & 7;
    f32x4 g0 = {1.f, 1.f, 1.f, 1.f}, g1 = g0;
    if (gain) { g0 = *(const f32x4*)(gain + k0 + 8 * c); g1 = *(const f32x4*)(gain + k0 + 8 * c + 4); }
#pragma unroll
    for (int j = 0; j < 4; ++j) { const int n = (lane >> 3) + 8 * j; const LAS float* s = scr + (8 * c) * 33 + n;
        v4u o; o.x = pk2(s[0 * 33] * g0[0], s[1 * 33] * g0[1]); o.y = pk2(s[2 * 33] * g0[2], s[3 * 33] * g0[3]); o.z = pk2(s[4 * 33] * g1[0], s[5 * 33] * g1[1]); o.w = pk2(s[6 * 33] * g1[2], s[7 * 33] * g1[3]);
        *(GAS v4u*)(WT + (size_t)(rowbase + n) * K + k0 + 8 * c) = o; }
    LDS_WAIT(); asm volatile("" ::: "memory");
}
__device__ __forceinline__ void conv_ffn(const Frame& F, const float* wg, const float* wu, const float* wd, const float* gain, unsigned char* ws) {
    using namespace cfg;
    { const GAS float *a = (const GAS float*)wg, *b = (const GAS float*)wu, *c = (const GAS float*)wd, *d = (const GAS float*)gain; asm volatile("" : "+s"(a), "+s"(b), "+s"(c), "+s"(d));
      wg = (const float*)a; wu = (const float*)b; wd = (const float*)c; gain = (const float*)d; }
    int lane = threadIdx.x; asm volatile("" : "+v"(lane)); lane &= 63;
    LAS float* scr = (LAS float*)(F.lds + RING_OFF + F.wave * 16384);
    const int gw = F.vcu * NWAVES + F.wave, NGW = F.G * NWAVES;
    constexpr int I_G = (DM / 64) * (DFF / 32), I_D = (DFF / 64) * (DM / 32);
    static_assert(I_G == I_D, "");
    for (int it = gw; it < 3 * I_G; it += NGW) {
        const int which = it / I_G, r = it - which * I_G;
        if (which < 2) { const int nblk = DFF / 32, kb = r / nblk, nb = r % nblk, n0 = 32 * nb;
            transpose_item(which ? wu : wg, DM, DFF, (bf16*)(ws + WS_WGU), 64 * kb, n0, 256 * (n0 >> 7) + 128 * which + (n0 & 127), gain, scr, lane); }
        else { const int nblk = DM / 32, kb = r / nblk, nb = r % nblk, n0 = 32 * nb;
            transpose_item(wd, DFF, DM, (bf16*)(ws + WS_WD), 64 * kb, n0, n0, nullptr, scr, lane); }
    }
}
__device__ __forceinline__ void conv_mix(const Frame& F, const float* win, const float* wout, const float* gain, unsigned char* ws) {
    using namespace cfg;
    { const GAS float *a = (const GAS float*)win, *b = (const GAS float*)wout, *d = (const GAS float*)gain; asm volatile("" : "+s"(a), "+s"(b), "+s"(d)); win = (const float*)a; wout = (const float*)b; gain = (const float*)d; }
    int lane = threadIdx.x; asm volatile("" : "+v"(lane)); lane &= 63;
    LAS float* scr = (LAS float*)(F.lds + RING_OFF + F.wave * 16384);
    const int gw = F.vcu * NWAVES + F.wave, NGW = F.G * NWAVES;
    constexpr int I_IN = (DM / 64) * (NIN / 32), I_O = (DM / 64) * (DM / 32);
    for (int it = gw; it < I_IN + I_O; it += NGW) {
        if (it < I_IN) { const int nblk = NIN / 32, kb = it / nblk, nb = it % nblk, n0 = 32 * nb;
            transpose_item(win, DM, NIN, (bf16*)(ws + WS_WIN), 64 * kb, n0, 256 * (n0 >> 8) + 128 * ((n0 & 63) >> 5) + 32 * ((n0 & 255) >> 6), gain, scr, lane); }
        else { const int r = it - I_IN, nblk = DM / 32, kb = r / nblk, nb = r % nblk, n0 = 32 * nb;
            transpose_item(wout, DM, DM, (bf16*)(ws + WS_WOUT), 64 * kb, n0, n0, nullptr, scr, lane); }
    }
}
template <bool FINAL>
__device__ __forceinline__ void row_phase(const Frame& F, const float* xp, const float* xs, float* out, const float* gain, bf16* R, unsigned long long* rss) {
    using namespace cfg;
    int lane = threadIdx.x; asm volatile("" : "+v"(lane)); lane &= 63;
    const int gw = F.vcu * NWAVES + F.wave, NGW = F.G * NWAVES;
    if constexpr (FINAL) {
        { const GAS float* a = (const GAS float*)gain; asm volatile("" : "+s"(a)); gain = (const float*)a; }
        f32x4 g[4][2];
#pragma unroll
        for (int k = 0; k < 4; ++k) { g[k][0] = ((const f32x4*)gain)[2 * (lane + 64 * k)]; g[k][1] = ((const f32x4*)gain)[2 * (lane + 64 * k) + 1]; }
        for (int m = gw; m < M; m += NGW) {
            const GAS v4u* xr = (const GAS v4u*)(R + (size_t)m * DM) + lane;
            v4u w[4]; f32x4 v[4][2]; float s = 0.f;
#pragma unroll
            for (int k = 0; k < 4; ++k) w[k] = xr[64 * k];
#pragma unroll
            for (int k = 0; k < 4; ++k) { v[k][0] = (f32x4){__uint_as_float(w[k].x << 16), __uint_as_float(w[k].x & 0xffff0000u), __uint_as_float(w[k].y << 16), __uint_as_float(w[k].y & 0xffff0000u)};
                v[k][1] = (f32x4){__uint_as_float(w[k].z << 16), __uint_as_float(w[k].z & 0xffff0000u), __uint_as_float(w[k].w << 16), __uint_as_float(w[k].w & 0xffff0000u)};
#pragma unroll
                for (int e = 0; e < 2; ++e) s += (v[k][e].x * v[k][e].x + v[k][e].y * v[k][e].y) + (v[k][e].z * v[k][e].z + v[k][e].w * v[k][e].w); }
            const float rinv = 1.0f / sqrtf(wave_sum_f(s) * (1.0f / DM) + EPS);
            GAS f32x4* o = (GAS f32x4*)(out + (size_t)m * DM);
#pragma unroll
            for (int k = 0; k < 4; ++k) { o[2 * (lane + 64 * k)] = v[k][0] * rinv * g[k][0]; o[2 * (lane + 64 * k) + 1] = v[k][1] * rinv * g[k][1]; }
        }
    } else {
        for (int m = gw; m < M; m += NGW) {
            const float* xrow = m < MP ? xp + (size_t)m * DM : xs + (size_t)(m - MP) * DM;
            const GAS f32x4* xr = (const GAS f32x4*)xrow + lane;
            f32x4 v[8]; float s = 0.f;
#pragma unroll
            for (int j = 0; j < 8; ++j) { v[j] = xr[64 * j]; s += (v[j].x * v[j].x + v[j].y * v[j].y) + (v[j].z * v[j].z + v[j].w * v[j].w); }
            const float ssum = wave_sum_f(s);
            GAS unsigned long long* o8 = (GAS unsigned long long*)(R + (size_t)m * DM) + lane;
#pragma unroll
            for (int j = 0; j < 8; ++j) o8[64 * j] = (unsigned long long)pk2(v[j].x, v[j].y) | ((unsigned long long)pk2(v[j].z, v[j].w) << 32);
            if (lane == 0) ((GAS unsigned long long*)rss)[m] = (unsigned long long)(ssum * 4294967296.0f);
        }
    }
}

struct Args { const float* in[20]; float* out; unsigned char* ws; int ph_lo, ph_hi, pad0, pad1; };
__global__ void __launch_bounds__(NWAVES * 64, 2) mk_fwd(Args args) {
    using namespace cfg;
    extern __shared__ __attribute__((aligned(16))) unsigned char lds[];
    Frame F;
    F.lds = (LAS unsigned char*)lds; F.MISC = (volatile LAS unsigned*)(F.lds + MISC_OFF);
    F.wave = __builtin_amdgcn_readfirstlane((int)threadIdx.x >> 6);
    F.G = gridDim.x; { const int bx = blockIdx.x; F.vcu = (F.G % 8 == 0) ? (bx % 8) * (F.G / 8) + bx / 8 : bx; }
    unsigned char* ws = args.ws; gu32* ctl = (gu32*)(ws + WS_CTL);
    const float* const p_xp = args.in[0]; const float* const p_xs = args.in[1]; const float* const p_f1n = args.in[2]; const float* const p_f1g = args.in[3]; const float* const p_f1u = args.in[4];
    const float* const p_f1d = args.in[5]; const float* const p_mixn = args.in[6]; const float* const p_win = args.in[7]; const float* const p_aqn = args.in[8]; const float* const p_akn = args.in[9];
    const float* const p_blam = args.in[10]; const float* const p_bsub = args.in[11]; const float* const p_crpb = args.in[12]; const float* const p_wout = args.in[13]; const float* const p_f2n = args.in[14];
    const float* const p_f2g = args.in[15]; const float* const p_f2u = args.in[16]; const float* const p_f2d = args.in[17]; const float* const p_t5 = args.in[18]; const float* const p_fin = args.in[19];
    float* out = args.out;
    bf16* RS = (bf16*)(ws + WS_R); bf16* ATB = (bf16*)(ws + WS_ATT); bf16* BIG = (bf16*)(ws + WS_BIG);
    for (int u = threadIdx.x; u < (LDS_BYTES - LDSCTL_OFF) / 4; u += NWAVES * 64) ((LAS unsigned*)(F.lds + LDSCTL_OFF))[u] = 0u;
    __syncthreads();
    XcdBarrier bar; bar.bar = (unsigned*)(ctl + CW_BAR); bar.x = 0; bar.st = nullptr;
    if (!MK_PER_PHASE) bar = xcd_barrier_post((unsigned*)(ctl + CW_BAR), F.MISC + 8);
    const int lo = args.ph_lo, hi = args.ph_hi;
    int ph = 0;
#define IN(k) (lo <= (k) && (k) < hi)
#define FRESH() GAS float* out_g = (GAS float*)out; GAS unsigned char* ws_g = (GAS unsigned char*)ws; GAS bf16* R_g = (GAS bf16*)RS; GAS bf16* BIG_g = (GAS bf16*)BIG; GAS bf16* AT_g = (GAS bf16*)ATB; const GAS float* xp_g = (const GAS float*)p_xp; const GAS float* xs_g = (const GAS float*)p_xs; \
    asm volatile("" : "+s"(out_g), "+s"(ws_g), "+s"(R_g), "+s"(BIG_g), "+s"(AT_g), "+s"(xp_g), "+s"(xs_g)); \
    float* out_ = (float*)out_g; unsigned char* ws_ = (unsigned char*)ws_g; bf16* R_ = (bf16*)R_g; bf16* BIG_ = (bf16*)BIG_g; bf16* ATB_ = (bf16*)AT_g; const float* xp_ = (const float*)xp_g; const float* xs_ = (const float*)xs_g; (void)ATB_; (void)BIG_; (void)R_; (void)xp_; (void)xs_; (void)out_
#define SEAM() do { if (IN(ph) && IN(ph + 1)) { if (MK_PER_PHASE) { if (threadIdx.x == 0) __hip_atomic_store(ctl, 0xBADBA0u, RLX_AGENT); } else xcd_barrier(bar); } ++ph; } while (0)

    for (int L = 0; L < 2; ++L) {
        unsigned long long* const rssA = (unsigned long long*)(ws + WS_RSS) + (size_t)(L == 0 ? 0 : 3) * M;
        unsigned long long* const rssB = (unsigned long long*)(ws + WS_RSS) + (size_t)(L == 0 ? 1 : 4) * M;
        unsigned long long* const rssC = (unsigned long long*)(ws + WS_RSS) + (size_t)(L == 0 ? 2 : 5) * M;
        if (IN(ph)) { FRESH();
            conv_ffn(F, p_f1g + (size_t)L * DM * DFF, p_f1u + (size_t)L * DM * DFF, p_f1d + (size_t)L * DM * DFF, p_f1n + L * DM, ws_);
            conv_mix(F, p_win + (size_t)L * DM * NIN, p_wout + (size_t)L * DM * DM, p_mixn + L * DM, ws_);
            if (L == 0) row_phase<false>(F, xp_, xs_, out_, nullptr, R_, rssA);
        }
        SEAM();
        if (IN(ph)) { FRESH();
            pg8::Gemm g{R_, (const bf16*)(ws_ + WS_WGU), M, NGU, DM}; pg8::StaticOrder S; S.init(M, NGU, F.G, (int)blockIdx.x, WGM_GU);
            pg8::EpiSwiglu E{BIG_, rssA};
#ifndef NO_GU
            pg8::gemm_phase<pg8::EpiSwiglu, pg8::StaticOrder, GEMM_ALIGN, GEMM_SP2>(F.lds + RING_OFF, g, S, E);
#endif
        }
        SEAM();
        if (IN(ph)) { FRESH();
            pg8::Gemm g{BIG_, (const bf16*)(ws_ + WS_WD), M, DM, DFF}; pg8::StaticOrder S; S.init(M, DM, F.G, (int)blockIdx.x, WGM_DN);
            pg8::EpiResid E{R_, 0.5f, rssB};
#ifndef NO_RES
            pg8::gemm_phase<pg8::EpiResid, pg8::StaticOrder, GEMM_ALIGN, GEMM_SP2>(F.lds + RING_OFF, g, S, E);
#endif
        }
        SEAM();
        if (IN(ph)) { FRESH();
            conv_ffn(F, p_f2g + (size_t)L * DM * DFF, p_f2u + (size_t)L * DM * DFF, p_f2d + (size_t)L * DM * DFF, p_f2n + L * DM, ws_);
            __syncthreads();
            pg8::Gemm g{R_, (const bf16*)(ws_ + WS_WIN), M, NIN, DM}; pg8::StaticOrder S; S.init(M, NIN, F.G, (int)blockIdx.x, WGM_GU);
            pg8::EpiWin E{BIG_, p_aqn + L * 64, p_akn + L * 64, rssB, (unsigned*)(ctl + CW_NRM + L * 336)};
#ifndef NO_WIN
            pg8::gemm_phase<pg8::EpiWin, pg8::StaticOrder, GEMM_ALIGN, GEMM_SP2>(F.lds + RING_OFF, g, S, E);
#endif
        }
        SEAM();
        if (IN(ph)) { FRESH(); bf16* const QKV_ = BIG_; bf16* const ATT_ = ATB_;
                att::Aux ax{p_t5, p_crpb + (size_t)L * 8 * 15 * 31, p_blam + L * 256, p_bsub + L * 128, (L == 0 ? 0.2f : 0.35550906759f)};
                const att::lptr al = (att::lptr)(F.lds + RING_OFF);
#ifdef ATT_PRIO
                if (F.wave >= 4) __builtin_amdgcn_s_setprio(1);
#endif
#ifndef PROBE_ATT_REP
#define PROBE_ATT_REP 1
#endif
                for (int rep_ = 0; rep_ < PROBE_ATT_REP; ++rep_) {
#ifndef REP_B
#define REP_B 1
#endif
#ifndef REP_A
#define REP_A 1
#endif
#ifndef REP_D
#define REP_D 1
#endif
#ifndef REP_C
#define REP_C 1
#endif
                float t5max = 0.f, rpbmax = 0.f;
                { int ln = threadIdx.x; asm volatile("" : "+v"(ln)); ln &= 63;
#pragma unroll
                  for (int k_ = 0; k_ < 6; ++k_) t5max = fmaxf(t5max, fabsf(p_t5[ln + 64 * k_]));
                  for (int k_ = 0; k_ < 59; ++k_) { const int ix = ln + 64 * k_; if (ix < 8 * 15 * 31) rpbmax = fmaxf(rpbmax, fabsf(ax.rpb[ix])); }
#pragma unroll
                  for (int o_ = 1; o_ < 64; o_ <<= 1) { t5max = fmaxf(t5max, __shfl_xor(t5max, o_)); rpbmax = fmaxf(rpbmax, __shfl_xor(rpbmax, o_)); } }
                t5max = __uint_as_float(__builtin_amdgcn_readfirstlane(__float_as_uint(t5max))); rpbmax = __uint_as_float(__builtin_amdgcn_readfirstlane(__float_as_uint(rpbmax)));
                const GAS unsigned* nrm2 = (const GAS unsigned*)(ctl + CW_NRM + L * 336);
#define SEQ_OF(r0_) ((r0_) < MP ? ((r0_) >> 14) : 2 + (((r0_) - MP) >> 13))
#define NRM(blk_, sq_) __uint_as_float(nrm2[(blk_) * 4 + (sq_)])
                for (int rb_ = 0; rb_ < REP_B; ++rb_)
                for (int u = F.vcu; u < 1536; u += F.G) {
#ifndef NO_ATT1
                    int r0, T, h, qb;
                    if (u < 1024) { r0 = (u >> 9) * TP; T = TP; h = (u >> 7) & 3; qb = u & 127; } else { const int v = u - 1024; r0 = MP + (v >> 8) * TS; T = TS; h = (v >> 6) & 3; qb = v & 63; }
                    const int sq = SEQ_OF(r0);
                    const float bnd = sqrtf(fmaxf(NRM(12 + 2 * h, sq), NRM(13 + 2 * h, sq)) * fmaxf(NRM(20 + 2 * h, sq), NRM(21 + 2 * h, sq))) * 1.01f + t5max * LOG2E;
                    if (__builtin_amdgcn_readfirstlane((int)(bnd <= 80.0f))) att::attn_unit<1, true>(QKV_, ATT_, al, r0, T, h, qb, ax); else att::attn_unit<1, false>(QKV_, ATT_, al, r0, T, h, qb, ax);
#endif
                }
                bool a_nomax;
                { int ln_ = threadIdx.x; asm volatile("" : "+v"(ln_)); ln_ &= 63; float gq = fabsf(p_aqn[L * 64 + ln_]), gk = fabsf(p_akn[L * 64 + ln_]);
#pragma unroll
                  for (int o_ = 1; o_ < 64; o_ <<= 1) { gq = fmaxf(gq, __shfl_xor(gq, o_)); gk = fmaxf(gk, __shfl_xor(gk, o_)); }
                  const float bound = 8.0f * LOG2E * gq * gk * 1.01f; a_nomax = __builtin_amdgcn_readfirstlane((int)(bound <= 80.0f)) != 0; }
                for (int ra_ = 0; ra_ < REP_A; ++ra_)
                for (int u = F.vcu; u < 1536; u += F.G) {
#ifndef NO_ATT0
                    int r0, T, h, qb;
                    if (u < 1024) { r0 = (u >> 9) * TP; T = TP; h = (u >> 6) & 7; qb = u & 63; } else { const int v = u - 1024; r0 = MP + (v >> 8) * TS; T = TS; h = (v >> 5) & 7; qb = v & 31; }
                    if (a_nomax) att::attn_unit<0, true>(QKV_, ATT_, al, r0, T, h, qb, ax); else att::attn_unit<0, false>(QKV_, ATT_, al, r0, T, h, qb, ax);
#endif
                }
                for (int rd_ = 0; rd_ < REP_D; ++rd_)
                for (int u = F.vcu; u < 1536; u += F.G) {
                    const int h = u / 192, qg = u % 192; int r0, T, qb;
                    if (qg < 128) { r0 = (qg >> 6) * TP; T = TP; qb = qg & 63; } else { r0 = MP + ((qg - 128) >> 5) * TS; T = TS; qb = (qg - 128) & 31; }
#ifndef NO_ATT3
                    { const int sq = SEQ_OF(r0); const float bnd = sqrtf(NRM(60 + h, sq) * NRM(68 + h, sq)) * 1.01f + t5max * LOG2E + 1.6f;
                      if (__builtin_amdgcn_readfirstlane((int)(bnd <= 80.0f))) att::attn_unit<3, true>(QKV_, ATT_, al, r0, T, h, qb, ax); else att::attn_unit<3, false>(QKV_, ATT_, al, r0, T, h, qb, ax); }
#endif
                }
                for (int rc_ = 0; rc_ < REP_C; ++rc_)
                for (int u = F.vcu; u < 1536; u += F.G) {
                    const int h = u / 192, qg = u % 192; int r0, T, qb;
                    if (qg < 128) { r0 = (qg >> 6) * TP; T = TP; qb = qg & 63; } else { r0 = MP + ((qg - 128) >> 5) * TS; T = TS; qb = (qg - 128) & 31; }
#ifndef NO_ATT2
                    { const int sq = SEQ_OF(r0); const float bnd = sqrtf(NRM(36 + h, sq) * NRM(44 + h, sq)) * 1.01f + rpbmax * LOG2E;
                      if (__builtin_amdgcn_readfirstlane((int)(bnd <= 80.0f))) att::attn_unit<2, true>(QKV_, ATT_, al, r0, T, h, qb, ax); else att::attn_unit<2, false>(QKV_, ATT_, al, r0, T, h, qb, ax); }
#endif
                }
                }
                    }
        SEAM();
        if (IN(ph)) { FRESH();
            pg8::Gemm g{ATB_, (const bf16*)(ws_ + WS_WOUT), M, DM, DM}; pg8::StaticOrder S; S.init(M, DM, F.G, (int)blockIdx.x, WGM_DN);
            pg8::EpiResid E{R_, 1.0f, rssC};
#ifndef NO_RES
            pg8::gemm_phase<pg8::EpiResid, pg8::StaticOrder, GEMM_ALIGN, GEMM_SP2>(F.lds + RING_OFF, g, S, E);
#endif
        }
        SEAM();
        if (IN(ph)) { FRESH();
            pg8::Gemm g{R_, (const bf16*)(ws_ + WS_WGU), M, NGU, DM}; pg8::StaticOrder S; S.init(M, NGU, F.G, (int)blockIdx.x, WGM_GU);
            pg8::EpiSwiglu E{BIG_, rssC};
#ifndef NO_GU
            pg8::gemm_phase<pg8::EpiSwiglu, pg8::StaticOrder, GEMM_ALIGN, GEMM_SP2>(F.lds + RING_OFF, g, S, E);
#endif
        }
        SEAM();
        if (IN(ph)) { FRESH();
            pg8::Gemm g{BIG_, (const bf16*)(ws_ + WS_WD), M, DM, DFF}; pg8::StaticOrder S; S.init(M, DM, F.G, (int)blockIdx.x, WGM_DN);
            pg8::EpiResid E{R_, 0.5f, L == 0 ? (unsigned long long*)(ws + WS_RSS) + (size_t)3 * M : (unsigned long long*)nullptr};
#ifndef NO_RES
            pg8::gemm_phase<pg8::EpiResid, pg8::StaticOrder, GEMM_ALIGN, GEMM_SP2>(F.lds + RING_OFF, g, S, E);
#endif
        }
        SEAM();
    }
    if (IN(ph)) { FRESH(); row_phase<true>(F, xp_, xs_, out_, p_fin, R_, nullptr); }
#undef IN
#undef SEAM
}
constexpr int N_PHASES = 17;

extern "C" void kernel_launch(void* const* d_in, const int* in_sizes, int n_in, void* d_out, int out_size, void* d_ws, size_t ws_size, hipStream_t stream) {
    static int grid = 0;
    if (grid == 0) {
        if (n_in != 20 || in_sizes[0] != cfg::MP * cfg::DM || in_sizes[1] != cfg::MS * cfg::DM || out_size != cfg::M * cfg::DM || ws_size < WS_END) {
            fprintf(stderr, "kernel_launch: shape mismatch (n_in %d, in0 %d, in1 %d, out %d, ws %zu need %zu); nothing launched\n", n_in, n_in > 0 ? in_sizes[0] : -1, n_in > 1 ? in_sizes[1] : -1, out_size, ws_size, (size_t)WS_END); grid = -1; return; }
        int dev = 0, cus = 0, per_cu = 0;
        if (hipGetDevice(&dev) != hipSuccess || hipDeviceGetAttribute(&cus, hipDeviceAttributeMultiprocessorCount, dev) != hipSuccess) { fprintf(stderr, "kernel_launch: device query failed\n"); grid = -1; return; }
        if (hipFuncSetAttribute((const void*)mk_fwd, hipFuncAttributeMaxDynamicSharedMemorySize, LDS_BYTES) != hipSuccess) { fprintf(stderr, "kernel_launch: hipFuncSetAttribute failed\n"); grid = -1; return; }
        if (hipOccupancyMaxActiveBlocksPerMultiprocessor(&per_cu, (const void*)mk_fwd, NWAVES * 64, LDS_BYTES) != hipSuccess || per_cu < 1) {
            fprintf(stderr, "kernel_launch: occupancy query reports %d workgroups per CU; nothing launched\n", per_cu); (void)hipGetLastError(); grid = -1; return; }
        (void)hipGetLastError();
        grid = cus;
    }
    if (grid < 0) return;
    if (hipMemsetAsync((char*)d_ws + WS_CTL, 0, CTL_ZERO_BYTES, stream) != hipSuccess || hipMemsetAsync((char*)d_ws + WS_RSS, 0, RSS_BYTES, stream) != hipSuccess) { fprintf(stderr, "kernel_launch: memset failed\n"); return; }
    Args a{};
    for (int i = 0; i < 20; ++i) a.in[i] = (const float*)d_in[i];
    a.out = (float*)d_out; a.ws = (unsigned char*)d_ws;
#if MK_PER_PHASE
    for (int p = 0; p < N_PHASES; ++p) { a.ph_lo = p; a.ph_hi = p + 1; hipLaunchKernelGGL(mk_fwd, dim3(grid), dim3(NWAVES * 64), LDS_BYTES, stream, a); }
#else
    a.ph_lo = 0; a.ph_hi = N_PHASES;
    hipLaunchKernelGGL(mk_fwd, dim3(grid), dim3(NWAVES * 64), LDS_BYTES, stream, a);
#endif
    const hipError_t le = hipPeekAtLastError();
    if (le != hipSuccess) fprintf(stderr, "kernel_launch: launch failed: %s\n", hipGetErrorName(le));
}
```

```cpp
#include <hip/hip_runtime.h>
#include <cstdio>
#include <cstdint>

#ifndef MK_PER_PHASE
#define MK_PER_PHASE 0
#endif

namespace cfg {
constexpr int DM = 2048, DFF = 5632, NIN = 5376, NGU = 2 * DFF;
constexpr int TP = 16384, TS = 8192, MP = 2 * TP, MS = 2 * TS, M = MP + MS;
constexpr float EPS = 1e-6f;
constexpr float LOG2E = 1.4426950408889634f;
constexpr float C2 = 0.125f * LOG2E;
}
namespace pg8 {
#define PG8_LAS __attribute__((address_space(3)))
typedef unsigned short bf16_t;
typedef short bf16x8 __attribute__((ext_vector_type(8)));
typedef float f32x4 __attribute__((ext_vector_type(4)));
typedef unsigned u32x4 __attribute__((ext_vector_type(4)));
constexpr int BM = 256, BK = 64, HALF = 128, HTB = HALF * BK * 2  , STAGE_BYTES = 8 * HTB, NXCD = 8, WGM = 8;

__host__ __device__ __forceinline__ int lds_byte(int r, int c) { const int st = (r >> 4) * 2 + (c >> 5), rr = r & 15, cc = c & 31, ob = rr * 64 + cc * 2; return st * 1024 + (ob ^ (((ob >> 9) & 1) << 5)); }
__host__ __device__ __forceinline__ void stage_rc(int b, int& R, int& C) { const int st = b / 1024, sb = b % 1024, swz = sb ^ (((sb >> 9) & 1) << 5); R = (st >> 1) * 16 + swz / 64; C = (st & 1) * 32 + (swz % 64) / 2; }
__host__ __device__ __forceinline__ int perm32(int rho) { const int n = rho >> 4, i = rho & 15; return 8 * (i >> 2) + 4 * n + (i & 3); }

struct Unit { int pm, pn; };
struct Gemm { const bf16_t* A; const bf16_t* Bt; int M, N, K; };

struct StaticOrder {
    int nM, nN, nwg, G, c, wgm;
    __host__ __device__ void init(int M, int N, int G_, int c_, int wgm_ = WGM) { nM = M / BM; nN = N / BM; nwg = nM * nN; G = G_; c = c_; wgm = wgm_; }
    __host__ __device__ bool next(int i, Unit& u) const {
        const long L = (long)i * G + c; if (L >= nwg) return false;
        int wgid = (int)L; { const int q = nwg / NXCD, r = nwg % NXCD, xcd = wgid % NXCD, off = wgid / NXCD; wgid = (xcd < r ? xcd * (q + 1) : r * (q + 1) + (xcd - r) * q) + off; }
        const int nig = wgm * nN, gid = wgid / nig, fm = gid * wgm, gsz = (nM - fm) < wgm ? (nM - fm) : wgm;
        u.pm = fm + ((wgid % nig) % gsz); u.pn = (wgid % nig) / gsz; return true;
    }
    __device__ __forceinline__ void a_ready(const Unit&) const {}
    __device__ __forceinline__ void done(const Unit&) const {}
};

__device__ __forceinline__ unsigned cvt_pk_bf16(float lo, float hi) { unsigned r; asm volatile("v_cvt_pk_bf16_f32 %0, %1, %2" : "=v"(r) : "v"(lo), "v"(hi)); return r; }
typedef float f32x2 __attribute__((ext_vector_type(2)));

struct EpiSwiglu {
    static constexpr bool PERM = true, AFTER_DRAIN = false, PROBE_TWICE = true;
    bf16_t* H; const unsigned long long* rss;
    __device__ __forceinline__ void operator()(const f32x4 (&acc)[2][2][4][2], const Unit& u, int wr, int wc, int fr, int fq) const {
        const int row0 = u.pm * BM + wr * 64 + fr, col0 = u.pn * 128 + wc * 32 + 8 * fq;
        float rv[2][4];
#pragma unroll
        for (int ai = 0; ai < 2; ++ai)
#pragma unroll
            for (int m = 0; m < 4; ++m) rv[ai][m] = (float)rss[row0 + ai * HALF + m * 16] * 2.3283064365386963e-10f;
#pragma unroll
        for (int ai = 0; ai < 2; ++ai)
#pragma unroll
            for (int m = 0; m < 4; ++m) {
                bf16_t* rowp = H + (unsigned)((row0 + ai * HALF + m * 16) * cfg::DFF + col0);
                const float rinv = __builtin_amdgcn_rsqf(rv[ai][m] * (1.0f / cfg::DM) + cfg::EPS);
                float hv[8];
#pragma unroll
                for (int n = 0; n < 2; ++n)
#pragma unroll
                    for (int j = 0; j < 4; ++j) {
                        const float g = acc[ai][0][m][n][j] * rinv, up = acc[ai][1][m][n][j] * rinv;
                        const float e = __builtin_amdgcn_exp2f(-g * cfg::LOG2E);
                        hv[n * 4 + j] = (g * up) * __builtin_amdgcn_rcpf(1.0f + e);
                    }
                u32x4 w; w.x = cvt_pk_bf16(hv[0], hv[1]); w.y = cvt_pk_bf16(hv[2], hv[3]); w.z = cvt_pk_bf16(hv[4], hv[5]); w.w = cvt_pk_bf16(hv[6], hv[7]);
                *(u32x4*)rowp = w;
                asm volatile("" ::: "memory");
            }
    }
};
__device__ __forceinline__ f32x4 bf16x4_lo(u32x4 w, int h) { f32x4 r; const unsigned a = h ? w.z : w.x, b = h ? w.w : w.y;
    r[0] = __uint_as_float(a << 16); r[1] = __uint_as_float(a & 0xffff0000u); r[2] = __uint_as_float(b << 16); r[3] = __uint_as_float(b & 0xffff0000u); return r; }
struct EpiResid {
    static constexpr bool PERM = true, AFTER_DRAIN = false, PROBE_TWICE = false;
    bf16_t* R; float alpha; unsigned long long* rssw;
    __device__ __forceinline__ void operator()(const f32x4 (&acc)[2][2][4][2], const Unit& u, int wr, int wc, int fr, int fq) const {
        bf16_t* rb = R + (size_t)u.pm * BM * cfg::DM;
        const unsigned off0 = (unsigned)(wr * 64 + fr) * cfg::DM + (unsigned)(u.pn * BM + wc * 32 + 8 * fq);
        float sel[2] = {0.f, 0.f};
        u32x4 vq[4][2];
#define RES_LOAD(S, it_) do { const unsigned o_ = off0 + (unsigned)(((it_) >> 2) * HALF + ((it_) & 3) * 16) * cfg::DM; \
        vq[S][0] = *(const u32x4*)(rb + o_); vq[S][1] = *(const u32x4*)(rb + o_ + HALF); } while (0)
#define RES_DO(S, it_) do { const int ai = (it_) >> 2, m = (it_) & 3; const unsigned off = off0 + (unsigned)(ai * HALF + m * 16) * cfg::DM; float ss = 0.f; \
        _Pragma("unroll") for (int bj = 0; bj < 2; ++bj) { const f32x4 o0 = bf16x4_lo(vq[S][bj], 0) + acc[ai][bj][m][0] * alpha, o1 = bf16x4_lo(vq[S][bj], 1) + acc[ai][bj][m][1] * alpha; \
            ss += (o0[0] * o0[0] + o0[1] * o0[1]) + (o0[2] * o0[2] + o0[3] * o0[3]) + (o1[0] * o1[0] + o1[1] * o1[1]) + (o1[2] * o1[2] + o1[3] * o1[3]); \
            u32x4 w; w.x = cvt_pk_bf16(o0[0], o0[1]); w.y = cvt_pk_bf16(o0[2], o0[3]); w.z = cvt_pk_bf16(o1[0], o1[1]); w.w = cvt_pk_bf16(o1[2], o1[3]); \
            *(u32x4*)(rb + off + bj * HALF) = w; } \
        if (rssw) { ss += __shfl_xor(ss, 16); ss += __shfl_xor(ss, 32); if (fq == m) sel[ai] = ss; } } while (0)
        RES_LOAD(0, 0); RES_LOAD(1, 1); RES_LOAD(2, 2);
        RES_LOAD(3, 3); RES_DO(0, 0); asm volatile("" ::: "memory");
        RES_LOAD(0, 4); RES_DO(1, 1); asm volatile("" ::: "memory");
        RES_LOAD(1, 5); RES_DO(2, 2); asm volatile("" ::: "memory");
        RES_LOAD(2, 6); RES_DO(3, 3); asm volatile("" ::: "memory");
        RES_LOAD(3, 7); RES_DO(0, 4); asm volatile("" ::: "memory");
        RES_DO(1, 5); asm volatile("" ::: "memory");
        RES_DO(2, 6); asm volatile("" ::: "memory");
        RES_DO(3, 7); asm volatile("" ::: "memory");
#undef RES_LOAD
#undef RES_DO
        if (rssw) {
#pragma unroll
            for (int ai = 0; ai < 2; ++ai) atomicAdd(rssw + u.pm * BM + wr * 64 + ai * HALF + fq * 16 + fr, (unsigned long long)(sel[ai] * 4294967296.0f));
        }
    }
};
struct EpiWin {
    static constexpr bool PERM = true, AFTER_DRAIN = false, PROBE_TWICE = false;
    bf16_t* QKV; const float* gq; const float* gk; const unsigned long long* rss; unsigned* nrm2;
    __device__ __forceinline__ void operator()(const f32x4 (&acc)[2][2][4][2], const Unit& u, int wr, int wc, int fr, int fq) const {
        const int pn = u.pn;
        int kind = 0; float sc = 1.f;
        if (pn < 2) { kind = 1; sc = cfg::C2; }
        else if (pn == 2) { kind = (wc < 2) ? 2 : 0; }
        else if (pn == 3 || pn == 4 || pn == 9 || pn == 10 || pn == 15 || pn == 16) sc = cfg::C2;
        const int row0 = u.pm * BM + wr * 64 + fr;
        const int colb = pn * 256 + wc * 64 + 8 * fq;
        float rv[2][4];
#pragma unroll
        for (int ai = 0; ai < 2; ++ai)
#pragma unroll
            for (int m = 0; m < 4; ++m) rv[ai][m] = (float)rss[row0 + ai * HALF + m * 16] * 2.3283064365386963e-10f;
        if (kind == 0) {
            const bool want = (pn >= 3 && pn <= 6) || (pn >= 9 && pn <= 12) || (pn >= 15 && pn <= 18);
            float nmax = 0.f;
#pragma unroll
            for (int ai = 0; ai < 2; ++ai)
#pragma unroll
                for (int m = 0; m < 4; ++m) {
                    bf16_t* rowp = QKV + (unsigned)((row0 + ai * HALF + m * 16) * cfg::NIN + colb);
                    const float rs_ = __builtin_amdgcn_rsqf(rv[ai][m] * (1.0f / cfg::DM) + cfg::EPS) * sc;
                    float ss = 0.f;
#pragma unroll
                    for (int bj = 0; bj < 2; ++bj) { const f32x4 v0 = acc[ai][bj][m][0] * rs_, v1 = acc[ai][bj][m][1] * rs_;
                        ss += (v0[0] * v0[0] + v0[1] * v0[1]) + (v0[2] * v0[2] + v0[3] * v0[3]) + (v1[0] * v1[0] + v1[1] * v1[1]) + (v1[2] * v1[2] + v1[3] * v1[3]);
                        u32x4 w; w.x = cvt_pk_bf16(v0[0], v0[1]); w.y = cvt_pk_bf16(v0[2], v0[3]); w.z = cvt_pk_bf16(v1[0], v1[1]); w.w = cvt_pk_bf16(v1[2], v1[3]);
                        *(u32x4*)(rowp + 32 * bj) = w; }
                    if (want) { ss += __shfl_xor(ss, 16); ss += __shfl_xor(ss, 32); nmax = fmaxf(nmax, ss); }
                    asm volatile("" ::: "memory");
                }
            if (want) {
                float t = nmax;
                t = fmaxf(t, __shfl_xor(t, 1)); t = fmaxf(t, __shfl_xor(t, 2)); t = fmaxf(t, __shfl_xor(t, 4)); t = fmaxf(t, __shfl_xor(t, 8));
                const int rowt = u.pm * BM; const int seq = rowt < cfg::MP ? (rowt >> 14) : 2 + ((rowt - cfg::MP) >> 13);
                if ((fr | fq) == 0) atomicMax(nrm2 + (4 * pn + wc) * 4 + seq, __float_as_uint(t));
            }
        } else {
            const float* g = (kind == 1) ? gq : gk;
            float invrev[2][2];
#pragma unroll
            for (int n = 0; n < 2; ++n)
#pragma unroll
                for (int jj = 0; jj < 2; ++jj) invrev[n][jj] = __builtin_amdgcn_exp2f(-(float)(4 * fq + 2 * n + jj) * (13.287712379549449f / 16.0f)) * 0.15915494309189535f;
#pragma unroll
            for (int ai = 0; ai < 2; ++ai)
#pragma unroll
                for (int m = 0; m < 4; ++m) {
                    const int row = row0 + ai * HALF + m * 16;
                    const int t = (row < cfg::MP) ? (row & (cfg::TP - 1)) : (row & (cfg::TS - 1));
                    float prow = (float)(t >> 6), pcol = (float)(row & 63);
                    asm volatile("" : "+v"(prow), "+v"(pcol) :: "memory");
                    float ss = 0.f;
#pragma unroll
                    for (int bj = 0; bj < 2; ++bj)
#pragma unroll
                        for (int n = 0; n < 2; ++n) { const f32x4 v = acc[ai][bj][m][n]; ss += (v[0] * v[0] + v[1] * v[1]) + (v[2] * v[2] + v[3] * v[3]); }
                    ss += __shfl_xor(ss, 16); ss += __shfl_xor(ss, 32);
                    const float rw = __builtin_amdgcn_rsqf(rv[ai][m] * (1.0f / cfg::DM) + cfg::EPS);
                    const float rinv = rw * __builtin_amdgcn_rsqf(ss * rw * rw * (1.0f / 64.0f) + cfg::EPS);
                    bf16_t* rowp = QKV + (unsigned)(row * cfg::NIN + colb);
#pragma unroll
                    for (int bj = 0; bj < 2; ++bj) {
                        const float pos = bj ? pcol : prow;
                        float o[8];
#pragma unroll
                        for (int n = 0; n < 2; ++n) {
                            const f32x4 y = acc[ai][bj][m][n] * rinv * *(const f32x4*)(g + 32 * bj + 8 * fq + 4 * n);
#pragma unroll
                            for (int jj = 0; jj < 2; ++jj) {
                                const float rev = __builtin_amdgcn_fractf(pos * invrev[n][jj]);
                                const float sn = __builtin_amdgcn_sinf(rev), cs = __builtin_amdgcn_cosf(rev);
                                const float x1 = y[2 * jj], x2 = y[2 * jj + 1];
                                o[4 * n + 2 * jj] = (x1 * cs - x2 * sn) * sc; o[4 * n + 2 * jj + 1] = (x1 * sn + x2 * cs) * sc;
                            }
                        }
                        u32x4 w; w.x = cvt_pk_bf16(o[0], o[1]); w.y = cvt_pk_bf16(o[2], o[3]); w.z = cvt_pk_bf16(o[4], o[5]); w.w = cvt_pk_bf16(o[6], o[7]);
                        *(u32x4*)(rowp + 32 * bj) = w;
                        asm volatile("" ::: "memory");
                    }
                }
        }
    }
};

template <class Epi, class Sched, bool ALIGN_EPI = false, bool SP2 = false>
__device__ __forceinline__ void gemm_phase(PG8_LAS unsigned char* lds, const Gemm g, const Sched& S, const Epi& E) {
    int tid_ = threadIdx.x; asm volatile("" : "+v"(tid_));
    const int tid = tid_, wid = __builtin_amdgcn_readfirstlane(tid >> 6), lane = tid & 63, wr = wid >> 2, wc = wid & 3, fr = lane & 15, fq = lane >> 4;
    const int K = g.K, nt = K / BK;
    unsigned voffA[2], voffB[2];
#pragma unroll
    for (int i = 0; i < 2; ++i) { int R, C; stage_rc(tid * 16 + i * 8192, R, C); const int Rb = Epi::PERM ? ((R & ~31) + perm32(R & 31)) : R;
        voffA[i] = (unsigned)(R * K + C) * 2u; voffB[i] = (unsigned)(Rb * K + C) * 2u; }
    const size_t kstep = (size_t)(BK * 2);
    const size_t hstep = (size_t)HALF * K * 2;
    const size_t tstep = 2 * hstep;
    const unsigned ldsw = (unsigned)wid * 1024u;
    const int aoff = lds_byte(wr * 64 + fr, fq * 8), boff = lds_byte(wc * 32 + fr, fq * 8);
#define PG8_SA(b, h) (((b) * 2 + (h)) * HTB)
#define PG8_SB(b, h) ((4 + (b) * 2 + (h)) * HTB)
#define PG8_STAGE(bufoff, gbase, voff) do { _Pragma("unroll") for (int _i = 0; _i < 2; ++_i) \
        __builtin_amdgcn_global_load_lds((const unsigned*)((const char*)(gbase) + (voff)[_i]), (PG8_LAS unsigned*)(lds + (bufoff) + ldsw + _i * 8192), 16, 0, 0); } while (0)
#define PG8_LDA(dst, b, h) do { _Pragma("unroll") for (int m = 0; m < 4; ++m) _Pragma("unroll") for (int k = 0; k < 2; ++k) dst[m][k] = *(const PG8_LAS bf16x8*)(lds + PG8_SA(b, h) + aoff + m * 2048 + k * 1024); } while (0)
#define PG8_LDB(dst, b, h) do { _Pragma("unroll") for (int n = 0; n < 2; ++n) _Pragma("unroll") for (int k = 0; k < 2; ++k) dst[n][k] = *(const PG8_LAS bf16x8*)(lds + PG8_SB(b, h) + boff + n * 2048 + k * 1024); } while (0)
#define PG8_MMA(ai, bj, At, Bt) do { __builtin_amdgcn_s_setprio(1); _Pragma("unroll") for (int m = 0; m < 4; ++m) _Pragma("unroll") for (int n = 0; n < 2; ++n) _Pragma("unroll") for (int k = 0; k < 2; ++k) \
        acc[ai][bj][m][n] = __builtin_amdgcn_mfma_f32_16x16x32_bf16(Bt[n][k], At[m][k], acc[ai][bj][m][n], 0, 0, 0); __builtin_amdgcn_s_setprio(0); } while (0)
#define PG8_WAIT_V(n) asm volatile("s_waitcnt vmcnt(" #n ")" ::: "memory")
#define PG8_WAIT_L(n) asm volatile("s_waitcnt lgkmcnt(" #n ")" ::: "memory")
#define PG8_BAR __builtin_amdgcn_s_barrier()
#define PG8_SCHED __builtin_amdgcn_sched_barrier(0)
    Unit cur, nxt; int ui = 0;
    if (!S.next(0, cur)) return;
    f32x4 acc[2][2][4][2];
#pragma unroll
    for (int a = 0; a < 2; ++a)
#pragma unroll
        for (int b = 0; b < 2; ++b)
#pragma unroll
            for (int m = 0; m < 4; ++m)
#pragma unroll
                for (int n = 0; n < 2; ++n) acc[a][b][m][n] = (f32x4){0.f, 0.f, 0.f, 0.f};
    bf16x8 At[4][2], B0[2][2], B1[2][2];
    const char* cA = (const char*)g.A + (size_t)cur.pm * tstep; const char* cB = (const char*)g.Bt + (size_t)cur.pn * tstep;
    S.a_ready(cur);
    if constexpr (SP2) {
        PG8_STAGE(PG8_SB(0, 0), cB, voffB); PG8_STAGE(PG8_SB(0, 1), cB + hstep, voffB); PG8_STAGE(PG8_SA(0, 0), cA, voffA); PG8_STAGE(PG8_SA(0, 1), cA + hstep, voffA);
        if (wr == 1) PG8_BAR;
        PG8_WAIT_V(2); PG8_BAR;
        PG8_STAGE(PG8_SB(1, 0), cB + kstep, voffB); PG8_STAGE(PG8_SA(1, 0), cA + kstep, voffA); PG8_STAGE(PG8_SB(1, 1), cB + hstep + kstep, voffB);
        PG8_WAIT_V(6); PG8_BAR;
    } else {
        PG8_STAGE(PG8_SB(0, 0), cB, voffB); PG8_STAGE(PG8_SA(0, 0), cA, voffA); PG8_STAGE(PG8_SB(0, 1), cB + hstep, voffB); PG8_STAGE(PG8_SA(0, 1), cA + hstep, voffA);
        if (wr == 1) PG8_BAR;
        PG8_WAIT_V(4); PG8_BAR;
        PG8_STAGE(PG8_SB(1, 0), cB + kstep, voffB); PG8_STAGE(PG8_SA(1, 0), cA + kstep, voffA); PG8_STAGE(PG8_SB(1, 1), cB + hstep + kstep, voffB);
        PG8_WAIT_V(6); PG8_BAR;
    }
    for (;;) {
        const bool has_next = S.next(ui + 1, nxt);
        const char* nA = has_next ? (const char*)g.A + (size_t)nxt.pm * tstep : cA; const char* nB = has_next ? (const char*)g.Bt + (size_t)nxt.pn * tstep : cB;
        for (int t = 0; t < nt; t += 2) {
            const bool last = (t == nt - 2);
            const char* a1 = cA + (size_t)(t + 1) * kstep;
            const char* a2 = last ? nA : cA + (size_t)(t + 2) * kstep; const char* b2 = last ? nB : cB + (size_t)(t + 2) * kstep;
            const char* a3 = a2 + kstep; const char* b3 = b2 + kstep;
            if (last && has_next) S.a_ready(nxt);
            if constexpr (SP2) {
            PG8_LDB(B0, 0, 0); PG8_LDB(B1, 0, 1); PG8_SCHED; PG8_LDA(At, 0, 0); PG8_STAGE(PG8_SA(1, 1), a1 + hstep, voffA);
            PG8_WAIT_V(8); PG8_WAIT_L(0); PG8_BAR; PG8_MMA(0, 0, At, B0); PG8_MMA(0, 1, At, B1); PG8_BAR; PG8_SCHED;
            PG8_LDA(At, 0, 1); PG8_STAGE(PG8_SB(0, 0), b2, voffB); PG8_STAGE(PG8_SB(0, 1), b2 + hstep, voffB); PG8_STAGE(PG8_SA(0, 0), a2, voffA);
            PG8_WAIT_V(8); PG8_WAIT_L(0); PG8_BAR; PG8_MMA(1, 0, At, B0); PG8_MMA(1, 1, At, B1); PG8_BAR; PG8_SCHED;
            PG8_LDB(B0, 1, 0); PG8_LDB(B1, 1, 1); PG8_SCHED; PG8_LDA(At, 1, 0); PG8_STAGE(PG8_SA(0, 1), a2 + hstep, voffA);
            PG8_WAIT_V(8); PG8_WAIT_L(0); PG8_BAR; PG8_MMA(0, 0, At, B0); PG8_MMA(0, 1, At, B1); PG8_BAR; PG8_SCHED;
            PG8_LDA(At, 1, 1); PG8_STAGE(PG8_SB(1, 0), b3, voffB); PG8_STAGE(PG8_SB(1, 1), b3 + hstep, voffB); PG8_STAGE(PG8_SA(1, 0), a3, voffA);
            PG8_WAIT_V(8); PG8_WAIT_L(0); PG8_BAR; PG8_MMA(1, 0, At, B0); PG8_MMA(1, 1, At, B1); PG8_BAR; PG8_SCHED;
            } else {
            PG8_LDB(B0, 0, 0); PG8_SCHED; PG8_LDA(At, 0, 0); PG8_STAGE(PG8_SA(1, 1), a1 + hstep, voffA);
            PG8_WAIT_L(8); PG8_BAR; PG8_WAIT_L(0); PG8_MMA(0, 0, At, B0); PG8_BAR; PG8_SCHED;
            PG8_LDB(B1, 0, 1); PG8_STAGE(PG8_SB(0, 0), b2, voffB);
            PG8_BAR; PG8_WAIT_L(0); PG8_MMA(0, 1, At, B1); PG8_BAR;
            PG8_LDA(At, 0, 1); PG8_STAGE(PG8_SA(0, 0), a2, voffA);
            PG8_BAR; PG8_WAIT_L(0); PG8_MMA(1, 0, At, B0); PG8_BAR; PG8_SCHED;
            PG8_STAGE(PG8_SB(0, 1), b2 + hstep, voffB);
            PG8_WAIT_V(6); PG8_BAR; PG8_MMA(1, 1, At, B1); PG8_BAR;
            PG8_LDB(B0, 1, 0); PG8_SCHED; PG8_LDA(At, 1, 0); PG8_STAGE(PG8_SA(0, 1), a2 + hstep, voffA);
            PG8_WAIT_L(8); PG8_BAR; PG8_WAIT_L(0); PG8_MMA(0, 0, At, B0); PG8_BAR; PG8_SCHED;
            PG8_LDB(B1, 1, 1); PG8_STAGE(PG8_SB(1, 0), b3, voffB);
            PG8_BAR; PG8_WAIT_L(0); PG8_MMA(0, 1, At, B1); PG8_BAR;
            PG8_LDA(At, 1, 1); PG8_STAGE(PG8_SA(1, 0), a3, voffA);
            PG8_BAR; PG8_WAIT_L(0); PG8_MMA(1, 0, At, B0); PG8_BAR; PG8_SCHED;
            PG8_STAGE(PG8_SB(1, 1), b3 + hstep, voffB);
            PG8_WAIT_V(6); PG8_BAR; PG8_MMA(1, 1, At, B1); PG8_BAR;
            }
        }
        if constexpr (ALIGN_EPI) { if (wr == 0) PG8_BAR; }
        if constexpr (!Epi::AFTER_DRAIN) { E(acc, cur, wr, wc, fr, fq);
#if defined(PROBE_EPI2)
            if constexpr (Epi::PROBE_TWICE) { asm volatile("" ::: "memory"); E(acc, cur, wr, wc, fr, fq); }
#endif
            S.done(cur); }
        if (!has_next) break;
#pragma unroll
        for (int a = 0; a < 2; ++a)
#pragma unroll
            for (int b = 0; b < 2; ++b)
#pragma unroll
                for (int m = 0; m < 4; ++m)
#pragma unroll
                    for (int n = 0; n < 2; ++n) acc[a][b][m][n] = (f32x4){0.f, 0.f, 0.f, 0.f};
        cur = nxt; cA = nA; cB = nB; ++ui;
        if constexpr (ALIGN_EPI) { if (wr == 1) PG8_BAR; }
    }
    PG8_WAIT_V(0);
    if constexpr (!ALIGN_EPI) { if (wr == 0) PG8_BAR; }
    PG8_BAR;
    if constexpr (Epi::AFTER_DRAIN) { E.fused(acc, cur, wr, wc, fr, fq, lds, wid, lane); S.done(cur); }
#undef PG8_SA
#undef PG8_SB
#undef PG8_STAGE
#undef PG8_LDA
#undef PG8_LDB
#undef PG8_MMA
#undef PG8_WAIT_V
#undef PG8_WAIT_L
#undef PG8_BAR
#undef PG8_SCHED
}
}
namespace att {
#define ATT_LAS __attribute__((address_space(3)))
using bf16x8 = __attribute__((ext_vector_type(8))) short;
using s16x4  = __attribute__((ext_vector_type(4))) short;
using f32x16 = __attribute__((ext_vector_type(16))) float;
using u32x4  = __attribute__((ext_vector_type(4))) unsigned;
typedef unsigned short bf16_t;
typedef ATT_LAS char* lptr;
constexpr int PITCH = cfg::NIN, OPITCH = cfg::DM;
constexpr float LOG2E = cfg::LOG2E, NEG = -1e30f, THR = 8.f;
#ifndef ATT_DMA_B
#define ATT_DMA_B 1
#endif
#ifndef ATT_RING_B
#define ATT_RING_B 1
#endif
template <bool RING> struct Map { static constexpr int L_K = 0, L_V = RING ? 49152 : 32768, L_WS = RING ? 98304 : 65536, L_LUT = RING ? 100352 : 67584, L_OST = RING ? 65536 : 81920, L_END = RING ? 112640 : 114688; };
constexpr int L_END = 114688;
constexpr int LUTB_R = 704, LUTD_R = 1344;
#define ATT_SBAR() __builtin_amdgcn_sched_barrier(0)
__device__ __forceinline__ void glds16(const void* g, unsigned lds_base) {
    unsigned sv; asm volatile("s_mov_b32 %0, m0\n\ts_mov_b32 m0, %2\n\ts_nop 0\n\tglobal_load_lds_dwordx4 %1, off\n\ts_mov_b32 m0, %0" : "=&s"(sv) : "v"(g), "s"(lds_base) : "memory"); }
template <int N> __device__ __forceinline__ void wait_bar() {
    if constexpr (N == 0) asm volatile("s_waitcnt vmcnt(0) lgkmcnt(0)\n\ts_barrier" ::: "memory");
    else if constexpr (N == 1) asm volatile("s_waitcnt vmcnt(1) lgkmcnt(0)\n\ts_barrier" ::: "memory");
    else if constexpr (N == 2) asm volatile("s_waitcnt vmcnt(2) lgkmcnt(0)\n\ts_barrier" ::: "memory");
    else if constexpr (N == 3) asm volatile("s_waitcnt vmcnt(3) lgkmcnt(0)\n\ts_barrier" ::: "memory");
    else if constexpr (N == 4) asm volatile("s_waitcnt vmcnt(4) lgkmcnt(0)\n\ts_barrier" ::: "memory");
    else { static_assert(N == 6, ""); asm volatile("s_waitcnt vmcnt(6) lgkmcnt(0)\n\ts_barrier" ::: "memory"); }
}
__device__ __forceinline__ int crow(int r, int hi) { return (r & 3) + 8 * (r >> 2) + 4 * hi; }
__device__ __forceinline__ unsigned cvtpk(float lo, float hi) { unsigned r; asm volatile("v_cvt_pk_bf16_f32 %0, %1, %2" : "=v"(r) : "v"(lo), "v"(hi)); return r; }
__device__ __forceinline__ float wave_sum(float v) {
#pragma unroll
    for (int o = 1; o < 64; o <<= 1) v += __shfl_xor(v, o);
    return v;
}
__device__ __forceinline__ int t5_bucket(int rel) {
    const int n = rel < 0 ? -rel : rel;
    int b = n;
    if (n >= 8) b = 8 + (n >= 15) + (n >= 27) + (n >= 50) + (n >= 91) + (n >= 166) + (n >= 305) + (n >= 559);
    return b + (rel > 0 ? 16 : 0);
}
template <int KC> __device__ __forceinline__ int kswz(int row, int colB) { return KC == 128 ? row * 256 + (colB ^ ((row & 7) << 4)) : row * 128 + (colB ^ (((row >> 1) & 7) << 4)); }
template <int NCB> __device__ __forceinline__ int v_st(int k, int c) { const int kk = k; return ((kk >> 3) * NCB + (c >> 5)) * 512 + ((kk & 7) * 32 + (c & 31)) * 2; }
__device__ __forceinline__ int v_rd_base(int lane) { return ((lane & 3) << 3) | (((lane >> 2) & 3) << 6) | (((lane >> 4) & 1) << 5) | (((lane >> 5) & 1) << 8); }
template <int OFF> __device__ __forceinline__ s16x4 tr_read(int vb) { s16x4 r; asm volatile("ds_read_b64_tr_b16 %0, %1 offset:%2" : "=&v"(r) : "v"(vb), "i"(OFF) : "memory"); return r; }
template <int NCB, int D0> __device__ __forceinline__ void pv_one(f32x16& od, int vb, bf16x8 pa0, bf16x8 pa1, bf16x8 pa2, bf16x8 pa3) {
#define ATT_VOFF(ks, half) (D0 * 512 + (ks) * (NCB * 1024) + (half) * (NCB * 512))
    const s16x4 l0 = tr_read<ATT_VOFF(0, 0)>(vb), h0 = tr_read<ATT_VOFF(0, 1)>(vb), l1 = tr_read<ATT_VOFF(1, 0)>(vb), h1 = tr_read<ATT_VOFF(1, 1)>(vb);
    const s16x4 l2 = tr_read<ATT_VOFF(2, 0)>(vb), h2 = tr_read<ATT_VOFF(2, 1)>(vb), l3 = tr_read<ATT_VOFF(3, 0)>(vb), h3 = tr_read<ATT_VOFF(3, 1)>(vb);
#undef ATT_VOFF
    asm volatile("s_waitcnt lgkmcnt(0)" ::: "memory"); ATT_SBAR();
#define ATT_PK(L, H) (bf16x8){L[0], L[1], L[2], L[3], H[0], H[1], H[2], H[3]}
    od = __builtin_amdgcn_mfma_f32_32x32x16_bf16(pa0, ATT_PK(l0, h0), od, 0, 0, 0);
    od = __builtin_amdgcn_mfma_f32_32x32x16_bf16(pa1, ATT_PK(l1, h1), od, 0, 0, 0);
    od = __builtin_amdgcn_mfma_f32_32x32x16_bf16(pa2, ATT_PK(l2, h2), od, 0, 0, 0);
    od = __builtin_amdgcn_mfma_f32_32x32x16_bf16(pa3, ATT_PK(l3, h3), od, 0, 0, 0);
#undef ATT_PK
}
template <int NCB, bool ONES> __device__ __forceinline__ void pv_all(f32x16* o, f32x16& lacc, int vb, bf16x8 pa0, bf16x8 pa1, bf16x8 pa2, bf16x8 pa3) {
    if constexpr (ONES) { const bf16x8 ones = {0x3F80, 0x3F80, 0x3F80, 0x3F80, 0x3F80, 0x3F80, 0x3F80, 0x3F80};
        lacc = __builtin_amdgcn_mfma_f32_32x32x16_bf16(pa0, ones, lacc, 0, 0, 0); lacc = __builtin_amdgcn_mfma_f32_32x32x16_bf16(pa1, ones, lacc, 0, 0, 0);
        lacc = __builtin_amdgcn_mfma_f32_32x32x16_bf16(pa2, ones, lacc, 0, 0, 0); lacc = __builtin_amdgcn_mfma_f32_32x32x16_bf16(pa3, ones, lacc, 0, 0, 0); }
    pv_one<NCB, 0>(o[0], vb, pa0, pa1, pa2, pa3); pv_one<NCB, 1>(o[1], vb, pa0, pa1, pa2, pa3);
    if constexpr (NCB == 4) { pv_one<NCB, 2>(o[2], vb, pa0, pa1, pa2, pa3); pv_one<NCB, 3>(o[3], vb, pa0, pa1, pa2, pa3); }
}
template <bool NOMAX> __device__ __forceinline__ void partialSM(f32x16& p0, f32x16& p1, float cb, float& m_reg, float& alpha) {
    if constexpr (NOMAX) { alpha = 1.f;
        (void)cb;
#pragma unroll
        for (int r = 0; r < 16; ++r) p0[r] = __builtin_amdgcn_exp2f(p0[r]);
        return; }
    float ma = fmaxf(p0[0], p0[1]), mb = fmaxf(p0[2], p0[3]), mc = fmaxf(p1[0], p1[1]), md = fmaxf(p1[2], p1[3]);
#pragma unroll
    for (int r = 4; r < 16; r += 4) { ma = fmaxf(fmaxf(ma, p0[r]), p0[r + 1]); mb = fmaxf(fmaxf(mb, p0[r + 2]), p0[r + 3]); mc = fmaxf(fmaxf(mc, p1[r]), p1[r + 1]); md = fmaxf(fmaxf(md, p1[r + 2]), p1[r + 3]); }
    float pmax = fmaxf(fmaxf(ma, mb), fmaxf(mc, md));
    { auto rr = __builtin_amdgcn_permlane32_swap(__float_as_uint(pmax), __float_as_uint(pmax), false, false); pmax = fmaxf(__uint_as_float(rr[0]), __uint_as_float(rr[1])); }
    pmax += cb;
    float mn;
    if (__builtin_expect(__all(pmax - m_reg <= THR), 1)) { mn = m_reg; alpha = 1.f; }
    else { mn = fmaxf(m_reg, pmax); alpha = __builtin_amdgcn_exp2f(m_reg - mn); m_reg = mn; }
    const float sub = cb - mn;
#pragma unroll
    for (int r = 0; r < 16; ++r) p0[r] += sub;
#pragma unroll
    for (int r = 0; r < 16; ++r) p1[r] += sub;
#pragma unroll
    for (int r = 0; r < 16; ++r) p0[r] = __builtin_amdgcn_exp2f(p0[r]);
}
template <bool ONES> __device__ __forceinline__ void finishSM(f32x16& p0, f32x16& p1, float alpha, float& l_reg, bf16x8& pa0, bf16x8& pa1, bf16x8& pa2, bf16x8& pa3) {
#pragma unroll
    for (int r = 0; r < 16; ++r) p1[r] = __builtin_amdgcn_exp2f(p1[r]);
    if constexpr (!ONES) {
    float sa = p0[0] + p0[1], sb = p0[2] + p0[3], sc_ = p1[0] + p1[1], sd = p1[2] + p1[3];
#pragma unroll
    for (int r = 4; r < 16; r += 4) { sa += p0[r]; sa += p0[r + 1]; sb += p0[r + 2]; sb += p0[r + 3]; sc_ += p1[r]; sc_ += p1[r + 1]; sd += p1[r + 2]; sd += p1[r + 3]; }
    float ps = (sa + sb) + (sc_ + sd);
    { auto rr = __builtin_amdgcn_permlane32_swap(__float_as_uint(ps), __float_as_uint(ps), false, false); ps = __uint_as_float(rr[0]) + __uint_as_float(rr[1]); }
    l_reg = l_reg * alpha + ps;
    }
#define ATT_PK4(P, BASE, OUT) do { unsigned a0 = cvtpk(P[BASE + 0], P[BASE + 1]), a1 = cvtpk(P[BASE + 2], P[BASE + 3]);   \
    unsigned b0 = cvtpk(P[BASE + 4], P[BASE + 5]), b1 = cvtpk(P[BASE + 6], P[BASE + 7]);                              \
    u32x4 w = {a0, a1, b0, b1}; OUT = __builtin_bit_cast(bf16x8, w); } while (0)
    ATT_PK4(p0, 0, pa0); ATT_PK4(p0, 8, pa1); ATT_PK4(p1, 0, pa2); ATT_PK4(p1, 8, pa3);
#undef ATT_PK4
}
template <int KC, bool USEC> __device__ __forceinline__ void qkt(f32x16& p0, f32x16& p1, lptr Ks, int cb0, const bf16x8* qr, const f32x16& c0, int r32, int hi) {
    if constexpr (!USEC) { p0 = f32x16{}; p1 = f32x16{}; }
#pragma unroll
    for (int d0 = 0; d0 < 4; ++d0) { const int cb = cb0 + d0 * 32 + hi * 16;
        const bf16x8 b0 = *(const ATT_LAS bf16x8*)(Ks + kswz<KC>(r32, cb));
        const bf16x8 b1 = *(const ATT_LAS bf16x8*)(Ks + kswz<KC>(32 + r32, cb));
        if (USEC && d0 == 0) { p0 = __builtin_amdgcn_mfma_f32_32x32x16_bf16(b0, qr[0], c0, 0, 0, 0); p1 = __builtin_amdgcn_mfma_f32_32x32x16_bf16(b1, qr[0], c0, 0, 0, 0); }
        else { p0 = __builtin_amdgcn_mfma_f32_32x32x16_bf16(b0, qr[d0], p0, 0, 0, 0); p1 = __builtin_amdgcn_mfma_f32_32x32x16_bf16(b1, qr[d0], p1, 0, 0, 0); } }
}
struct Aux { const float* t5; const float* rpb; const float* lam_p; const float* subln; float lam_init; };

template <int MODE, bool NOMAX = false>
__device__ __forceinline__ void attn_unit(const bf16_t* __restrict__ QKV, bf16_t* __restrict__ ATT, lptr lds, int row0, int T, int h, int qb, const Aux& ax) {
#ifndef ATT_ONES
#define ATT_ONES 1
#endif
    constexpr bool ONES = (ATT_ONES != 0) && (MODE != 1);
    constexpr bool DMA = (MODE == 1) && (ATT_DMA_B != 0);
    constexpr bool RING = DMA || ((MODE != 0) && (ATT_RING_B != 0));
    constexpr int L_K = Map<RING>::L_K, L_V = Map<RING>::L_V, L_WS = Map<RING>::L_WS, L_LUT = Map<RING>::L_LUT, L_OST = Map<RING>::L_OST;
    constexpr int KC = (MODE == 1) ? 128 : 64, DV = (MODE == 1) ? 128 : 64, NCB = DV / 32, NR = KC / 64;
    constexpr int KBYTES = 64 * KC * 2, VBYTES = 64 * DV * 2, QROWS = (MODE == 1) ? 128 : 256;
    int tid_ = threadIdx.x; asm volatile("" : "+v"(tid_));
    const int tid = tid_, lane = tid & 63, r32 = lane & 31, hi = lane >> 5;
    const int wid = __builtin_amdgcn_readfirstlane(tid >> 6);
    const int map = (MODE == 1) ? (wid >> 2) : 0, wq = (MODE == 1) ? (wid & 3) : wid;
    const int q0 = qb * QROWS, qw = q0 + wq * 32, qpos = qw + r32;
    int qcol, kcol, vcol, ocol;
    if (MODE == 0)      { qcol = 64 * h;          kcol = 512 + 64 * (h >> 2); vcol = 640 + 64 * (h >> 2); ocol = 64 * h; }
    else if (MODE == 1) { qcol = 768 + 128 * h + 64 * map; kcol = 1280 + 128 * h; vcol = 1792 + 128 * h; ocol = 512 + 128 * h; }
    else if (MODE == 2) { qcol = 2304 + 64 * h;   kcol = 2816 + 64 * h;       vcol = 3328 + 64 * h;       ocol = 1024 + 64 * h; }
    else                { qcol = 3840 + 64 * h;   kcol = 4352 + 64 * h;       vcol = 4864 + 64 * h;       ocol = 1536 + 64 * h; }
    int tlo = 0, NT = T >> 6;
    if (MODE == 3) { int lo = q0 - 1024; lo = lo < 0 ? 0 : lo; int hi_k = q0 + 255 + 1024; hi_k = hi_k > T - 1 ? T - 1 : hi_k; int a = lo >> 6, b = hi_k >> 6;
        if (((b - a + 1) & 1) != 0) { if (a > 0) --a; else ++b; } tlo = a; NT = b - a + 1; }
    if (MODE == 2) { const int rows = T >> 6, R0 = 4 * qb; int a = R0 - 4; a = a < 0 ? 0 : (a > rows - 8 ? rows - 8 : a); int b = R0 - 1; b = b < 0 ? 0 : (b > rows - 8 ? rows - 8 : b); b += 7;
        if (((b - a + 1) & 1) != 0) { if (a > 0) --a; else ++b; } tlo = a; NT = b - a + 1; }
    const int sr = (KC == 128) ? (tid >> 4) : (tid >> 3), sc = (KC == 128) ? (tid & 15) * 8 : (tid & 7) * 8;
    const bf16_t* Kg = QKV + (size_t)(row0 + sr) * PITCH + kcol + sc;
    const bf16_t* Vg = QKV + (size_t)(row0 + sr) * PITCH + vcol + sc;
    const int kst0 = kswz<KC>(sr, sc * 2), kst1 = kswz<KC>(32 + sr, sc * 2), vst0 = v_st<NCB>(sr, sc), vst1 = v_st<NCB>(32 + sr, sc);
    const bf16_t* Kd[NR]; const bf16_t* Vd[NR];
#pragma unroll
    for (int n = 0; n < NR; ++n) {
        const int X = (n * 8 + wid) * 1024 + lane * 16;
        int krow, kchunk;
        if (KC == 128) { krow = X >> 8; kchunk = ((X >> 4) & 15) ^ (krow & 7); } else { krow = X >> 7; kchunk = ((X >> 4) & 7) ^ ((krow >> 1) & 7); }
        Kd[n] = QKV + (size_t)(row0 + krow) * PITCH + kcol + kchunk * 8;
        const int blk = X >> 9, kkh = blk / NCB, cblk = blk % NCB, kkl = (X >> 6) & 7, cl = (X & 63) >> 1;
        const int vk = kkh * 8 + kkl;
        Vd[n] = QKV + (size_t)(row0 + vk) * PITCH + vcol + cblk * 32 + cl;
    }
    const unsigned kdst = (unsigned)(uintptr_t)(lds + L_K) + wid * 1024, vdst = (unsigned)(uintptr_t)(lds + L_V) + wid * 1024;
#define DMA_K(tt, slot) do { const size_t ro_ = (size_t)((tlo + (tt)) * 64) * PITCH; _Pragma("unroll") for (int n_ = 0; n_ < NR; ++n_) glds16(Kd[n_] + ro_, (unsigned)__builtin_amdgcn_readfirstlane((int)(kdst + (slot) * KBYTES + n_ * 8192))); } while (0)
#define DMA_V(tt, slot) do { const size_t ro_ = (size_t)((tlo + (tt)) * 64) * PITCH; _Pragma("unroll") for (int n_ = 0; n_ < NR; ++n_) glds16(Vd[n_] + ro_, (unsigned)__builtin_amdgcn_readfirstlane((int)(vdst + (slot) * VBYTES + n_ * 8192))); } while (0)
    const lptr K_lds = lds + L_K, V_lds = lds + L_V;
    const int vb0 = (int)(uintptr_t)V_lds + v_rd_base(lane);
    ATT_LAS float* wsf = (ATT_LAS float*)(lds + L_WS) + wid * 64; ATT_LAS float* li_l = wsf; ATT_LAS float* al_l = wsf + 32;
    struct { bf16x8 k[NR], v[NR]; } st_[2];
#define SLOAD(i, tt) do { const size_t ro_ = (size_t)((tlo + (tt)) * 64) * PITCH; st_[i].k[0] = *(const bf16x8*)(Kg + ro_); st_[i].v[0] = *(const bf16x8*)(Vg + ro_); \
        if constexpr (NR == 2) { st_[i].k[1] = *(const bf16x8*)(Kg + ro_ + (size_t)32 * PITCH); st_[i].v[1] = *(const bf16x8*)(Vg + ro_ + (size_t)32 * PITCH); } } while (0)
#define SWRITE(b, i) do { *(ATT_LAS bf16x8*)(K_lds + (b) * KBYTES + kst0) = st_[i].k[0]; *(ATT_LAS bf16x8*)(V_lds + (b) * VBYTES + vst0) = st_[i].v[0]; \
        if constexpr (NR == 2) { *(ATT_LAS bf16x8*)(K_lds + (b) * KBYTES + kst1) = st_[i].k[1]; *(ATT_LAS bf16x8*)(V_lds + (b) * VBYTES + vst1) = st_[i].v[1]; } } while (0)
#define SWAIT() do { if constexpr (NR == 2) asm volatile("s_waitcnt vmcnt(4)" ::: "memory"); else asm volatile("s_waitcnt vmcnt(2)" ::: "memory"); } while (0)
#define RESC(a) do { if (!NOMAX && __any((a) < 1.f)) { if (hi == 0) al_l[r32] = (a); asm volatile("s_waitcnt lgkmcnt(0)" ::: "memory"); \
        _Pragma("unroll") for (int r = 0; r < 16; ++r) { const float f_ = al_l[crow(r, hi)]; if (ONES) lacc[r] *= f_; _Pragma("unroll") for (int d = 0; d < NCB; ++d) o[d][r] *= f_; } } } while (0)
    if constexpr (DMA) { DMA_K(0, 0); DMA_V(0, 0); DMA_K(1, 1); } else {
    SLOAD(0, 0); SLOAD(1, 1);
    }
    bf16x8 qr[4];
    { const bf16_t* Qw = QKV + (size_t)(row0 + qpos) * PITCH + qcol + hi * 8;
#pragma unroll
      for (int d0 = 0; d0 < 4; ++d0) qr[d0] = *(const bf16x8*)(Qw + d0 * 16); }
    ATT_LAS float* lut = (ATT_LAS float*)(lds + L_LUT);
    if (MODE == 1) { for (int i = tid; i < 2 * LUTB_R + 1; i += 512) lut[i] = ax.t5[t5_bucket(i - LUTB_R) * 12 + h] * LOG2E; }
    if (MODE == 3) { for (int i = tid; i < 2 * LUTD_R + 1; i += 512) { const int rel = i - LUTD_R, n = rel < 0 ? -rel : rel;
            const int mult = (n <= 64 ? 1 : 0) + (((n & 3) == 0 && n <= 256) ? 1 : 0) + (((n & 15) == 0 && n <= 1024) ? 1 : 0);
            lut[i] = mult == 0 ? NEG : ax.t5[t5_bucket(rel) * 12 + 4 + h] * LOG2E + (mult == 1 ? 0.f : (mult == 2 ? 1.f : 1.5849625007211562f)); } }
    if (MODE == 2) { for (int i = tid; i < 15 * 128; i += 512) { const int dr = i >> 7, dc = (i & 127) - 48; lut[i] = (dc >= 0 && dc <= 30) ? ax.rpb[(h * 15 + dr) * 31 + dc] * LOG2E : NEG; } }
    float cL = 0.f, cR = 0.f; int c_cs = 0, c_rs = 0, c_R = 0, c_c = 0;
    if (MODE == 2) { const int rows = T >> 6; c_R = 4 * qb + (wid >> 1); c_c = 32 * (wid & 1) + r32; c_cs = c_c - 8; c_cs = c_cs < 0 ? 0 : (c_cs > 48 ? 48 : c_cs); c_rs = c_R - 4; c_rs = c_rs < 0 ? 0 : (c_rs > rows - 8 ? rows - 8 : c_rs); }
#define MODIFY(P0, P1, tt, CB) do { CB = 0.f; const int k0_ = (tlo + (tt)) * 64; \
        if constexpr (MODE == 1) { if (k0_ + 63 - qw <= -559) CB = cL; else if (k0_ - qw - 31 >= 559) CB = cR; else { const ATT_LAS float* lp_ = lut + (k0_ - qpos + LUTB_R + 4 * hi); \
            _Pragma("unroll") for (int r = 0; r < 16; ++r) { P0[r] += lp_[(r & 3) + 8 * (r >> 2)]; P1[r] += lp_[32 + (r & 3) + 8 * (r >> 2)]; } } } \
        if constexpr (MODE == 3) { const ATT_LAS float* lp_ = lut + (k0_ - qpos + LUTD_R + 4 * hi); \
            _Pragma("unroll") for (int r = 0; r < 16; ++r) { P0[r] += lp_[(r & 3) + 8 * (r >> 2)]; P1[r] += lp_[32 + (r & 3) + 8 * (r >> 2)]; } } \
        if constexpr (MODE == 2) { const int kr_ = tlo + (tt); if (kr_ < c_rs || kr_ > c_rs + 7) { _Pragma("unroll") for (int r = 0; r < 16; ++r) { P0[r] = NEG; P1[r] = NEG; } } \
            else { const ATT_LAS float* lp_ = lut + ((kr_ - c_R + 7) * 128 + 48 + 15 - c_c + 4 * hi); const int kb_ = 4 * hi - c_cs; \
              _Pragma("unroll") for (int r = 0; r < 16; ++r) { const int ko_ = (r & 3) + 8 * (r >> 2); const float a_ = lp_[ko_], b_ = lp_[32 + ko_]; \
                P0[r] = ((unsigned)(kb_ + ko_) <= 15u) ? P0[r] + a_ : NEG; P1[r] = ((unsigned)(kb_ + 32 + ko_) <= 15u) ? P1[r] + b_ : NEG; } } } \
    } while (0)
    __syncthreads();
    if (MODE == 1) { cL = lut[0]; cR = lut[2 * LUTB_R]; }
    constexpr bool USEC = false;
    float m_reg = NEG, l_reg = 0.f, cbcur = 0.f, cbacc = 0.f; f32x16 o[NCB], lacc = f32x16{}, cbt = f32x16{};
#define REGSC(CB) do { if constexpr (MODE == 1 && NOMAX) { if ((CB) != cbacc) { const float f_ = __builtin_amdgcn_exp2f(cbacc - (CB)); cbacc = (CB); l_reg *= f_; \
        _Pragma("unroll") for (int r = 0; r < 16; ++r) { if (ONES) lacc[r] *= f_; _Pragma("unroll") for (int d = 0; d < NCB; ++d) o[d][r] *= f_; } } } } while (0)
#define REGIONC(tt) do { if constexpr (USEC) { const int k0_ = (tlo + (tt)) * 64; const float cb_ = (k0_ + 63 - qw <= -559) ? cL : ((k0_ - qw - 31 >= 559) ? cR : 0.f); \
        if (cb_ != cbcur) { cbcur = cb_; _Pragma("unroll") for (int r = 0; r < 16; ++r) cbt[r] = cb_; } } } while (0)
#pragma unroll
    for (int d = 0; d < NCB; ++d) o[d] = f32x16{};
    f32x16 pA0, pA1, pB0, pB1; float alA, alB, cbA, cbB; bf16x8 pa0, pa1, pa2, pa3;
    const int cb0 = map * 128;
    if constexpr (DMA) {
    int s_prev = 2, s_cur = 0, s_next = 1;
#define ROT() do { const int t_ = s_prev; s_prev = s_cur; s_cur = s_next; s_next = t_; } while (0)
#define STEP_ISSUE(t) do { if ((t) + 2 < NT) DMA_K((t) + 2, s_prev); DMA_V((t) + 1, s_next); } while (0)
#define STEP_WAIT(t) do { if ((t) + 2 < NT) wait_bar<2 * NR>(); else wait_bar<NR>(); } while (0)
    STEP_ISSUE(0);
    wait_bar<3 * NR>();
    REGIONC(0); qkt<KC, USEC>(pA0, pA1, K_lds, cb0, qr, cbt, r32, hi); MODIFY(pA0, pA1, 0, cbA); partialSM<NOMAX>(pA0, pA1, cbA, m_reg, alA);
    STEP_WAIT(0); ROT();
    for (int j = 1; j + 1 < NT; j += 2) {
        STEP_ISSUE(j);
        REGIONC(j); ATT_SBAR(); qkt<KC, USEC>(pB0, pB1, K_lds + s_cur * KBYTES, cb0, qr, cbt, r32, hi);
        REGSC(cbA); finishSM<ONES>(pA0, pA1, alA, l_reg, pa0, pa1, pa2, pa3); ATT_SBAR();
        pv_all<NCB, ONES>(o, lacc, vb0 + s_prev * (int)VBYTES, pa0, pa1, pa2, pa3); MODIFY(pB0, pB1, j, cbB); partialSM<NOMAX>(pB0, pB1, cbB, m_reg, alB);
        RESC(alB); STEP_WAIT(j); ROT();
        STEP_ISSUE(j + 1);
        REGIONC(j + 1); ATT_SBAR(); qkt<KC, USEC>(pA0, pA1, K_lds + s_cur * KBYTES, cb0, qr, cbt, r32, hi);
        REGSC(cbB); finishSM<ONES>(pB0, pB1, alB, l_reg, pa0, pa1, pa2, pa3); ATT_SBAR();
        pv_all<NCB, ONES>(o, lacc, vb0 + s_prev * (int)VBYTES, pa0, pa1, pa2, pa3); MODIFY(pA0, pA1, j + 1, cbA); partialSM<NOMAX>(pA0, pA1, cbA, m_reg, alA);
        RESC(alA); STEP_WAIT(j + 1); ROT();
    }
    REGIONC(NT - 1); ATT_SBAR(); qkt<KC, USEC>(pB0, pB1, K_lds + s_cur * KBYTES, cb0, qr, cbt, r32, hi);
    REGSC(cbA); finishSM<ONES>(pA0, pA1, alA, l_reg, pa0, pa1, pa2, pa3); ATT_SBAR();
    pv_all<NCB, ONES>(o, lacc, vb0 + s_prev * (int)VBYTES, pa0, pa1, pa2, pa3); MODIFY(pB0, pB1, NT - 1, cbB); partialSM<NOMAX>(pB0, pB1, cbB, m_reg, alB);
    RESC(alB);
    wait_bar<0>();
    REGSC(cbB); finishSM<ONES>(pB0, pB1, alB, l_reg, pa0, pa1, pa2, pa3); ATT_SBAR();
    pv_all<NCB, ONES>(o, lacc, vb0 + s_cur * (int)VBYTES, pa0, pa1, pa2, pa3);
    __syncthreads();
#undef ROT
#undef STEP_ISSUE
#undef STEP_WAIT
    } else if constexpr (RING) {
    int s_prev = 2, s_cur = 0, s_next = 1;
#define ROT() do { const int t_ = s_prev; s_prev = s_cur; s_cur = s_next; s_next = t_; } while (0)
    asm volatile("s_waitcnt vmcnt(0)" ::: "memory"); SWRITE(0, 0); if (2 < NT) SLOAD(0, 2); __syncthreads();
    SWAIT(); SWRITE(1, 1); if (3 < NT) SLOAD(1, 3);
    REGIONC(0); qkt<KC, USEC>(pA0, pA1, K_lds, cb0, qr, cbt, r32, hi); MODIFY(pA0, pA1, 0, cbA); partialSM<NOMAX>(pA0, pA1, cbA, m_reg, alA);
    __syncthreads(); ROT();
    for (int j = 1; j + 1 < NT; j += 2) {
        REGIONC(j); ATT_SBAR(); qkt<KC, USEC>(pB0, pB1, K_lds + s_cur * KBYTES, cb0, qr, cbt, r32, hi);
        REGSC(cbA); finishSM<ONES>(pA0, pA1, alA, l_reg, pa0, pa1, pa2, pa3); ATT_SBAR();
        SWAIT(); SWRITE(s_next, 0); if (j + 3 < NT) SLOAD(0, j + 3); ATT_SBAR();
        pv_all<NCB, ONES>(o, lacc, vb0 + s_prev * (int)VBYTES, pa0, pa1, pa2, pa3); MODIFY(pB0, pB1, j, cbB); partialSM<NOMAX>(pB0, pB1, cbB, m_reg, alB);
        RESC(alB); __syncthreads(); ROT();
        REGIONC(j + 1); ATT_SBAR(); qkt<KC, USEC>(pA0, pA1, K_lds + s_cur * KBYTES, cb0, qr, cbt, r32, hi);
        REGSC(cbB); finishSM<ONES>(pB0, pB1, alB, l_reg, pa0, pa1, pa2, pa3); ATT_SBAR();
        SWAIT(); SWRITE(s_next, 1); if (j + 4 < NT) SLOAD(1, j + 4); ATT_SBAR();
        pv_all<NCB, ONES>(o, lacc, vb0 + s_prev * (int)VBYTES, pa0, pa1, pa2, pa3); MODIFY(pA0, pA1, j + 1, cbA); partialSM<NOMAX>(pA0, pA1, cbA, m_reg, alA);
        RESC(alA); __syncthreads(); ROT();
    }
    REGIONC(NT - 1); ATT_SBAR(); qkt<KC, USEC>(pB0, pB1, K_lds + s_cur * KBYTES, cb0, qr, cbt, r32, hi);
    REGSC(cbA); finishSM<ONES>(pA0, pA1, alA, l_reg, pa0, pa1, pa2, pa3); ATT_SBAR();
    pv_all<NCB, ONES>(o, lacc, vb0 + s_prev * (int)VBYTES, pa0, pa1, pa2, pa3); MODIFY(pB0, pB1, NT - 1, cbB); partialSM<NOMAX>(pB0, pB1, cbB, m_reg, alB);
    RESC(alB);
    REGSC(cbB); finishSM<ONES>(pB0, pB1, alB, l_reg, pa0, pa1, pa2, pa3); ATT_SBAR();
    pv_all<NCB, ONES>(o, lacc, vb0 + s_cur * (int)VBYTES, pa0, pa1, pa2, pa3);
    __syncthreads();
#undef ROT
    } else {
    asm volatile("s_waitcnt vmcnt(0)" ::: "memory"); SWRITE(0, 0); __syncthreads();
    REGIONC(0); qkt<KC, USEC>(pA0, pA1, K_lds, cb0, qr, cbt, r32, hi); MODIFY(pA0, pA1, 0, cbA); partialSM<NOMAX>(pA0, pA1, cbA, m_reg, alA);
    if (2 < NT) SLOAD(0, 2);
    SWAIT(); SWRITE(1, 1); __syncthreads();
    for (int j = 1; j + 1 < NT; j += 2) {
        REGIONC(j); ATT_SBAR(); qkt<KC, USEC>(pB0, pB1, K_lds + KBYTES, cb0, qr, cbt, r32, hi);
        REGSC(cbA); finishSM<ONES>(pA0, pA1, alA, l_reg, pa0, pa1, pa2, pa3); ATT_SBAR();
        SLOAD(1, j + 2); ATT_SBAR();
        pv_all<NCB, ONES>(o, lacc, vb0, pa0, pa1, pa2, pa3); MODIFY(pB0, pB1, j, cbB); partialSM<NOMAX>(pB0, pB1, cbB, m_reg, alB);
        __syncthreads(); SWAIT(); SWRITE(0, 0);
        RESC(alB); __syncthreads();
        REGIONC(j + 1); ATT_SBAR(); qkt<KC, USEC>(pA0, pA1, K_lds, cb0, qr, cbt, r32, hi);
        REGSC(cbB); finishSM<ONES>(pB0, pB1, alB, l_reg, pa0, pa1, pa2, pa3); ATT_SBAR();
        if (j + 3 < NT) SLOAD(0, j + 3); ATT_SBAR();
        pv_all<NCB, ONES>(o, lacc, vb0 + VBYTES, pa0, pa1, pa2, pa3); MODIFY(pA0, pA1, j + 1, cbA); partialSM<NOMAX>(pA0, pA1, cbA, m_reg, alA);
        __syncthreads(); SWAIT(); SWRITE(1, 1);
        RESC(alA); __syncthreads();
    }
    REGIONC(NT - 1); ATT_SBAR(); qkt<KC, USEC>(pB0, pB1, K_lds + KBYTES, cb0, qr, cbt, r32, hi);
    REGSC(cbA); finishSM<ONES>(pA0, pA1, alA, l_reg, pa0, pa1, pa2, pa3); ATT_SBAR();
    pv_all<NCB, ONES>(o, lacc, vb0, pa0, pa1, pa2, pa3); MODIFY(pB0, pB1, NT - 1, cbB); partialSM<NOMAX>(pB0, pB1, cbB, m_reg, alB);
    __syncthreads(); RESC(alB);
    REGSC(cbB); finishSM<ONES>(pB0, pB1, alB, l_reg, pa0, pa1, pa2, pa3); ATT_SBAR();
    pv_all<NCB, ONES>(o, lacc, vb0 + VBYTES, pa0, pa1, pa2, pa3);
    }
    float rli[16];
    if constexpr (ONES) {
#pragma unroll
        for (int r = 0; r < 16; ++r) rli[r] = __builtin_amdgcn_rcpf(lacc[r]);
    } else {
        if (hi == 0) li_l[r32] = l_reg; asm volatile("s_waitcnt lgkmcnt(0)" ::: "memory");
#pragma unroll
        for (int r = 0; r < 16; ++r) rli[r] = __builtin_amdgcn_rcpf(li_l[crow(r, hi)]);
    }
    if constexpr (MODE != 1) {
        ATT_LAS bf16_t* stg = (ATT_LAS bf16_t*)(lds + L_OST) + wid * 2048;
#pragma unroll
        for (int r = 0; r < 16; ++r) { const int orow = crow(r, hi);
#pragma unroll
            for (int d0 = 0; d0 < 2; ++d0) stg[orow * 64 + d0 * 32 + r32] = (bf16_t)(cvtpk(o[d0][r] * rli[r], 0.f) & 0xffffu); }
        asm volatile("s_waitcnt lgkmcnt(0)" ::: "memory");
        bf16_t* Ow = ATT + (size_t)(row0 + q0 + wid * 32) * OPITCH + ocol;
#pragma unroll
        for (int i = 0; i < 4; ++i) { const int row = i * 8 + (lane >> 3), ch = lane & 7; const u32x4 v = *(const ATT_LAS u32x4*)(stg + row * 64 + ch * 8); *(u32x4*)(Ow + (size_t)row * OPITCH + ch * 8) = v; }
    } else {
        __syncthreads();
        ATT_LAS float* ex = (ATT_LAS float*)(lds + L_K) + (wid & 3) * 4096;
        if (map == 1) {
#pragma unroll
            for (int d0 = 0; d0 < 4; ++d0)
#pragma unroll
                for (int r = 0; r < 16; ++r) ex[(d0 * 16 + r) * 64 + lane] = o[d0][r] * rli[r];
        }
        __syncthreads();
        if (map == 0) {
            const float sa = wave_sum(ax.lam_p[lane] * ax.lam_p[64 + lane]), sb = wave_sum(ax.lam_p[128 + lane] * ax.lam_p[192 + lane]);
            const float lam = __builtin_amdgcn_exp2f(sa * LOG2E) - __builtin_amdgcn_exp2f(sb * LOG2E) + ax.lam_init;
            float ssq[16];
#pragma unroll
            for (int r = 0; r < 16; ++r) ssq[r] = 0.f;
#pragma unroll
            for (int d0 = 0; d0 < 4; ++d0)
#pragma unroll
                for (int r = 0; r < 16; ++r) { const float d = o[d0][r] * rli[r] - lam * ex[(d0 * 16 + r) * 64 + lane]; o[d0][r] = d; ssq[r] += d * d; }
#pragma unroll
            for (int r = 0; r < 16; ++r) { float s = ssq[r]; s += __shfl_xor(s, 1); s += __shfl_xor(s, 2); s += __shfl_xor(s, 4); s += __shfl_xor(s, 8); s += __shfl_xor(s, 16);
                ssq[r] = __builtin_amdgcn_rsqf(s * (1.0f / 128.0f) + cfg::EPS) * (1.0f - ax.lam_init); }
            float gsub[4];
#pragma unroll
            for (int d0 = 0; d0 < 4; ++d0) gsub[d0] = ax.subln[d0 * 32 + r32];
            ATT_LAS bf16_t* stg = (ATT_LAS bf16_t*)(lds + L_OST) + wid * 4096;
#pragma unroll
            for (int r = 0; r < 16; ++r) { const int orow = crow(r, hi);
#pragma unroll
                for (int d0 = 0; d0 < 4; ++d0) stg[orow * 128 + d0 * 32 + r32] = (bf16_t)(cvtpk(o[d0][r] * ssq[r] * gsub[d0], 0.f) & 0xffffu); }
            asm volatile("s_waitcnt lgkmcnt(0)" ::: "memory");
            bf16_t* Ow = ATT + (size_t)(row0 + q0 + wid * 32) * OPITCH + ocol;
#pragma unroll
            for (int i = 0; i < 8; ++i) { const int row = i * 4 + (lane >> 4), ch = lane & 15; const u32x4 v = *(const ATT_LAS u32x4*)(stg + row * 128 + ch * 8); *(u32x4*)(Ow + (size_t)row * OPITCH + ch * 8) = v; }
        }
    }
    __syncthreads();
#undef DMA_K
#undef DMA_V
#undef SLOAD
#undef SWRITE
#undef SWAIT
#undef RESC
#undef MODIFY
#undef REGIONC
#undef REGSC
}
#undef ATT_SBAR
}
#define GAS __attribute__((address_space(1)))
#define LAS __attribute__((address_space(3)))
typedef unsigned short bf16;
typedef unsigned v4u __attribute__((ext_vector_type(4)));
typedef float f32x4 __attribute__((ext_vector_type(4)));
typedef short bf16x8 __attribute__((ext_vector_type(8)));
typedef GAS unsigned gu32;
typedef GAS unsigned long long gu64;
#define RLX_AGENT __ATOMIC_RELAXED, __HIP_MEMORY_SCOPE_AGENT
#define LDS_WAIT() asm volatile("s_waitcnt lgkmcnt(0)" ::: "memory")
#define VM_WAIT() asm volatile("s_waitcnt vmcnt(0)" ::: "memory")
__device__ __forceinline__ unsigned long long rt() { return __builtin_amdgcn_s_memrealtime(); }
__device__ __forceinline__ unsigned f2bf(float f) { unsigned u = __builtin_bit_cast(unsigned, f); return (u + 0x7fffu + ((u >> 16) & 1u)) >> 16; }
__device__ __forceinline__ unsigned pk2(float lo, float hi) { return f2bf(lo) | (f2bf(hi) << 16); }

#define XB_TMO      128
#define XB_XCNT(j)  (256  + 64 * (j))
#define XB_XSUB(j)  (1280 + 64 * (j))
#define XB_XGEN(j)  (2304 + 64 * (j))
#define XB_TOP      3328
#define XB_TOPGEN   3392
#define XCD_BAR_WORDS 3456
#define XB_SPIN_CAP (1u << 18)

__device__ __forceinline__ unsigned xb_ld(unsigned* p)              { return __hip_atomic_load(p, __ATOMIC_RELAXED, __HIP_MEMORY_SCOPE_AGENT); }
__device__ __forceinline__ unsigned xb_add(unsigned* p, unsigned v) { return __hip_atomic_fetch_add(p, v, __ATOMIC_RELAXED, __HIP_MEMORY_SCOPE_AGENT); }
__device__ __forceinline__ unsigned xb_xcc_id() { return (unsigned)__builtin_amdgcn_s_getreg((3 << 11) | 20) & 0xFu; }
#define XB_SPIN(cond, bar) do { unsigned _sp = 0; while (cond) { __builtin_amdgcn_s_sleep(1); \
    if ((++_sp & 255u) == 0u) { if (xb_ld(&(bar)[XB_TMO])) break; if (_sp > XB_SPIN_CAP) { atomicAdd(&(bar)[XB_TMO], 1u); break; } } } } while (0)

struct XcdBarrier {
    unsigned* bar; unsigned x;
    volatile LAS unsigned* st;
};

__device__ __forceinline__ XcdBarrier xcd_barrier_post(unsigned* bar, volatile LAS unsigned* st) {
    XcdBarrier b; b.bar = bar; b.x = xb_xcc_id(); b.st = st;
    if (threadIdx.x == 0) (void)xb_add(&bar[XB_XCNT(b.x)], 1u);
    return b;
}
__device__ __forceinline__ void xcd_barrier_complete(unsigned* bar, unsigned x, unsigned& nloc, unsigned& nx) {
    const unsigned G = gridDim.x * gridDim.y * gridDim.z;
    unsigned sum, cnt, mine, sp = 0u;
    for (;;) {
        sum = 0u; cnt = 0u; mine = 0u;
#pragma unroll
        for (unsigned j = 0; j < 16; ++j) { const unsigned c = xb_ld(&bar[XB_XCNT(j)]); sum += c; cnt += (c > 0u) ? 1u : 0u; mine = (j == x) ? c : mine; }
        if (sum == G) break;
        __builtin_amdgcn_s_sleep(1);
        if ((++sp & 255u) == 0u) { if (xb_ld(&bar[XB_TMO])) break; if (sp > XB_SPIN_CAP) { atomicAdd(&bar[XB_TMO], 1u); break; } }
    }
    nloc = mine > 0u ? mine : 1u; nx = cnt > 0u ? cnt : 1u;
}

__device__ __forceinline__ void xcd_barrier(const XcdBarrier& b) {
    asm volatile("s_waitcnt vmcnt(0)" ::: "memory");
    __syncthreads();
    if (threadIdx.x == 0) {
        unsigned* bar = b.bar;
        __builtin_amdgcn_s_waitcnt(0);
        unsigned nloc = b.st[0], nx = b.st[1];
        if (nloc == 0u) { xcd_barrier_complete(bar, b.x, nloc, nx); b.st[0] = nloc; b.st[1] = nx; }
        const unsigned old = xb_add(&bar[XB_XSUB(b.x)], 1u);
        const unsigned gen = old / nloc;
        if (old + 1u == (gen + 1u) * nloc) {
            __builtin_amdgcn_fence(__ATOMIC_RELEASE, "agent");
            asm volatile("s_waitcnt vmcnt(0)" ::: "memory");
            const unsigned og = xb_add(&bar[XB_TOP], 1u);
            const unsigned tg = og / nx;
            if (og + 1u == (tg + 1u) * nx) xb_add(&bar[XB_TOPGEN], 1u);
            else XB_SPIN(xb_ld(&bar[XB_TOPGEN]) == tg, bar);
            __builtin_amdgcn_fence(__ATOMIC_ACQUIRE, "agent");
            xb_add(&bar[XB_XGEN(b.x)], 1u);
            asm volatile("s_waitcnt vmcnt(0)" ::: "memory");
        } else {
            XB_SPIN(xb_ld(&bar[XB_XGEN(b.x)]) == gen, bar);
            __builtin_amdgcn_fence(__ATOMIC_ACQUIRE, "agent");
            asm volatile("s_waitcnt vmcnt(0)" ::: "memory");
        }
    }
    __syncthreads();
}

__device__ __forceinline__ void xcd_local_barrier(const XcdBarrier& b) {
    asm volatile("s_waitcnt vmcnt(0)" ::: "memory");
    __syncthreads();
    if (threadIdx.x == 0) {
        unsigned* bar = b.bar;
        __builtin_amdgcn_s_waitcnt(0);
        unsigned nloc = b.st[0]; nloc = nloc ? nloc : 1u;
        const unsigned old = xb_add(&bar[XB_XSUB(b.x)], 1u);
        const unsigned gen = old / nloc;
        if (old + 1u == (gen + 1u) * nloc) xb_add(&bar[XB_XGEN(b.x)], 1u);
        else XB_SPIN(xb_ld(&bar[XB_XGEN(b.x)]) == gen, bar);
        __builtin_amdgcn_fence(__ATOMIC_ACQUIRE, "agent");
        asm volatile("s_waitcnt vmcnt(0)" ::: "memory");
    }
    __syncthreads();
}

constexpr int NWAVES = 8;
constexpr size_t MiB = 1u << 20;
constexpr size_t WS_CTL = 0, CTL_ZERO_BYTES = 1 * MiB;
constexpr size_t WS_WGU = 2 * MiB, WS_WD = 46 * MiB, WS_WIN = 68 * MiB, WS_WOUT = 89 * MiB;
constexpr size_t WS_R = 98 * MiB;
constexpr size_t WS_ATT = 290 * MiB;
constexpr size_t WS_BIG = 482 * MiB;
constexpr size_t WS_RSS = 1010 * MiB, RSS_BYTES = 3 * MiB;
constexpr size_t WS_END = 1013 * MiB;
static_assert(WS_WGU + (size_t)cfg::NGU * cfg::DM * 2 <= WS_WD && WS_WD + (size_t)cfg::DM * cfg::DFF * 2 <= WS_WIN && WS_WIN + (size_t)cfg::NIN * cfg::DM * 2 <= WS_WOUT &&
              WS_WOUT + (size_t)cfg::DM * cfg::DM * 2 <= WS_R && WS_R + (size_t)cfg::M * cfg::DM * 2 <= WS_ATT && WS_ATT + (size_t)cfg::M * cfg::DM * 2 <= WS_BIG && WS_BIG + (size_t)cfg::M * cfg::DFF * 2 <= WS_END, "d_ws map");
#ifndef WGM_DN
#define WGM_DN 4
#endif
#ifndef GEMM_SP2
#define GEMM_SP2 true
#endif
#ifndef GEMM_ALIGN
#define GEMM_ALIGN true
#endif
#ifndef WGM_GU
#define WGM_GU 8
#endif
constexpr int CW_BAR = 4096;
constexpr int CW_NRM = 8192;
constexpr int RING_OFF = 0, RING_BYTES = 131072, LDSCTL_OFF = RING_BYTES, MISC_OFF = LDSCTL_OFF + 320, LDS_BYTES = 147456;
static_assert(att::L_END <= RING_BYTES && MISC_OFF + 128 <= LDS_BYTES, "LDS map");

struct Frame {
    LAS unsigned char* lds; volatile LAS unsigned* MISC; int wave, vcu, G;
};
__device__ __forceinline__ float wave_sum_f(float v) {
#pragma unroll
    for (int o = 1; o < 64; o <<= 1) v += __shfl_xor(v, o);
    return v;
}
__device__ __forceinline__ void transpose_item(const float* W, int K, int N, bf16* WT, int k0, int n0, int rowbase, const float* gain, LAS float* scr, int lane) {
#pragma unroll 8
    for (int i = 0; i < 32; ++i) { const int kk = 2 * i + (lane >> 5); scr[kk * 33 + (lane & 31)] = W[(size_t)(k0 + kk) * N + n0 + (lane & 31)]; }
    LDS_WAIT(); asm volatile("" ::: "memory");
    const int c = lane & 7;
    f32x4 g0 = {1.f, 1.f, 1.f, 1.f}, g1 = g0;
    if (gain) { g0 = *(const f32x4*)(gain + k0 + 8 * c); g1 = *(const f32x4*)(gain + k0 + 8 * c + 4); }
#pragma unroll
    for (int j = 0; j < 4; ++j) { const int n = (lane >> 3) + 8 * j; const LAS float* s = scr + (8 * c) * 33 + n;
        v4u o; o.x = pk2(s[0 * 33] * g0[0], s[1 * 33] * g0[1]); o.y = pk2(s[2 * 33] * g0[2], s[3 * 33] * g0[3]); o.z = pk2(s[4 * 33] * g1[0], s[5 * 33] * g1[1]); o.w = pk2(s[6 * 33] * g1[2], s[7 * 33] * g1[3]);
        *(GAS v4u*)(WT + (size_t)(rowbase + n) * K + k0 + 8 * c) = o; }
    LDS_WAIT(); asm volatile("" ::: "memory");
}
__device__ __forceinline__ void conv_ffn(const Frame& F, const float* wg, const float* wu, const float* wd, const float* gain, unsigned char* ws) {
    using namespace cfg;
    { const GAS float *a = (const GAS float*)wg, *b = (const GAS float*)wu, *c = (const GAS float*)wd, *d = (const GAS float*)gain; asm volatile("" : "+s"(a), "+s"(b), "+s"(c), "+s"(d));
      wg = (const float*)a; wu = (const float*)b; wd = (const float*)c; gain = (const float*)d; }
    int lane = threadIdx.x; asm volatile("" : "+v"(lane)); lane &= 63;
    LAS float* scr = (LAS float*)(F.lds + RING_OFF + F.wave * 16384);
    const int gw = F.vcu * NWAVES + F.wave, NGW = F.G * NWAVES;
    constexpr int I_G = (DM / 64) * (DFF / 32), I_D = (DFF / 64) * (DM / 32);
    static_assert(I_G == I_D, "");
    for (int it = gw; it < 3 * I_G; it += NGW) {
        const int which = it / I_G, r = it - which * I_G;
        if (which < 2) { const int nblk = DFF / 32, kb = r / nblk, nb = r % nblk, n0 = 32 * nb;
            transpose_item(which ? wu : wg, DM, DFF, (bf16*)(ws + WS_WGU), 64 * kb, n0, 256 * (n0 >> 7) + 128 * which + (n0 & 127), gain, scr, lane); }
        else { const int nblk = DM / 32, kb = r / nblk, nb = r % nblk, n0 = 32 * nb;
            transpose_item(wd, DFF, DM, (bf16*)(ws + WS_WD), 64 * kb, n0, n0, nullptr, scr, lane); }
    }
}
__device__ __forceinline__ void conv_mix(const Frame& F, const float* win, const float* wout, const float* gain, unsigned char* ws) {
    using namespace cfg;
    { const GAS float *a = (const GAS float*)win, *b = (const GAS float*)wout, *d = (const GAS float*)gain; asm volatile("" : "+s"(a), "+s"(b), "+s"(d)); win = (const float*)a; wout = (const float*)b; gain = (const float*)d; }
    int lane = threadIdx.x; asm volatile("" : "+v"(lane)); lane &= 63;
    LAS float* scr = (LAS float*)(F.lds + RING_OFF + F.wave * 16384);
    const int gw = F.vcu * NWAVES + F.wave, NGW = F.G * NWAVES;
    constexpr int I_IN = (DM / 64) * (NIN / 32), I_O = (DM / 64) * (DM / 32);
    for (int it = gw; it < I_IN + I_O; it += NGW) {
        if (it < I_IN) { const int nblk = NIN / 32, kb = it / nblk, nb = it % nblk, n0 = 32 * nb;
            transpose_item(win, DM, NIN, (bf16*)(ws + WS_WIN), 64 * kb, n0, 256 * (n0 >> 8) + 128 * ((n0 & 63) >> 5) + 32 * ((n0 & 255) >> 6), gain, scr, lane); }
        else { const int r = it - I_IN, nblk = DM / 32, kb = r / nblk, nb = r % nblk, n0 = 32 * nb;
            transpose_item(wout, DM, DM, (bf16*)(ws + WS_WOUT), 64 * kb, n0, n0, nullptr, scr, lane); }
    }
}
template <bool FINAL>
__device__ __forceinline__ void row_phase(const Frame& F, const float* xp, const float* xs, float* out, const float* gain, bf16* R, unsigned long long* rss) {
    using namespace cfg;
    int lane = threadIdx.x; asm volatile("" : "+v"(lane)); lane &= 63;
    const int gw = F.vcu * NWAVES + F.wave, NGW = F.G * NWAVES;
    if constexpr (FINAL) {
        { const GAS float* a = (const GAS float*)gain; asm volatile("" : "+s"(a)); gain = (const float*)a; }
        f32x4 g[4][2];
#pragma unroll
        for (int k = 0; k < 4; ++k) { g[k][0] = ((const f32x4*)gain)[2 * (lane + 64 * k)]; g[k][1] = ((const f32x4*)gain)[2 * (lane + 64 * k) + 1]; }
        for (int m = gw; m < M; m += NGW) {
            const GAS v4u* xr = (const GAS v4u*)(R + (size_t)m * DM) + lane;
            v4u w[4]; f32x4 v[4][2]; float s = 0.f;
#pragma unroll
            for (int k = 0; k < 4; ++k) w[k] = xr[64 * k];
#pragma unroll
            for (int k = 0; k < 4; ++k) { v[k][0] = (f32x4){__uint_as_float(w[k].x << 16), __uint_as_float(w[k].x & 0xffff0000u), __uint_as_float(w[k].y << 16), __uint_as_float(w[k].y & 0xffff0000u)};
                v[k][1] = (f32x4){__uint_as_float(w[k].z << 16), __uint_as_float(w[k].z & 0xffff0000u), __uint_as_float(w[k].w << 16), __uint_as_float(w[k].w & 0xffff0000u)};
#pragma unroll
                for (int e = 0; e < 2; ++e) s += (v[k][e].x * v[k][e].x + v[k][e].y * v[k][e].y) + (v[k][e].z * v[k][e].z + v[k][e].w * v[k][e].w); }
            const float rinv = 1.0f / sqrtf(wave_sum_f(s) * (1.0f / DM) + EPS);
            GAS f32x4* o = (GAS f32x4*)(out + (size_t)m * DM);
#pragma unroll
            for (int k = 0; k < 4; ++k) { o[2 * (lane + 64 * k)] = v[k][0] * rinv * g[k][0]; o[2 * (lane + 64 * k) + 1] = v[k][1] * rinv * g[k][1]; }
        }
    } else {
        for (int m = gw; m < M; m += NGW) {
            const float* xrow = m < MP ? xp + (size_t)m * DM : xs + (size_t)(m - MP) * DM;
            const GAS f32x4* xr = (const GAS f32x4*)xrow + lane;
            f32x4 v[8]; float s = 0.f;
#pragma unroll
            for (int j = 0; j < 8; ++j) { v[j] = xr[64 * j]; s += (v[j].x * v[j].x + v[j].y * v[j].y) + (v[j].z * v[j].z + v[j].w * v[j].w); }
            const float ssum = wave_sum_f(s);
            GAS unsigned long long* o8 = (GAS unsigned long long*)(R + (size_t)m * DM) + lane;
#pragma unroll
            for (int j = 0; j < 8; ++j) o8[64 * j] = (unsigned long long)pk2(v[j].x, v[j].y) | ((unsigned long long)pk2(v[j].z, v[j].w) << 32);
            if (lane == 0) ((GAS unsigned long long*)rss)[m] = (unsigned long long)(ssum * 4294967296.0f);
        }
    }
}

struct Args { const float* in[20]; float* out; unsigned char* ws; int ph_lo, ph_hi, pad0, pad1; };
__global__ void __launch_bounds__(NWAVES * 64, 2) mk_fwd(Args args) {
    using namespace cfg;
    extern __shared__ __attribute__((aligned(16))) unsigned char lds[];
    Frame F;
    F.lds = (LAS unsigned char*)lds; F.MISC = (volatile LAS unsigned*)(F.lds + MISC_OFF);
    F.wave = __builtin_amdgcn_readfirstlane((int)threadIdx.x >> 6);
    F.G = gridDim.x; { const int bx = blockIdx.x; F.vcu = (F.G % 8 == 0) ? (bx % 8) * (F.G / 8) + bx / 8 : bx; }
    unsigned char* ws = args.ws; gu32* ctl = (gu32*)(ws + WS_CTL);
    const float* const p_xp = args.in[0]; const float* const p_xs = args.in[1]; const float* const p_f1n = args.in[2]; const float* const p_f1g = args.in[3]; const float* const p_f1u = args.in[4];
    const float* const p_f1d = args.in[5]; const float* const p_mixn = args.in[6]; const float* const p_win = args.in[7]; const float* const p_aqn = args.in[8]; const float* const p_akn = args.in[9];
    const float* const p_blam = args.in[10]; const float* const p_bsub = args.in[11]; const float* const p_crpb = args.in[12]; const float* const p_wout = args.in[13]; const float* const p_f2n = args.in[14];
    const float* const p_f2g = args.in[15]; const float* const p_f2u = args.in[16]; const float* const p_f2d = args.in[17]; const float* const p_t5 = args.in[18]; const float* const p_fin = args.in[19];
    float* out = args.out;
    bf16* RS = (bf16*)(ws + WS_R); bf16* ATB = (bf16*)(ws + WS_ATT); bf16* BIG = (bf16*)(ws + WS_BIG);
    for (int u = threadIdx.x; u < (LDS_BYTES - LDSCTL_OFF) / 4; u += NWAVES * 64) ((LAS unsigned*)(F.lds + LDSCTL_OFF))[u] = 0u;
    __syncthreads();
    XcdBarrier bar; bar.bar = (unsigned*)(ctl + CW_BAR); bar.x = 0; bar.st = nullptr;
    if (!MK_PER_PHASE) bar = xcd_barrier_post((unsigned*)(ctl + CW_BAR), F.MISC + 8);
    const int lo = args.ph_lo, hi = args.ph_hi;
    int ph = 0;
#define IN(k) (lo <= (k) && (k) < hi)
#define FRESH() GAS float* out_g = (GAS float*)out; GAS unsigned char* ws_g = (GAS unsigned char*)ws; GAS bf16* R_g = (GAS bf16*)RS; GAS bf16* BIG_g = (GAS bf16*)BIG; GAS bf16* AT_g = (GAS bf16*)ATB; const GAS float* xp_g = (const GAS float*)p_xp; const GAS float* xs_g = (const GAS float*)p_xs; \
    asm volatile("" : "+s"(out_g), "+s"(ws_g), "+s"(R_g), "+s"(BIG_g), "+s"(AT_g), "+s"(xp_g), "+s"(xs_g)); \
    float* out_ = (float*)out_g; unsigned char* ws_ = (unsigned char*)ws_g; bf16* R_ = (bf16*)R_g; bf16* BIG_ = (bf16*)BIG_g; bf16* ATB_ = (bf16*)AT_g; const float* xp_ = (const float*)xp_g; const float* xs_ = (const float*)xs_g; (void)ATB_; (void)BIG_; (void)R_; (void)xp_; (void)xs_; (void)out_
#define SEAM() do { if (IN(ph) && IN(ph + 1)) { if (MK_PER_PHASE) { if (threadIdx.x == 0) __hip_atomic_store(ctl, 0xBADBA0u, RLX_AGENT); } else xcd_barrier(bar); } ++ph; } while (0)

    for (int L = 0; L < 2; ++L) {
        unsigned long long* const rssA = (unsigned long long*)(ws + WS_RSS) + (size_t)(L == 0 ? 0 : 3) * M;
        unsigned long long* const rssB = (unsigned long long*)(ws + WS_RSS) + (size_t)(L == 0 ? 1 : 4) * M;
        unsigned long long* const rssC = (unsigned long long*)(ws + WS_RSS) + (size_t)(L == 0 ? 2 : 5) * M;
        if (IN(ph)) { FRESH();
            conv_ffn(F, p_f1g + (size_t)L * DM * DFF, p_f1u + (size_t)L * DM * DFF, p_f1d + (size_t)L * DM * DFF, p_f1n + L * DM, ws_);
            conv_mix(F, p_win + (size_t)L * DM * NIN, p_wout + (size_t)L * DM * DM, p_mixn + L * DM, ws_);
            if (L == 0) row_phase<false>(F, xp_, xs_, out_, nullptr, R_, rssA);
        }
        SEAM();
        if (IN(ph)) { FRESH();
            pg8::Gemm g{R_, (const bf16*)(ws_ + WS_WGU), M, NGU, DM}; pg8::StaticOrder S; S.init(M, NGU, F.G, (int)blockIdx.x, WGM_GU);
            pg8::EpiSwiglu E{BIG_, rssA};
#ifndef NO_GU
            pg8::gemm_phase<pg8::EpiSwiglu, pg8::StaticOrder, GEMM_ALIGN, GEMM_SP2>(F.lds + RING_OFF, g, S, E);
#endif
        }
        SEAM();
        if (IN(ph)) { FRESH();
            pg8::Gemm g{BIG_, (const bf16*)(ws_ + WS_WD), M, DM, DFF}; pg8::StaticOrder S; S.init(M, DM, F.G, (int)blockIdx.x, WGM_DN);
            pg8::EpiResid E{R_, 0.5f, rssB};
#ifndef NO_RES
            pg8::gemm_phase<pg8::EpiResid, pg8::StaticOrder, GEMM_ALIGN, GEMM_SP2>(F.lds + RING_OFF, g, S, E);
#endif
        }
        SEAM();
        if (IN(ph)) { FRESH();
            conv_ffn(F, p_f2g + (size_t)L * DM * DFF, p_f2u + (size_t)L * DM * DFF, p_f2d + (size_t)L * DM * DFF, p_f2n + L * DM, ws_);
            __syncthreads();
            pg8::Gemm g{R_, (const bf16*)(ws_ + WS_WIN), M, NIN, DM}; pg8::StaticOrder S; S.init(M, NIN, F.G, (int)blockIdx.x, WGM_GU);
            pg8::EpiWin E{BIG_, p_aqn + L * 64, p_akn + L * 64, rssB, (unsigned*)(ctl + CW_NRM + L * 336)};
#ifndef NO_WIN
            pg8::gemm_phase<pg8::EpiWin, pg8::StaticOrder, GEMM_ALIGN, GEMM_SP2>(F.lds + RING_OFF, g, S, E);
#endif
        }
        SEAM();
        if (IN(ph)) { FRESH(); bf16* const QKV_ = BIG_; bf16* const ATT_ = ATB_;
                att::Aux ax{p_t5, p_crpb + (size_t)L * 8 * 15 * 31, p_blam + L * 256, p_bsub + L * 128, (L == 0 ? 0.2f : 0.35550906759f)};
                const att::lptr al = (att::lptr)(F.lds + RING_OFF);
#ifdef ATT_PRIO
                if (F.wave >= 4) __builtin_amdgcn_s_setprio(1);
#endif
#ifndef PROBE_ATT_REP
#define PROBE_ATT_REP 1
#endif
                for (int rep_ = 0; rep_ < PROBE_ATT_REP; ++rep_) {
#ifndef REP_B
#define REP_B 1
#endif
#ifndef REP_A
#define REP_A 1
#endif
#ifndef REP_D
#define REP_D 1
#endif
#ifndef REP_C
#define REP_C 1
#endif
                float t5max = 0.f, rpbmax = 0.f;
                { int ln = threadIdx.x; asm volatile("" : "+v"(ln)); ln &= 63;
#pragma unroll
                  for (int k_ = 0; k_ < 6; ++k_) t5max = fmaxf(t5max, fabsf(p_t5[ln + 64 * k_]));
                  for (int k_ = 0; k_ < 59; ++k_) { const int ix = ln + 64 * k_; if (ix < 8 * 15 * 31) rpbmax = fmaxf(rpbmax, fabsf(ax.rpb[ix])); }
#pragma unroll
                  for (int o_ = 1; o_ < 64; o_ <<= 1) { t5max = fmaxf(t5max, __shfl_xor(t5max, o_)); rpbmax = fmaxf(rpbmax, __shfl_xor(rpbmax, o_)); } }
                t5max = __uint_as_float(__builtin_amdgcn_readfirstlane(__float_as_uint(t5max))); rpbmax = __uint_as_float(__builtin_amdgcn_readfirstlane(__float_as_uint(rpbmax)));
                const GAS unsigned* nrm2 = (const GAS unsigned*)(ctl + CW_NRM + L * 336);
#define SEQ_OF(r0_) ((r0_) < MP ? ((r0_) >> 14) : 2 + (((r0_) - MP) >> 13))
#define NRM(blk_, sq_) __uint_as_float(nrm2[(blk_) * 4 + (sq_)])
                for (int rb_ = 0; rb_ < REP_B; ++rb_)
                for (int u = F.vcu; u < 1536; u += F.G) {
#ifndef NO_ATT1
                    int r0, T, h, qb;
                    if (u < 1024) { r0 = (u >> 9) * TP; T = TP; h = (u >> 7) & 3; qb = u & 127; } else { const int v = u - 1024; r0 = MP + (v >> 8) * TS; T = TS; h = (v >> 6) & 3; qb = v & 63; }
                    const int sq = SEQ_OF(r0);
                    const float bnd = sqrtf(fmaxf(NRM(12 + 2 * h, sq), NRM(13 + 2 * h, sq)) * fmaxf(NRM(20 + 2 * h, sq), NRM(21 + 2 * h, sq))) * 1.01f + t5max * LOG2E;
                    if (__builtin_amdgcn_readfirstlane((int)(bnd <= 80.0f))) att::attn_unit<1, true>(QKV_, ATT_, al, r0, T, h, qb, ax); else att::attn_unit<1, false>(QKV_, ATT_, al, r0, T, h, qb, ax);
#endif
                }
                bool a_nomax;
                { int ln_ = threadIdx.x; asm volatile("" : "+v"(ln_)); ln_ &= 63; float gq = fabsf(p_aqn[L * 64 + ln_]), gk = fabsf(p_akn[L * 64 + ln_]);
#pragma unroll
                  for (int o_ = 1; o_ < 64; o_ <<= 1) { gq = fmaxf(gq, __shfl_xor(gq, o_)); gk = fmaxf(gk, __shfl_xor(gk, o_)); }
                  const float bound = 8.0f * LOG2E * gq * gk * 1.01f; a_nomax = __builtin_amdgcn_readfirstlane((int)(bound <= 80.0f)) != 0; }
                for (int ra_ = 0; ra_ < REP_A; ++ra_)
                for (int u = F.vcu; u < 1536; u += F.G) {
#ifndef NO_ATT0
                    int r0, T, h, qb;
                    if (u < 1024) { r0 = (u >> 9) * TP; T = TP; h = (u >> 6) & 7; qb = u & 63; } else { const int v = u - 1024; r0 = MP + (v >> 8) * TS; T = TS; h = (v >> 5) & 7; qb = v & 31; }
                    if (a_nomax) att::attn_unit<0, true>(QKV_, ATT_, al, r0, T, h, qb, ax); else att::attn_unit<0, false>(QKV_, ATT_, al, r0, T, h, qb, ax);
#endif
                }
                for (int rd_ = 0; rd_ < REP_D; ++rd_)
                for (int u = F.vcu; u < 1536; u += F.G) {
                    const int h = u / 192, qg = u % 192; int r0, T, qb;
                    if (qg < 128) { r0 = (qg >> 6) * TP; T = TP; qb = qg & 63; } else { r0 = MP + ((qg - 128) >> 5) * TS; T = TS; qb = (qg - 128) & 31; }
#ifndef NO_ATT3
                    { const int sq = SEQ_OF(r0); const float bnd = sqrtf(NRM(60 + h, sq) * NRM(68 + h, sq)) * 1.01f + t5max * LOG2E + 1.6f;
                      if (__builtin_amdgcn_readfirstlane((int)(bnd <= 80.0f))) att::attn_unit<3, true>(QKV_, ATT_, al, r0, T, h, qb, ax); else att::attn_unit<3, false>(QKV_, ATT_, al, r0, T, h, qb, ax); }
#endif
                }
                for (int rc_ = 0; rc_ < REP_C; ++rc_)
                for (int u = F.vcu; u < 1536; u += F.G) {
                    const int h = u / 192, qg = u % 192; int r0, T, qb;
                    if (qg < 128) { r0 = (qg >> 6) * TP; T = TP; qb = qg & 63; } else { r0 = MP + ((qg - 128) >> 5) * TS; T = TS; qb = (qg - 128) & 31; }
#ifndef NO_ATT2
                    { const int sq = SEQ_OF(r0); const float bnd = sqrtf(NRM(36 + h, sq) * NRM(44 + h, sq)) * 1.01f + rpbmax * LOG2E;
                      if (__builtin_amdgcn_readfirstlane((int)(bnd <= 80.0f))) att::attn_unit<2, true>(QKV_, ATT_, al, r0, T, h, qb, ax); else att::attn_unit<2, false>(QKV_, ATT_, al, r0, T, h, qb, ax); }
#endif
                }
                }
                    }
        SEAM();
        if (IN(ph)) { FRESH();
            pg8::Gemm g{ATB_, (const bf16*)(ws_ + WS_WOUT), M, DM, DM}; pg8::StaticOrder S; S.init(M, DM, F.G, (int)blockIdx.x, WGM_DN);
            pg8::EpiResid E{R_, 1.0f, rssC};
#ifndef NO_RES
            pg8::gemm_phase<pg8::EpiResid, pg8::StaticOrder, GEMM_ALIGN, GEMM_SP2>(F.lds + RING_OFF, g, S, E);
#endif
        }
        SEAM();
        if (IN(ph)) { FRESH();
            pg8::Gemm g{R_, (const bf16*)(ws_ + WS_WGU), M, NGU, DM}; pg8::StaticOrder S; S.init(M, NGU, F.G, (int)blockIdx.x, WGM_GU);
            pg8::EpiSwiglu E{BIG_, rssC};
#ifndef NO_GU
            pg8::gemm_phase<pg8::EpiSwiglu, pg8::StaticOrder, GEMM_ALIGN, GEMM_SP2>(F.lds + RING_OFF, g, S, E);
#endif
        }
        SEAM();
        if (IN(ph)) { FRESH();
            pg8::Gemm g{BIG_, (const bf16*)(ws_ + WS_WD), M, DM, DFF}; pg8::StaticOrder S; S.init(M, DM, F.G, (int)blockIdx.x, WGM_DN);
            pg8::EpiResid E{R_, 0.5f, L == 0 ? (unsigned long long*)(ws + WS_RSS) + (size_t)3 * M : (unsigned long long*)nullptr};
#ifndef NO_RES
            pg8::gemm_phase<pg8::EpiResid, pg8::StaticOrder, GEMM_ALIGN, GEMM_SP2>(F.lds + RING_OFF, g, S, E);
#endif
        }
        SEAM();
    }
    if (IN(ph)) { FRESH(); row_phase<true>(F, xp_, xs_, out_, p_fin, R_, nullptr); }
#undef IN
#undef SEAM
}
constexpr int N_PHASES = 17;

extern "C" void kernel_launch(void* const* d_in, const int* in_sizes, int n_in, void* d_out, int out_size, void* d_ws, size_t ws_size, hipStream_t stream) {
    static int grid = 0;
    if (grid == 0) {
        if (n_in != 20 || in_sizes[0] != cfg::MP * cfg::DM || in_sizes[1] != cfg::MS * cfg::DM || out_size != cfg::M * cfg::DM || ws_size < WS_END) {
            fprintf(stderr, "kernel_launch: shape mismatch (n_in %d, in0 %d, in1 %d, out %d, ws %zu need %zu); nothing launched\n", n_in, n_in > 0 ? in_sizes[0] : -1, n_in > 1 ? in_sizes[1] : -1, out_size, ws_size, (size_t)WS_END); grid = -1; return; }
        int dev = 0, cus = 0, per_cu = 0;
        if (hipGetDevice(&dev) != hipSuccess || hipDeviceGetAttribute(&cus, hipDeviceAttributeMultiprocessorCount, dev) != hipSuccess) { fprintf(stderr, "kernel_launch: device query failed\n"); grid = -1; return; }
        if (hipFuncSetAttribute((const void*)mk_fwd, hipFuncAttributeMaxDynamicSharedMemorySize, LDS_BYTES) != hipSuccess) { fprintf(stderr, "kernel_launch: hipFuncSetAttribute failed\n"); grid = -1; return; }
        if (hipOccupancyMaxActiveBlocksPerMultiprocessor(&per_cu, (const void*)mk_fwd, NWAVES * 64, LDS_BYTES) != hipSuccess || per_cu < 1) {
            fprintf(stderr, "kernel_launch: occupancy query reports %d workgroups per CU; nothing launched\n", per_cu); (void)hipGetLastError(); grid = -1; return; }
        (void)hipGetLastError();
        grid = cus;
    }
    if (grid < 0) return;
    if (hipMemsetAsync((char*)d_ws + WS_CTL, 0, CTL_ZERO_BYTES, stream) != hipSuccess || hipMemsetAsync((char*)d_ws + WS_RSS, 0, RSS_BYTES, stream) != hipSuccess) { fprintf(stderr, "kernel_launch: memset failed\n"); return; }
    Args a{};
    for (int i = 0; i < 20; ++i) a.in[i] = (const float*)d_in[i];
    a.out = (float*)d_out; a.ws = (unsigned char*)d_ws;
#if MK_PER_PHASE
    for (int p = 0; p < N_PHASES; ++p) { a.ph_lo = p; a.ph_hi = p + 1; hipLaunchKernelGGL(mk_fwd, dim3(grid), dim3(NWAVES * 64), LDS_BYTES, stream, a); }
#else
    a.ph_lo = 0; a.ph_hi = N_PHASES;
    hipLaunchKernelGGL(mk_fwd, dim3(grid), dim3(NWAVES * 64), LDS_BYTES, stream, a);
#endif
    const hipError_t le = hipPeekAtLastError();
    if (le != hipSuccess) fprintf(stderr, "kernel_launch: launch failed: %s\n", hipGetErrorName(le));
}
```
